# Optimizing an MI355X kernel written in HIP

```python
import jax, jax.numpy as jnp
from jax import lax
import numpy as np

D_MODEL = 1024
BATCH = 8
SEQ = 2048
DEPTH = 2

MIX_W = D_MODEL
N_BRANCH = 3
CONV_WIDTH = 4
DN_HEADS = 8
DN_HEAD_DIM = MIX_W // DN_HEADS
DN_CHUNK = 64
SB_HEADS = 16
SB_HEAD_DIM = MIX_W // SB_HEADS
SB_BLOCK = 128
SSM_HEADS = 16
SSM_HEAD_DIM = MIX_W // SSM_HEADS
SSM_STATE = 128
SSM_GROUPS = 4
SSM_CHUNK = 64
D_FF = 4 * D_MODEL
EPS = 1e-6

DN_QKV = 3 * MIX_W
SSM_CONV_DIM = MIX_W + 2 * SSM_GROUPS * SSM_STATE
IN_SIZES = (DN_QKV, MIX_W, DN_HEADS, DN_HEADS, 3 * MIX_W, MIX_W, SSM_CONV_DIM, SSM_HEADS, N_BRANCH * D_MODEL)
IN_DIM = sum(IN_SIZES)

kernel_name = "hybrid_gdn_stickbreak_mamba2_block"


def rms_norm(x, w):
    xf = x.astype(jnp.float32)
    xf = xf * lax.rsqrt(jnp.mean(xf * xf, axis=-1, keepdims=True) + EPS)
    return (xf * w.astype(jnp.float32)).astype(x.dtype)


def group_rms_norm(x, w, groups):
    shp = x.shape
    xf = x.astype(jnp.float32).reshape(*shp[:-1], groups, shp[-1] // groups)
    xf = xf * lax.rsqrt(jnp.mean(xf * xf, axis=-1, keepdims=True) + EPS)
    return (xf.reshape(shp) * w.astype(jnp.float32)).astype(x.dtype)


def l2_normalize(x):
    return x * lax.rsqrt(jnp.sum(x * x, axis=-1, keepdims=True) + EPS)


def split_columns(t, sizes):
    out, start = [], 0
    for s in sizes:
        out.append(t[..., start:start + s])
        start += s
    return out


def causal_dwconv(x, w, b=None):
    k_width, seq = w.shape[0], x.shape[1]
    xp = jnp.pad(x, ((0, 0), (k_width - 1, 0), (0, 0)))
    y = xp[:, 0:seq] * w[0]
    for k in range(1, k_width):
        y = y + xp[:, k:k + seq] * w[k]
    return y if b is None else y + b


def gated_delta_rule(q, k, v, g, beta):
    dtype = v.dtype
    q, k, v, g, beta = (t.astype(jnp.float32) for t in (q, k, v, g, beta))
    bsz, seq, h, dk = q.shape
    dv = v.shape[-1]
    c = DN_CHUNK
    n = seq // c

    def to_chunks(t):
        t = t.reshape(bsz, n, c, *t.shape[2:])
        return jnp.swapaxes(t, 2, 3)

    q = to_chunks(q) * dk ** -0.5
    k, v = to_chunks(k), to_chunks(v)
    g, beta = to_chunks(g), to_chunks(beta)
    gc = jnp.cumsum(g, axis=-1)
    causal = jnp.tril(jnp.ones((c, c), dtype=bool))
    strict = jnp.tril(jnp.ones((c, c), dtype=bool), -1)
    decay = jnp.exp(jnp.where(causal, gc[..., :, None] - gc[..., None, :], -jnp.inf))

    kb = k * beta[..., None]
    vb = v * beta[..., None]
    lower = jnp.where(strict, jnp.einsum('bnhid,bnhjd->bnhij', kb, k) * decay, 0.0)
    tmat = lower + jnp.eye(c, dtype=jnp.float32)
    rhs = jnp.concatenate([vb, kb * jnp.exp(gc)[..., None]], axis=-1)
    sol = lax.linalg.triangular_solve(tmat, rhs, left_side=True, lower=True, unit_diagonal=True)
    u, w = sol[..., :dv], sol[..., dv:]

    attn = jnp.einsum('bnhid,bnhjd->bnhij', q, k) * decay
    qg = q * jnp.exp(gc)[..., None]
    kd = k * jnp.exp(gc[..., -1:] - gc)[..., None]
    glast = jnp.exp(gc[..., -1])

    def step(state, xs):
        u_c, w_c, attn_c, qg_c, kd_c, gl_c = xs
        v_new = u_c - jnp.einsum('bhcd,bhde->bhce', w_c, state)
        o_c = jnp.einsum('bhcd,bhde->bhce', qg_c, state) + jnp.einsum('bhij,bhje->bhie', attn_c, v_new)
        state = state * gl_c[..., None, None] + jnp.einsum('bhcd,bhce->bhde', kd_c, v_new)
        return state, o_c

    xs = tuple(jnp.moveaxis(t, 1, 0) for t in (u, w, attn, qg, kd, glast))
    s0 = jnp.zeros((bsz, h, dk, dv), jnp.float32)
    _, o = lax.scan(step, s0, xs)
    o = jnp.transpose(o, (1, 0, 3, 2, 4)).reshape(bsz, seq, h, dv)
    return o.astype(dtype)


def gated_deltanet_branch(qkv, gate, a, b, conv_w, a_log, dt_bias, norm_w):
    bsz, seq, _ = qkv.shape
    qkv = jax.nn.silu(causal_dwconv(qkv, conv_w))
    q, k, v = (t.reshape(bsz, seq, DN_HEADS, DN_HEAD_DIM) for t in split_columns(qkv, (MIX_W, MIX_W, MIX_W)))
    q, k = l2_normalize(q), l2_normalize(k)
    beta = jax.nn.sigmoid(b.astype(jnp.float32))
    g = -jnp.exp(a_log.astype(jnp.float32)) * jax.nn.softplus(a.astype(jnp.float32) + dt_bias.astype(jnp.float32))
    o = gated_delta_rule(q, k, v, g, beta)
    o = rms_norm(o, norm_w) * jax.nn.silu(gate.reshape(bsz, seq, DN_HEADS, DN_HEAD_DIM))
    return o.reshape(bsz, seq, MIX_W)


def stick_breaking_branch(qkv):
    bsz, seq, _ = qkv.shape
    dtype = qkv.dtype
    q, k, v = (t.reshape(bsz, seq, SB_HEADS, SB_HEAD_DIM).astype(jnp.float32)
               for t in split_columns(qkv, (MIX_W, MIX_W, MIX_W)))
    scale = SB_HEAD_DIM ** -0.5
    outs = []
    for i in range(seq // SB_BLOCK):
        t0, t1 = i * SB_BLOCK, (i + 1) * SB_BLOCK
        qb, kb, vb = q[:, t0:t1], k[:, :t1], v[:, :t1]
        z = jnp.einsum('bthd,bshd->bhts', qb, kb) * scale
        t_idx = t0 + jnp.arange(SB_BLOCK)
        s_idx = jnp.arange(t1)
        mask = s_idx[None, :] < t_idx[:, None]
        log_keep = jnp.where(mask, -jax.nn.softplus(z), 0.0)
        reach = lax.cumsum(log_keep, axis=3, reverse=True) - log_keep
        log_a = jax.nn.log_sigmoid(z) + reach
        weights = jnp.exp(jnp.where(mask, log_a, -jnp.inf))
        outs.append(jnp.einsum('bhts,bshd->bthd', weights, vb))
    o = jnp.concatenate(outs, axis=1)
    return o.reshape(bsz, seq, MIX_W).astype(dtype)


def ssd_chunked(x, a, bm, cm):
    dtype = x.dtype
    x, a, bm, cm = (t.astype(jnp.float32) for t in (x, a, bm, cm))
    bsz, seq, h, p = x.shape
    g, n_state = bm.shape[2], bm.shape[3]
    r = h // g
    c = SSM_CHUNK
    nc = seq // c
    x = x.reshape(bsz, nc, c, g, r, p)
    a = a.reshape(bsz, nc, c, g, r)
    bm = bm.reshape(bsz, nc, c, g, n_state)
    cm = cm.reshape(bsz, nc, c, g, n_state)
    a_cum = jnp.cumsum(a, axis=2)
    causal = jnp.tril(jnp.ones((c, c), dtype=bool))
    seg = a_cum[:, :, :, None] - a_cum[:, :, None, :]
    lmat = jnp.exp(jnp.where(causal[:, :, None, None], seg, -jnp.inf))
    scores = jnp.einsum('bclgn,bcsgn->bclsg', cm, bm)
    y_diag = jnp.einsum('bclsg,bclsgr,bcsgrp->bclgrp', scores, lmat, x)
    decay_states = jnp.exp(a_cum[:, :, -1:] - a_cum)
    chunk_states = jnp.einsum('bclgn,bclgr,bclgrp->bcgrpn', bm, decay_states, x)
    chunk_decay = jnp.exp(a_cum[:, :, -1])

    def step(state, xs):
        st, dec = xs
        return state * dec[..., None, None] + st, state

    h0 = jnp.zeros((bsz, g, r, p, n_state), jnp.float32)
    _, h_prev = lax.scan(step, h0, (jnp.moveaxis(chunk_states, 1, 0), jnp.moveaxis(chunk_decay, 1, 0)))
    h_prev = jnp.moveaxis(h_prev, 0, 1)
    y_off = jnp.einsum('bclgn,bcgrpn,bclgr->bclgrp', cm, h_prev, jnp.exp(a_cum))
    return (y_diag + y_off).reshape(bsz, seq, h, p).astype(dtype)


def mamba2_branch(z, xbc, dt, conv_w, conv_b, a_log, dt_bias, d_skip, norm_w):
    bsz, seq, _ = z.shape
    gn = SSM_GROUPS * SSM_STATE
    xbc = jax.nn.silu(causal_dwconv(xbc, conv_w, conv_b))
    xs, bm, cm = split_columns(xbc, (MIX_W, gn, gn))
    xs = xs.reshape(bsz, seq, SSM_HEADS, SSM_HEAD_DIM)
    bm = bm.reshape(bsz, seq, SSM_GROUPS, SSM_STATE)
    cm = cm.reshape(bsz, seq, SSM_GROUPS, SSM_STATE)
    dt = jax.nn.softplus(dt.astype(jnp.float32) + dt_bias.astype(jnp.float32))
    a = -jnp.exp(a_log.astype(jnp.float32)) * dt
    y = ssd_chunked(xs * dt[..., None].astype(xs.dtype), a, bm, cm)
    y = y + xs * d_skip[:, None]
    y = y.reshape(bsz, seq, MIX_W) * jax.nn.silu(z)
    return group_rms_norm(y, norm_w, SSM_GROUPS)


def hybrid_mixer(xn, w_in, dn_conv_w, dn_a_log, dn_dt_bias, dn_norm_w,
                 ssm_conv_w, ssm_conv_b, ssm_a_log, ssm_dt_bias, ssm_d, ssm_norm_w,
                 w_branch, w_out):
    bsz, seq, _ = xn.shape
    proj = xn @ w_in
    (dn_qkv, dn_gate, dn_a, dn_b, sb_qkv, ssm_z, ssm_xbc, ssm_dt, gate_logits) = split_columns(proj, IN_SIZES)
    o_dn = gated_deltanet_branch(dn_qkv, dn_gate, dn_a, dn_b, dn_conv_w, dn_a_log, dn_dt_bias, dn_norm_w)
    o_sb = stick_breaking_branch(sb_qkv)
    o_ssm = mamba2_branch(ssm_z, ssm_xbc, ssm_dt, ssm_conv_w, ssm_conv_b, ssm_a_log, ssm_dt_bias, ssm_d, ssm_norm_w)
    branches = jnp.stack([o_dn, o_sb, o_ssm], axis=2)
    projected = jnp.einsum('bsim,imd->bsid', branches, w_branch)
    gates = jax.nn.sigmoid(gate_logits.reshape(bsz, seq, N_BRANCH, D_MODEL))
    merged = jnp.sum(gates * projected, axis=2)
    return merged @ w_out


def setup_inputs(seed: int = 0) -> dict:
    key = jax.random.key(seed)
    ks = jax.random.split(key, 20)
    L = DEPTH

    def nrm(k, shape, scale):
        return jax.random.normal(k, shape, jnp.float32) * scale

    def log_uniform_a(k, shape):
        return jnp.log(jax.random.uniform(k, shape, jnp.float32, minval=1.0, maxval=16.0))

    def dt_bias_init(k, shape):
        dt = jnp.exp(jax.random.uniform(k, shape, jnp.float32, minval=np.log(1e-3), maxval=np.log(1e-1)))
        return dt + jnp.log(-jnp.expm1(-dt))

    return {
        "x": nrm(ks[0], (BATCH, SEQ, D_MODEL), 1.0),
        "norm_mix": 1.0 + nrm(ks[1], (L, D_MODEL), 0.02),
        "w_in": nrm(ks[2], (L, D_MODEL, IN_DIM), D_MODEL ** -0.5),
        "dn_conv_w": nrm(ks[3], (L, CONV_WIDTH, DN_QKV), CONV_WIDTH ** -0.5),
        "dn_a_log": log_uniform_a(ks[4], (L, DN_HEADS)),
        "dn_dt_bias": dt_bias_init(ks[5], (L, DN_HEADS)),
        "dn_norm_w": 1.0 + nrm(ks[6], (L, DN_HEAD_DIM), 0.02),
        "ssm_conv_w": nrm(ks[7], (L, CONV_WIDTH, SSM_CONV_DIM), CONV_WIDTH ** -0.5),
        "ssm_conv_b": nrm(ks[8], (L, SSM_CONV_DIM), 0.02),
        "ssm_a_log": log_uniform_a(ks[9], (L, SSM_HEADS)),
        "ssm_dt_bias": dt_bias_init(ks[10], (L, SSM_HEADS)),
        "ssm_d": 1.0 + nrm(ks[11], (L, SSM_HEADS), 0.02),
        "ssm_norm_w": 1.0 + nrm(ks[12], (L, MIX_W), 0.02),
        "w_branch": nrm(ks[13], (L, N_BRANCH, MIX_W, D_MODEL), MIX_W ** -0.5),
        "w_out": nrm(ks[14], (L, D_MODEL, D_MODEL), D_MODEL ** -0.5),
        "norm_mlp": 1.0 + nrm(ks[15], (L, D_MODEL), 0.02),
        "w_up": nrm(ks[16], (L, D_MODEL, D_FF), D_MODEL ** -0.5),
        "w_down": nrm(ks[17], (L, D_FF, D_MODEL), D_FF ** -0.5),
        "norm_final": 1.0 + nrm(ks[18], (D_MODEL,), 0.02),
    }


def reference(x, norm_mix, w_in, dn_conv_w, dn_a_log, dn_dt_bias, dn_norm_w,
              ssm_conv_w, ssm_conv_b, ssm_a_log, ssm_dt_bias, ssm_d, ssm_norm_w,
              w_branch, w_out, norm_mlp, w_up, w_down, norm_final):
    for l in range(DEPTH):
        h = rms_norm(x, norm_mix[l])
        x = x + hybrid_mixer(h, w_in[l], dn_conv_w[l], dn_a_log[l], dn_dt_bias[l], dn_norm_w[l],
                             ssm_conv_w[l], ssm_conv_b[l], ssm_a_log[l], ssm_dt_bias[l], ssm_d[l],
                             ssm_norm_w[l], w_branch[l], w_out[l])
        h = rms_norm(x, norm_mlp[l])
        x = x + jnp.square(jax.nn.relu(h @ w_up[l])) @ w_down[l]
    return rms_norm(x, norm_final)
```

```cpp
#include <hip/hip_runtime.h>
#include <hip/hip_cooperative_groups.h>
#include <cstdio>
#include <cstdint>
namespace cg = cooperative_groups;
__device__ __forceinline__ int opaque_tid() { int t = (int)threadIdx.x; asm volatile("" : "+v"(t)); return t; }
namespace pg8 {
#define PG8_LAS __attribute__((address_space(3)))
typedef unsigned short bf16_t;
typedef short bf16x8 __attribute__((ext_vector_type(8)));
typedef float f32x4 __attribute__((ext_vector_type(4)));
typedef unsigned u32x4 __attribute__((ext_vector_type(4)));
constexpr int BM = 256, BK = 64, HALF = 128, HTB = HALF * BK * 2  , STAGE_BYTES = 8 * HTB, NXCD = 8, WGM = 8;

__host__ __device__ __forceinline__ int lds_byte(int r, int c) { const int st = (r >> 4) * 2 + (c >> 5), rr = r & 15, cc = c & 31, ob = rr * 64 + cc * 2; return st * 1024 + (ob ^ (((ob >> 9) & 1) << 5)); }
__host__ __device__ __forceinline__ void stage_rc(int b, int& R, int& C) { const int st = b / 1024, sb = b % 1024, swz = sb ^ (((sb >> 9) & 1) << 5); R = (st >> 1) * 16 + swz / 64; C = (st & 1) * 32 + (swz % 64) / 2; }
__host__ __device__ __forceinline__ int perm32(int rho) { const int n = rho >> 4, i = rho & 15; return 8 * (i >> 2) + 4 * n + (i & 3); }

struct Unit { int pm, pn; };
struct Gemm { const bf16_t* A; const bf16_t* Bt; int M, N, K; };

struct StaticOrder {
    int nM, nN, nwg, G, c;
    __host__ __device__ void init(int M, int N, int G_, int c_) { nM = M / BM; nN = N / BM; nwg = nM * nN; G = G_; c = c_; }
    __host__ __device__ bool next(int i, Unit& u) const {
        const long L = (long)i * G + c; if (L >= nwg) return false;
        int wgid = (int)L; { const int q = nwg / NXCD, r = nwg % NXCD, xcd = wgid % NXCD, off = wgid / NXCD; wgid = (xcd < r ? xcd * (q + 1) : r * (q + 1) + (xcd - r) * q) + off; }
        const int nig = WGM * nN, gid = wgid / nig, fm = gid * WGM, gsz = (nM - fm) < WGM ? (nM - fm) : WGM;
        u.pm = fm + ((wgid % nig) % gsz); u.pn = (wgid % nig) / gsz; return true;
    }
    __device__ __forceinline__ void a_ready(const Unit&) const {}
    __device__ __forceinline__ void done(const Unit&) const {}
};
__device__ __forceinline__ unsigned cvt_pk_bf16(float lo, float hi) { unsigned r; asm volatile("v_cvt_pk_bf16_f32 %0, %1, %2" : "=v"(r) : "v"(lo), "v"(hi)); return r; }
template <class Epi, class Sched, bool ALIGN_EPI = false, bool SP2 = false>
__device__ __forceinline__ void gemm_phase(PG8_LAS unsigned char* lds, const Gemm g, const Sched& S, const Epi& E) {
    const int tid = opaque_tid(), wid = __builtin_amdgcn_readfirstlane(tid >> 6), lane = tid & 63, wr = wid >> 2, wc = wid & 3, fr = lane & 15, fq = lane >> 4;
    const int K = g.K, nt = K / BK;
    unsigned voffA[2], voffB[2];
#pragma unroll
    for (int i = 0; i < 2; ++i) { int R, C; stage_rc(tid * 16 + i * 8192, R, C); const int Rb = Epi::PERM ? ((R & ~31) + perm32(R & 31)) : R;
        voffA[i] = (unsigned)(R * K + C) * 2u; voffB[i] = (unsigned)(Rb * K + C) * 2u; }
    const size_t kstep = (size_t)(BK * 2);
    const size_t hstep = (size_t)HALF * K * 2;
    const size_t tstep = 2 * hstep;
    const unsigned ldsw = (unsigned)wid * 1024u;
    const int aoff = lds_byte(wr * 64 + fr, fq * 8), boff = lds_byte(wc * 32 + fr, fq * 8);
#define PG8_SA(b, h) (((b) * 2 + (h)) * HTB)
#define PG8_SB(b, h) ((4 + (b) * 2 + (h)) * HTB)
#define PG8_STAGE(bufoff, gbase, voff) do { _Pragma("unroll") for (int _i = 0; _i < 2; ++_i) \
        __builtin_amdgcn_global_load_lds((const unsigned*)((const char*)(gbase) + (voff)[_i]), (PG8_LAS unsigned*)(lds + (bufoff) + ldsw + _i * 8192), 16, 0, 0); } while (0)
#define PG8_LDA(dst, b, h) do { _Pragma("unroll") for (int m = 0; m < 4; ++m) _Pragma("unroll") for (int k = 0; k < 2; ++k) dst[m][k] = *(const PG8_LAS bf16x8*)(lds + PG8_SA(b, h) + aoff + m * 2048 + k * 1024); } while (0)
#define PG8_LDB(dst, b, h) do { _Pragma("unroll") for (int n = 0; n < 2; ++n) _Pragma("unroll") for (int k = 0; k < 2; ++k) dst[n][k] = *(const PG8_LAS bf16x8*)(lds + PG8_SB(b, h) + boff + n * 2048 + k * 1024); } while (0)
#define PG8_MMA(ai, bj, At, Bt) do { __builtin_amdgcn_s_setprio(1); _Pragma("unroll") for (int m = 0; m < 4; ++m) _Pragma("unroll") for (int n = 0; n < 2; ++n) _Pragma("unroll") for (int k = 0; k < 2; ++k) \
        acc[ai][bj][m][n] = __builtin_amdgcn_mfma_f32_16x16x32_bf16(Bt[n][k], At[m][k], acc[ai][bj][m][n], 0, 0, 0); __builtin_amdgcn_s_setprio(0); } while (0)
#define PG8_WAIT_V(n) asm volatile("s_waitcnt vmcnt(" #n ")" ::: "memory")
#define PG8_WAIT_L(n) asm volatile("s_waitcnt lgkmcnt(" #n ")" ::: "memory")
#define PG8_BAR __builtin_amdgcn_s_barrier()
#define PG8_SCHED __builtin_amdgcn_sched_barrier(0)
    Unit cur, nxt; int ui = 0;
    if (!S.next(0, cur)) return;
    f32x4 acc[2][2][4][2];
#pragma unroll
    for (int a = 0; a < 2; ++a)
#pragma unroll
        for (int b = 0; b < 2; ++b)
#pragma unroll
            for (int m = 0; m < 4; ++m)
#pragma unroll
                for (int n = 0; n < 2; ++n) acc[a][b][m][n] = (f32x4){0.f, 0.f, 0.f, 0.f};
    bf16x8 At[4][2], B0[2][2], B1[2][2];
    const char* cA = (const char*)g.A + (size_t)cur.pm * tstep; const char* cB = (const char*)g.Bt + (size_t)cur.pn * tstep;
    S.a_ready(cur);
    if constexpr (SP2) {
        PG8_STAGE(PG8_SB(0, 0), cB, voffB); PG8_STAGE(PG8_SB(0, 1), cB + hstep, voffB); PG8_STAGE(PG8_SA(0, 0), cA, voffA); PG8_STAGE(PG8_SA(0, 1), cA + hstep, voffA);
        if (wr == 1) PG8_BAR;
        PG8_WAIT_V(2); PG8_BAR;
        PG8_STAGE(PG8_SB(1, 0), cB + kstep, voffB); PG8_STAGE(PG8_SA(1, 0), cA + kstep, voffA); PG8_STAGE(PG8_SB(1, 1), cB + hstep + kstep, voffB);
        PG8_WAIT_V(6); PG8_BAR;
    } else {
        PG8_STAGE(PG8_SB(0, 0), cB, voffB); PG8_STAGE(PG8_SA(0, 0), cA, voffA); PG8_STAGE(PG8_SB(0, 1), cB + hstep, voffB); PG8_STAGE(PG8_SA(0, 1), cA + hstep, voffA);
        if (wr == 1) PG8_BAR;
        PG8_WAIT_V(4); PG8_BAR;
        PG8_STAGE(PG8_SB(1, 0), cB + kstep, voffB); PG8_STAGE(PG8_SA(1, 0), cA + kstep, voffA); PG8_STAGE(PG8_SB(1, 1), cB + hstep + kstep, voffB);
        PG8_WAIT_V(6); PG8_BAR;
    }
    for (;;) {
        const bool has_next = S.next(ui + 1, nxt);
        const char* nA = has_next ? (const char*)g.A + (size_t)nxt.pm * tstep : cA; const char* nB = has_next ? (const char*)g.Bt + (size_t)nxt.pn * tstep : cB;
        for (int t = 0; t < nt; t += 2) {
            const bool last = (t == nt - 2);
            const char* a1 = cA + (size_t)(t + 1) * kstep;
            const char* a2 = last ? nA : cA + (size_t)(t + 2) * kstep; const char* b2 = last ? nB : cB + (size_t)(t + 2) * kstep;
            const char* a3 = a2 + kstep; const char* b3 = b2 + kstep;
            if (last && has_next) S.a_ready(nxt);
            if constexpr (SP2) {
            PG8_LDB(B0, 0, 0); PG8_LDB(B1, 0, 1); PG8_SCHED; PG8_LDA(At, 0, 0); PG8_STAGE(PG8_SA(1, 1), a1 + hstep, voffA);
            PG8_WAIT_V(8); PG8_WAIT_L(0); PG8_BAR; PG8_MMA(0, 0, At, B0); PG8_MMA(0, 1, At, B1); PG8_BAR; PG8_SCHED;
            PG8_LDA(At, 0, 1); PG8_STAGE(PG8_SB(0, 0), b2, voffB); PG8_STAGE(PG8_SB(0, 1), b2 + hstep, voffB); PG8_STAGE(PG8_SA(0, 0), a2, voffA);
            PG8_WAIT_V(8); PG8_WAIT_L(0); PG8_BAR; PG8_MMA(1, 0, At, B0); PG8_MMA(1, 1, At, B1); PG8_BAR; PG8_SCHED;
            PG8_LDB(B0, 1, 0); PG8_LDB(B1, 1, 1); PG8_SCHED; PG8_LDA(At, 1, 0); PG8_STAGE(PG8_SA(0, 1), a2 + hstep, voffA);
            PG8_WAIT_V(8); PG8_WAIT_L(0); PG8_BAR; PG8_MMA(0, 0, At, B0); PG8_MMA(0, 1, At, B1); PG8_BAR; PG8_SCHED;
            PG8_LDA(At, 1, 1); PG8_STAGE(PG8_SB(1, 0), b3, voffB); PG8_STAGE(PG8_SB(1, 1), b3 + hstep, voffB); PG8_STAGE(PG8_SA(1, 0), a3, voffA);
            PG8_WAIT_V(8); PG8_WAIT_L(0); PG8_BAR; PG8_MMA(1, 0, At, B0); PG8_MMA(1, 1, At, B1); PG8_BAR; PG8_SCHED;
            } else {
            PG8_LDB(B0, 0, 0); PG8_SCHED; PG8_LDA(At, 0, 0); PG8_STAGE(PG8_SA(1, 1), a1 + hstep, voffA);
            PG8_WAIT_L(8); PG8_BAR; PG8_WAIT_L(0); PG8_MMA(0, 0, At, B0); PG8_BAR; PG8_SCHED;
            PG8_LDB(B1, 0, 1); PG8_STAGE(PG8_SB(0, 0), b2, voffB);
            PG8_BAR; PG8_WAIT_L(0); PG8_MMA(0, 1, At, B1); PG8_BAR;
            PG8_LDA(At, 0, 1); PG8_STAGE(PG8_SA(0, 0), a2, voffA);
            PG8_BAR; PG8_WAIT_L(0); PG8_MMA(1, 0, At, B0); PG8_BAR; PG8_SCHED;
            PG8_STAGE(PG8_SB(0, 1), b2 + hstep, voffB);
            PG8_WAIT_V(6); PG8_BAR; PG8_MMA(1, 1, At, B1); PG8_BAR;
            PG8_LDB(B0, 1, 0); PG8_SCHED; PG8_LDA(At, 1, 0); PG8_STAGE(PG8_SA(0, 1), a2 + hstep, voffA);
            PG8_WAIT_L(8); PG8_BAR; PG8_WAIT_L(0); PG8_MMA(0, 0, At, B0); PG8_BAR; PG8_SCHED;
            PG8_LDB(B1, 1, 1); PG8_STAGE(PG8_SB(1, 0), b3, voffB);
            PG8_BAR; PG8_WAIT_L(0); PG8_MMA(0, 1, At, B1); PG8_BAR;
            PG8_LDA(At, 1, 1); PG8_STAGE(PG8_SA(1, 0), a3, voffA);
            PG8_BAR; PG8_WAIT_L(0); PG8_MMA(1, 0, At, B0); PG8_BAR; PG8_SCHED;
            PG8_STAGE(PG8_SB(1, 1), b3 + hstep, voffB);
            PG8_WAIT_V(6); PG8_BAR; PG8_MMA(1, 1, At, B1); PG8_BAR;
            }
        }
        if constexpr (ALIGN_EPI) { if (wr == 0) PG8_BAR; }
        if constexpr (!Epi::AFTER_DRAIN) { E(acc, cur, wr, wc, fr, fq); S.done(cur); }
        if (!has_next) break;
#pragma unroll
        for (int a = 0; a < 2; ++a)
#pragma unroll
            for (int b = 0; b < 2; ++b)
#pragma unroll
                for (int m = 0; m < 4; ++m)
#pragma unroll
                    for (int n = 0; n < 2; ++n) acc[a][b][m][n] = (f32x4){0.f, 0.f, 0.f, 0.f};
        cur = nxt; cA = nA; cB = nB; ++ui;
        if constexpr (ALIGN_EPI) { if (wr == 1) PG8_BAR; }
    }
    PG8_WAIT_V(0);
    if constexpr (!ALIGN_EPI) { if (wr == 0) PG8_BAR; }
    PG8_BAR;
    if constexpr (Epi::AFTER_DRAIN) { E.fused(acc, cur, wr, wc, fr, fq, lds, wid, lane); S.done(cur); }
#undef PG8_SA
#undef PG8_SB
#undef PG8_STAGE
#undef PG8_LDA
#undef PG8_LDB
#undef PG8_MMA
#undef PG8_WAIT_V
#undef PG8_WAIT_L
#undef PG8_BAR
#undef PG8_SCHED
}
}

constexpr int NB = 8, SEQ = 2048, DM = 1024, MT = NB * SEQ, DFF = 4096, IN_DIM = 13344;
constexpr int NTHREADS = 512, NWAVES = 8, LDS_BYTES = 147456;
constexpr float EPS = 1e-6f;
typedef unsigned short bf16;
typedef unsigned v4u __attribute__((ext_vector_type(4)));
typedef unsigned v2u __attribute__((ext_vector_type(2)));
typedef float f32x4 __attribute__((ext_vector_type(4)));
typedef short bf16x8 __attribute__((ext_vector_type(8)));
enum { B_H = 0, B_DNG = 1, B_SBQ = 2, B_SSZ = 3, B_DNQ = 4, B_DNK = 5, B_DNV = 6, B_SBK = 7, B_SBV = 8, B_SSX = 9, B_SSBC = 10, NBUF = 11 };
constexpr size_t BUFE = (size_t)MT * DM;
constexpr size_t WS_W = NBUF * BUFE * 2;
constexpr size_t W_IN = 0, W_G = W_IN + (size_t)10240 * 1024, W_OUT = W_G + (size_t)6144 * 1024, W_UP = W_OUT + (size_t)1024 * 1024,
                 W_DOWN = W_UP + (size_t)4096 * 1024, W_END = W_DOWN + (size_t)4096 * 1024;
constexpr size_t WS_SMALL = WS_W + W_END * 2;
constexpr size_t WS_CTL = WS_SMALL + (size_t)MT * 64 * 4;
constexpr size_t WS_NEED = WS_CTL + 4096;

__device__ __forceinline__ float bf2f(unsigned u) { return __builtin_bit_cast(float, u << 16); }
__device__ __forceinline__ unsigned f2bf(float f) { unsigned u = __builtin_bit_cast(unsigned, f); return (u + 0x7fffu + ((u >> 16) & 1u)) >> 16; }
__device__ __forceinline__ unsigned pk2(float lo, float hi) { return f2bf(lo) | (f2bf(hi) << 16); }
__device__ __forceinline__ void unpack8(v4u r, float* o) {
    o[0] = bf2f(r.x & 0xffffu); o[1] = __builtin_bit_cast(float, r.x & 0xffff0000u); o[2] = bf2f(r.y & 0xffffu); o[3] = __builtin_bit_cast(float, r.y & 0xffff0000u);
    o[4] = bf2f(r.z & 0xffffu); o[5] = __builtin_bit_cast(float, r.z & 0xffff0000u); o[6] = bf2f(r.w & 0xffffu); o[7] = __builtin_bit_cast(float, r.w & 0xffff0000u);
}
__device__ __forceinline__ v4u pack8(const float* v) { v4u w; w.x = pk2(v[0], v[1]); w.y = pk2(v[2], v[3]); w.z = pk2(v[4], v[5]); w.w = pk2(v[6], v[7]); return w; }
__device__ __forceinline__ float sigmoidf_(float x) { return 1.f / (1.f + __expf(-x)); }
__device__ __forceinline__ float siluf_(float x) { return x / (1.f + __expf(-x)); }
__device__ __forceinline__ float softplusf_(float x) { return fmaxf(x, 0.f) + log1pf(__expf(-fabsf(x))); }
template <int CTRL> __device__ __forceinline__ float dppf(float v) { return __builtin_bit_cast(float, __builtin_amdgcn_update_dpp(0, __builtin_bit_cast(int, v), CTRL, 0xF, 0xF, true)); }
__device__ __forceinline__ float red8(float v) { v += dppf<0xB1>(v); v += dppf<0x4E>(v); v += dppf<0x141>(v); return v; }
__device__ __forceinline__ float red16(float v) { v = red8(v); v += dppf<0x140>(v); return v; }
__device__ __forceinline__ float wave_sum(float v) {
#pragma unroll
    for (int o = 1; o < 64; o <<= 1) v += __shfl_xor(v, o);
    return v;
}
#define LDS_WAIT() asm volatile("s_waitcnt lgkmcnt(0)" ::: "memory")

struct Args { const float* in[19]; float* out; unsigned char* ws; };

struct EpiRoute {
    static constexpr bool PERM = true, AFTER_DRAIN = false;
    bf16* base;
    __device__ __forceinline__ void operator()(const pg8::f32x4 (&acc)[2][2][4][2], const pg8::Unit& u, int wr, int wc, int fr, int fq) const {
        bf16* O = base + (size_t)(1 + (u.pn >> 2)) * BUFE;
        const int col0 = (u.pn & 3) * 256 + wc * 32 + 8 * fq, row0 = u.pm * 256 + wr * 64 + fr;
#pragma unroll
        for (int ai = 0; ai < 2; ++ai)
#pragma unroll
            for (int m = 0; m < 4; ++m) { bf16* rowp = O + (size_t)(row0 + ai * 128 + m * 16) * DM + col0;
#pragma unroll
                for (int bj = 0; bj < 2; ++bj) { const pg8::f32x4 v0 = acc[ai][bj][m][0], v1 = acc[ai][bj][m][1];
                    v4u w; w.x = pk2(v0[0], v0[1]); w.y = pk2(v0[2], v0[3]); w.z = pk2(v1[0], v1[1]); w.w = pk2(v1[2], v1[3]);
                    *(v4u*)(rowp + bj * 128) = w; } }
    }
};
struct EpiRelu2 {
    static constexpr bool PERM = true, AFTER_DRAIN = false;
    bf16* O;
    __device__ __forceinline__ void operator()(const pg8::f32x4 (&acc)[2][2][4][2], const pg8::Unit& u, int wr, int wc, int fr, int fq) const {
        const int col0 = u.pn * 256 + wc * 32 + 8 * fq, row0 = u.pm * 256 + wr * 64 + fr;
#pragma unroll
        for (int ai = 0; ai < 2; ++ai)
#pragma unroll
            for (int m = 0; m < 4; ++m) { bf16* rowp = O + (size_t)(row0 + ai * 128 + m * 16) * DFF + col0;
#pragma unroll
                for (int bj = 0; bj < 2; ++bj) { float v[8];
#pragma unroll
                    for (int i = 0; i < 4; ++i) { float a = fmaxf(acc[ai][bj][m][0][i], 0.f), b = fmaxf(acc[ai][bj][m][1][i], 0.f); v[i] = a * a; v[4 + i] = b * b; }
                    *(v4u*)(rowp + bj * 128) = pack8(v); } }
    }
};
struct EpiResid {
    static constexpr bool PERM = true, AFTER_DRAIN = false;
    const float* xin; float* xout;
    __device__ __forceinline__ void operator()(const pg8::f32x4 (&acc)[2][2][4][2], const pg8::Unit& u, int wr, int wc, int fr, int fq) const {
        const int col0 = u.pn * 256 + wc * 32 + 8 * fq, row0 = u.pm * 256 + wr * 64 + fr;
#pragma unroll
        for (int ai = 0; ai < 2; ++ai)
#pragma unroll
            for (int m = 0; m < 4; ++m) { const size_t ro = (size_t)(row0 + ai * 128 + m * 16) * DM + col0;
#pragma unroll
                for (int bj = 0; bj < 2; ++bj) { const size_t o = ro + bj * 128;
                    const f32x4 a = *(const f32x4*)(xin + o), b = *(const f32x4*)(xin + o + 4);
                    f32x4 r0, r1;
#pragma unroll
                    for (int i = 0; i < 4; ++i) { r0[i] = a[i] + acc[ai][bj][m][0][i]; r1[i] = b[i] + acc[ai][bj][m][1][i]; }
                    *(f32x4*)(xout + o) = r0; *(f32x4*)(xout + o + 4) = r1; } }
    }
};
struct SchedGate {
    int G, c;
    __device__ __forceinline__ bool next(int i, pg8::Unit& u) const {
        const int tile = c + (i / 6) * G; if (tile >= 256) return false;
        const int s = i % 6, br = s >> 1, pm = tile >> 2, pn = tile & 3;
        if ((s & 1) == 0) { u.pm = pm; u.pn = br * 4 + pn; } else { u.pm = (1 + br) * 64 + pm; u.pn = (3 + br) * 4 + pn; }
        return true;
    }
    __device__ __forceinline__ void a_ready(const pg8::Unit&) const {}
    __device__ __forceinline__ void done(const pg8::Unit&) const {}
};
struct EpiGate {
    static constexpr bool PERM = true, AFTER_DRAIN = false;
    bf16* gsc; float* macc; bf16* merged;
    __device__ __forceinline__ void operator()(const pg8::f32x4 (&acc)[2][2][4][2], const pg8::Unit& u, int wr, int wc, int fr, int fq) const {
        const int j = u.pn >> 2, pn = u.pn & 3, pm = u.pm & 63;
        const int col0 = pn * 256 + wc * 32 + 8 * fq, row0 = pm * 256 + wr * 64 + fr;
#pragma unroll
        for (int ai = 0; ai < 2; ++ai)
#pragma unroll
            for (int m = 0; m < 4; ++m) { const size_t ro = (size_t)(row0 + ai * 128 + m * 16) * DM + col0;
#pragma unroll
                for (int bj = 0; bj < 2; ++bj) { const size_t o = ro + bj * 128; float v[8];
#pragma unroll
                    for (int i = 0; i < 4; ++i) { v[i] = acc[ai][bj][m][0][i]; v[4 + i] = acc[ai][bj][m][1][i]; }
                    if (j < 3) {
#pragma unroll
                        for (int i = 0; i < 8; ++i) v[i] = sigmoidf_(v[i]);
                        *(v4u*)(gsc + o) = pack8(v);
                    } else {
                        float g[8]; unpack8(*(const v4u*)(gsc + o), g);
#pragma unroll
                        for (int i = 0; i < 8; ++i) v[i] *= g[i];
                        if (j > 3) { const f32x4 a = *(const f32x4*)(macc + o), b = *(const f32x4*)(macc + o + 4);
#pragma unroll
                            for (int i = 0; i < 4; ++i) { v[i] += a[i]; v[4 + i] += b[i]; } }
                        if (j < 5) { *(f32x4*)(macc + o) = (f32x4){v[0], v[1], v[2], v[3]}; *(f32x4*)(macc + o + 4) = (f32x4){v[4], v[5], v[6], v[7]}; }
                        else *(v4u*)(merged + o) = pack8(v);
                    } } }
    }
};

__device__ __forceinline__ void transpose_item(const float* __restrict__ W, int ldw, bf16* __restrict__ WT, int K, int nblk, float* scr, int item, int lane) {
    const int kb = item / nblk, nb = item % nblk, k0 = 64 * kb, n0 = 32 * nb;
#pragma unroll 8
    for (int i = 0; i < 32; ++i) { const int kk = 2 * i + (lane >> 5); scr[kk * 33 + (lane & 31)] = W[(size_t)(k0 + kk) * ldw + n0 + (lane & 31)]; }
    LDS_WAIT();
    const int c = lane & 7;
#pragma unroll
    for (int j = 0; j < 4; ++j) { const int n = (lane >> 3) + 8 * j; const float* s = scr + (8 * c) * 33 + n;
        v4u o; o.x = pk2(s[0 * 33], s[1 * 33]); o.y = pk2(s[2 * 33], s[3 * 33]); o.z = pk2(s[4 * 33], s[5 * 33]); o.w = pk2(s[6 * 33], s[7 * 33]);
        *(v4u*)(WT + (size_t)(n0 + n) * K + k0 + 8 * c) = o; }
    LDS_WAIT();
}
__device__ __forceinline__ void rms_row_to_bf16(const float* xrow, const float* w, bf16* orow, int lane) {
    const f32x4* xr = (const f32x4*)xrow + lane; const f32x4* wr = (const f32x4*)w + lane;
    f32x4 v[4]; float s = 0.f;
#pragma unroll
    for (int j = 0; j < 4; ++j) { v[j] = xr[64 * j]; s += (v[j][0] * v[j][0] + v[j][1] * v[j][1]) + (v[j][2] * v[j][2] + v[j][3] * v[j][3]); }
    const float rstd = rsqrtf(wave_sum(s) * (1.f / DM) + EPS);
    unsigned long long* o8 = (unsigned long long*)orow + lane;
#pragma unroll
    for (int j = 0; j < 4; ++j) { const f32x4 ww = wr[64 * j];
        o8[64 * j] = (unsigned long long)pk2(v[j][0] * rstd * ww[0], v[j][1] * rstd * ww[1]) | ((unsigned long long)pk2(v[j][2] * rstd * ww[2], v[j][3] * rstd * ww[3]) << 32); }
}
__device__ __forceinline__ void phase0(unsigned char* lds, const Args& a, int l, const float* xin) {
    const int tid = opaque_tid(), lane = tid & 63, wave = tid >> 6, gw = blockIdx.x * NWAVES + wave, NGW = gridDim.x * NWAVES;
    bf16* Wreg = (bf16*)(a.ws + WS_W);
    const float* w_in = a.in[2] + (size_t)l * DM * IN_DIM;
    {
        float* scr = (float*)lds + wave * (64 * 33);
        const float* w_br = a.in[13] + (size_t)l * 3 * DM * DM; const float* w_out = a.in[14] + (size_t)l * DM * DM;
        const float* w_up = a.in[16] + (size_t)l * DM * DFF; const float* w_down = a.in[17] + (size_t)l * DFF * DM;
        constexpr int NSEG = 17, NIT = NSEG * 512 + 2048 + 2048;
        for (int it = gw; it < NIT; it += NGW) {
            if (it < NSEG * 512) {
                const int seg = it >> 9, r = it & 511;
                const float* W; int ldw; bf16* WT;
                if (seg < 13) {
                    const int co = seg == 0 ? 3072 : seg == 1 ? 4112 : seg == 2 ? 7184 : seg == 3 ? 0 : seg == 4 ? 1024 : seg == 5 ? 2048 : seg == 6 ? 5136 : seg == 7 ? 6160 : seg == 8 ? 8208 : seg == 9 ? 9232
                                 : 10272 + (seg - 10) * 1024;
                    W = w_in + co; ldw = IN_DIM; WT = Wreg + (size_t)seg * DM * DM;
                } else if (seg < 16) { W = w_br + (size_t)(seg - 13) * DM * DM; ldw = DM; WT = Wreg + W_G + (size_t)(3 + seg - 13) * DM * DM; }
                else { W = w_out; ldw = DM; WT = Wreg + W_OUT; }
                transpose_item(W, ldw, WT, DM, 32, scr, r, lane);
            } else if (it < NSEG * 512 + 2048) transpose_item(w_up, DFF, Wreg + W_UP, DM, 128, scr, it - NSEG * 512, lane);
            else transpose_item(w_down, DM, Wreg + W_DOWN, DFF, 32, scr, it - NSEG * 512 - 2048, lane);
        }
    }
    __syncthreads();
    {
        float* Ws = (float*)lds;
        for (int idx = tid; idx < 32 * DM; idx += NTHREADS) { const int k = idx >> 5, c = idx & 31; Ws[c * DM + k] = w_in[(size_t)k * IN_DIM + (c < 16 ? 4096 + c : 10256 + c - 16)]; }
        __syncthreads();
        const float* nw = a.in[1] + (size_t)l * DM;
        bf16* H = (bf16*)a.ws; float* small = (float*)(a.ws + WS_SMALL);
        float p0 = 0.f, p1 = 0.f;
        if (lane < 8) { p0 = __expf(a.in[4][l * 8 + lane]); p1 = a.in[5][l * 8 + lane]; }
        else if (lane >= 16 && lane < 32) { p0 = __expf(a.in[9][l * 16 + lane - 16]); p1 = a.in[10][l * 16 + lane - 16]; }
        for (int m = gw; m < MT; m += NGW) {
            const float* xrow = xin + (size_t)m * DM;
            float xv[16]; float s = 0.f;
#pragma unroll
            for (int i = 0; i < 16; ++i) { xv[i] = xrow[lane + 64 * i]; s += xv[i] * xv[i]; }
            const float rstd = rsqrtf(wave_sum(s) * (1.f / DM) + EPS);
            bf16* hrow = H + (size_t)m * DM;
#pragma unroll
            for (int i = 0; i < 16; ++i) { xv[i] = xv[i] * rstd * nw[lane + 64 * i]; hrow[lane + 64 * i] = (bf16)f2bf(xv[i]); }
            float mine = 0.f;
#pragma unroll 4
            for (int c = 0; c < 32; ++c) { float acc = 0.f;
#pragma unroll
                for (int i = 0; i < 16; ++i) acc += xv[i] * Ws[c * DM + lane + 64 * i];
                acc = wave_sum(acc); mine = (lane == c) ? acc : mine; }
            if (lane < 8) small[(size_t)m * 64 + lane] = -p0 * softplusf_(mine + p1);
            else if (lane < 16) small[(size_t)m * 64 + lane] = sigmoidf_(mine);
            else if (lane < 32) { const float dt = softplusf_(mine + p1); small[(size_t)m * 64 + lane] = dt; small[(size_t)m * 64 + lane + 16] = -p0 * dt; }
        }
    }
}

__device__ __forceinline__ void conv8(const bf16* p, int pos, const float* w, int wstride, const float* bias, float* out) {
    float acc[8];
#pragma unroll
    for (int i = 0; i < 8; ++i) acc[i] = bias ? bias[i] : 0.f;
#pragma unroll
    for (int j = 0; j < 4; ++j) { const int back = 3 - j;
        if (pos - back >= 0) { float xv[8]; unpack8(*(const v4u*)(p - (size_t)back * DM), xv);
            const f32x4 w0 = *(const f32x4*)(w + j * wstride), w1 = *(const f32x4*)(w + j * wstride + 4);
#pragma unroll
            for (int i = 0; i < 4; ++i) { acc[i] += xv[i] * w0[i]; acc[4 + i] += xv[4 + i] * w1[i]; } } }
#pragma unroll
    for (int i = 0; i < 8; ++i) out[i] = siluf_(acc[i]);
}

__device__ __forceinline__ void dn_item(unsigned char* lds, const Args& a, int l, int item) {
    const int b = item >> 4, h = (item >> 1) & 7, eh = item & 1;
    float* qs = (float*)lds; float* ks = qs + 32 * 128; float* vs = ks + 32 * 128; float* os = vs + 32 * 64; float* gs = os + 32 * 64; float* bs = gs + 32;
    const int tid = opaque_tid(), e = tid >> 3, ds = tid & 7;
    bf16* base = (bf16*)a.ws;
    const bf16* Q = base + (size_t)B_DNQ * BUFE; const bf16* K = base + (size_t)B_DNK * BUFE; bf16* V = base + (size_t)B_DNV * BUFE;
    const float* small = (const float*)(a.ws + WS_SMALL);
    const float* cw = a.in[3] + (size_t)l * 4 * 3072;
    const size_t rowbase = (size_t)b * SEQ;
    float S[16];
#pragma unroll
    for (int i = 0; i < 16; ++i) S[i] = 0.f;
    for (int c = 0; c < SEQ / 32; ++c) {
        const int t0 = c * 32;
        {
            const int tt = tid >> 4, c8 = tid & 15, pos = t0 + tt; const size_t off = (rowbase + pos) * DM + h * 128 + c8 * 8;
            float q8[8], k8[8];
            conv8(Q + off, pos, cw + h * 128 + c8 * 8, 3072, nullptr, q8);
            conv8(K + off, pos, cw + 1024 + h * 128 + c8 * 8, 3072, nullptr, k8);
            float sq = 0.f, sk = 0.f;
#pragma unroll
            for (int i = 0; i < 8; ++i) { sq += q8[i] * q8[i]; sk += k8[i] * k8[i]; }
            sq = red16(sq); sk = red16(sk);
            const float rq = rsqrtf(sq + EPS) * 0.08838834764831845f, rk = rsqrtf(sk + EPS);
#pragma unroll
            for (int i = 0; i < 8; ++i) { qs[tt * 128 + c8 * 8 + i] = q8[i] * rq; ks[tt * 128 + c8 * 8 + i] = k8[i] * rk; }
        }
        if (tid < 256) { const int tt = tid >> 3, c8 = tid & 7, pos = t0 + tt; float v8[8];
            conv8(V + (rowbase + pos) * DM + h * 128 + eh * 64 + c8 * 8, pos, cw + 2048 + h * 128 + eh * 64 + c8 * 8, 3072, nullptr, v8);
#pragma unroll
            for (int i = 0; i < 8; ++i) vs[tt * 64 + c8 * 8 + i] = v8[i];
        } else if (tid < 288) { const int tt = tid - 256; const size_t r = rowbase + t0 + tt; gs[tt] = __expf(small[r * 64 + h]); bs[tt] = small[r * 64 + 8 + h]; }
        __syncthreads();
        if (c > 0) {
            const int tt = tid >> 4, e4 = (tid & 15) * 4; const float* o = os + tt * 64 + e4;
            v2u w; w.x = pk2(o[0], o[1]); w.y = pk2(o[2], o[3]);
            *(v2u*)(V + (rowbase + t0 - 32 + tt) * DM + h * 128 + eh * 64 + e4) = w;
        }
        __syncthreads();
        for (int tt = 0; tt < 32; ++tt) {
            float kv[16], qv[16];
#pragma unroll
            for (int i = 0; i < 4; ++i) { const f32x4 k4 = *(const f32x4*)(ks + tt * 128 + 32 * i + 4 * ds), q4 = *(const f32x4*)(qs + tt * 128 + 32 * i + 4 * ds);
#pragma unroll
                for (int r = 0; r < 4; ++r) { kv[4 * i + r] = k4[r]; qv[4 * i + r] = q4[r]; } }
            float kS = 0.f;
#pragma unroll
            for (int i = 0; i < 16; ++i) kS += kv[i] * S[i];
            kS = red8(kS);
            const float eg = gs[tt], vn = bs[tt] * (vs[tt * 64 + e] - eg * kS);
            float o = 0.f;
#pragma unroll
            for (int i = 0; i < 16; ++i) { S[i] = eg * S[i] + kv[i] * vn; o += qv[i] * S[i]; }
            o = red8(o);
            if (ds == 0) os[tt * 64 + e] = o;
        }
        __syncthreads();
    }
    {   const int tt = tid >> 4, e4 = (tid & 15) * 4; const float* o = os + tt * 64 + e4;
        v2u w; w.x = pk2(o[0], o[1]); w.y = pk2(o[2], o[3]);
        *(v2u*)(V + (rowbase + SEQ - 32 + tt) * DM + h * 128 + eh * 64 + e4) = w; }
    __syncthreads();
}

__device__ __forceinline__ void ssm_item(unsigned char* lds, const Args& a, int l, int item) {
    const int b = item >> 4, hd = item & 15, g = hd >> 2;
    float* xs = (float*)lds; float* Bs = xs + 32 * 64; float* Cs = Bs + 32 * 128; float* ys = Cs + 32 * 128; float* dts = ys + 32 * 64; float* das = dts + 32;
    const int tid = opaque_tid(), p = tid >> 3, ns = tid & 7;
    bf16* base = (bf16*)a.ws;
    const bf16* X = base + (size_t)B_SSX * BUFE; const bf16* BC = base + (size_t)B_SSBC * BUFE; bf16* Z = base + (size_t)B_SSZ * BUFE;
    const float* small = (const float*)(a.ws + WS_SMALL);
    const float* cw = a.in[7] + (size_t)l * 4 * 2048; const float* cb = a.in[8] + (size_t)l * 2048;
    const float dskip = a.in[11][l * 16 + hd];
    const size_t rowbase = (size_t)b * SEQ;
    float hst[16];
#pragma unroll
    for (int i = 0; i < 16; ++i) hst[i] = 0.f;
    for (int c = 0; c < SEQ / 32; ++c) {
        const int t0 = c * 32;
        {   const int tt = tid >> 4, c8 = tid & 15, pos = t0 + tt; const size_t ro = (rowbase + pos) * DM; float o8[8];
            conv8(BC + ro + g * 128 + c8 * 8, pos, cw + 1024 + g * 128 + c8 * 8, 2048, cb + 1024 + g * 128 + c8 * 8, o8);
#pragma unroll
            for (int i = 0; i < 8; ++i) Bs[tt * 128 + c8 * 8 + i] = o8[i];
            conv8(BC + ro + 512 + g * 128 + c8 * 8, pos, cw + 1536 + g * 128 + c8 * 8, 2048, cb + 1536 + g * 128 + c8 * 8, o8);
#pragma unroll
            for (int i = 0; i < 8; ++i) Cs[tt * 128 + c8 * 8 + i] = o8[i];
        }
        if (tid < 256) { const int tt = tid >> 3, c8 = tid & 7, pos = t0 + tt; float o8[8];
            conv8(X + (rowbase + pos) * DM + hd * 64 + c8 * 8, pos, cw + hd * 64 + c8 * 8, 2048, cb + hd * 64 + c8 * 8, o8);
#pragma unroll
            for (int i = 0; i < 8; ++i) xs[tt * 64 + c8 * 8 + i] = o8[i];
        } else if (tid < 288) { const int tt = tid - 256; const size_t r = rowbase + t0 + tt; dts[tt] = small[r * 64 + 16 + hd]; das[tt] = __expf(small[r * 64 + 32 + hd]); }
        __syncthreads();
        for (int tt = 0; tt < 32; ++tt) {
            const float dA = das[tt], xv = xs[tt * 64 + p], xdt = xv * dts[tt];
            float y = 0.f;
#pragma unroll
            for (int i = 0; i < 4; ++i) { const f32x4 b4 = *(const f32x4*)(Bs + tt * 128 + 32 * i + 4 * ns), c4 = *(const f32x4*)(Cs + tt * 128 + 32 * i + 4 * ns);
#pragma unroll
                for (int r = 0; r < 4; ++r) { hst[4 * i + r] = dA * hst[4 * i + r] + xdt * b4[r]; y += hst[4 * i + r] * c4[r]; } }
            y = red8(y);
            if (ns == 0) ys[tt * 64 + p] = y + xv * dskip;
        }
        __syncthreads();
        {   const int tt = tid >> 4, p4 = (tid & 15) * 4; bf16* zp = Z + (rowbase + t0 + tt) * DM + hd * 64 + p4; const float* y = ys + tt * 64 + p4;
            const v2u zr = *(const v2u*)zp;
            const float z0 = bf2f(zr.x & 0xffffu), z1 = __builtin_bit_cast(float, zr.x & 0xffff0000u), z2 = bf2f(zr.y & 0xffffu), z3 = __builtin_bit_cast(float, zr.y & 0xffff0000u);
            v2u w; w.x = pk2(y[0] * siluf_(z0), y[1] * siluf_(z1)); w.y = pk2(y[2] * siluf_(z2), y[3] * siluf_(z3));
            *(v2u*)zp = w; }
        __syncthreads();
    }
}

__device__ __forceinline__ void sb_item(unsigned char* lds, const Args& a, int b, int hd, int qi) {
    constexpr int LD = 72;
    bf16* Ks = (bf16*)lds; bf16* Vs = Ks + 2 * 64 * LD;
    const int tid = opaque_tid(), w = tid >> 6, lane = tid & 63, fr = lane & 15, fq = lane >> 4;
    bf16* base = (bf16*)a.ws;
    bf16* Qb = base + (size_t)B_SBQ * BUFE; const bf16* Kb = base + (size_t)B_SBK * BUFE; const bf16* Vb = base + (size_t)B_SBV * BUFE;
    const size_t rowbase = (size_t)b * SEQ;
    const int t0 = qi * 128, myq = t0 + w * 16 + fr, wmax = t0 + w * 16 + 15;
    bf16* qrow = Qb + (rowbase + myq) * DM + hd * 64;
    bf16x8 qf[2];
    qf[0] = *(const bf16x8*)(qrow + fq * 8); qf[1] = *(const bf16x8*)(qrow + 32 + fq * 8);
    f32x4 oacc[4];
#pragma unroll
    for (int i = 0; i < 4; ++i) oacc[i] = (f32x4){0.f, 0.f, 0.f, 0.f};
    float carry = 0.f;
    const int kr = tid >> 3, d8 = (tid & 7) * 8;
    v4u kreg, vreg;
    int kt = 2 * (qi + 1) - 1;
#define SB_LOAD(t) do { const size_t o_ = (rowbase + (size_t)(t) * 64 + kr) * DM + hd * 64 + d8; kreg = *(const v4u*)(Kb + o_); vreg = *(const v4u*)(Vb + o_); } while (0)
#define SB_STORE(bu) do { *(v4u*)(Ks + (bu) * 64 * LD + kr * LD + d8) = kreg; bf16* vd_ = Vs + (bu) * 64 * LD + d8 * LD + kr; \
        vd_[0] = (bf16)(vreg.x & 0xffffu); vd_[LD] = (bf16)(vreg.x >> 16); vd_[2 * LD] = (bf16)(vreg.y & 0xffffu); vd_[3 * LD] = (bf16)(vreg.y >> 16); \
        vd_[4 * LD] = (bf16)(vreg.z & 0xffffu); vd_[5 * LD] = (bf16)(vreg.z >> 16); vd_[6 * LD] = (bf16)(vreg.w & 0xffffu); vd_[7 * LD] = (bf16)(vreg.w >> 16); } while (0)
    SB_LOAD(kt); SB_STORE(0);
    __syncthreads();
    int cur = 0;
    for (; kt >= 0; --kt) {
        if (kt > 0) SB_LOAD(kt - 1);
        const int kbase = kt * 64;
        if (kbase <= wmax) {
            const bf16* Kc = Ks + cur * 64 * LD; const bf16* Vc = Vs + cur * 64 * LD;
            f32x4 z[4];
#pragma unroll
            for (int nt = 0; nt < 4; ++nt) { z[nt] = (f32x4){0.f, 0.f, 0.f, 0.f};
#pragma unroll
                for (int k2 = 0; k2 < 2; ++k2) { const bf16x8 af = *(const bf16x8*)(Kc + (nt * 16 + fr) * LD + k2 * 32 + fq * 8);
                    z[nt] = __builtin_amdgcn_mfma_f32_16x16x32_bf16(af, qf[k2], z[nt], 0, 0, 0); } }
            float lk[4][4], la[4][4], T[4], tot[4], suf[4];
#pragma unroll
            for (int nt = 0; nt < 4; ++nt) { float t = 0.f;
#pragma unroll
                for (int j = 0; j < 4; ++j) { const int key = kbase + nt * 16 + fq * 4 + j; const float zz = z[nt][j] * 0.125f, sp = softplusf_(zz);
                    lk[nt][j] = key < myq ? -sp : 0.f; la[nt][j] = zz - sp; t += lk[nt][j]; }
                T[nt] = t; }
#pragma unroll
            for (int nt = 0; nt < 4; ++nt) { const float s1 = T[nt] + __shfl_xor(T[nt], 16); tot[nt] = s1 + __shfl_xor(s1, 32);
                suf[nt] = fq == 0 ? tot[nt] - T[nt] : fq == 1 ? tot[nt] - s1 : fq == 2 ? s1 - T[nt] : 0.f; }
            float run = carry; float wv[4][4];
#pragma unroll
            for (int nt = 3; nt >= 0; --nt) { const float r3 = run + suf[nt], r2 = r3 + lk[nt][3], r1 = r2 + lk[nt][2], r0 = r1 + lk[nt][1];
                const int key0 = kbase + nt * 16 + fq * 4;
                wv[nt][0] = key0 + 0 < myq ? __expf(la[nt][0] + r0) : 0.f; wv[nt][1] = key0 + 1 < myq ? __expf(la[nt][1] + r1) : 0.f;
                wv[nt][2] = key0 + 2 < myq ? __expf(la[nt][2] + r2) : 0.f; wv[nt][3] = key0 + 3 < myq ? __expf(la[nt][3] + r3) : 0.f;
                run += tot[nt]; }
            carry = run;
#pragma unroll
            for (int kk = 0; kk < 2; ++kk) {
                v4u bw; bw.x = pk2(wv[2 * kk][0], wv[2 * kk][1]); bw.y = pk2(wv[2 * kk][2], wv[2 * kk][3]); bw.z = pk2(wv[2 * kk + 1][0], wv[2 * kk + 1][1]); bw.w = pk2(wv[2 * kk + 1][2], wv[2 * kk + 1][3]);
                const bf16x8 bfr = __builtin_bit_cast(bf16x8, bw);
#pragma unroll
                for (int mt = 0; mt < 4; ++mt) { const bf16* vp = Vc + (mt * 16 + fr) * LD + 32 * kk + 4 * fq;
                    const v2u lo = *(const v2u*)vp, hi = *(const v2u*)(vp + 16);
                    v4u av; av.x = lo.x; av.y = lo.y; av.z = hi.x; av.w = hi.y;
                    oacc[mt] = __builtin_amdgcn_mfma_f32_16x16x32_bf16(__builtin_bit_cast(bf16x8, av), bfr, oacc[mt], 0, 0, 0); }
            }
        }
        if (kt > 0) SB_STORE(cur ^ 1);
        __syncthreads();
        cur ^= 1;
    }
#undef SB_LOAD
#undef SB_STORE
#pragma unroll
    for (int mt = 0; mt < 4; ++mt) { v2u wq; wq.x = pk2(oacc[mt][0], oacc[mt][1]); wq.y = pk2(oacc[mt][2], oacc[mt][3]); *(v2u*)(qrow + mt * 16 + fq * 4) = wq; }
}

__device__ __forceinline__ void phase_mixers(unsigned char* lds, const Args& a, int l) {
    unsigned* counter = (unsigned*)(a.ws + WS_CTL) + 64 * l;
    volatile unsigned* slot = (volatile unsigned*)(lds + LDS_BYTES - 64);
    constexpr unsigned NITEMS = 128 + 128 + 2048;
    for (;;) {
        if (threadIdx.x == 0) *slot = __hip_atomic_fetch_add(counter, 1u, __ATOMIC_RELAXED, __HIP_MEMORY_SCOPE_AGENT);
        __syncthreads();
        const unsigned item = *slot;
        __syncthreads();
        if (item >= NITEMS) break;
        if (item < 128) dn_item(lds, a, l, (int)item);
        else if (item < 256) ssm_item(lds, a, l, (int)item - 128);
        else { const int r = (int)item - 256, qi = 15 - (r >> 7), bh = r & 127; sb_item(lds, a, bh >> 4, bh & 15, qi); }
    }
}

__device__ __forceinline__ void phase_norms(const Args& a, int l) {
    const int tid = opaque_tid(), lane = tid & 63, wave = tid >> 6, gw = blockIdx.x * NWAVES + wave, NGW = gridDim.x * NWAVES;
    bf16* base = (bf16*)a.ws;
    const bf16* Oraw = base + (size_t)B_DNV * BUFE; bf16* G = base + (size_t)B_DNG * BUFE; bf16* Y = base + (size_t)B_SSZ * BUFE;
    const float* dnw = a.in[6] + (size_t)l * 128 + (lane & 7) * 16; const float* snw = a.in[12] + (size_t)l * DM + lane * 16;
    float w1[16], w2[16];
#pragma unroll
    for (int i = 0; i < 16; ++i) { w1[i] = dnw[i]; w2[i] = snw[i]; }
    for (int m = gw; m < MT; m += NGW) {
        const size_t o = (size_t)m * DM + lane * 16;
        float v[16], g[16];
        unpack8(*(const v4u*)(Oraw + o), v); unpack8(*(const v4u*)(Oraw + o + 8), v + 8);
        unpack8(*(const v4u*)(G + o), g); unpack8(*(const v4u*)(G + o + 8), g + 8);
        float s = 0.f;
#pragma unroll
        for (int i = 0; i < 16; ++i) s += v[i] * v[i];
        s = red8(s);
        float r = rsqrtf(s * (1.f / 128.f) + EPS);
#pragma unroll
        for (int i = 0; i < 16; ++i) v[i] = v[i] * r * w1[i] * siluf_(g[i]);
        *(v4u*)(G + o) = pack8(v); *(v4u*)(G + o + 8) = pack8(v + 8);
        unpack8(*(const v4u*)(Y + o), v); unpack8(*(const v4u*)(Y + o + 8), v + 8);
        s = 0.f;
#pragma unroll
        for (int i = 0; i < 16; ++i) s += v[i] * v[i];
        s = red16(s);
        r = rsqrtf(s * (1.f / 256.f) + EPS);
#pragma unroll
        for (int i = 0; i < 16; ++i) v[i] = v[i] * r * w2[i];
        *(v4u*)(Y + o) = pack8(v); *(v4u*)(Y + o + 8) = pack8(v + 8);
    }
}

__global__ void __launch_bounds__(NTHREADS, 2) hybrid_fwd(Args a) {
    extern __shared__ __attribute__((aligned(16))) unsigned char lds[];
    cg::grid_group grid = cg::this_grid();
    bf16* base = (bf16*)a.ws; bf16* Wreg = (bf16*)(a.ws + WS_W);
    PG8_LAS unsigned char* ldsl = (PG8_LAS unsigned char*)lds;
    if (blockIdx.x == 0 && threadIdx.x < 2) __hip_atomic_store((unsigned*)(a.ws + WS_CTL) + 64 * threadIdx.x, 0u, __ATOMIC_RELAXED, __HIP_MEMORY_SCOPE_AGENT);
#pragma unroll 1
    for (int l = 0; l < 2; ++l) {
        asm volatile("" : "+s"(l));
        const float* xin = l == 0 ? a.in[0] : a.out;
        phase0(lds, a, l, xin);
        grid.sync();
        {   pg8::Gemm g{base, Wreg + W_IN, MT, 10240, DM}; pg8::StaticOrder S; S.init(MT, 10240, (int)gridDim.x, (int)blockIdx.x);
            EpiRoute E{base};
            pg8::gemm_phase<EpiRoute, pg8::StaticOrder, false, true>(ldsl, g, S, E); }
        grid.sync();
        phase_mixers(lds, a, l);
        grid.sync();
        phase_norms(a, l);
        grid.sync();
        {   pg8::Gemm g{base, Wreg + W_G, 4 * MT, 6144, DM}; SchedGate S{(int)gridDim.x, (int)blockIdx.x};
            EpiGate E{base + (size_t)B_SBK * BUFE, (float*)(base + (size_t)B_DNK * BUFE), base + (size_t)B_DNQ * BUFE};
            pg8::gemm_phase<EpiGate, SchedGate, false, true>(ldsl, g, S, E); }
        grid.sync();
        {   pg8::Gemm g{base + (size_t)B_DNQ * BUFE, Wreg + W_OUT, MT, DM, DM}; pg8::StaticOrder S; S.init(MT, DM, (int)gridDim.x, (int)blockIdx.x);
            EpiResid E{xin, a.out};
            pg8::gemm_phase<EpiResid, pg8::StaticOrder, false, true>(ldsl, g, S, E); }
        grid.sync();
        {   const float* nw = a.in[15] + (size_t)l * DM;
            const int tid = opaque_tid(), lane = tid & 63, gw = blockIdx.x * NWAVES + (tid >> 6), NGW = gridDim.x * NWAVES;
            for (int m = gw; m < MT; m += NGW) rms_row_to_bf16(a.out + (size_t)m * DM, nw, base + (size_t)m * DM, lane); }
        grid.sync();
        {   pg8::Gemm g{base, Wreg + W_UP, MT, DFF, DM}; pg8::StaticOrder S; S.init(MT, DFF, (int)gridDim.x, (int)blockIdx.x);
            EpiRelu2 E{base + (size_t)B_DNQ * BUFE};
            pg8::gemm_phase<EpiRelu2, pg8::StaticOrder, false, true>(ldsl, g, S, E); }
        grid.sync();
        {   pg8::Gemm g{base + (size_t)B_DNQ * BUFE, Wreg + W_DOWN, MT, DM, DFF}; pg8::StaticOrder S; S.init(MT, DM, (int)gridDim.x, (int)blockIdx.x);
            EpiResid E{a.out, a.out};
            pg8::gemm_phase<EpiResid, pg8::StaticOrder, false, true>(ldsl, g, S, E); }
        grid.sync();
    }
    {
        const float* nw = a.in[18];
        const int tid = opaque_tid(), lane = tid & 63, gw = blockIdx.x * NWAVES + (tid >> 6), NGW = gridDim.x * NWAVES;
        for (int m = gw; m < MT; m += NGW) {
            f32x4* xr = (f32x4*)(a.out + (size_t)m * DM) + lane; const f32x4* wr = (const f32x4*)nw + lane;
            f32x4 v[4]; float s = 0.f;
#pragma unroll
            for (int j = 0; j < 4; ++j) { v[j] = xr[64 * j]; s += (v[j][0] * v[j][0] + v[j][1] * v[j][1]) + (v[j][2] * v[j][2] + v[j][3] * v[j][3]); }
            const float rstd = rsqrtf(wave_sum(s) * (1.f / DM) + EPS);
#pragma unroll
            for (int j = 0; j < 4; ++j) { const f32x4 ww = wr[64 * j]; f32x4 r;
#pragma unroll
                for (int i = 0; i < 4; ++i) r[i] = v[j][i] * rstd * ww[i];
                xr[64 * j] = r; }
        }
    }
}

extern "C" void kernel_launch(void* const* d_in, const int* in_sizes, int n_in, void* d_out, int out_size, void* d_ws, size_t ws_size, hipStream_t stream) {
    static int grid = 0;
    if (grid == 0) {
        if (n_in != 19 || out_size != MT * DM || ws_size < WS_NEED) { fprintf(stderr, "kernel_launch: unexpected shapes (n_in %d out %d ws %zu need %zu)\n", n_in, out_size, ws_size, (size_t)WS_NEED); grid = -1; return; }
        int dev = 0, cus = 0, per_cu = 0;
        hipGetDevice(&dev); hipDeviceGetAttribute(&cus, hipDeviceAttributeMultiprocessorCount, dev);
        if (hipFuncSetAttribute((const void*)hybrid_fwd, hipFuncAttributeMaxDynamicSharedMemorySize, LDS_BYTES) != hipSuccess) { fprintf(stderr, "kernel_launch: hipFuncSetAttribute failed\n"); grid = -1; return; }
        if (hipOccupancyMaxActiveBlocksPerMultiprocessor(&per_cu, (const void*)hybrid_fwd, NTHREADS, LDS_BYTES) != hipSuccess || per_cu < 1) { fprintf(stderr, "kernel_launch: occupancy query gave %d\n", per_cu); per_cu = 1; }
        (void)hipGetLastError();
        grid = cus * per_cu;
    }
    if (grid < 0) return;
    Args a{};
    for (int i = 0; i < 19; ++i) a.in[i] = (const float*)d_in[i];
    a.out = (float*)d_out; a.ws = (unsigned char*)d_ws;
    void* args[] = {&a};
    hipError_t e = hipLaunchCooperativeKernel((const void*)hybrid_fwd, dim3(grid), dim3(NTHREADS), args, LDS_BYTES, stream);
    if (e != hipSuccess) fprintf(stderr, "cooperative launch failed: %s (grid %d)\n", hipGetErrorString(e), grid);
}
```

```cpp
#include <hip/hip_runtime.h>
#include <hip/hip_cooperative_groups.h>
#include <cstdio>
#include <cstdint>
namespace cg = cooperative_groups;
__device__ __forceinline__ int opaque_tid() { int t = (int)threadIdx.x; asm volatile("" : "+v"(t)); return t; }
namespace pg8 {
#define PG8_LAS __attribute__((address_space(3)))
typedef unsigned short bf16_t;
typedef short bf16x8 __attribute__((ext_vector_type(8)));
typedef float f32x4 __attribute__((ext_vector_type(4)));
typedef unsigned u32x4 __attribute__((ext_vector_type(4)));
constexpr int BM = 256, BK = 64, HALF = 128, HTB = HALF * BK * 2  , STAGE_BYTES = 8 * HTB, NXCD = 8, WGM = 8;

__host__ __device__ __forceinline__ int lds_byte(int r, int c) { const int st = (r >> 4) * 2 + (c >> 5), rr = r & 15, cc = c & 31, ob = rr * 64 + cc * 2; return st * 1024 + (ob ^ (((ob >> 9) & 1) << 5)); }
__host__ __device__ __forceinline__ void stage_rc(int b, int& R, int& C) { const int st = b / 1024, sb = b % 1024, swz = sb ^ (((sb >> 9) & 1) << 5); R = (st >> 1) * 16 + swz / 64; C = (st & 1) * 32 + (swz % 64) / 2; }
__host__ __device__ __forceinline__ int perm32(int rho) { const int n = rho >> 4, i = rho & 15; return 8 * (i >> 2) + 4 * n + (i & 3); }

struct Unit { int pm, pn; };
struct Gemm { const bf16_t* A; const bf16_t* Bt; int M, N, K; };

struct StaticOrder {
    int nM, nN, nwg, G, c;
    __host__ __device__ void init(int M, int N, int G_, int c_) { nM = M / BM; nN = N / BM; nwg = nM * nN; G = G_; c = c_; }
    __host__ __device__ bool next(int i, Unit& u) const {
        const long L = (long)i * G + c; if (L >= nwg) return false;
        int wgid = (int)L; { const int q = nwg / NXCD, r = nwg % NXCD, xcd = wgid % NXCD, off = wgid / NXCD; wgid = (xcd < r ? xcd * (q + 1) : r * (q + 1) + (xcd - r) * q) + off; }
        const int nig = WGM * nN, gid = wgid / nig, fm = gid * WGM, gsz = (nM - fm) < WGM ? (nM - fm) : WGM;
        u.pm = fm + ((wgid % nig) % gsz); u.pn = (wgid % nig) / gsz; return true;
    }
    __device__ __forceinline__ void a_ready(const Unit&) const {}
    __device__ __forceinline__ void done(const Unit&) const {}
};
__device__ __forceinline__ unsigned cvt_pk_bf16(float lo, float hi) { unsigned r; asm volatile("v_cvt_pk_bf16_f32 %0, %1, %2" : "=v"(r) : "v"(lo), "v"(hi)); return r; }
template <class Epi, class Sched, bool ALIGN_EPI = false, bool SP2 = false>
__device__ __forceinline__ void gemm_phase(PG8_LAS unsigned char* lds, const Gemm g, const Sched& S, const Epi& E) {
    const int tid = opaque_tid(), wid = __builtin_amdgcn_readfirstlane(tid >> 6), lane = tid & 63, wr = wid >> 2, wc = wid & 3, fr = lane & 15, fq = lane >> 4;
    const int K = g.K, nt = K / BK;
    unsigned voffA[2], voffB[2];
#pragma unroll
    for (int i = 0; i < 2; ++i) { int R, C; stage_rc(tid * 16 + i * 8192, R, C); const int Rb = Epi::PERM ? ((R & ~31) + perm32(R & 31)) : R;
        voffA[i] = (unsigned)(R * K + C) * 2u; voffB[i] = (unsigned)(Rb * K + C) * 2u; }
    const size_t kstep = (size_t)(BK * 2);
    const size_t hstep = (size_t)HALF * K * 2;
    const size_t tstep = 2 * hstep;
    const unsigned ldsw = (unsigned)wid * 1024u;
    const int aoff = lds_byte(wr * 64 + fr, fq * 8), boff = lds_byte(wc * 32 + fr, fq * 8);
#define PG8_SA(b, h) (((b) * 2 + (h)) * HTB)
#define PG8_SB(b, h) ((4 + (b) * 2 + (h)) * HTB)
#define PG8_STAGE(bufoff, gbase, voff) do { _Pragma("unroll") for (int _i = 0; _i < 2; ++_i) \
        __builtin_amdgcn_global_load_lds((const unsigned*)((const char*)(gbase) + (voff)[_i]), (PG8_LAS unsigned*)(lds + (bufoff) + ldsw + _i * 8192), 16, 0, 0); } while (0)
#define PG8_LDA(dst, b, h) do { _Pragma("unroll") for (int m = 0; m < 4; ++m) _Pragma("unroll") for (int k = 0; k < 2; ++k) dst[m][k] = *(const PG8_LAS bf16x8*)(lds + PG8_SA(b, h) + aoff + m * 2048 + k * 1024); } while (0)
#define PG8_LDB(dst, b, h) do { _Pragma("unroll") for (int n = 0; n < 2; ++n) _Pragma("unroll") for (int k = 0; k < 2; ++k) dst[n][k] = *(const PG8_LAS bf16x8*)(lds + PG8_SB(b, h) + boff + n * 2048 + k * 1024); } while (0)
#define PG8_MMA(ai, bj, At, Bt) do { __builtin_amdgcn_s_setprio(1); _Pragma("unroll") for (int m = 0; m < 4; ++m) _Pragma("unroll") for (int n = 0; n < 2; ++n) _Pragma("unroll") for (int k = 0; k < 2; ++k) \
        acc[ai][bj][m][n] = __builtin_amdgcn_mfma_f32_16x16x32_bf16(Bt[n][k], At[m][k], acc[ai][bj][m][n], 0, 0, 0); __builtin_amdgcn_s_setprio(0); } while (0)
#define PG8_WAIT_V(n) asm volatile("s_waitcnt vmcnt(" #n ")" ::: "memory")
#define PG8_WAIT_L(n) asm volatile("s_waitcnt lgkmcnt(" #n ")" ::: "memory")
#define PG8_BAR __builtin_amdgcn_s_barrier()
#define PG8_SCHED __builtin_amdgcn_sched_barrier(0)
    Unit cur, nxt; int ui = 0;
    if (!S.next(0, cur)) return;
    f32x4 acc[2][2][4][2];
#pragma unroll
    for (int a = 0; a < 2; ++a)
#pragma unroll
        for (int b = 0; b < 2; ++b)
#pragma unroll
            for (int m = 0; m < 4; ++m)
#pragma unroll
                for (int n = 0; n < 2; ++n) acc[a][b][m][n] = (f32x4){0.f, 0.f, 0.f, 0.f};
    bf16x8 At[4][2], B0[2][2], B1[2][2];
    const char* cA = (const char*)g.A + (size_t)cur.pm * tstep; const char* cB = (const char*)g.Bt + (size_t)cur.pn * tstep;
    S.a_ready(cur);
    if constexpr (SP2) {
        PG8_STAGE(PG8_SB(0, 0), cB, voffB); PG8_STAGE(PG8_SB(0, 1), cB + hstep, voffB); PG8_STAGE(PG8_SA(0, 0), cA, voffA); PG8_STAGE(PG8_SA(0, 1), cA + hstep, voffA);
        if (wr == 1) PG8_BAR;
        PG8_WAIT_V(2); PG8_BAR;
        PG8_STAGE(PG8_SB(1, 0), cB + kstep, voffB); PG8_STAGE(PG8_SA(1, 0), cA + kstep, voffA); PG8_STAGE(PG8_SB(1, 1), cB + hstep + kstep, voffB);
        PG8_WAIT_V(6); PG8_BAR;
    } else {
        PG8_STAGE(PG8_SB(0, 0), cB, voffB); PG8_STAGE(PG8_SA(0, 0), cA, voffA); PG8_STAGE(PG8_SB(0, 1), cB + hstep, voffB); PG8_STAGE(PG8_SA(0, 1), cA + hstep, voffA);
        if (wr == 1) PG8_BAR;
        PG8_WAIT_V(4); PG8_BAR;
        PG8_STAGE(PG8_SB(1, 0), cB + kstep, voffB); PG8_STAGE(PG8_SA(1, 0), cA + kstep, voffA); PG8_STAGE(PG8_SB(1, 1), cB + hstep + kstep, voffB);
        PG8_WAIT_V(6); PG8_BAR;
    }
    for (;;) {
        const bool has_next = S.next(ui + 1, nxt);
        const char* nA = has_next ? (const char*)g.A + (size_t)nxt.pm * tstep : cA; const char* nB = has_next ? (const char*)g.Bt + (size_t)nxt.pn * tstep : cB;
        for (int t = 0; t < nt; t += 2) {
            const bool last = (t == nt - 2);
            const char* a1 = cA + (size_t)(t + 1) * kstep;
            const char* a2 = last ? nA : cA + (size_t)(t + 2) * kstep; const char* b2 = last ? nB : cB + (size_t)(t + 2) * kstep;
            const char* a3 = a2 + kstep; const char* b3 = b2 + kstep;
            if (last && has_next) S.a_ready(nxt);
            if constexpr (SP2) {
            PG8_LDB(B0, 0, 0); PG8_LDB(B1, 0, 1); PG8_SCHED; PG8_LDA(At, 0, 0); PG8_STAGE(PG8_SA(1, 1), a1 + hstep, voffA);
            PG8_WAIT_V(8); PG8_WAIT_L(0); PG8_BAR; PG8_MMA(0, 0, At, B0); PG8_MMA(0, 1, At, B1); PG8_BAR; PG8_SCHED;
            PG8_LDA(At, 0, 1); PG8_STAGE(PG8_SB(0, 0), b2, voffB); PG8_STAGE(PG8_SB(0, 1), b2 + hstep, voffB); PG8_STAGE(PG8_SA(0, 0), a2, voffA);
            PG8_WAIT_V(8); PG8_WAIT_L(0); PG8_BAR; PG8_MMA(1, 0, At, B0); PG8_MMA(1, 1, At, B1); PG8_BAR; PG8_SCHED;
            PG8_LDB(B0, 1, 0); PG8_LDB(B1, 1, 1); PG8_SCHED; PG8_LDA(At, 1, 0); PG8_STAGE(PG8_SA(0, 1), a2 + hstep, voffA);
            PG8_WAIT_V(8); PG8_WAIT_L(0); PG8_BAR; PG8_MMA(0, 0, At, B0); PG8_MMA(0, 1, At, B1); PG8_BAR; PG8_SCHED;
            PG8_LDA(At, 1, 1); PG8_STAGE(PG8_SB(1, 0), b3, voffB); PG8_STAGE(PG8_SB(1, 1), b3 + hstep, voffB); PG8_STAGE(PG8_SA(1, 0), a3, voffA);
            PG8_WAIT_V(8); PG8_WAIT_L(0); PG8_BAR; PG8_MMA(1, 0, At, B0); PG8_MMA(1, 1, At, B1); PG8_BAR; PG8_SCHED;
            } else {
            PG8_LDB(B0, 0, 0); PG8_SCHED; PG8_LDA(At, 0, 0); PG8_STAGE(PG8_SA(1, 1), a1 + hstep, voffA);
            PG8_WAIT_L(8); PG8_BAR; PG8_WAIT_L(0); PG8_MMA(0, 0, At, B0); PG8_BAR; PG8_SCHED;
            PG8_LDB(B1, 0, 1); PG8_STAGE(PG8_SB(0, 0), b2, voffB);
            PG8_BAR; PG8_WAIT_L(0); PG8_MMA(0, 1, At, B1); PG8_BAR;
            PG8_LDA(At, 0, 1); PG8_STAGE(PG8_SA(0, 0), a2, voffA);
            PG8_BAR; PG8_WAIT_L(0); PG8_MMA(1, 0, At, B0); PG8_BAR; PG8_SCHED;
            PG8_STAGE(PG8_SB(0, 1), b2 + hstep, voffB);
            PG8_WAIT_V(6); PG8_BAR; PG8_MMA(1, 1, At, B1); PG8_BAR;
            PG8_LDB(B0, 1, 0); PG8_SCHED; PG8_LDA(At, 1, 0); PG8_STAGE(PG8_SA(0, 1), a2 + hstep, voffA);
            PG8_WAIT_L(8); PG8_BAR; PG8_WAIT_L(0); PG8_MMA(0, 0, At, B0); PG8_BAR; PG8_SCHED;
            PG8_LDB(B1, 1, 1); PG8_STAGE(PG8_SB(1, 0), b3, voffB);
            PG8_BAR; PG8_WAIT_L(0); PG8_MMA(0, 1, At, B1); PG8_BAR;
            PG8_LDA(At, 1, 1); PG8_STAGE(PG8_SA(1, 0), a3, voffA);
            PG8_BAR; PG8_WAIT_L(0); PG8_MMA(1, 0, At, B0); PG8_BAR; PG8_SCHED;
            PG8_STAGE(PG8_SB(1, 1), b3 + hstep, voffB);
            PG8_WAIT_V(6); PG8_BAR; PG8_MMA(1, 1, At, B1); PG8_BAR;
            }
        }
        if constexpr (ALIGN_EPI) { if (wr == 0) PG8_BAR; }
        if constexpr (!Epi::AFTER_DRAIN) { E(acc, cur, wr, wc, fr, fq); S.done(cur); }
        if (!has_next) break;
#pragma unroll
        for (int a = 0; a < 2; ++a)
#pragma unroll
            for (int b = 0; b < 2; ++b)
#pragma unroll
                for (int m = 0; m < 4; ++m)
#pragma unroll
                    for (int n = 0; n < 2; ++n) acc[a][b][m][n] = (f32x4){0.f, 0.f, 0.f, 0.f};
        cur = nxt; cA = nA; cB = nB; ++ui;
        if constexpr (ALIGN_EPI) { if (wr == 1) PG8_BAR; }
    }
    PG8_WAIT_V(0);
    if constexpr (!ALIGN_EPI) { if (wr == 0) PG8_BAR; }
    PG8_BAR;
    if constexpr (Epi::AFTER_DRAIN) { E.fused(acc, cur, wr, wc, fr, fq, lds, wid, lane); S.done(cur); }
#undef PG8_SA
#undef PG8_SB
#undef PG8_STAGE
#undef PG8_LDA
#undef PG8_LDB
#undef PG8_MMA
#undef PG8_WAIT_V
#undef PG8_WAIT_L
#undef PG8_BAR
#undef PG8_SCHED
}
}

constexpr int NB = 8, SEQ = 2048, DM = 1024, MT = NB * SEQ, DFF = 4096, IN_DIM = 13344;
constexpr int NTHREADS = 512, NWAVES = 8, LDS_BYTES = 147456;
constexpr float EPS = 1e-6f;
typedef unsigned short bf16;
typedef unsigned v4u __attribute__((ext_vector_type(4)));
typedef unsigned v2u __attribute__((ext_vector_type(2)));
typedef float f32x4 __attribute__((ext_vector_type(4)));
typedef short bf16x8 __attribute__((ext_vector_type(8)));
enum { B_H = 0, B_DNG = 1, B_SBQ = 2, B_SSZ = 3, B_DNQ = 4, B_DNK = 5, B_DNV = 6, B_SBK = 7, B_SBV = 8, B_SSX = 9, B_SSBC = 10, NBUF = 11 };
constexpr size_t BUFE = (size_t)MT * DM;
constexpr size_t WS_W = NBUF * BUFE * 2;
constexpr size_t W_IN = 0, W_G = W_IN + (size_t)10240 * 1024, W_OUT = W_G + (size_t)6144 * 1024, W_UP = W_OUT + (size_t)1024 * 1024,
                 W_DOWN = W_UP + (size_t)4096 * 1024, W_END = W_DOWN + (size_t)4096 * 1024;
constexpr size_t WS_SMALL = WS_W + W_END * 2;
constexpr size_t WS_CTL = WS_SMALL + (size_t)MT * 64 * 4;
constexpr size_t WS_NEED = WS_CTL + 4096;

__device__ __forceinline__ float bf2f(unsigned u) { return __builtin_bit_cast(float, u << 16); }
__device__ __forceinline__ unsigned f2bf(float f) { unsigned u = __builtin_bit_cast(unsigned, f); return (u + 0x7fffu + ((u >> 16) & 1u)) >> 16; }
typedef float f32x2 __attribute__((ext_vector_type(2)));
typedef __bf16 bf16x2_t __attribute__((ext_vector_type(2)));
__device__ __forceinline__ unsigned pk2(float lo, float hi) { f32x2 v = {lo, hi}; return __builtin_bit_cast(unsigned, __builtin_convertvector(v, bf16x2_t)); }
__device__ __forceinline__ void unpack8(v4u r, float* o) {
    o[0] = bf2f(r.x & 0xffffu); o[1] = __builtin_bit_cast(float, r.x & 0xffff0000u); o[2] = bf2f(r.y & 0xffffu); o[3] = __builtin_bit_cast(float, r.y & 0xffff0000u);
    o[4] = bf2f(r.z & 0xffffu); o[5] = __builtin_bit_cast(float, r.z & 0xffff0000u); o[6] = bf2f(r.w & 0xffffu); o[7] = __builtin_bit_cast(float, r.w & 0xffff0000u);
}
__device__ __forceinline__ v4u pack8(const float* v) { v4u w; w.x = pk2(v[0], v[1]); w.y = pk2(v[2], v[3]); w.z = pk2(v[4], v[5]); w.w = pk2(v[6], v[7]); return w; }
__device__ __forceinline__ float sigmoidf_(float x) { return 1.f / (1.f + __expf(-x)); }
__device__ __forceinline__ float siluf_(float x) { return x / (1.f + __expf(-x)); }
__device__ __forceinline__ float softplusf_(float x) { return fmaxf(x, 0.f) + log1pf(__expf(-fabsf(x))); }
template <int CTRL> __device__ __forceinline__ float dppf(float v) { return __builtin_bit_cast(float, __builtin_amdgcn_update_dpp(0, __builtin_bit_cast(int, v), CTRL, 0xF, 0xF, true)); }
__device__ __forceinline__ float red8(float v) { v += dppf<0xB1>(v); v += dppf<0x4E>(v); v += dppf<0x141>(v); return v; }
__device__ __forceinline__ float red16(float v) { v = red8(v); v += dppf<0x140>(v); return v; }
__device__ __forceinline__ float wave_sum(float v) {
#pragma unroll
    for (int o = 1; o < 64; o <<= 1) v += __shfl_xor(v, o);
    return v;
}
#define LDS_WAIT() asm volatile("s_waitcnt lgkmcnt(0)" ::: "memory")

struct Args { const float* in[19]; float* out; unsigned char* ws; };
#ifndef PROBE_SEL
#define PROBE_SEL 0
#endif
__device__ __forceinline__ unsigned long long rt() { return __builtin_amdgcn_s_memrealtime(); }
#define PT0() unsigned long long pt_ = PROBE_SEL ? rt() : 0ull
#define PT1(k) do { if (PROBE_SEL & (1 << (k))) probe_acc += rt() - pt_; } while (0)

struct EpiRoute {
    static constexpr bool PERM = true, AFTER_DRAIN = false;
    bf16* base;
    __device__ __forceinline__ void operator()(const pg8::f32x4 (&acc)[2][2][4][2], const pg8::Unit& u, int wr, int wc, int fr, int fq) const {
        bf16* O = base + (size_t)(1 + (u.pn >> 2)) * BUFE;
        const int col0 = (u.pn & 3) * 256 + wc * 32 + 8 * fq, row0 = u.pm * 256 + wr * 64 + fr;
#pragma unroll
        for (int ai = 0; ai < 2; ++ai)
#pragma unroll
            for (int m = 0; m < 4; ++m) { bf16* rowp = O + (size_t)(row0 + ai * 128 + m * 16) * DM + col0;
#pragma unroll
                for (int bj = 0; bj < 2; ++bj) { const pg8::f32x4 v0 = acc[ai][bj][m][0], v1 = acc[ai][bj][m][1];
                    v4u w; w.x = pk2(v0[0], v0[1]); w.y = pk2(v0[2], v0[3]); w.z = pk2(v1[0], v1[1]); w.w = pk2(v1[2], v1[3]);
                    *(v4u*)(rowp + bj * 128) = w; } }
    }
};
struct EpiRelu2 {
    static constexpr bool PERM = true, AFTER_DRAIN = false;
    bf16* O;
    __device__ __forceinline__ void operator()(const pg8::f32x4 (&acc)[2][2][4][2], const pg8::Unit& u, int wr, int wc, int fr, int fq) const {
        const int col0 = u.pn * 256 + wc * 32 + 8 * fq, row0 = u.pm * 256 + wr * 64 + fr;
#pragma unroll
        for (int ai = 0; ai < 2; ++ai)
#pragma unroll
            for (int m = 0; m < 4; ++m) { bf16* rowp = O + (size_t)(row0 + ai * 128 + m * 16) * DFF + col0;
#pragma unroll
                for (int bj = 0; bj < 2; ++bj) { float v[8];
#pragma unroll
                    for (int i = 0; i < 4; ++i) { float a = fmaxf(acc[ai][bj][m][0][i], 0.f), b = fmaxf(acc[ai][bj][m][1][i], 0.f); v[i] = a * a; v[4 + i] = b * b; }
                    *(v4u*)(rowp + bj * 128) = pack8(v); } }
    }
};
struct EpiResid {
    static constexpr bool PERM = true, AFTER_DRAIN = false;
    const float* xin; float* xout;
    __device__ __forceinline__ void operator()(const pg8::f32x4 (&acc)[2][2][4][2], const pg8::Unit& u, int wr, int wc, int fr, int fq) const {
        const int col0 = u.pn * 256 + wc * 32 + 8 * fq, row0 = u.pm * 256 + wr * 64 + fr;
#pragma unroll
        for (int ai = 0; ai < 2; ++ai)
#pragma unroll
            for (int m = 0; m < 4; ++m) { const size_t ro = (size_t)(row0 + ai * 128 + m * 16) * DM + col0;
#pragma unroll
                for (int bj = 0; bj < 2; ++bj) { const size_t o = ro + bj * 128;
                    const f32x4 a = *(const f32x4*)(xin + o), b = *(const f32x4*)(xin + o + 4);
                    f32x4 r0, r1;
#pragma unroll
                    for (int i = 0; i < 4; ++i) { r0[i] = a[i] + acc[ai][bj][m][0][i]; r1[i] = b[i] + acc[ai][bj][m][1][i]; }
                    *(f32x4*)(xout + o) = r0; *(f32x4*)(xout + o + 4) = r1; } }
    }
};
struct SchedGate {
    int G, c;
    __device__ __forceinline__ bool next(int i, pg8::Unit& u) const {
        const int tile = c + (i / 6) * G; if (tile >= 256) return false;
        const int s = i % 6, br = s >> 1, pm = tile >> 2, pn = tile & 3;
        if ((s & 1) == 0) { u.pm = pm; u.pn = br * 4 + pn; } else { u.pm = (1 + br) * 64 + pm; u.pn = (3 + br) * 4 + pn; }
        return true;
    }
    __device__ __forceinline__ void a_ready(const pg8::Unit&) const {}
    __device__ __forceinline__ void done(const pg8::Unit&) const {}
};
struct EpiGate {
    static constexpr bool PERM = true, AFTER_DRAIN = false;
    bf16* gsc; float* macc; bf16* merged;
    __device__ __forceinline__ void operator()(const pg8::f32x4 (&acc)[2][2][4][2], const pg8::Unit& u, int wr, int wc, int fr, int fq) const {
        const int j = u.pn >> 2, pn = u.pn & 3, pm = u.pm & 63;
        const int col0 = pn * 256 + wc * 32 + 8 * fq, row0 = pm * 256 + wr * 64 + fr;
#pragma unroll
        for (int ai = 0; ai < 2; ++ai)
#pragma unroll
            for (int m = 0; m < 4; ++m) { const size_t ro = (size_t)(row0 + ai * 128 + m * 16) * DM + col0;
#pragma unroll
                for (int bj = 0; bj < 2; ++bj) { const size_t o = ro + bj * 128; float v[8];
#pragma unroll
                    for (int i = 0; i < 4; ++i) { v[i] = acc[ai][bj][m][0][i]; v[4 + i] = acc[ai][bj][m][1][i]; }
                    if (j < 3) {
#pragma unroll
                        for (int i = 0; i < 8; ++i) v[i] = sigmoidf_(v[i]);
                        *(v4u*)(gsc + o) = pack8(v);
                    } else {
                        float g[8]; unpack8(*(const v4u*)(gsc + o), g);
#pragma unroll
                        for (int i = 0; i < 8; ++i) v[i] *= g[i];
                        if (j > 3) { const f32x4 a = *(const f32x4*)(macc + o), b = *(const f32x4*)(macc + o + 4);
#pragma unroll
                            for (int i = 0; i < 4; ++i) { v[i] += a[i]; v[4 + i] += b[i]; } }
                        if (j < 5) { *(f32x4*)(macc + o) = (f32x4){v[0], v[1], v[2], v[3]}; *(f32x4*)(macc + o + 4) = (f32x4){v[4], v[5], v[6], v[7]}; }
                        else *(v4u*)(merged + o) = pack8(v);
                    } } }
    }
};

__device__ __forceinline__ void transpose_item(const float* __restrict__ W, int ldw, bf16* __restrict__ WT, int K, int nblk, float* scr, int item, int lane) {
    const int kb = item / nblk, nb = item % nblk, k0 = 64 * kb, n0 = 32 * nb;
#pragma unroll 8
    for (int i = 0; i < 32; ++i) { const int kk = 2 * i + (lane >> 5); scr[kk * 33 + (lane & 31)] = W[(size_t)(k0 + kk) * ldw + n0 + (lane & 31)]; }
    LDS_WAIT();
    const int c = lane & 7;
#pragma unroll
    for (int j = 0; j < 4; ++j) { const int n = (lane >> 3) + 8 * j; const float* s = scr + (8 * c) * 33 + n;
        v4u o; o.x = pk2(s[0 * 33], s[1 * 33]); o.y = pk2(s[2 * 33], s[3 * 33]); o.z = pk2(s[4 * 33], s[5 * 33]); o.w = pk2(s[6 * 33], s[7 * 33]);
        *(v4u*)(WT + (size_t)(n0 + n) * K + k0 + 8 * c) = o; }
    LDS_WAIT();
}
__device__ __forceinline__ void rms_row_to_bf16(const float* xrow, const float* w, bf16* orow, int lane) {
    const f32x4* xr = (const f32x4*)xrow + lane; const f32x4* wr = (const f32x4*)w + lane;
    f32x4 v[4]; float s = 0.f;
#pragma unroll
    for (int j = 0; j < 4; ++j) { v[j] = xr[64 * j]; s += (v[j][0] * v[j][0] + v[j][1] * v[j][1]) + (v[j][2] * v[j][2] + v[j][3] * v[j][3]); }
    const float rstd = rsqrtf(wave_sum(s) * (1.f / DM) + EPS);
    unsigned long long* o8 = (unsigned long long*)orow + lane;
#pragma unroll
    for (int j = 0; j < 4; ++j) { const f32x4 ww = wr[64 * j];
        o8[64 * j] = (unsigned long long)pk2(v[j][0] * rstd * ww[0], v[j][1] * rstd * ww[1]) | ((unsigned long long)pk2(v[j][2] * rstd * ww[2], v[j][3] * rstd * ww[3]) << 32); }
}
__device__ __forceinline__ void phase0(unsigned char* lds, const Args& a, int l, const float* xin) {
    const int tid = opaque_tid(), lane = tid & 63, wave = tid >> 6, gw = blockIdx.x * NWAVES + wave, NGW = gridDim.x * NWAVES;
    bf16* Wreg = (bf16*)(a.ws + WS_W);
    const float* w_in = a.in[2] + (size_t)l * DM * IN_DIM;
    {
        float* scr = (float*)lds + wave * (64 * 33);
        const float* w_br = a.in[13] + (size_t)l * 3 * DM * DM; const float* w_out = a.in[14] + (size_t)l * DM * DM;
        const float* w_up = a.in[16] + (size_t)l * DM * DFF; const float* w_down = a.in[17] + (size_t)l * DFF * DM;
        constexpr int NSEG = 17, NIT = NSEG * 512 + 2048 + 2048;
        for (int it = gw; it < NIT; it += NGW) {
            if (it < NSEG * 512) {
                const int seg = it >> 9, r = it & 511;
                const float* W; int ldw; bf16* WT;
                if (seg < 13) {
                    const int co = seg == 0 ? 3072 : seg == 1 ? 4112 : seg == 2 ? 7184 : seg == 3 ? 0 : seg == 4 ? 1024 : seg == 5 ? 2048 : seg == 6 ? 5136 : seg == 7 ? 6160 : seg == 8 ? 8208 : seg == 9 ? 9232
                                 : 10272 + (seg - 10) * 1024;
                    W = w_in + co; ldw = IN_DIM; WT = Wreg + (size_t)seg * DM * DM;
                } else if (seg < 16) { W = w_br + (size_t)(seg - 13) * DM * DM; ldw = DM; WT = Wreg + W_G + (size_t)(3 + seg - 13) * DM * DM; }
                else { W = w_out; ldw = DM; WT = Wreg + W_OUT; }
                transpose_item(W, ldw, WT, DM, 32, scr, r, lane);
            } else if (it < NSEG * 512 + 2048) transpose_item(w_up, DFF, Wreg + W_UP, DM, 128, scr, it - NSEG * 512, lane);
            else transpose_item(w_down, DM, Wreg + W_DOWN, DFF, 32, scr, it - NSEG * 512 - 2048, lane);
        }
    }
    __syncthreads();
    {
        float* Ws = (float*)lds;
        for (int idx = tid; idx < 32 * DM; idx += NTHREADS) { const int k = idx >> 5, c = idx & 31; Ws[c * DM + k] = w_in[(size_t)k * IN_DIM + (c < 16 ? 4096 + c : 10256 + c - 16)]; }
        __syncthreads();
        const float* nw = a.in[1] + (size_t)l * DM;
        bf16* H = (bf16*)a.ws; float* small = (float*)(a.ws + WS_SMALL);
        float p0 = 0.f, p1 = 0.f;
        if (lane < 8) { p0 = __expf(a.in[4][l * 8 + lane]); p1 = a.in[5][l * 8 + lane]; }
        else if (lane >= 16 && lane < 32) { p0 = __expf(a.in[9][l * 16 + lane - 16]); p1 = a.in[10][l * 16 + lane - 16]; }
        for (int m = gw; m < MT; m += NGW) {
            const float* xrow = xin + (size_t)m * DM;
            float xv[16]; float s = 0.f;
#pragma unroll
            for (int i = 0; i < 16; ++i) { xv[i] = xrow[lane + 64 * i]; s += xv[i] * xv[i]; }
            const float rstd = rsqrtf(wave_sum(s) * (1.f / DM) + EPS);
            bf16* hrow = H + (size_t)m * DM;
#pragma unroll
            for (int i = 0; i < 16; ++i) { xv[i] = xv[i] * rstd * nw[lane + 64 * i]; hrow[lane + 64 * i] = (bf16)f2bf(xv[i]); }
            float mine = 0.f;
#pragma unroll 4
            for (int c = 0; c < 32; ++c) { float acc = 0.f;
#pragma unroll
                for (int i = 0; i < 16; ++i) acc += xv[i] * Ws[c * DM + lane + 64 * i];
                acc = wave_sum(acc); mine = (lane == c) ? acc : mine; }
            if (lane < 8) small[(size_t)m * 64 + lane] = -p0 * softplusf_(mine + p1);
            else if (lane < 16) small[(size_t)m * 64 + lane] = sigmoidf_(mine);
            else if (lane < 32) { const float dt = softplusf_(mine + p1); small[(size_t)m * 64 + lane] = dt; small[(size_t)m * 64 + lane + 16] = -p0 * dt; }
        }
    }
}

__device__ __forceinline__ void conv8(const bf16* p, int pos, const float* w, int wstride, const float* bias, float* out) {
    float acc[8];
#pragma unroll
    for (int i = 0; i < 8; ++i) acc[i] = bias ? bias[i] : 0.f;
#pragma unroll
    for (int j = 0; j < 4; ++j) { const int back = 3 - j;
        if (pos - back >= 0) { float xv[8]; unpack8(*(const v4u*)(p - (size_t)back * DM), xv);
            const f32x4 w0 = *(const f32x4*)(w + j * wstride), w1 = *(const f32x4*)(w + j * wstride + 4);
#pragma unroll
            for (int i = 0; i < 4; ++i) { acc[i] += xv[i] * w0[i]; acc[4 + i] += xv[4 + i] * w1[i]; } } }
#pragma unroll
    for (int i = 0; i < 8; ++i) out[i] = siluf_(acc[i]);
}

__device__ __forceinline__ void conv8r(const v4u (&raw)[4], const float* w, int wstride, const float* bias, float* out) {
    float acc[8];
#pragma unroll
    for (int i = 0; i < 8; ++i) acc[i] = bias ? bias[i] : 0.f;
#pragma unroll
    for (int j = 0; j < 4; ++j) { float xv[8]; unpack8(raw[j], xv);
        const f32x4 w0 = *(const f32x4*)(w + j * wstride), w1 = *(const f32x4*)(w + j * wstride + 4);
#pragma unroll
        for (int i = 0; i < 4; ++i) { acc[i] += xv[i] * w0[i]; acc[4 + i] += xv[4 + i] * w1[i]; } }
#pragma unroll
    for (int i = 0; i < 8; ++i) out[i] = siluf_(acc[i]);
}
#define LOAD4(dst, p, pos) do { _Pragma("unroll") for (int j_ = 0; j_ < 4; ++j_) { const int back_ = 3 - j_; \
        if ((pos) - back_ >= 0) dst[j_] = *(const v4u*)((p) - (size_t)back_ * DM); else dst[j_] = (v4u){0u, 0u, 0u, 0u}; } } while (0)

__device__ __forceinline__ void dn_item(unsigned char* lds, const Args& a, int l, int item) {
    const int b = item >> 4, h = (item >> 1) & 7, eh = item & 1;
    float* qs = (float*)lds; float* ks = qs + 32 * 128; float* vs = ks + 32 * 128; float* os = vs + 32 * 64; float* gs = os + 32 * 64; float* bs = gs + 32;
    const int tid = opaque_tid(), e = tid >> 3, ds = tid & 7;
    bf16* base = (bf16*)a.ws;
    const bf16* Q = base + (size_t)B_DNQ * BUFE; const bf16* K = base + (size_t)B_DNK * BUFE; bf16* V = base + (size_t)B_DNV * BUFE;
    const float* small = (const float*)(a.ws + WS_SMALL);
    const float* cw = a.in[3] + (size_t)l * 4 * 3072;
    const size_t rowbase = (size_t)b * SEQ;
    const int tq = tid >> 4, cq = tid & 15, tv = (tid >> 3) & 31, cv = tid & 7;
    f32x2 S2[8];
#pragma unroll
    for (int i = 0; i < 8; ++i) S2[i] = (f32x2){0.f, 0.f};
    v4u rq[4], rk[4], rv[4]; float rg = 0.f, rb = 0.f;
#define DN_LOADS(c_) do { const int t0_ = (c_) * 32; { const int pos_ = t0_ + tq; const size_t off_ = (rowbase + pos_) * DM + h * 128 + cq * 8; LOAD4(rq, Q + off_, pos_); LOAD4(rk, K + off_, pos_); } \
        if (tid < 256) { const int pos_ = t0_ + tv; LOAD4(rv, V + (rowbase + pos_) * DM + h * 128 + eh * 64 + cv * 8, pos_); } \
        else if (tid < 288) { const size_t r_ = rowbase + t0_ + (tid - 256); rg = small[r_ * 64 + h]; rb = small[r_ * 64 + 8 + h]; } } while (0)
    DN_LOADS(0);
    for (int c = 0; c < SEQ / 32; ++c) {
        const int t0 = c * 32;
        {   float q8[8], k8[8];
            conv8r(rq, cw + h * 128 + cq * 8, 3072, nullptr, q8);
            conv8r(rk, cw + 1024 + h * 128 + cq * 8, 3072, nullptr, k8);
            float sq = 0.f, sk = 0.f;
#pragma unroll
            for (int i = 0; i < 8; ++i) { sq += q8[i] * q8[i]; sk += k8[i] * k8[i]; }
            sq = red16(sq); sk = red16(sk);
            const float rqn = rsqrtf(sq + EPS) * 0.08838834764831845f, rkn = rsqrtf(sk + EPS);
            *(f32x4*)(qs + tq * 128 + cq * 8) = (f32x4){q8[0] * rqn, q8[1] * rqn, q8[2] * rqn, q8[3] * rqn}; *(f32x4*)(qs + tq * 128 + cq * 8 + 4) = (f32x4){q8[4] * rqn, q8[5] * rqn, q8[6] * rqn, q8[7] * rqn};
            *(f32x4*)(ks + tq * 128 + cq * 8) = (f32x4){k8[0] * rkn, k8[1] * rkn, k8[2] * rkn, k8[3] * rkn}; *(f32x4*)(ks + tq * 128 + cq * 8 + 4) = (f32x4){k8[4] * rkn, k8[5] * rkn, k8[6] * rkn, k8[7] * rkn};
        }
        if (tid < 256) { float v8[8]; conv8r(rv, cw + 2048 + h * 128 + eh * 64 + cv * 8, 3072, nullptr, v8);
            *(f32x4*)(vs + tv * 64 + cv * 8) = (f32x4){v8[0], v8[1], v8[2], v8[3]}; *(f32x4*)(vs + tv * 64 + cv * 8 + 4) = (f32x4){v8[4], v8[5], v8[6], v8[7]};
        } else if (tid < 288) { gs[tid - 256] = __expf(rg); bs[tid - 256] = rb; }
        __syncthreads();
        if (c > 0) {
            const int e4 = cq * 4; const float* o = os + tq * 64 + e4;
            v2u w; w.x = pk2(o[0], o[1]); w.y = pk2(o[2], o[3]);
            *(v2u*)(V + (rowbase + t0 - 32 + tq) * DM + h * 128 + eh * 64 + e4) = w;
        }
        if (c + 1 < SEQ / 32) DN_LOADS(c + 1);
        __syncthreads();
#pragma unroll 2
        for (int tt = 0; tt < 32; ++tt) {
            f32x4 k4[4], q4[4];
#pragma unroll
            for (int i = 0; i < 4; ++i) { k4[i] = *(const f32x4*)(ks + tt * 128 + 32 * i + 4 * ds); q4[i] = *(const f32x4*)(qs + tt * 128 + 32 * i + 4 * ds); }
            f32x2 ka = {0.f, 0.f}, kb = {0.f, 0.f};
#pragma unroll
            for (int i = 0; i < 4; ++i) { ka += (f32x2){k4[i][0], k4[i][1]} * S2[2 * i]; kb += (f32x2){k4[i][2], k4[i][3]} * S2[2 * i + 1]; }
            ka += kb;
            const float kS = red8(ka[0] + ka[1]);
            const float eg = gs[tt], vn = bs[tt] * (vs[tt * 64 + e] - eg * kS);
            const f32x2 eg2 = {eg, eg}, vn2 = {vn, vn};
            f32x2 oa = {0.f, 0.f}, ob = {0.f, 0.f};
#pragma unroll
            for (int i = 0; i < 4; ++i) {
                S2[2 * i] = eg2 * S2[2 * i] + (f32x2){k4[i][0], k4[i][1]} * vn2; S2[2 * i + 1] = eg2 * S2[2 * i + 1] + (f32x2){k4[i][2], k4[i][3]} * vn2;
                oa += (f32x2){q4[i][0], q4[i][1]} * S2[2 * i]; ob += (f32x2){q4[i][2], q4[i][3]} * S2[2 * i + 1]; }
            oa += ob;
            const float o = red8(oa[0] + oa[1]);
            if (ds == 0) os[tt * 64 + e] = o;
        }
        __syncthreads();
    }
#undef DN_LOADS
    {   const int e4 = cq * 4; const float* o = os + tq * 64 + e4;
        v2u w; w.x = pk2(o[0], o[1]); w.y = pk2(o[2], o[3]);
        *(v2u*)(V + (rowbase + SEQ - 32 + tq) * DM + h * 128 + eh * 64 + e4) = w; }
    __syncthreads();
}

__device__ __forceinline__ void ssm_item(unsigned char* lds, const Args& a, int l, int item) {
    const int b = item >> 4, hd = item & 15, g = hd >> 2;
    float* xs = (float*)lds; float* Bs = xs + 32 * 64; float* Cs = Bs + 32 * 128; float* ys = Cs + 32 * 128; float* dts = ys + 32 * 64; float* das = dts + 32;
    const int tid = opaque_tid(), p = tid >> 3, ns = tid & 7;
    bf16* base = (bf16*)a.ws;
    const bf16* X = base + (size_t)B_SSX * BUFE; const bf16* BC = base + (size_t)B_SSBC * BUFE; bf16* Z = base + (size_t)B_SSZ * BUFE;
    const float* small = (const float*)(a.ws + WS_SMALL);
    const float* cw = a.in[7] + (size_t)l * 4 * 2048; const float* cb = a.in[8] + (size_t)l * 2048;
    const float dskip = a.in[11][l * 16 + hd];
    const size_t rowbase = (size_t)b * SEQ;
    const int tq = tid >> 4, cq = tid & 15, tv = (tid >> 3) & 31, cv = tid & 7;
    f32x2 h2[8];
#pragma unroll
    for (int i = 0; i < 8; ++i) h2[i] = (f32x2){0.f, 0.f};
    v4u rB[4], rC[4], rx[4]; v2u rz; float rdt = 0.f, rda = 0.f;
#define SSM_LOADS(c_) do { const int t0_ = (c_) * 32; { const int pos_ = t0_ + tq; const size_t ro_ = (rowbase + pos_) * DM; LOAD4(rB, BC + ro_ + g * 128 + cq * 8, pos_); LOAD4(rC, BC + ro_ + 512 + g * 128 + cq * 8, pos_); \
            rz = *(const v2u*)(Z + ro_ + hd * 64 + cq * 4); } \
        if (tid < 256) { const int pos_ = t0_ + tv; LOAD4(rx, X + (rowbase + pos_) * DM + hd * 64 + cv * 8, pos_); } \
        else if (tid < 288) { const size_t r_ = rowbase + t0_ + (tid - 256); rdt = small[r_ * 64 + 16 + hd]; rda = small[r_ * 64 + 32 + hd]; } } while (0)
    SSM_LOADS(0);
    for (int c = 0; c < SEQ / 32; ++c) {
        const int t0 = c * 32;
        {   float o8[8];
            conv8r(rB, cw + 1024 + g * 128 + cq * 8, 2048, cb + 1024 + g * 128 + cq * 8, o8);
            *(f32x4*)(Bs + tq * 128 + cq * 8) = (f32x4){o8[0], o8[1], o8[2], o8[3]}; *(f32x4*)(Bs + tq * 128 + cq * 8 + 4) = (f32x4){o8[4], o8[5], o8[6], o8[7]};
            conv8r(rC, cw + 1536 + g * 128 + cq * 8, 2048, cb + 1536 + g * 128 + cq * 8, o8);
            *(f32x4*)(Cs + tq * 128 + cq * 8) = (f32x4){o8[0], o8[1], o8[2], o8[3]}; *(f32x4*)(Cs + tq * 128 + cq * 8 + 4) = (f32x4){o8[4], o8[5], o8[6], o8[7]};
        }
        if (tid < 256) { float o8[8]; conv8r(rx, cw + hd * 64 + cv * 8, 2048, cb + hd * 64 + cv * 8, o8);
            *(f32x4*)(xs + tv * 64 + cv * 8) = (f32x4){o8[0], o8[1], o8[2], o8[3]}; *(f32x4*)(xs + tv * 64 + cv * 8 + 4) = (f32x4){o8[4], o8[5], o8[6], o8[7]};
        } else if (tid < 288) { dts[tid - 256] = rdt; das[tid - 256] = __expf(rda); }
        const v2u zr = rz;
        __syncthreads();
        if (c + 1 < SEQ / 32) SSM_LOADS(c + 1);
#pragma unroll 2
        for (int tt = 0; tt < 32; ++tt) {
            const float dA = das[tt], xv = xs[tt * 64 + p], xdt = xv * dts[tt];
            const f32x2 dA2 = {dA, dA}, xdt2 = {xdt, xdt};
            f32x2 ya = {0.f, 0.f}, yb = {0.f, 0.f};
#pragma unroll
            for (int i = 0; i < 4; ++i) { const f32x4 b4 = *(const f32x4*)(Bs + tt * 128 + 32 * i + 4 * ns), c4 = *(const f32x4*)(Cs + tt * 128 + 32 * i + 4 * ns);
                h2[2 * i] = dA2 * h2[2 * i] + xdt2 * (f32x2){b4[0], b4[1]}; h2[2 * i + 1] = dA2 * h2[2 * i + 1] + xdt2 * (f32x2){b4[2], b4[3]};
                ya += h2[2 * i] * (f32x2){c4[0], c4[1]}; yb += h2[2 * i + 1] * (f32x2){c4[2], c4[3]}; }
            ya += yb;
            const float y = red8(ya[0] + ya[1]);
            if (ns == 0) ys[tt * 64 + p] = y + xv * dskip;
        }
        __syncthreads();
        {   bf16* zp = Z + (rowbase + t0 + tq) * DM + hd * 64 + cq * 4; const float* y = ys + tq * 64 + cq * 4;
            const float z0 = bf2f(zr.x & 0xffffu), z1 = __builtin_bit_cast(float, zr.x & 0xffff0000u), z2 = bf2f(zr.y & 0xffffu), z3 = __builtin_bit_cast(float, zr.y & 0xffff0000u);
            v2u w; w.x = pk2(y[0] * siluf_(z0), y[1] * siluf_(z1)); w.y = pk2(y[2] * siluf_(z2), y[3] * siluf_(z3));
            *(v2u*)zp = w; }
        __syncthreads();
    }
#undef SSM_LOADS
}

__device__ __forceinline__ void sb_item(unsigned char* lds, const Args& a, int b, int hd, int qi) {
    constexpr int LD = 72;
    bf16* Ks = (bf16*)lds; bf16* Vs = Ks + 2 * 64 * LD;
    const int tid = opaque_tid(), w = tid >> 6, lane = tid & 63, fr = lane & 15, fq = lane >> 4;
    bf16* base = (bf16*)a.ws;
    bf16* Qb = base + (size_t)B_SBQ * BUFE; const bf16* Kb = base + (size_t)B_SBK * BUFE; const bf16* Vb = base + (size_t)B_SBV * BUFE;
    const size_t rowbase = (size_t)b * SEQ;
    const int t0 = qi * 128, myq = t0 + w * 16 + fr, wmax = t0 + w * 16 + 15;
    bf16* qrow = Qb + (rowbase + myq) * DM + hd * 64;
    bf16x8 qf[2];
    qf[0] = *(const bf16x8*)(qrow + fq * 8); qf[1] = *(const bf16x8*)(qrow + 32 + fq * 8);
    f32x4 oacc[4];
#pragma unroll
    for (int i = 0; i < 4; ++i) oacc[i] = (f32x4){0.f, 0.f, 0.f, 0.f};
    float carry = 1.f;
    const int kr = tid >> 3, d8 = (tid & 7) * 8;
    v4u kreg, vreg;
    int kt = 2 * (qi + 1) - 1;
#define SB_LOAD(t) do { const size_t o_ = (rowbase + (size_t)(t) * 64 + kr) * DM + hd * 64 + d8; kreg = *(const v4u*)(Kb + o_); vreg = *(const v4u*)(Vb + o_); } while (0)
#define SB_STORE(bu) do { *(v4u*)(Ks + (bu) * 64 * LD + kr * LD + d8) = kreg; bf16* vd_ = Vs + (bu) * 64 * LD + d8 * LD + kr; \
        vd_[0] = (bf16)(vreg.x & 0xffffu); vd_[LD] = (bf16)(vreg.x >> 16); vd_[2 * LD] = (bf16)(vreg.y & 0xffffu); vd_[3 * LD] = (bf16)(vreg.y >> 16); \
        vd_[4 * LD] = (bf16)(vreg.z & 0xffffu); vd_[5 * LD] = (bf16)(vreg.z >> 16); vd_[6 * LD] = (bf16)(vreg.w & 0xffffu); vd_[7 * LD] = (bf16)(vreg.w >> 16); } while (0)
    SB_LOAD(kt); SB_STORE(0);
    __syncthreads();
    int cur = 0;
    for (; kt >= 0; --kt) {
        if (kt > 0) SB_LOAD(kt - 1);
        const int kbase = kt * 64;
        if (kbase <= wmax) {
            const bf16* Kc = Ks + cur * 64 * LD; const bf16* Vc = Vs + cur * 64 * LD;
            f32x4 z[4];
#pragma unroll
            for (int nt = 0; nt < 4; ++nt) { z[nt] = (f32x4){0.f, 0.f, 0.f, 0.f};
#pragma unroll
                for (int k2 = 0; k2 < 2; ++k2) { const bf16x8 af = *(const bf16x8*)(Kc + (nt * 16 + fr) * LD + k2 * 32 + fq * 8);
                    z[nt] = __builtin_amdgcn_mfma_f32_16x16x32_bf16(af, qf[k2], z[nt], 0, 0, 0); } }
            float kp[4][4], sg[4][4], T[4], tot[4], suf[4];
            const bool masked = kbase + 64 > t0 + w * 16;
#pragma unroll
            for (int nt = 0; nt < 4; ++nt) {
#pragma unroll
                for (int j = 0; j < 4; ++j) { const float z2 = z[nt][j] * 0.18033688011112042f;
                    const float ea = __builtin_amdgcn_exp2f(-fabsf(z2)), rc = __builtin_amdgcn_rcpf(1.f + ea); const bool pos = z2 >= 0.f;
                    sg[nt][j] = (pos ? 1.f : ea) * rc; kp[nt][j] = (pos ? ea : 1.f) * rc; }
                if (masked) {
#pragma unroll
                    for (int j = 0; j < 4; ++j) { const bool valid = kbase + nt * 16 + fq * 4 + j < myq; sg[nt][j] = valid ? sg[nt][j] : 0.f; kp[nt][j] = valid ? kp[nt][j] : 1.f; } }
                T[nt] = (kp[nt][0] * kp[nt][1]) * (kp[nt][2] * kp[nt][3]); }
#pragma unroll
            for (int nt = 0; nt < 4; ++nt) { const float p16 = __shfl_xor(T[nt], 16), s1 = T[nt] * p16, p32 = __shfl_xor(s1, 32); tot[nt] = s1 * p32;
                suf[nt] = fq == 0 ? p16 * p32 : fq == 1 ? p32 : fq == 2 ? p16 : 1.f; }
            float run = carry; float wv[4][4];
#pragma unroll
            for (int nt = 3; nt >= 0; --nt) { const float r3 = run * suf[nt], r2 = r3 * kp[nt][3], r1 = r2 * kp[nt][2], r0 = r1 * kp[nt][1];
                wv[nt][0] = sg[nt][0] * r0; wv[nt][1] = sg[nt][1] * r1; wv[nt][2] = sg[nt][2] * r2; wv[nt][3] = sg[nt][3] * r3;
                run *= tot[nt]; }
            carry = run;
#pragma unroll
            for (int kk = 0; kk < 2; ++kk) {
                v4u bw; bw.x = pk2(wv[2 * kk][0], wv[2 * kk][1]); bw.y = pk2(wv[2 * kk][2], wv[2 * kk][3]); bw.z = pk2(wv[2 * kk + 1][0], wv[2 * kk + 1][1]); bw.w = pk2(wv[2 * kk + 1][2], wv[2 * kk + 1][3]);
                const bf16x8 bfr = __builtin_bit_cast(bf16x8, bw);
#pragma unroll
                for (int mt = 0; mt < 4; ++mt) { const bf16* vp = Vc + (mt * 16 + fr) * LD + 32 * kk + 4 * fq;
                    const v2u lo = *(const v2u*)vp, hi = *(const v2u*)(vp + 16);
                    v4u av; av.x = lo.x; av.y = lo.y; av.z = hi.x; av.w = hi.y;
                    oacc[mt] = __builtin_amdgcn_mfma_f32_16x16x32_bf16(__builtin_bit_cast(bf16x8, av), bfr, oacc[mt], 0, 0, 0); }
            }
        }
        if (kt > 0) SB_STORE(cur ^ 1);
        __syncthreads();
        cur ^= 1;
    }
#undef SB_LOAD
#undef SB_STORE
#pragma unroll
    for (int mt = 0; mt < 4; ++mt) { v2u wq; wq.x = pk2(oacc[mt][0], oacc[mt][1]); wq.y = pk2(oacc[mt][2], oacc[mt][3]); *(v2u*)(qrow + mt * 16 + fq * 4) = wq; }
}

__device__ __forceinline__ void phase_mixers(unsigned char* lds, const Args& a, int l, unsigned long long& probe_acc) {
    unsigned* counter = (unsigned*)(a.ws + WS_CTL) + 64 * l;
    volatile unsigned* slot = (volatile unsigned*)(lds + LDS_BYTES - 64);
    constexpr unsigned NITEMS = 128 + 128 + 2048;
    for (;;) {
        if (threadIdx.x == 0) *slot = __hip_atomic_fetch_add(counter, 1u, __ATOMIC_RELAXED, __HIP_MEMORY_SCOPE_AGENT);
        __syncthreads();
        const unsigned item = *slot;
        __syncthreads();
        if (item >= NITEMS) break;
        PT0();
        if (item < 128) { dn_item(lds, a, l, (int)item); if (item == 0) PT1(9); }
        else if (item < 256) { ssm_item(lds, a, l, (int)item - 128); if (item == 128) PT1(10); }
        else { const int r = (int)item - 256, qi = 15 - (r >> 7), bh = r & 127; sb_item(lds, a, bh >> 4, bh & 15, qi); if (item == 256) PT1(11); }
    }
}

__device__ __forceinline__ void phase_norms(const Args& a, int l) {
    const int tid = opaque_tid(), lane = tid & 63, wave = tid >> 6, gw = blockIdx.x * NWAVES + wave, NGW = gridDim.x * NWAVES;
    bf16* base = (bf16*)a.ws;
    const bf16* Oraw = base + (size_t)B_DNV * BUFE; bf16* G = base + (size_t)B_DNG * BUFE; bf16* Y = base + (size_t)B_SSZ * BUFE;
    const float* dnw = a.in[6] + (size_t)l * 128 + (lane & 7) * 16; const float* snw = a.in[12] + (size_t)l * DM + lane * 16;
    float w1[16], w2[16];
#pragma unroll
    for (int i = 0; i < 16; ++i) { w1[i] = dnw[i]; w2[i] = snw[i]; }
    for (int m = gw; m < MT; m += NGW) {
        const size_t o = (size_t)m * DM + lane * 16;
        float v[16], g[16];
        unpack8(*(const v4u*)(Oraw + o), v); unpack8(*(const v4u*)(Oraw + o + 8), v + 8);
        unpack8(*(const v4u*)(G + o), g); unpack8(*(const v4u*)(G + o + 8), g + 8);
        float s = 0.f;
#pragma unroll
        for (int i = 0; i < 16; ++i) s += v[i] * v[i];
        s = red8(s);
        float r = rsqrtf(s * (1.f / 128.f) + EPS);
#pragma unroll
        for (int i = 0; i < 16; ++i) v[i] = v[i] * r * w1[i] * siluf_(g[i]);
        *(v4u*)(G + o) = pack8(v); *(v4u*)(G + o + 8) = pack8(v + 8);
        unpack8(*(const v4u*)(Y + o), v); unpack8(*(const v4u*)(Y + o + 8), v + 8);
        s = 0.f;
#pragma unroll
        for (int i = 0; i < 16; ++i) s += v[i] * v[i];
        s = red16(s);
        r = rsqrtf(s * (1.f / 256.f) + EPS);
#pragma unroll
        for (int i = 0; i < 16; ++i) v[i] = v[i] * r * w2[i];
        *(v4u*)(Y + o) = pack8(v); *(v4u*)(Y + o + 8) = pack8(v + 8);
    }
}

__global__ void __launch_bounds__(NTHREADS, 2) hybrid_fwd(Args a) {
    extern __shared__ __attribute__((aligned(16))) unsigned char lds[];
    cg::grid_group grid = cg::this_grid();
    bf16* base = (bf16*)a.ws; bf16* Wreg = (bf16*)(a.ws + WS_W);
    PG8_LAS unsigned char* ldsl = (PG8_LAS unsigned char*)lds;
    unsigned long long probe_acc = 0ull;
    if (blockIdx.x == 0 && threadIdx.x < 2) __hip_atomic_store((unsigned*)(a.ws + WS_CTL) + 64 * threadIdx.x, 0u, __ATOMIC_RELAXED, __HIP_MEMORY_SCOPE_AGENT);
#pragma unroll 1
    for (int l = 0; l < 2; ++l) {
        asm volatile("" : "+s"(l));
        const float* xin = l == 0 ? a.in[0] : a.out;
        { PT0(); phase0(lds, a, l, xin);
        grid.sync(); PT1(0); }
        {   pg8::Gemm g{base, Wreg + W_IN, MT, 10240, DM}; pg8::StaticOrder S; S.init(MT, 10240, (int)gridDim.x, (int)blockIdx.x);
            EpiRoute E{base};
            PT0(); pg8::gemm_phase<EpiRoute, pg8::StaticOrder, false, true>(ldsl, g, S, E);
        grid.sync(); PT1(1); }
        { PT0(); phase_mixers(lds, a, l, probe_acc);
        grid.sync(); PT1(2); }
        { PT0(); phase_norms(a, l);
        grid.sync(); PT1(3); }
        {   pg8::Gemm g{base, Wreg + W_G, 4 * MT, 6144, DM}; SchedGate S{(int)gridDim.x, (int)blockIdx.x};
            EpiGate E{base + (size_t)B_SBK * BUFE, (float*)(base + (size_t)B_DNK * BUFE), base + (size_t)B_DNQ * BUFE};
            PT0(); pg8::gemm_phase<EpiGate, SchedGate, false, true>(ldsl, g, S, E);
        grid.sync(); PT1(4); }
        {   pg8::Gemm g{base + (size_t)B_DNQ * BUFE, Wreg + W_OUT, MT, DM, DM}; pg8::StaticOrder S; S.init(MT, DM, (int)gridDim.x, (int)blockIdx.x);
            EpiResid E{xin, a.out};
            PT0(); pg8::gemm_phase<EpiResid, pg8::StaticOrder, false, true>(ldsl, g, S, E);
        grid.sync(); PT1(5); }
        {   const float* nw = a.in[15] + (size_t)l * DM;
            const int tid = opaque_tid(), lane = tid & 63, gw = blockIdx.x * NWAVES + (tid >> 6), NGW = gridDim.x * NWAVES;
            PT0(); for (int m = gw; m < MT; m += NGW) rms_row_to_bf16(a.out + (size_t)m * DM, nw, base + (size_t)m * DM, lane);
        grid.sync(); PT1(6); }
        {   pg8::Gemm g{base, Wreg + W_UP, MT, DFF, DM}; pg8::StaticOrder S; S.init(MT, DFF, (int)gridDim.x, (int)blockIdx.x);
            EpiRelu2 E{base + (size_t)B_DNQ * BUFE};
            PT0(); pg8::gemm_phase<EpiRelu2, pg8::StaticOrder, false, true>(ldsl, g, S, E);
        grid.sync(); PT1(7); }
        {   pg8::Gemm g{base + (size_t)B_DNQ * BUFE, Wreg + W_DOWN, MT, DM, DFF}; pg8::StaticOrder S; S.init(MT, DM, (int)gridDim.x, (int)blockIdx.x);
            EpiResid E{a.out, a.out};
            PT0(); pg8::gemm_phase<EpiResid, pg8::StaticOrder, false, true>(ldsl, g, S, E);
        grid.sync(); PT1(8); }
    }
    {
        const float* nw = a.in[18];
        const int tid = opaque_tid(), lane = tid & 63, gw = blockIdx.x * NWAVES + (tid >> 6), NGW = gridDim.x * NWAVES;
        for (int m = gw; m < MT; m += NGW) {
            f32x4* xr = (f32x4*)(a.out + (size_t)m * DM) + lane; const f32x4* wr = (const f32x4*)nw + lane;
            f32x4 v[4]; float s = 0.f;
#pragma unroll
            for (int j = 0; j < 4; ++j) { v[j] = xr[64 * j]; s += (v[j][0] * v[j][0] + v[j][1] * v[j][1]) + (v[j][2] * v[j][2] + v[j][3] * v[j][3]); }
            const float rstd = rsqrtf(wave_sum(s) * (1.f / DM) + EPS);
#pragma unroll
            for (int j = 0; j < 4; ++j) { const f32x4 ww = wr[64 * j]; f32x4 r;
#pragma unroll
                for (int i = 0; i < 4; ++i) r[i] = v[j][i] * rstd * ww[i];
                xr[64 * j] = r; }
        }
    }
    if (PROBE_SEL) { const unsigned long long t0 = rt(); while (rt() - t0 < probe_acc) __builtin_amdgcn_s_sleep(8); }
}

extern "C" void kernel_launch(void* const* d_in, const int* in_sizes, int n_in, void* d_out, int out_size, void* d_ws, size_t ws_size, hipStream_t stream) {
    static int grid = 0;
    if (grid == 0) {
        if (n_in != 19 || out_size != MT * DM || ws_size < WS_NEED) { fprintf(stderr, "kernel_launch: unexpected shapes (n_in %d out %d ws %zu need %zu)\n", n_in, out_size, ws_size, (size_t)WS_NEED); grid = -1; return; }
        int dev = 0, cus = 0, per_cu = 0;
        hipGetDevice(&dev); hipDeviceGetAttribute(&cus, hipDeviceAttributeMultiprocessorCount, dev);
        if (hipFuncSetAttribute((const void*)hybrid_fwd, hipFuncAttributeMaxDynamicSharedMemorySize, LDS_BYTES) != hipSuccess) { fprintf(stderr, "kernel_launch: hipFuncSetAttribute failed\n"); grid = -1; return; }
        if (hipOccupancyMaxActiveBlocksPerMultiprocessor(&per_cu, (const void*)hybrid_fwd, NTHREADS, LDS_BYTES) != hipSuccess || per_cu < 1) { fprintf(stderr, "kernel_launch: occupancy query gave %d\n", per_cu); per_cu = 1; }
        (void)hipGetLastError();
        grid = cus * per_cu;
    }
    if (grid < 0) return;
    Args a{};
    for (int i = 0; i < 19; ++i) a.in[i] = (const float*)d_in[i];
    a.out = (float*)d_out; a.ws = (unsigned char*)d_ws;
    void* args[] = {&a};
    hipError_t e = hipLaunchCooperativeKernel((const void*)hybrid_fwd, dim3(grid), dim3(NTHREADS), args, LDS_BYTES, stream);
    if (e != hipSuccess) fprintf(stderr, "cooperative launch failed: %s (grid %d)\n", hipGetErrorString(e), grid);
}
```

```cpp
#include <hip/hip_runtime.h>
#include <hip/hip_cooperative_groups.h>
#include <cstdio>
#include <cstdint>
namespace cg = cooperative_groups;
__device__ __forceinline__ int opaque_tid() { int t = (int)threadIdx.x; asm volatile("" : "+v"(t)); return t; }
namespace pg8 {
#define PG8_LAS __attribute__((address_space(3)))
typedef unsigned short bf16_t;
typedef short bf16x8 __attribute__((ext_vector_type(8)));
typedef float f32x4 __attribute__((ext_vector_type(4)));
typedef unsigned u32x4 __attribute__((ext_vector_type(4)));
constexpr int BM = 256, BK = 64, HALF = 128, HTB = HALF * BK * 2  , STAGE_BYTES = 8 * HTB, NXCD = 8, WGM = 8;

__host__ __device__ __forceinline__ int lds_byte(int r, int c) { const int st = (r >> 4) * 2 + (c >> 5), rr = r & 15, cc = c & 31, ob = rr * 64 + cc * 2; return st * 1024 + (ob ^ (((ob >> 9) & 1) << 5)); }
__host__ __device__ __forceinline__ void stage_rc(int b, int& R, int& C) { const int st = b / 1024, sb = b % 1024, swz = sb ^ (((sb >> 9) & 1) << 5); R = (st >> 1) * 16 + swz / 64; C = (st & 1) * 32 + (swz % 64) / 2; }
__host__ __device__ __forceinline__ int perm32(int rho) { const int n = rho >> 4, i = rho & 15; return 8 * (i >> 2) + 4 * n + (i & 3); }

struct Unit { int pm, pn; };
struct Gemm { const bf16_t* A; const bf16_t* Bt; int M, N, K; };

struct StaticOrder {
    int nM, nN, nwg, G, c;
    __host__ __device__ void init(int M, int N, int G_, int c_) { nM = M / BM; nN = N / BM; nwg = nM * nN; G = G_; c = c_; }
    __host__ __device__ bool next(int i, Unit& u) const {
        const long L = (long)i * G + c; if (L >= nwg) return false;
        int wgid = (int)L; { const int q = nwg / NXCD, r = nwg % NXCD, xcd = wgid % NXCD, off = wgid / NXCD; wgid = (xcd < r ? xcd * (q + 1) : r * (q + 1) + (xcd - r) * q) + off; }
        const int nig = WGM * nN, gid = wgid / nig, fm = gid * WGM, gsz = (nM - fm) < WGM ? (nM - fm) : WGM;
        u.pm = fm + ((wgid % nig) % gsz); u.pn = (wgid % nig) / gsz; return true;
    }
    __device__ __forceinline__ void a_ready(const Unit&) const {}
    __device__ __forceinline__ void done(const Unit&) const {}
};
__device__ __forceinline__ unsigned cvt_pk_bf16(float lo, float hi) { unsigned r; asm volatile("v_cvt_pk_bf16_f32 %0, %1, %2" : "=v"(r) : "v"(lo), "v"(hi)); return r; }
template <class Epi, class Sched, bool ALIGN_EPI = false, bool SP2 = false>
__device__ __forceinline__ void gemm_phase(PG8_LAS unsigned char* lds, const Gemm g, const Sched& S, const Epi& E) {
    const int tid = opaque_tid(), wid = __builtin_amdgcn_readfirstlane(tid >> 6), lane = tid & 63, wr = wid >> 2, wc = wid & 3, fr = lane & 15, fq = lane >> 4;
    const int K = g.K, nt = K / BK;
    unsigned voffA[2], voffB[2];
#pragma unroll
    for (int i = 0; i < 2; ++i) { int R, C; stage_rc(tid * 16 + i * 8192, R, C); const int Rb = Epi::PERM ? ((R & ~31) + perm32(R & 31)) : R;
        voffA[i] = (unsigned)(R * K + C) * 2u; voffB[i] = (unsigned)(Rb * K + C) * 2u; }
    const size_t kstep = (size_t)(BK * 2);
    const size_t hstep = (size_t)HALF * K * 2;
    const size_t tstep = 2 * hstep;
    const unsigned ldsw = (unsigned)wid * 1024u;
    const int aoff = lds_byte(wr * 64 + fr, fq * 8), boff = lds_byte(wc * 32 + fr, fq * 8);
#define PG8_SA(b, h) (((b) * 2 + (h)) * HTB)
#define PG8_SB(b, h) ((4 + (b) * 2 + (h)) * HTB)
#define PG8_STAGE(bufoff, gbase, voff) do { _Pragma("unroll") for (int _i = 0; _i < 2; ++_i) \
        __builtin_amdgcn_global_load_lds((const unsigned*)((const char*)(gbase) + (voff)[_i]), (PG8_LAS unsigned*)(lds + (bufoff) + ldsw + _i * 8192), 16, 0, 0); } while (0)
#define PG8_LDA(dst, b, h) do { _Pragma("unroll") for (int m = 0; m < 4; ++m) _Pragma("unroll") for (int k = 0; k < 2; ++k) dst[m][k] = *(const PG8_LAS bf16x8*)(lds + PG8_SA(b, h) + aoff + m * 2048 + k * 1024); } while (0)
#define PG8_LDB(dst, b, h) do { _Pragma("unroll") for (int n = 0; n < 2; ++n) _Pragma("unroll") for (int k = 0; k < 2; ++k) dst[n][k] = *(const PG8_LAS bf16x8*)(lds + PG8_SB(b, h) + boff + n * 2048 + k * 1024); } while (0)
#define PG8_MMA(ai, bj, At, Bt) do { __builtin_amdgcn_s_setprio(1); _Pragma("unroll") for (int m = 0; m < 4; ++m) _Pragma("unroll") for (int n = 0; n < 2; ++n) _Pragma("unroll") for (int k = 0; k < 2; ++k) \
        acc[ai][bj][m][n] = __builtin_amdgcn_mfma_f32_16x16x32_bf16(Bt[n][k], At[m][k], acc[ai][bj][m][n], 0, 0, 0); __builtin_amdgcn_s_setprio(0); } while (0)
#define PG8_WAIT_V(n) asm volatile("s_waitcnt vmcnt(" #n ")" ::: "memory")
#define PG8_WAIT_L(n) asm volatile("s_waitcnt lgkmcnt(" #n ")" ::: "memory")
#define PG8_BAR __builtin_amdgcn_s_barrier()
#define PG8_SCHED __builtin_amdgcn_sched_barrier(0)
    Unit cur, nxt; int ui = 0;
    if (!S.next(0, cur)) return;
    f32x4 acc[2][2][4][2];
#pragma unroll
    for (int a = 0; a < 2; ++a)
#pragma unroll
        for (int b = 0; b < 2; ++b)
#pragma unroll
            for (int m = 0; m < 4; ++m)
#pragma unroll
                for (int n = 0; n < 2; ++n) acc[a][b][m][n] = (f32x4){0.f, 0.f, 0.f, 0.f};
    bf16x8 At[4][2], B0[2][2], B1[2][2];
    const char* cA = (const char*)g.A + (size_t)cur.pm * tstep; const char* cB = (const char*)g.Bt + (size_t)cur.pn * tstep;
    S.a_ready(cur);
    if constexpr (SP2) {
        PG8_STAGE(PG8_SB(0, 0), cB, voffB); PG8_STAGE(PG8_SB(0, 1), cB + hstep, voffB); PG8_STAGE(PG8_SA(0, 0), cA, voffA); PG8_STAGE(PG8_SA(0, 1), cA + hstep, voffA);
        if (wr == 1) PG8_BAR;
        PG8_WAIT_V(2); PG8_BAR;
        PG8_STAGE(PG8_SB(1, 0), cB + kstep, voffB); PG8_STAGE(PG8_SA(1, 0), cA + kstep, voffA); PG8_STAGE(PG8_SB(1, 1), cB + hstep + kstep, voffB);
        PG8_WAIT_V(6); PG8_BAR;
    } else {
        PG8_STAGE(PG8_SB(0, 0), cB, voffB); PG8_STAGE(PG8_SA(0, 0), cA, voffA); PG8_STAGE(PG8_SB(0, 1), cB + hstep, voffB); PG8_STAGE(PG8_SA(0, 1), cA + hstep, voffA);
        if (wr == 1) PG8_BAR;
        PG8_WAIT_V(4); PG8_BAR;
        PG8_STAGE(PG8_SB(1, 0), cB + kstep, voffB); PG8_STAGE(PG8_SA(1, 0), cA + kstep, voffA); PG8_STAGE(PG8_SB(1, 1), cB + hstep + kstep, voffB);
        PG8_WAIT_V(6); PG8_BAR;
    }
    for (;;) {
        const bool has_next = S.next(ui + 1, nxt);
        const char* nA = has_next ? (const char*)g.A + (size_t)nxt.pm * tstep : cA; const char* nB = has_next ? (const char*)g.Bt + (size_t)nxt.pn * tstep : cB;
        for (int t = 0; t < nt; t += 2) {
            const bool last = (t == nt - 2);
            const char* a1 = cA + (size_t)(t + 1) * kstep;
            const char* a2 = last ? nA : cA + (size_t)(t + 2) * kstep; const char* b2 = last ? nB : cB + (size_t)(t + 2) * kstep;
            const char* a3 = a2 + kstep; const char* b3 = b2 + kstep;
            if (last && has_next) S.a_ready(nxt);
            if constexpr (SP2) {
            PG8_LDB(B0, 0, 0); PG8_LDB(B1, 0, 1); PG8_SCHED; PG8_LDA(At, 0, 0); PG8_STAGE(PG8_SA(1, 1), a1 + hstep, voffA);
            PG8_WAIT_V(8); PG8_WAIT_L(0); PG8_BAR; PG8_MMA(0, 0, At, B0); PG8_MMA(0, 1, At, B1); PG8_BAR; PG8_SCHED;
            PG8_LDA(At, 0, 1); PG8_STAGE(PG8_SB(0, 0), b2, voffB); PG8_STAGE(PG8_SB(0, 1), b2 + hstep, voffB); PG8_STAGE(PG8_SA(0, 0), a2, voffA);
            PG8_WAIT_V(8); PG8_WAIT_L(0); PG8_BAR; PG8_MMA(1, 0, At, B0); PG8_MMA(1, 1, At, B1); PG8_BAR; PG8_SCHED;
            PG8_LDB(B0, 1, 0); PG8_LDB(B1, 1, 1); PG8_SCHED; PG8_LDA(At, 1, 0); PG8_STAGE(PG8_SA(0, 1), a2 + hstep, voffA);
            PG8_WAIT_V(8); PG8_WAIT_L(0); PG8_BAR; PG8_MMA(0, 0, At, B0); PG8_MMA(0, 1, At, B1); PG8_BAR; PG8_SCHED;
            PG8_LDA(At, 1, 1); PG8_STAGE(PG8_SB(1, 0), b3, voffB); PG8_STAGE(PG8_SB(1, 1), b3 + hstep, voffB); PG8_STAGE(PG8_SA(1, 0), a3, voffA);
            PG8_WAIT_V(8); PG8_WAIT_L(0); PG8_BAR; PG8_MMA(1, 0, At, B0); PG8_MMA(1, 1, At, B1); PG8_BAR; PG8_SCHED;
            } else {
            PG8_LDB(B0, 0, 0); PG8_SCHED; PG8_LDA(At, 0, 0); PG8_STAGE(PG8_SA(1, 1), a1 + hstep, voffA);
            PG8_WAIT_L(8); PG8_BAR; PG8_WAIT_L(0); PG8_MMA(0, 0, At, B0); PG8_BAR; PG8_SCHED;
            PG8_LDB(B1, 0, 1); PG8_STAGE(PG8_SB(0, 0), b2, voffB);
            PG8_BAR; PG8_WAIT_L(0); PG8_MMA(0, 1, At, B1); PG8_BAR;
            PG8_LDA(At, 0, 1); PG8_STAGE(PG8_SA(0, 0), a2, voffA);
            PG8_BAR; PG8_WAIT_L(0); PG8_MMA(1, 0, At, B0); PG8_BAR; PG8_SCHED;
            PG8_STAGE(PG8_SB(0, 1), b2 + hstep, voffB);
            PG8_WAIT_V(6); PG8_BAR; PG8_MMA(1, 1, At, B1); PG8_BAR;
            PG8_LDB(B0, 1, 0); PG8_SCHED; PG8_LDA(At, 1, 0); PG8_STAGE(PG8_SA(0, 1), a2 + hstep, voffA);
            PG8_WAIT_L(8); PG8_BAR; PG8_WAIT_L(0); PG8_MMA(0, 0, At, B0); PG8_BAR; PG8_SCHED;
            PG8_LDB(B1, 1, 1); PG8_STAGE(PG8_SB(1, 0), b3, voffB);
            PG8_BAR; PG8_WAIT_L(0); PG8_MMA(0, 1, At, B1); PG8_BAR;
            PG8_LDA(At, 1, 1); PG8_STAGE(PG8_SA(1, 0), a3, voffA);
            PG8_BAR; PG8_WAIT_L(0); PG8_MMA(1, 0, At, B0); PG8_BAR; PG8_SCHED;
            PG8_STAGE(PG8_SB(1, 1), b3 + hstep, voffB);
            PG8_WAIT_V(6); PG8_BAR; PG8_MMA(1, 1, At, B1); PG8_BAR;
            }
        }
        if constexpr (ALIGN_EPI) { if (wr == 0) PG8_BAR; }
        if constexpr (!Epi::AFTER_DRAIN) { E(acc, cur, wr, wc, fr, fq); S.done(cur); }
        if (!has_next) break;
#pragma unroll
        for (int a = 0; a < 2; ++a)
#pragma unroll
            for (int b = 0; b < 2; ++b)
#pragma unroll
                for (int m = 0; m < 4; ++m)
#pragma unroll
                    for (int n = 0; n < 2; ++n) acc[a][b][m][n] = (f32x4){0.f, 0.f, 0.f, 0.f};
        cur = nxt; cA = nA; cB = nB; ++ui;
        if constexpr (ALIGN_EPI) { if (wr == 1) PG8_BAR; }
    }
    PG8_WAIT_V(0);
    if constexpr (!ALIGN_EPI) { if (wr == 0) PG8_BAR; }
    PG8_BAR;
    if constexpr (Epi::AFTER_DRAIN) { E.fused(acc, cur, wr, wc, fr, fq, lds, wid, lane); S.done(cur); }
#undef PG8_SA
#undef PG8_SB
#undef PG8_STAGE
#undef PG8_LDA
#undef PG8_LDB
#undef PG8_MMA
#undef PG8_WAIT_V
#undef PG8_WAIT_L
#undef PG8_BAR
#undef PG8_SCHED
}
}

constexpr int NB = 8, SEQ = 2048, DM = 1024, MT = NB * SEQ, DFF = 4096, IN_DIM = 13344;
constexpr int NTHREADS = 512, NWAVES = 8, LDS_BYTES = 147456;
constexpr float EPS = 1e-6f;
typedef unsigned short bf16;
typedef unsigned v4u __attribute__((ext_vector_type(4)));
typedef unsigned v2u __attribute__((ext_vector_type(2)));
typedef float f32x4 __attribute__((ext_vector_type(4)));
typedef short bf16x8 __attribute__((ext_vector_type(8)));
enum { B_H = 0, B_DNG = 1, B_SBQ = 2, B_SSZ = 3, B_DNQ = 4, B_DNK = 5, B_DNV = 6, B_SBK = 7, B_SBV = 8, B_SSX = 9, B_SSBC = 10, NBUF = 11 };
constexpr size_t BUFE = (size_t)MT * DM;
constexpr size_t WS_W = NBUF * BUFE * 2;
constexpr size_t W_IN = 0, W_G = W_IN + (size_t)10240 * 1024, W_OUT = W_G + (size_t)6144 * 1024, W_UP = W_OUT + (size_t)1024 * 1024,
                 W_DOWN = W_UP + (size_t)4096 * 1024, W_END = W_DOWN + (size_t)4096 * 1024;
constexpr size_t WS_SMALL = WS_W + W_END * 2;
constexpr size_t WS_CTL = WS_SMALL + (size_t)MT * 64 * 4;
constexpr size_t WS_NEED = WS_CTL + 4096;

__device__ __forceinline__ float bf2f(unsigned u) { return __builtin_bit_cast(float, u << 16); }
__device__ __forceinline__ unsigned f2bf(float f) { unsigned u = __builtin_bit_cast(unsigned, f); return (u + 0x7fffu + ((u >> 16) & 1u)) >> 16; }
typedef float f32x2 __attribute__((ext_vector_type(2)));
typedef __bf16 bf16x2_t __attribute__((ext_vector_type(2)));
__device__ __forceinline__ unsigned pk2(float lo, float hi) { f32x2 v = {lo, hi}; return __builtin_bit_cast(unsigned, __builtin_convertvector(v, bf16x2_t)); }
__device__ __forceinline__ void unpack8(v4u r, float* o) {
    o[0] = bf2f(r.x & 0xffffu); o[1] = __builtin_bit_cast(float, r.x & 0xffff0000u); o[2] = bf2f(r.y & 0xffffu); o[3] = __builtin_bit_cast(float, r.y & 0xffff0000u);
    o[4] = bf2f(r.z & 0xffffu); o[5] = __builtin_bit_cast(float, r.z & 0xffff0000u); o[6] = bf2f(r.w & 0xffffu); o[7] = __builtin_bit_cast(float, r.w & 0xffff0000u);
}
__device__ __forceinline__ v4u pack8(const float* v) { v4u w; w.x = pk2(v[0], v[1]); w.y = pk2(v[2], v[3]); w.z = pk2(v[4], v[5]); w.w = pk2(v[6], v[7]); return w; }
__device__ __forceinline__ float sigmoidf_(float x) { return 1.f / (1.f + __expf(-x)); }
__device__ __forceinline__ float siluf_(float x) { return x / (1.f + __expf(-x)); }
__device__ __forceinline__ float softplusf_(float x) { return fmaxf(x, 0.f) + log1pf(__expf(-fabsf(x))); }
template <int CTRL> __device__ __forceinline__ float dppf(float v) { return __builtin_bit_cast(float, __builtin_amdgcn_update_dpp(0, __builtin_bit_cast(int, v), CTRL, 0xF, 0xF, true)); }
__device__ __forceinline__ float red8(float v) { v += dppf<0xB1>(v); v += dppf<0x4E>(v); v += dppf<0x141>(v); return v; }
__device__ __forceinline__ float red16(float v) { v = red8(v); v += dppf<0x140>(v); return v; }
__device__ __forceinline__ float wave_sum(float v) {
#pragma unroll
    for (int o = 1; o < 64; o <<= 1) v += __shfl_xor(v, o);
    return v;
}
#define LDS_WAIT() asm volatile("s_waitcnt lgkmcnt(0)" ::: "memory")

struct Args { const float* in[19]; float* out; unsigned char* ws; };
#ifndef PROBE_SEL
#define PROBE_SEL 0
#endif
__device__ __forceinline__ unsigned long long rt() { return __builtin_amdgcn_s_memrealtime(); }
#define PT0() unsigned long long pt_ = PROBE_SEL ? rt() : 0ull
#define PT1(k) do { if (PROBE_SEL & (1 << (k))) probe_acc += rt() - pt_; } while (0)

struct EpiRoute {
    static constexpr bool PERM = true, AFTER_DRAIN = false;
    bf16* base;
    __device__ __forceinline__ void operator()(const pg8::f32x4 (&acc)[2][2][4][2], const pg8::Unit& u, int wr, int wc, int fr, int fq) const {
        bf16* O = base + (size_t)(1 + (u.pn >> 2)) * BUFE;
        const int col0 = (u.pn & 3) * 256 + wc * 32 + 8 * fq, row0 = u.pm * 256 + wr * 64 + fr;
#pragma unroll
        for (int ai = 0; ai < 2; ++ai)
#pragma unroll
            for (int m = 0; m < 4; ++m) { bf16* rowp = O + (size_t)(row0 + ai * 128 + m * 16) * DM + col0;
#pragma unroll
                for (int bj = 0; bj < 2; ++bj) { const pg8::f32x4 v0 = acc[ai][bj][m][0], v1 = acc[ai][bj][m][1];
                    v4u w; w.x = pk2(v0[0], v0[1]); w.y = pk2(v0[2], v0[3]); w.z = pk2(v1[0], v1[1]); w.w = pk2(v1[2], v1[3]);
                    *(v4u*)(rowp + bj * 128) = w; } }
    }
};
struct EpiRelu2 {
    static constexpr bool PERM = true, AFTER_DRAIN = false;
    bf16* O;
    __device__ __forceinline__ void operator()(const pg8::f32x4 (&acc)[2][2][4][2], const pg8::Unit& u, int wr, int wc, int fr, int fq) const {
        const int col0 = u.pn * 256 + wc * 32 + 8 * fq, row0 = u.pm * 256 + wr * 64 + fr;
#pragma unroll
        for (int ai = 0; ai < 2; ++ai)
#pragma unroll
            for (int m = 0; m < 4; ++m) { bf16* rowp = O + (size_t)(row0 + ai * 128 + m * 16) * DFF + col0;
#pragma unroll
                for (int bj = 0; bj < 2; ++bj) { float v[8];
#pragma unroll
                    for (int i = 0; i < 4; ++i) { float a = fmaxf(acc[ai][bj][m][0][i], 0.f), b = fmaxf(acc[ai][bj][m][1][i], 0.f); v[i] = a * a; v[4 + i] = b * b; }
                    *(v4u*)(rowp + bj * 128) = pack8(v); } }
    }
};
struct EpiResid {
    static constexpr bool PERM = true, AFTER_DRAIN = false;
    const float* xin; float* xout;
    __device__ __forceinline__ void operator()(const pg8::f32x4 (&acc)[2][2][4][2], const pg8::Unit& u, int wr, int wc, int fr, int fq) const {
        const int col0 = u.pn * 256 + wc * 32 + 8 * fq, row0 = u.pm * 256 + wr * 64 + fr;
#pragma unroll
        for (int ai = 0; ai < 2; ++ai)
#pragma unroll
            for (int m = 0; m < 4; ++m) { const size_t ro = (size_t)(row0 + ai * 128 + m * 16) * DM + col0;
#pragma unroll
                for (int bj = 0; bj < 2; ++bj) { const size_t o = ro + bj * 128;
                    const f32x4 a = *(const f32x4*)(xin + o), b = *(const f32x4*)(xin + o + 4);
                    f32x4 r0, r1;
#pragma unroll
                    for (int i = 0; i < 4; ++i) { r0[i] = a[i] + acc[ai][bj][m][0][i]; r1[i] = b[i] + acc[ai][bj][m][1][i]; }
                    *(f32x4*)(xout + o) = r0; *(f32x4*)(xout + o + 4) = r1; } }
    }
};
struct SchedGate {
    int G, c;
    __device__ __forceinline__ bool next(int i, pg8::Unit& u) const {
        const int tile = c + (i / 6) * G; if (tile >= 256) return false;
        const int s = i % 6, br = s >> 1, pm = tile >> 2, pn = tile & 3;
        if ((s & 1) == 0) { u.pm = pm; u.pn = br * 4 + pn; } else { u.pm = (1 + br) * 64 + pm; u.pn = (3 + br) * 4 + pn; }
        return true;
    }
    __device__ __forceinline__ void a_ready(const pg8::Unit&) const {}
    __device__ __forceinline__ void done(const pg8::Unit&) const {}
};
struct EpiGate {
    static constexpr bool PERM = true, AFTER_DRAIN = false;
    bf16* gsc; float* macc; bf16* merged;
    __device__ __forceinline__ void operator()(const pg8::f32x4 (&acc)[2][2][4][2], const pg8::Unit& u, int wr, int wc, int fr, int fq) const {
        const int j = u.pn >> 2, pn = u.pn & 3, pm = u.pm & 63;
        const int col0 = pn * 256 + wc * 32 + 8 * fq, row0 = pm * 256 + wr * 64 + fr;
#pragma unroll
        for (int ai = 0; ai < 2; ++ai)
#pragma unroll
            for (int m = 0; m < 4; ++m) { const size_t ro = (size_t)(row0 + ai * 128 + m * 16) * DM + col0;
#pragma unroll
                for (int bj = 0; bj < 2; ++bj) { const size_t o = ro + bj * 128; float v[8];
#pragma unroll
                    for (int i = 0; i < 4; ++i) { v[i] = acc[ai][bj][m][0][i]; v[4 + i] = acc[ai][bj][m][1][i]; }
                    if (j < 3) {
#pragma unroll
                        for (int i = 0; i < 8; ++i) v[i] = sigmoidf_(v[i]);
                        *(v4u*)(gsc + o) = pack8(v);
                    } else {
                        float g[8]; unpack8(*(const v4u*)(gsc + o), g);
#pragma unroll
                        for (int i = 0; i < 8; ++i) v[i] *= g[i];
                        if (j > 3) { const f32x4 a = *(const f32x4*)(macc + o), b = *(const f32x4*)(macc + o + 4);
#pragma unroll
                            for (int i = 0; i < 4; ++i) { v[i] += a[i]; v[4 + i] += b[i]; } }
                        if (j < 5) { *(f32x4*)(macc + o) = (f32x4){v[0], v[1], v[2], v[3]}; *(f32x4*)(macc + o + 4) = (f32x4){v[4], v[5], v[6], v[7]}; }
                        else *(v4u*)(merged + o) = pack8(v);
                    } } }
    }
};

__device__ __forceinline__ void transpose_item(const float* __restrict__ W, int ldw, bf16* __restrict__ WT, int K, int nblk, float* scr, int item, int lane) {
    const int kb = item / nblk, nb = item % nblk, k0 = 64 * kb, n0 = 32 * nb;
#pragma unroll 8
    for (int i = 0; i < 32; ++i) { const int kk = 2 * i + (lane >> 5); scr[kk * 33 + (lane & 31)] = W[(size_t)(k0 + kk) * ldw + n0 + (lane & 31)]; }
    LDS_WAIT();
    const int c = lane & 7;
#pragma unroll
    for (int j = 0; j < 4; ++j) { const int n = (lane >> 3) + 8 * j; const float* s = scr + (8 * c) * 33 + n;
        v4u o; o.x = pk2(s[0 * 33], s[1 * 33]); o.y = pk2(s[2 * 33], s[3 * 33]); o.z = pk2(s[4 * 33], s[5 * 33]); o.w = pk2(s[6 * 33], s[7 * 33]);
        *(v4u*)(WT + (size_t)(n0 + n) * K + k0 + 8 * c) = o; }
    LDS_WAIT();
}
__device__ __forceinline__ void rms_row_to_bf16(const float* xrow, const float* w, bf16* orow, int lane) {
    const f32x4* xr = (const f32x4*)xrow + lane; const f32x4* wr = (const f32x4*)w + lane;
    f32x4 v[4]; float s = 0.f;
#pragma unroll
    for (int j = 0; j < 4; ++j) { v[j] = xr[64 * j]; s += (v[j][0] * v[j][0] + v[j][1] * v[j][1]) + (v[j][2] * v[j][2] + v[j][3] * v[j][3]); }
    const float rstd = rsqrtf(wave_sum(s) * (1.f / DM) + EPS);
    unsigned long long* o8 = (unsigned long long*)orow + lane;
#pragma unroll
    for (int j = 0; j < 4; ++j) { const f32x4 ww = wr[64 * j];
        o8[64 * j] = (unsigned long long)pk2(v[j][0] * rstd * ww[0], v[j][1] * rstd * ww[1]) | ((unsigned long long)pk2(v[j][2] * rstd * ww[2], v[j][3] * rstd * ww[3]) << 32); }
}
__device__ __forceinline__ void phase0(unsigned char* lds, const Args& a, int l, const float* xin) {
    const int tid = opaque_tid(), lane = tid & 63, wave = tid >> 6, gw = blockIdx.x * NWAVES + wave, NGW = gridDim.x * NWAVES;
    bf16* Wreg = (bf16*)(a.ws + WS_W);
    const float* w_in = a.in[2] + (size_t)l * DM * IN_DIM;
    {
        float* scr = (float*)lds + wave * (64 * 33);
        const float* w_br = a.in[13] + (size_t)l * 3 * DM * DM; const float* w_out = a.in[14] + (size_t)l * DM * DM;
        const float* w_up = a.in[16] + (size_t)l * DM * DFF; const float* w_down = a.in[17] + (size_t)l * DFF * DM;
        constexpr int NSEG = 17, NIT = NSEG * 512 + 2048 + 2048;
        for (int it = gw; it < NIT; it += NGW) {
            if (it < NSEG * 512) {
                const int seg = it >> 9, r = it & 511;
                const float* W; int ldw; bf16* WT;
                if (seg < 13) {
                    const int co = seg == 0 ? 3072 : seg == 1 ? 4112 : seg == 2 ? 7184 : seg == 3 ? 0 : seg == 4 ? 1024 : seg == 5 ? 2048 : seg == 6 ? 5136 : seg == 7 ? 6160 : seg == 8 ? 8208 : seg == 9 ? 9232
                                 : 10272 + (seg - 10) * 1024;
                    W = w_in + co; ldw = IN_DIM; WT = Wreg + (size_t)seg * DM * DM;
                } else if (seg < 16) { W = w_br + (size_t)(seg - 13) * DM * DM; ldw = DM; WT = Wreg + W_G + (size_t)(3 + seg - 13) * DM * DM; }
                else { W = w_out; ldw = DM; WT = Wreg + W_OUT; }
                transpose_item(W, ldw, WT, DM, 32, scr, r, lane);
            } else if (it < NSEG * 512 + 2048) transpose_item(w_up, DFF, Wreg + W_UP, DM, 128, scr, it - NSEG * 512, lane);
            else transpose_item(w_down, DM, Wreg + W_DOWN, DFF, 32, scr, it - NSEG * 512 - 2048, lane);
        }
    }
    __syncthreads();
    {
        float* Ws = (float*)lds;
        for (int idx = tid; idx < 32 * DM; idx += NTHREADS) { const int k = idx >> 5, c = idx & 31; Ws[c * DM + k] = w_in[(size_t)k * IN_DIM + (c < 16 ? 4096 + c : 10256 + c - 16)]; }
        __syncthreads();
        const float* nw = a.in[1] + (size_t)l * DM;
        bf16* H = (bf16*)a.ws; float* small = (float*)(a.ws + WS_SMALL);
        float p0 = 0.f, p1 = 0.f;
        if (lane < 8) { p0 = __expf(a.in[4][l * 8 + lane]); p1 = a.in[5][l * 8 + lane]; }
        else if (lane >= 16 && lane < 32) { p0 = __expf(a.in[9][l * 16 + lane - 16]); p1 = a.in[10][l * 16 + lane - 16]; }
        for (int m = gw; m < MT; m += NGW) {
            const float* xrow = xin + (size_t)m * DM;
            float xv[16]; float s = 0.f;
#pragma unroll
            for (int i = 0; i < 16; ++i) { xv[i] = xrow[lane + 64 * i]; s += xv[i] * xv[i]; }
            const float rstd = rsqrtf(wave_sum(s) * (1.f / DM) + EPS);
            bf16* hrow = H + (size_t)m * DM;
#pragma unroll
            for (int i = 0; i < 16; ++i) { xv[i] = xv[i] * rstd * nw[lane + 64 * i]; hrow[lane + 64 * i] = (bf16)f2bf(xv[i]); }
            float mine = 0.f;
#pragma unroll 4
            for (int c = 0; c < 32; ++c) { float acc = 0.f;
#pragma unroll
                for (int i = 0; i < 16; ++i) acc += xv[i] * Ws[c * DM + lane + 64 * i];
                acc = wave_sum(acc); mine = (lane == c) ? acc : mine; }
            if (lane < 8) small[(size_t)m * 64 + lane] = -p0 * softplusf_(mine + p1);
            else if (lane < 16) small[(size_t)m * 64 + lane] = sigmoidf_(mine);
            else if (lane < 32) { const float dt = softplusf_(mine + p1); small[(size_t)m * 64 + lane] = dt; small[(size_t)m * 64 + lane + 16] = -p0 * dt; }
        }
    }
}

__device__ __forceinline__ void conv8(const bf16* p, int pos, const float* w, int wstride, const float* bias, float* out) {
    float acc[8];
#pragma unroll
    for (int i = 0; i < 8; ++i) acc[i] = bias ? bias[i] : 0.f;
#pragma unroll
    for (int j = 0; j < 4; ++j) { const int back = 3 - j;
        if (pos - back >= 0) { float xv[8]; unpack8(*(const v4u*)(p - (size_t)back * DM), xv);
            const f32x4 w0 = *(const f32x4*)(w + j * wstride), w1 = *(const f32x4*)(w + j * wstride + 4);
#pragma unroll
            for (int i = 0; i < 4; ++i) { acc[i] += xv[i] * w0[i]; acc[4 + i] += xv[4 + i] * w1[i]; } } }
#pragma unroll
    for (int i = 0; i < 8; ++i) out[i] = siluf_(acc[i]);
}

__device__ __forceinline__ void conv8r(const v4u (&raw)[4], const float* w, int wstride, const float* bias, float* out) {
    float acc[8];
#pragma unroll
    for (int i = 0; i < 8; ++i) acc[i] = bias ? bias[i] : 0.f;
#pragma unroll
    for (int j = 0; j < 4; ++j) { float xv[8]; unpack8(raw[j], xv);
        const f32x4 w0 = *(const f32x4*)(w + j * wstride), w1 = *(const f32x4*)(w + j * wstride + 4);
#pragma unroll
        for (int i = 0; i < 4; ++i) { acc[i] += xv[i] * w0[i]; acc[4 + i] += xv[4 + i] * w1[i]; } }
#pragma unroll
    for (int i = 0; i < 8; ++i) out[i] = siluf_(acc[i]);
}
#define LOAD4(dst, p, pos) do { _Pragma("unroll") for (int j_ = 0; j_ < 4; ++j_) { const int back_ = 3 - j_; \
        if ((pos) - back_ >= 0) dst[j_] = *(const v4u*)((p) - (size_t)back_ * DM); else dst[j_] = (v4u){0u, 0u, 0u, 0u}; } } while (0)

__device__ __forceinline__ void dn_item(unsigned char* lds, const Args& a, int l, int item) {
    const int b = item >> 4, h = (item >> 1) & 7, eh = item & 1;
    float* qs = (float*)lds; float* ks = qs + 32 * 128; float* vs = ks + 32 * 128; float* os = vs + 32 * 64; float* gs = os + 32 * 64; float* bs = gs + 32;
    const int tid = opaque_tid(), e = tid >> 3, ds = tid & 7;
    bf16* base = (bf16*)a.ws;
    const bf16* Q = base + (size_t)B_DNQ * BUFE; const bf16* K = base + (size_t)B_DNK * BUFE; bf16* V = base + (size_t)B_DNV * BUFE;
    const float* small = (const float*)(a.ws + WS_SMALL);
    const float* cw = a.in[3] + (size_t)l * 4 * 3072;
    const size_t rowbase = (size_t)b * SEQ;
    const int tq = tid >> 4, cq = tid & 15, tv = (tid >> 3) & 31, cv = tid & 7;
    f32x2 S2[8];
#pragma unroll
    for (int i = 0; i < 8; ++i) S2[i] = (f32x2){0.f, 0.f};
    v4u rq[4], rk[4], rv[4]; float rg = 0.f, rb = 0.f;
#define DN_LOADS(c_) do { const int t0_ = (c_) * 32; { const int pos_ = t0_ + tq; const size_t off_ = (rowbase + pos_) * DM + h * 128 + cq * 8; LOAD4(rq, Q + off_, pos_); LOAD4(rk, K + off_, pos_); } \
        if (tid < 256) { const int pos_ = t0_ + tv; LOAD4(rv, V + (rowbase + pos_) * DM + h * 128 + eh * 64 + cv * 8, pos_); } \
        else if (tid < 288) { const size_t r_ = rowbase + t0_ + (tid - 256); rg = small[r_ * 64 + h]; rb = small[r_ * 64 + 8 + h]; } } while (0)
    DN_LOADS(0);
    for (int c = 0; c < SEQ / 32; ++c) {
        const int t0 = c * 32;
        {   float q8[8], k8[8];
            conv8r(rq, cw + h * 128 + cq * 8, 3072, nullptr, q8);
            conv8r(rk, cw + 1024 + h * 128 + cq * 8, 3072, nullptr, k8);
            float sq = 0.f, sk = 0.f;
#pragma unroll
            for (int i = 0; i < 8; ++i) { sq += q8[i] * q8[i]; sk += k8[i] * k8[i]; }
            sq = red16(sq); sk = red16(sk);
            const float rqn = rsqrtf(sq + EPS) * 0.08838834764831845f, rkn = rsqrtf(sk + EPS);
            *(f32x4*)(qs + tq * 128 + cq * 8) = (f32x4){q8[0] * rqn, q8[1] * rqn, q8[2] * rqn, q8[3] * rqn}; *(f32x4*)(qs + tq * 128 + cq * 8 + 4) = (f32x4){q8[4] * rqn, q8[5] * rqn, q8[6] * rqn, q8[7] * rqn};
            *(f32x4*)(ks + tq * 128 + cq * 8) = (f32x4){k8[0] * rkn, k8[1] * rkn, k8[2] * rkn, k8[3] * rkn}; *(f32x4*)(ks + tq * 128 + cq * 8 + 4) = (f32x4){k8[4] * rkn, k8[5] * rkn, k8[6] * rkn, k8[7] * rkn};
        }
        if (tid < 256) { float v8[8]; conv8r(rv, cw + 2048 + h * 128 + eh * 64 + cv * 8, 3072, nullptr, v8);
            *(f32x4*)(vs + tv * 64 + cv * 8) = (f32x4){v8[0], v8[1], v8[2], v8[3]}; *(f32x4*)(vs + tv * 64 + cv * 8 + 4) = (f32x4){v8[4], v8[5], v8[6], v8[7]};
        } else if (tid < 288) { gs[tid - 256] = __expf(rg); bs[tid - 256] = rb; }
        __syncthreads();
        if (c > 0) {
            const int e4 = cq * 4; const float* o = os + tq * 64 + e4;
            v2u w; w.x = pk2(o[0], o[1]); w.y = pk2(o[2], o[3]);
            *(v2u*)(V + (rowbase + t0 - 32 + tq) * DM + h * 128 + eh * 64 + e4) = w;
        }
        if (c + 1 < SEQ / 32) DN_LOADS(c + 1);
        __syncthreads();
#pragma unroll 2
        for (int tt = 0; tt < 32; ++tt) {
            f32x4 k4[4], q4[4];
#pragma unroll
            for (int i = 0; i < 4; ++i) { k4[i] = *(const f32x4*)(ks + tt * 128 + 32 * i + 4 * ds); q4[i] = *(const f32x4*)(qs + tt * 128 + 32 * i + 4 * ds); }
            f32x2 ka = {0.f, 0.f}, kb = {0.f, 0.f};
#pragma unroll
            for (int i = 0; i < 4; ++i) { ka += (f32x2){k4[i][0], k4[i][1]} * S2[2 * i]; kb += (f32x2){k4[i][2], k4[i][3]} * S2[2 * i + 1]; }
            ka += kb;
            const float kS = red8(ka[0] + ka[1]);
            const float eg = gs[tt], vn = bs[tt] * (vs[tt * 64 + e] - eg * kS);
            const f32x2 eg2 = {eg, eg}, vn2 = {vn, vn};
            f32x2 oa = {0.f, 0.f}, ob = {0.f, 0.f};
#pragma unroll
            for (int i = 0; i < 4; ++i) {
                S2[2 * i] = eg2 * S2[2 * i] + (f32x2){k4[i][0], k4[i][1]} * vn2; S2[2 * i + 1] = eg2 * S2[2 * i + 1] + (f32x2){k4[i][2], k4[i][3]} * vn2;
                oa += (f32x2){q4[i][0], q4[i][1]} * S2[2 * i]; ob += (f32x2){q4[i][2], q4[i][3]} * S2[2 * i + 1]; }
            oa += ob;
            const float o = red8(oa[0] + oa[1]);
            if (ds == 0) os[tt * 64 + e] = o;
        }
        __syncthreads();
    }
#undef DN_LOADS
    {   const int e4 = cq * 4; const float* o = os + tq * 64 + e4;
        v2u w; w.x = pk2(o[0], o[1]); w.y = pk2(o[2], o[3]);
        *(v2u*)(V + (rowbase + SEQ - 32 + tq) * DM + h * 128 + eh * 64 + e4) = w; }
    __syncthreads();
}

template <int K> __device__ __forceinline__ void mma16(f32x4& acc, const bf16* Ap, int lda, const bf16* Bp, int ldb, int fr, int fq) {
#pragma unroll
    for (int k = 0; k < K; k += 32) { const bf16x8 af = *(const bf16x8*)(Ap + fr * lda + k + fq * 8), bfv = *(const bf16x8*)(Bp + fr * ldb + k + fq * 8);
        acc = __builtin_amdgcn_mfma_f32_16x16x32_bf16(af, bfv, acc, 0, 0, 0); }
}
__device__ __forceinline__ void ssm_item(unsigned char* lds, const Args& a, int l, int item) {
    constexpr int LDC = 136, LDX = 40;
    const int b = item >> 4, hd = item & 15, g = hd >> 2;
    bf16* Cs = (bf16*)lds;
    bf16* Bs = Cs + 32 * LDC;
    bf16* BT = Bs + 32 * LDC;
    bf16* xdtT = BT + 128 * LDX;
    bf16* xddT = xdtT + 64 * LDX;
    bf16* Wm = xddT + 64 * LDX;
    bf16* hB = Wm + 32 * LDX;
    float* xs = (float*)(hB + 64 * LDC);
    float* acs = xs + 32 * 64;
    const int tid = opaque_tid(), w = tid >> 6, lane = tid & 63, fr = lane & 15, fq = lane >> 4;
    bf16* base = (bf16*)a.ws;
    const bf16* X = base + (size_t)B_SSX * BUFE; const bf16* BC = base + (size_t)B_SSBC * BUFE; bf16* Z = base + (size_t)B_SSZ * BUFE;
    const float* small = (const float*)(a.ws + WS_SMALL);
    const float* cw = a.in[7] + (size_t)l * 4 * 2048; const float* cb = a.in[8] + (size_t)l * 2048;
    const float dskip = a.in[11][l * 16 + hd];
    const size_t rowbase = (size_t)b * SEQ;
    const int tq = tid >> 4, cq = tid & 15, tv = (tid >> 3) & 31, cv = tid & 7;
    const int it = w >> 2, pt = w & 3;
    f32x4 hacc[4];
#pragma unroll
    for (int i = 0; i < 4; ++i) hacc[i] = (f32x4){0.f, 0.f, 0.f, 0.f};
    for (int i = tid; i < 64 * LDC / 2; i += NTHREADS) ((unsigned*)hB)[i] = 0u;
    v4u rB[4], rC[4], rx[4]; float ra = 0.f, rdtv = 0.f; unsigned rz[4];
#define SSM_LOADS(c_) do { const int t0_ = (c_) * 32; { const int pos_ = t0_ + tq; const size_t ro_ = (rowbase + pos_) * DM; LOAD4(rB, BC + ro_ + g * 128 + cq * 8, pos_); LOAD4(rC, BC + ro_ + 512 + g * 128 + cq * 8, pos_); } \
        if (tid < 256) { const int pos_ = t0_ + tv; LOAD4(rx, X + (rowbase + pos_) * DM + hd * 64 + cv * 8, pos_); } \
        { const size_t r_ = rowbase + t0_ + (lane & 31); rdtv = small[r_ * 64 + 16 + hd]; ra = small[r_ * 64 + 32 + hd]; } \
        _Pragma("unroll") for (int jj_ = 0; jj_ < 4; ++jj_) rz[jj_] = Z[(rowbase + t0_ + 16 * it + 4 * fq + jj_) * DM + hd * 64 + 16 * pt + fr]; } while (0)
    SSM_LOADS(0);
    for (int c = 0; c < SEQ / 32; ++c) {
        const int t0 = c * 32;
        float acum = ra;
#pragma unroll
        for (int off = 1; off < 32; off <<= 1) { const float t = __shfl_up(acum, off, 32); if ((lane & 31) >= off) acum += t; }
        const float ac_last = __shfl(acum, 31);
        {   float o8[8];
            conv8r(rB, cw + 1024 + g * 128 + cq * 8, 2048, cb + 1024 + g * 128 + cq * 8, o8);
            *(v4u*)(Bs + tq * LDC + cq * 8) = pack8(o8);
#pragma unroll
            for (int i = 0; i < 8; ++i) BT[(cq * 8 + i) * LDX + tq] = (bf16)f2bf(o8[i]);
            conv8r(rC, cw + 1536 + g * 128 + cq * 8, 2048, cb + 1536 + g * 128 + cq * 8, o8);
            *(v4u*)(Cs + tq * LDC + cq * 8) = pack8(o8);
        }
        if (tid < 256) { float o8[8]; conv8r(rx, cw + hd * 64 + cv * 8, 2048, cb + hd * 64 + cv * 8, o8);
            const float dtv = __shfl(rdtv, tv), dd = dtv * __expf(ac_last - __shfl(acum, tv));
            *(f32x4*)(xs + tv * 64 + cv * 8) = (f32x4){o8[0], o8[1], o8[2], o8[3]}; *(f32x4*)(xs + tv * 64 + cv * 8 + 4) = (f32x4){o8[4], o8[5], o8[6], o8[7]};
#pragma unroll
            for (int i = 0; i < 8; ++i) { xdtT[(cv * 8 + i) * LDX + tv] = (bf16)f2bf(o8[i] * dtv); xddT[(cv * 8 + i) * LDX + tv] = (bf16)f2bf(o8[i] * dd); }
        }
        if (tid < 32) acs[tid] = acum;
        unsigned zr[4];
#pragma unroll
        for (int jj = 0; jj < 4; ++jj) zr[jj] = rz[jj];
        __syncthreads();
        if (c + 1 < SEQ / 32) SSM_LOADS(c + 1);
        if (w < 4) { const int gi = w >> 1, gj = w & 1; f32x4 acc = {0.f, 0.f, 0.f, 0.f};
            mma16<128>(acc, Cs + gi * 16 * LDC, LDC, Bs + gj * 16 * LDC, LDC, fr, fq);
            const int sI = 16 * gj + fr; const float as = acs[sI];
#pragma unroll
            for (int jj = 0; jj < 4; ++jj) { const int lI = 16 * gi + 4 * fq + jj; const float v = sI <= lI ? acc[jj] * __expf(acs[lI] - as) : 0.f; Wm[lI * LDX + sI] = (bf16)f2bf(v); } }
        __syncthreads();
        {   f32x4 a1 = {0.f, 0.f, 0.f, 0.f}, a2 = {0.f, 0.f, 0.f, 0.f};
            mma16<32>(a1, Wm + it * 16 * LDX, LDX, xdtT + pt * 16 * LDX, LDX, fr, fq);
            mma16<128>(a2, Cs + it * 16 * LDC, LDC, hB + pt * 16 * LDC, LDC, fr, fq);
            const int p = 16 * pt + fr;
#pragma unroll
            for (int jj = 0; jj < 4; ++jj) { const int lI = 16 * it + 4 * fq + jj;
                const float y = a1[jj] + __expf(acs[lI]) * a2[jj] + xs[lI * 64 + p] * dskip;
                Z[(rowbase + t0 + lI) * DM + hd * 64 + p] = (bf16)f2bf(y * siluf_(bf2f(zr[jj]))); }
            const float dl = __expf(ac_last);
#pragma unroll
            for (int p2 = 0; p2 < 4; ++p2) { hacc[p2] = hacc[p2] * dl; mma16<32>(hacc[p2], xddT + p2 * 16 * LDX, LDX, BT + w * 16 * LDX, LDX, fr, fq); }
        }
        __syncthreads();
#pragma unroll
        for (int p2 = 0; p2 < 4; ++p2)
#pragma unroll
            for (int jj = 0; jj < 4; ++jj) hB[(16 * p2 + 4 * fq + jj) * LDC + 16 * w + fr] = (bf16)f2bf(hacc[p2][jj]);
    }
#undef SSM_LOADS
    __syncthreads();
}

__device__ __forceinline__ void sb_item(unsigned char* lds, const Args& a, int b, int hd, int qi) {
    constexpr int LD = 72;
    bf16* Ks = (bf16*)lds; bf16* Vs = Ks + 2 * 64 * LD;
    const int tid = opaque_tid(), w = tid >> 6, lane = tid & 63, fr = lane & 15, fq = lane >> 4;
    bf16* base = (bf16*)a.ws;
    bf16* Qb = base + (size_t)B_SBQ * BUFE; const bf16* Kb = base + (size_t)B_SBK * BUFE; const bf16* Vb = base + (size_t)B_SBV * BUFE;
    const size_t rowbase = (size_t)b * SEQ;
    const int t0 = qi * 128, myq = t0 + w * 16 + fr, wmax = t0 + w * 16 + 15;
    bf16* qrow = Qb + (rowbase + myq) * DM + hd * 64;
    bf16x8 qf[2];
    qf[0] = *(const bf16x8*)(qrow + fq * 8); qf[1] = *(const bf16x8*)(qrow + 32 + fq * 8);
    f32x4 oacc[4];
#pragma unroll
    for (int i = 0; i < 4; ++i) oacc[i] = (f32x4){0.f, 0.f, 0.f, 0.f};
    float carry = 1.f;
    const int kr = tid >> 3, d8 = (tid & 7) * 8;
    v4u kreg, vreg;
    int kt = 2 * (qi + 1) - 1;
#define SB_LOAD(t) do { const size_t o_ = (rowbase + (size_t)(t) * 64 + kr) * DM + hd * 64 + d8; kreg = *(const v4u*)(Kb + o_); vreg = *(const v4u*)(Vb + o_); } while (0)
#define SB_STORE(bu) do { *(v4u*)(Ks + (bu) * 64 * LD + kr * LD + d8) = kreg; bf16* vd_ = Vs + (bu) * 64 * LD + d8 * LD + kr; \
        vd_[0] = (bf16)(vreg.x & 0xffffu); vd_[LD] = (bf16)(vreg.x >> 16); vd_[2 * LD] = (bf16)(vreg.y & 0xffffu); vd_[3 * LD] = (bf16)(vreg.y >> 16); \
        vd_[4 * LD] = (bf16)(vreg.z & 0xffffu); vd_[5 * LD] = (bf16)(vreg.z >> 16); vd_[6 * LD] = (bf16)(vreg.w & 0xffffu); vd_[7 * LD] = (bf16)(vreg.w >> 16); } while (0)
    SB_LOAD(kt); SB_STORE(0);
    __syncthreads();
    int cur = 0;
    for (; kt >= 0; --kt) {
        if (kt > 0) SB_LOAD(kt - 1);
        const int kbase = kt * 64;
        if (kbase <= wmax) {
            const bf16* Kc = Ks + cur * 64 * LD; const bf16* Vc = Vs + cur * 64 * LD;
            f32x4 z[4];
#pragma unroll
            for (int nt = 0; nt < 4; ++nt) { z[nt] = (f32x4){0.f, 0.f, 0.f, 0.f};
#pragma unroll
                for (int k2 = 0; k2 < 2; ++k2) { const bf16x8 af = *(const bf16x8*)(Kc + (nt * 16 + fr) * LD + k2 * 32 + fq * 8);
                    z[nt] = __builtin_amdgcn_mfma_f32_16x16x32_bf16(af, qf[k2], z[nt], 0, 0, 0); } }
            float kp[4][4], sg[4][4], T[4], tot[4], suf[4];
            const bool masked = kbase + 64 > t0 + w * 16;
#pragma unroll
            for (int nt = 0; nt < 4; ++nt) {
#pragma unroll
                for (int j = 0; j < 4; ++j) { const float z2 = z[nt][j] * 0.18033688011112042f;
                    const float ea = __builtin_amdgcn_exp2f(-fabsf(z2)), rc = __builtin_amdgcn_rcpf(1.f + ea); const bool pos = z2 >= 0.f;
                    sg[nt][j] = (pos ? 1.f : ea) * rc; kp[nt][j] = (pos ? ea : 1.f) * rc; }
                if (masked) {
#pragma unroll
                    for (int j = 0; j < 4; ++j) { const bool valid = kbase + nt * 16 + fq * 4 + j < myq; sg[nt][j] = valid ? sg[nt][j] : 0.f; kp[nt][j] = valid ? kp[nt][j] : 1.f; } }
                T[nt] = (kp[nt][0] * kp[nt][1]) * (kp[nt][2] * kp[nt][3]); }
#pragma unroll
            for (int nt = 0; nt < 4; ++nt) { const float p16 = __shfl_xor(T[nt], 16), s1 = T[nt] * p16, p32 = __shfl_xor(s1, 32); tot[nt] = s1 * p32;
                suf[nt] = fq == 0 ? p16 * p32 : fq == 1 ? p32 : fq == 2 ? p16 : 1.f; }
            float run = carry; float wv[4][4];
#pragma unroll
            for (int nt = 3; nt >= 0; --nt) { const float r3 = run * suf[nt], r2 = r3 * kp[nt][3], r1 = r2 * kp[nt][2], r0 = r1 * kp[nt][1];
                wv[nt][0] = sg[nt][0] * r0; wv[nt][1] = sg[nt][1] * r1; wv[nt][2] = sg[nt][2] * r2; wv[nt][3] = sg[nt][3] * r3;
                run *= tot[nt]; }
            carry = run;
#pragma unroll
            for (int kk = 0; kk < 2; ++kk) {
                v4u bw; bw.x = pk2(wv[2 * kk][0], wv[2 * kk][1]); bw.y = pk2(wv[2 * kk][2], wv[2 * kk][3]); bw.z = pk2(wv[2 * kk + 1][0], wv[2 * kk + 1][1]); bw.w = pk2(wv[2 * kk + 1][2], wv[2 * kk + 1][3]);
                const bf16x8 bfr = __builtin_bit_cast(bf16x8, bw);
#pragma unroll
                for (int mt = 0; mt < 4; ++mt) { const bf16* vp = Vc + (mt * 16 + fr) * LD + 32 * kk + 4 * fq;
                    const v2u lo = *(const v2u*)vp, hi = *(const v2u*)(vp + 16);
                    v4u av; av.x = lo.x; av.y = lo.y; av.z = hi.x; av.w = hi.y;
                    oacc[mt] = __builtin_amdgcn_mfma_f32_16x16x32_bf16(__builtin_bit_cast(bf16x8, av), bfr, oacc[mt], 0, 0, 0); }
            }
        }
        if (kt > 0) SB_STORE(cur ^ 1);
        __syncthreads();
        cur ^= 1;
    }
#undef SB_LOAD
#undef SB_STORE
#pragma unroll
    for (int mt = 0; mt < 4; ++mt) { v2u wq; wq.x = pk2(oacc[mt][0], oacc[mt][1]); wq.y = pk2(oacc[mt][2], oacc[mt][3]); *(v2u*)(qrow + mt * 16 + fq * 4) = wq; }
}

__device__ __forceinline__ void phase_mixers(unsigned char* lds, const Args& a, int l, unsigned long long& probe_acc) {
    unsigned* counter = (unsigned*)(a.ws + WS_CTL) + 64 * l;
    volatile unsigned* slot = (volatile unsigned*)(lds + LDS_BYTES - 64);
    constexpr unsigned NITEMS = 128 + 128 + 2048;
    for (;;) {
        if (threadIdx.x == 0) *slot = __hip_atomic_fetch_add(counter, 1u, __ATOMIC_RELAXED, __HIP_MEMORY_SCOPE_AGENT);
        __syncthreads();
        const unsigned item = *slot;
        __syncthreads();
        if (item >= NITEMS) break;
        PT0();
        if (item < 128) { dn_item(lds, a, l, (int)item); if (item == 0) PT1(9); }
        else if (item < 256) { ssm_item(lds, a, l, (int)item - 128); if (item == 128) PT1(10); }
        else { const int r = (int)item - 256, qi = 15 - (r >> 7), bh = r & 127; sb_item(lds, a, bh >> 4, bh & 15, qi); if (item == 256) PT1(11); }
    }
}

__device__ __forceinline__ void phase_norms(const Args& a, int l) {
    const int tid = opaque_tid(), lane = tid & 63, wave = tid >> 6, gw = blockIdx.x * NWAVES + wave, NGW = gridDim.x * NWAVES;
    bf16* base = (bf16*)a.ws;
    const bf16* Oraw = base + (size_t)B_DNV * BUFE; bf16* G = base + (size_t)B_DNG * BUFE; bf16* Y = base + (size_t)B_SSZ * BUFE;
    const float* dnw = a.in[6] + (size_t)l * 128 + (lane & 7) * 16; const float* snw = a.in[12] + (size_t)l * DM + lane * 16;
    float w1[16], w2[16];
#pragma unroll
    for (int i = 0; i < 16; ++i) { w1[i] = dnw[i]; w2[i] = snw[i]; }
    for (int m = gw; m < MT; m += NGW) {
        const size_t o = (size_t)m * DM + lane * 16;
        float v[16], g[16];
        unpack8(*(const v4u*)(Oraw + o), v); unpack8(*(const v4u*)(Oraw + o + 8), v + 8);
        unpack8(*(const v4u*)(G + o), g); unpack8(*(const v4u*)(G + o + 8), g + 8);
        float s = 0.f;
#pragma unroll
        for (int i = 0; i < 16; ++i) s += v[i] * v[i];
        s = red8(s);
        float r = rsqrtf(s * (1.f / 128.f) + EPS);
#pragma unroll
        for (int i = 0; i < 16; ++i) v[i] = v[i] * r * w1[i] * siluf_(g[i]);
        *(v4u*)(G + o) = pack8(v); *(v4u*)(G + o + 8) = pack8(v + 8);
        unpack8(*(const v4u*)(Y + o), v); unpack8(*(const v4u*)(Y + o + 8), v + 8);
        s = 0.f;
#pragma unroll
        for (int i = 0; i < 16; ++i) s += v[i] * v[i];
        s = red16(s);
        r = rsqrtf(s * (1.f / 256.f) + EPS);
#pragma unroll
        for (int i = 0; i < 16; ++i) v[i] = v[i] * r * w2[i];
        *(v4u*)(Y + o) = pack8(v); *(v4u*)(Y + o + 8) = pack8(v + 8);
    }
}

__global__ void __launch_bounds__(NTHREADS, 2) hybrid_fwd(Args a) {
    extern __shared__ __attribute__((aligned(16))) unsigned char lds[];
    cg::grid_group grid = cg::this_grid();
    bf16* base = (bf16*)a.ws; bf16* Wreg = (bf16*)(a.ws + WS_W);
    PG8_LAS unsigned char* ldsl = (PG8_LAS unsigned char*)lds;
    unsigned long long probe_acc = 0ull;
    if (blockIdx.x == 0 && threadIdx.x < 2) __hip_atomic_store((unsigned*)(a.ws + WS_CTL) + 64 * threadIdx.x, 0u, __ATOMIC_RELAXED, __HIP_MEMORY_SCOPE_AGENT);
#pragma unroll 1
    for (int l = 0; l < 2; ++l) {
        asm volatile("" : "+s"(l));
        const float* xin = l == 0 ? a.in[0] : a.out;
        { PT0(); phase0(lds, a, l, xin);
        grid.sync(); PT1(0); }
        {   pg8::Gemm g{base, Wreg + W_IN, MT, 10240, DM}; pg8::StaticOrder S; S.init(MT, 10240, (int)gridDim.x, (int)blockIdx.x);
            EpiRoute E{base};
            PT0(); pg8::gemm_phase<EpiRoute, pg8::StaticOrder, false, true>(ldsl, g, S, E);
        grid.sync(); PT1(1); }
        { PT0(); phase_mixers(lds, a, l, probe_acc);
        grid.sync(); PT1(2); }
        { PT0(); phase_norms(a, l);
        grid.sync(); PT1(3); }
        {   pg8::Gemm g{base, Wreg + W_G, 4 * MT, 6144, DM}; SchedGate S{(int)gridDim.x, (int)blockIdx.x};
            EpiGate E{base + (size_t)B_SBK * BUFE, (float*)(base + (size_t)B_DNK * BUFE), base + (size_t)B_DNQ * BUFE};
            PT0(); pg8::gemm_phase<EpiGate, SchedGate, false, true>(ldsl, g, S, E);
        grid.sync(); PT1(4); }
        {   pg8::Gemm g{base + (size_t)B_DNQ * BUFE, Wreg + W_OUT, MT, DM, DM}; pg8::StaticOrder S; S.init(MT, DM, (int)gridDim.x, (int)blockIdx.x);
            EpiResid E{xin, a.out};
            PT0(); pg8::gemm_phase<EpiResid, pg8::StaticOrder, false, true>(ldsl, g, S, E);
        grid.sync(); PT1(5); }
        {   const float* nw = a.in[15] + (size_t)l * DM;
            const int tid = opaque_tid(), lane = tid & 63, gw = blockIdx.x * NWAVES + (tid >> 6), NGW = gridDim.x * NWAVES;
            PT0(); for (int m = gw; m < MT; m += NGW) rms_row_to_bf16(a.out + (size_t)m * DM, nw, base + (size_t)m * DM, lane);
        grid.sync(); PT1(6); }
        {   pg8::Gemm g{base, Wreg + W_UP, MT, DFF, DM}; pg8::StaticOrder S; S.init(MT, DFF, (int)gridDim.x, (int)blockIdx.x);
            EpiRelu2 E{base + (size_t)B_DNQ * BUFE};
            PT0(); pg8::gemm_phase<EpiRelu2, pg8::StaticOrder, false, true>(ldsl, g, S, E);
        grid.sync(); PT1(7); }
        {   pg8::Gemm g{base + (size_t)B_DNQ * BUFE, Wreg + W_DOWN, MT, DM, DFF}; pg8::StaticOrder S; S.init(MT, DM, (int)gridDim.x, (int)blockIdx.x);
            EpiResid E{a.out, a.out};
            PT0(); pg8::gemm_phase<EpiResid, pg8::StaticOrder, false, true>(ldsl, g, S, E);
        grid.sync(); PT1(8); }
    }
    {
        const float* nw = a.in[18];
        const int tid = opaque_tid(), lane = tid & 63, gw = blockIdx.x * NWAVES + (tid >> 6), NGW = gridDim.x * NWAVES;
        for (int m = gw; m < MT; m += NGW) {
            f32x4* xr = (f32x4*)(a.out + (size_t)m * DM) + lane; const f32x4* wr = (const f32x4*)nw + lane;
            f32x4 v[4]; float s = 0.f;
#pragma unroll
            for (int j = 0; j < 4; ++j) { v[j] = xr[64 * j]; s += (v[j][0] * v[j][0] + v[j][1] * v[j][1]) + (v[j][2] * v[j][2] + v[j][3] * v[j][3]); }
            const float rstd = rsqrtf(wave_sum(s) * (1.f / DM) + EPS);
#pragma unroll
            for (int j = 0; j < 4; ++j) { const f32x4 ww = wr[64 * j]; f32x4 r;
#pragma unroll
                for (int i = 0; i < 4; ++i) r[i] = v[j][i] * rstd * ww[i];
                xr[64 * j] = r; }
        }
    }
    if (PROBE_SEL) { const unsigned long long t0 = rt(); while (rt() - t0 < probe_acc) __builtin_amdgcn_s_sleep(8); }
}

extern "C" void kernel_launch(void* const* d_in, const int* in_sizes, int n_in, void* d_out, int out_size, void* d_ws, size_t ws_size, hipStream_t stream) {
    static int grid = 0;
    if (grid == 0) {
        if (n_in != 19 || out_size != MT * DM || ws_size < WS_NEED) { fprintf(stderr, "kernel_launch: unexpected shapes (n_in %d out %d ws %zu need %zu)\n", n_in, out_size, ws_size, (size_t)WS_NEED); grid = -1; return; }
        int dev = 0, cus = 0, per_cu = 0;
        hipGetDevice(&dev); hipDeviceGetAttribute(&cus, hipDeviceAttributeMultiprocessorCount, dev);
        if (hipFuncSetAttribute((const void*)hybrid_fwd, hipFuncAttributeMaxDynamicSharedMemorySize, LDS_BYTES) != hipSuccess) { fprintf(stderr, "kernel_launch: hipFuncSetAttribute failed\n"); grid = -1; return; }
        if (hipOccupancyMaxActiveBlocksPerMultiprocessor(&per_cu, (const void*)hybrid_fwd, NTHREADS, LDS_BYTES) != hipSuccess || per_cu < 1) { fprintf(stderr, "kernel_launch: occupancy query gave %d\n", per_cu); per_cu = 1; }
        (void)hipGetLastError();
        grid = cus * per_cu;
    }
    if (grid < 0) return;
    Args a{};
    for (int i = 0; i < 19; ++i) a.in[i] = (const float*)d_in[i];
    a.out = (float*)d_out; a.ws = (unsigned char*)d_ws;
    void* args[] = {&a};
    hipError_t e = hipLaunchCooperativeKernel((const void*)hybrid_fwd, dim3(grid), dim3(NTHREADS), args, LDS_BYTES, stream);
    if (e != hipSuccess) fprintf(stderr, "cooperative launch failed: %s (grid %d)\n", hipGetErrorString(e), grid);
}
```

```cpp
#include <hip/hip_runtime.h>
#include <hip/hip_cooperative_groups.h>
#include <cstdio>
#include <cstdint>
namespace cg = cooperative_groups;
__device__ __forceinline__ int opaque_tid() { int t = (int)threadIdx.x; asm volatile("" : "+v"(t)); return t; }
namespace pg8 {
#define PG8_LAS __attribute__((address_space(3)))
typedef unsigned short bf16_t;
typedef short bf16x8 __attribute__((ext_vector_type(8)));
typedef float f32x4 __attribute__((ext_vector_type(4)));
typedef unsigned u32x4 __attribute__((ext_vector_type(4)));
constexpr int BM = 256, BK = 64, HALF = 128, HTB = HALF * BK * 2  , STAGE_BYTES = 8 * HTB, NXCD = 8, WGM = 8;

__host__ __device__ __forceinline__ int lds_byte(int r, int c) { const int st = (r >> 4) * 2 + (c >> 5), rr = r & 15, cc = c & 31, ob = rr * 64 + cc * 2; return st * 1024 + (ob ^ (((ob >> 9) & 1) << 5)); }
__host__ __device__ __forceinline__ void stage_rc(int b, int& R, int& C) { const int st = b / 1024, sb = b % 1024, swz = sb ^ (((sb >> 9) & 1) << 5); R = (st >> 1) * 16 + swz / 64; C = (st & 1) * 32 + (swz % 64) / 2; }
__host__ __device__ __forceinline__ int perm32(int rho) { const int n = rho >> 4, i = rho & 15; return 8 * (i >> 2) + 4 * n + (i & 3); }

struct Unit { int pm, pn; };
struct Gemm { const bf16_t* A; const bf16_t* Bt; int M, N, K; };

struct StaticOrder {
    int nM, nN, nwg, G, c;
    __host__ __device__ void init(int M, int N, int G_, int c_) { nM = M / BM; nN = N / BM; nwg = nM * nN; G = G_; c = c_; }
    __host__ __device__ bool next(int i, Unit& u) const {
        const long L = (long)i * G + c; if (L >= nwg) return false;
        int wgid = (int)L; { const int q = nwg / NXCD, r = nwg % NXCD, xcd = wgid % NXCD, off = wgid / NXCD; wgid = (xcd < r ? xcd * (q + 1) : r * (q + 1) + (xcd - r) * q) + off; }
        const int nig = WGM * nN, gid = wgid / nig, fm = gid * WGM, gsz = (nM - fm) < WGM ? (nM - fm) : WGM;
        u.pm = fm + ((wgid % nig) % gsz); u.pn = (wgid % nig) / gsz; return true;
    }
    __device__ __forceinline__ void a_ready(const Unit&) const {}
    __device__ __forceinline__ void done(const Unit&) const {}
};
__device__ __forceinline__ unsigned cvt_pk_bf16(float lo, float hi) { unsigned r; asm volatile("v_cvt_pk_bf16_f32 %0, %1, %2" : "=v"(r) : "v"(lo), "v"(hi)); return r; }
template <class Epi, class Sched, bool ALIGN_EPI = false, bool SP2 = false>
__device__ __forceinline__ void gemm_phase(PG8_LAS unsigned char* lds, const Gemm g, const Sched& S, const Epi& E) {
    const int tid = opaque_tid(), wid = __builtin_amdgcn_readfirstlane(tid >> 6), lane = tid & 63, wr = wid >> 2, wc = wid & 3, fr = lane & 15, fq = lane >> 4;
    const int K = g.K, nt = K / BK;
    unsigned voffA[2], voffB[2];
#pragma unroll
    for (int i = 0; i < 2; ++i) { int R, C; stage_rc(tid * 16 + i * 8192, R, C); const int Rb = Epi::PERM ? ((R & ~31) + perm32(R & 31)) : R;
        voffA[i] = (unsigned)(R * K + C) * 2u; voffB[i] = (unsigned)(Rb * K + C) * 2u; }
    const size_t kstep = (size_t)(BK * 2);
    const size_t hstep = (size_t)HALF * K * 2;
    const size_t tstep = 2 * hstep;
    const unsigned ldsw = (unsigned)wid * 1024u;
    const int aoff = lds_byte(wr * 64 + fr, fq * 8), boff = lds_byte(wc * 32 + fr, fq * 8);
#define PG8_SA(b, h) (((b) * 2 + (h)) * HTB)
#define PG8_SB(b, h) ((4 + (b) * 2 + (h)) * HTB)
#define PG8_STAGE(bufoff, gbase, voff) do { _Pragma("unroll") for (int _i = 0; _i < 2; ++_i) \
        __builtin_amdgcn_global_load_lds((const unsigned*)((const char*)(gbase) + (voff)[_i]), (PG8_LAS unsigned*)(lds + (bufoff) + ldsw + _i * 8192), 16, 0, 0); } while (0)
#define PG8_LDA(dst, b, h) do { _Pragma("unroll") for (int m = 0; m < 4; ++m) _Pragma("unroll") for (int k = 0; k < 2; ++k) dst[m][k] = *(const PG8_LAS bf16x8*)(lds + PG8_SA(b, h) + aoff + m * 2048 + k * 1024); } while (0)
#define PG8_LDB(dst, b, h) do { _Pragma("unroll") for (int n = 0; n < 2; ++n) _Pragma("unroll") for (int k = 0; k < 2; ++k) dst[n][k] = *(const PG8_LAS bf16x8*)(lds + PG8_SB(b, h) + boff + n * 2048 + k * 1024); } while (0)
#define PG8_MMA(ai, bj, At, Bt) do { __builtin_amdgcn_s_setprio(1); _Pragma("unroll") for (int m = 0; m < 4; ++m) _Pragma("unroll") for (int n = 0; n < 2; ++n) _Pragma("unroll") for (int k = 0; k < 2; ++k) \
        acc[ai][bj][m][n] = __builtin_amdgcn_mfma_f32_16x16x32_bf16(Bt[n][k], At[m][k], acc[ai][bj][m][n], 0, 0, 0); __builtin_amdgcn_s_setprio(0); } while (0)
#define PG8_WAIT_V(n) asm volatile("s_waitcnt vmcnt(" #n ")" ::: "memory")
#define PG8_WAIT_L(n) asm volatile("s_waitcnt lgkmcnt(" #n ")" ::: "memory")
#define PG8_BAR __builtin_amdgcn_s_barrier()
#define PG8_SCHED __builtin_amdgcn_sched_barrier(0)
    Unit cur, nxt; int ui = 0;
    if (!S.next(0, cur)) return;
    f32x4 acc[2][2][4][2];
#pragma unroll
    for (int a = 0; a < 2; ++a)
#pragma unroll
        for (int b = 0; b < 2; ++b)
#pragma unroll
            for (int m = 0; m < 4; ++m)
#pragma unroll
                for (int n = 0; n < 2; ++n) acc[a][b][m][n] = (f32x4){0.f, 0.f, 0.f, 0.f};
    bf16x8 At[4][2], B0[2][2], B1[2][2];
    const char* cA = (const char*)g.A + (size_t)cur.pm * tstep; const char* cB = (const char*)g.Bt + (size_t)cur.pn * tstep;
    S.a_ready(cur);
    if constexpr (SP2) {
        PG8_STAGE(PG8_SB(0, 0), cB, voffB); PG8_STAGE(PG8_SB(0, 1), cB + hstep, voffB); PG8_STAGE(PG8_SA(0, 0), cA, voffA); PG8_STAGE(PG8_SA(0, 1), cA + hstep, voffA);
        if (wr == 1) PG8_BAR;
        PG8_WAIT_V(2); PG8_BAR;
        PG8_STAGE(PG8_SB(1, 0), cB + kstep, voffB); PG8_STAGE(PG8_SA(1, 0), cA + kstep, voffA); PG8_STAGE(PG8_SB(1, 1), cB + hstep + kstep, voffB);
        PG8_WAIT_V(6); PG8_BAR;
    } else {
        PG8_STAGE(PG8_SB(0, 0), cB, voffB); PG8_STAGE(PG8_SA(0, 0), cA, voffA); PG8_STAGE(PG8_SB(0, 1), cB + hstep, voffB); PG8_STAGE(PG8_SA(0, 1), cA + hstep, voffA);
        if (wr == 1) PG8_BAR;
        PG8_WAIT_V(4); PG8_BAR;
        PG8_STAGE(PG8_SB(1, 0), cB + kstep, voffB); PG8_STAGE(PG8_SA(1, 0), cA + kstep, voffA); PG8_STAGE(PG8_SB(1, 1), cB + hstep + kstep, voffB);
        PG8_WAIT_V(6); PG8_BAR;
    }
    for (;;) {
        const bool has_next = S.next(ui + 1, nxt);
        const char* nA = has_next ? (const char*)g.A + (size_t)nxt.pm * tstep : cA; const char* nB = has_next ? (const char*)g.Bt + (size_t)nxt.pn * tstep : cB;
        for (int t = 0; t < nt; t += 2) {
            const bool last = (t == nt - 2);
            const char* a1 = cA + (size_t)(t + 1) * kstep;
            const char* a2 = last ? nA : cA + (size_t)(t + 2) * kstep; const char* b2 = last ? nB : cB + (size_t)(t + 2) * kstep;
            const char* a3 = a2 + kstep; const char* b3 = b2 + kstep;
            if (last && has_next) S.a_ready(nxt);
            if constexpr (SP2) {
            PG8_LDB(B0, 0, 0); PG8_LDB(B1, 0, 1); PG8_SCHED; PG8_LDA(At, 0, 0); PG8_STAGE(PG8_SA(1, 1), a1 + hstep, voffA);
            PG8_WAIT_V(8); PG8_WAIT_L(0); PG8_BAR; PG8_MMA(0, 0, At, B0); PG8_MMA(0, 1, At, B1); PG8_BAR; PG8_SCHED;
            PG8_LDA(At, 0, 1); PG8_STAGE(PG8_SB(0, 0), b2, voffB); PG8_STAGE(PG8_SB(0, 1), b2 + hstep, voffB); PG8_STAGE(PG8_SA(0, 0), a2, voffA);
            PG8_WAIT_V(8); PG8_WAIT_L(0); PG8_BAR; PG8_MMA(1, 0, At, B0); PG8_MMA(1, 1, At, B1); PG8_BAR; PG8_SCHED;
            PG8_LDB(B0, 1, 0); PG8_LDB(B1, 1, 1); PG8_SCHED; PG8_LDA(At, 1, 0); PG8_STAGE(PG8_SA(0, 1), a2 + hstep, voffA);
            PG8_WAIT_V(8); PG8_WAIT_L(0); PG8_BAR; PG8_MMA(0, 0, At, B0); PG8_MMA(0, 1, At, B1); PG8_BAR; PG8_SCHED;
            PG8_LDA(At, 1, 1); PG8_STAGE(PG8_SB(1, 0), b3, voffB); PG8_STAGE(PG8_SB(1, 1), b3 + hstep, voffB); PG8_STAGE(PG8_SA(1, 0), a3, voffA);
            PG8_WAIT_V(8); PG8_WAIT_L(0); PG8_BAR; PG8_MMA(1, 0, At, B0); PG8_MMA(1, 1, At, B1); PG8_BAR; PG8_SCHED;
            } else {
            PG8_LDB(B0, 0, 0); PG8_SCHED; PG8_LDA(At, 0, 0); PG8_STAGE(PG8_SA(1, 1), a1 + hstep, voffA);
            PG8_WAIT_L(8); PG8_BAR; PG8_WAIT_L(0); PG8_MMA(0, 0, At, B0); PG8_BAR; PG8_SCHED;
            PG8_LDB(B1, 0, 1); PG8_STAGE(PG8_SB(0, 0), b2, voffB);
            PG8_BAR; PG8_WAIT_L(0); PG8_MMA(0, 1, At, B1); PG8_BAR;
            PG8_LDA(At, 0, 1); PG8_STAGE(PG8_SA(0, 0), a2, voffA);
            PG8_BAR; PG8_WAIT_L(0); PG8_MMA(1, 0, At, B0); PG8_BAR; PG8_SCHED;
            PG8_STAGE(PG8_SB(0, 1), b2 + hstep, voffB);
            PG8_WAIT_V(6); PG8_BAR; PG8_MMA(1, 1, At, B1); PG8_BAR;
            PG8_LDB(B0, 1, 0); PG8_SCHED; PG8_LDA(At, 1, 0); PG8_STAGE(PG8_SA(0, 1), a2 + hstep, voffA);
            PG8_WAIT_L(8); PG8_BAR; PG8_WAIT_L(0); PG8_MMA(0, 0, At, B0); PG8_BAR; PG8_SCHED;
            PG8_LDB(B1, 1, 1); PG8_STAGE(PG8_SB(1, 0), b3, voffB);
            PG8_BAR; PG8_WAIT_L(0); PG8_MMA(0, 1, At, B1); PG8_BAR;
            PG8_LDA(At, 1, 1); PG8_STAGE(PG8_SA(1, 0), a3, voffA);
            PG8_BAR; PG8_WAIT_L(0); PG8_MMA(1, 0, At, B0); PG8_BAR; PG8_SCHED;
            PG8_STAGE(PG8_SB(1, 1), b3 + hstep, voffB);
            PG8_WAIT_V(6); PG8_BAR; PG8_MMA(1, 1, At, B1); PG8_BAR;
            }
        }
        if constexpr (ALIGN_EPI) { if (wr == 0) PG8_BAR; }
        if constexpr (!Epi::AFTER_DRAIN) { E(acc, cur, wr, wc, fr, fq); S.done(cur); }
        if (!has_next) break;
#pragma unroll
        for (int a = 0; a < 2; ++a)
#pragma unroll
            for (int b = 0; b < 2; ++b)
#pragma unroll
                for (int m = 0; m < 4; ++m)
#pragma unroll
                    for (int n = 0; n < 2; ++n) acc[a][b][m][n] = (f32x4){0.f, 0.f, 0.f, 0.f};
        cur = nxt; cA = nA; cB = nB; ++ui;
        if constexpr (ALIGN_EPI) { if (wr == 1) PG8_BAR; }
    }
    PG8_WAIT_V(0);
    if constexpr (!ALIGN_EPI) { if (wr == 0) PG8_BAR; }
    PG8_BAR;
    if constexpr (Epi::AFTER_DRAIN) { E.fused(acc, cur, wr, wc, fr, fq, lds, wid, lane); S.done(cur); }
#undef PG8_SA
#undef PG8_SB
#undef PG8_STAGE
#undef PG8_LDA
#undef PG8_LDB
#undef PG8_MMA
#undef PG8_WAIT_V
#undef PG8_WAIT_L
#undef PG8_BAR
#undef PG8_SCHED
}
}

constexpr int NB = 8, SEQ = 2048, DM = 1024, MT = NB * SEQ, DFF = 4096, IN_DIM = 13344;
constexpr int NTHREADS = 512, NWAVES = 8, LDS_BYTES = 147456;
constexpr float EPS = 1e-6f;
typedef unsigned short bf16;
typedef unsigned v4u __attribute__((ext_vector_type(4)));
typedef unsigned v2u __attribute__((ext_vector_type(2)));
typedef float f32x4 __attribute__((ext_vector_type(4)));
typedef short bf16x8 __attribute__((ext_vector_type(8)));
enum { B_H = 0, B_DNG = 1, B_SBQ = 2, B_SSZ = 3, B_DNQ = 4, B_DNK = 5, B_DNV = 6, B_SBK = 7, B_SBV = 8, B_SSX = 9, B_SSBC = 10, NBUF = 11 };
constexpr size_t BUFE = (size_t)MT * DM;
constexpr size_t WS_W = NBUF * BUFE * 2;
constexpr size_t W_IN = 0, W_G = W_IN + (size_t)10240 * 1024, W_OUT = W_G + (size_t)6144 * 1024, W_UP = W_OUT + (size_t)1024 * 1024,
                 W_DOWN = W_UP + (size_t)4096 * 1024, W_END = W_DOWN + (size_t)4096 * 1024;
constexpr size_t WS_SMALL = WS_W + W_END * 2;
constexpr size_t WS_CTL = WS_SMALL + (size_t)MT * 64 * 4;
constexpr size_t WS_NEED = WS_CTL + 4096;

__device__ __forceinline__ float bf2f(unsigned u) { return __builtin_bit_cast(float, u << 16); }
__device__ __forceinline__ unsigned f2bf(float f) { unsigned u = __builtin_bit_cast(unsigned, f); return (u + 0x7fffu + ((u >> 16) & 1u)) >> 16; }
typedef float f32x2 __attribute__((ext_vector_type(2)));
typedef __bf16 bf16x2_t __attribute__((ext_vector_type(2)));
__device__ __forceinline__ unsigned pk2(float lo, float hi) { f32x2 v = {lo, hi}; return __builtin_bit_cast(unsigned, __builtin_convertvector(v, bf16x2_t)); }
__device__ __forceinline__ void unpack8(v4u r, float* o) {
    o[0] = bf2f(r.x & 0xffffu); o[1] = __builtin_bit_cast(float, r.x & 0xffff0000u); o[2] = bf2f(r.y & 0xffffu); o[3] = __builtin_bit_cast(float, r.y & 0xffff0000u);
    o[4] = bf2f(r.z & 0xffffu); o[5] = __builtin_bit_cast(float, r.z & 0xffff0000u); o[6] = bf2f(r.w & 0xffffu); o[7] = __builtin_bit_cast(float, r.w & 0xffff0000u);
}
__device__ __forceinline__ v4u pack8(const float* v) { v4u w; w.x = pk2(v[0], v[1]); w.y = pk2(v[2], v[3]); w.z = pk2(v[4], v[5]); w.w = pk2(v[6], v[7]); return w; }
__device__ __forceinline__ float sigmoidf_(float x) { return 1.f / (1.f + __expf(-x)); }
__device__ __forceinline__ float siluf_(float x) { return x / (1.f + __expf(-x)); }
__device__ __forceinline__ float softplusf_(float x) { return fmaxf(x, 0.f) + log1pf(__expf(-fabsf(x))); }
template <int CTRL> __device__ __forceinline__ float dppf(float v) { return __builtin_bit_cast(float, __builtin_amdgcn_update_dpp(0, __builtin_bit_cast(int, v), CTRL, 0xF, 0xF, true)); }
__device__ __forceinline__ float red8(float v) { v += dppf<0xB1>(v); v += dppf<0x4E>(v); v += dppf<0x141>(v); return v; }
__device__ __forceinline__ float red16(float v) { v = red8(v); v += dppf<0x140>(v); return v; }
__device__ __forceinline__ float wave_sum(float v) {
#pragma unroll
    for (int o = 1; o < 64; o <<= 1) v += __shfl_xor(v, o);
    return v;
}
#define LDS_WAIT() asm volatile("s_waitcnt lgkmcnt(0)" ::: "memory")

struct Args { const float* in[19]; float* out; unsigned char* ws; };
#ifndef PROBE_SEL
#define PROBE_SEL 0
#endif
__device__ __forceinline__ unsigned long long rt() { return __builtin_amdgcn_s_memrealtime(); }
#define PT0() unsigned long long pt_ = PROBE_SEL ? rt() : 0ull
#define PT1(k) do { if (PROBE_SEL & (1 << (k))) probe_acc += rt() - pt_; } while (0)

struct EpiRoute {
    static constexpr bool PERM = true, AFTER_DRAIN = false;
    bf16* base;
    __device__ __forceinline__ void operator()(const pg8::f32x4 (&acc)[2][2][4][2], const pg8::Unit& u, int wr, int wc, int fr, int fq) const {
        bf16* O = base + (size_t)(1 + (u.pn >> 2)) * BUFE;
        const int col0 = (u.pn & 3) * 256 + wc * 32 + 8 * fq, row0 = u.pm * 256 + wr * 64 + fr;
#pragma unroll
        for (int ai = 0; ai < 2; ++ai)
#pragma unroll
            for (int m = 0; m < 4; ++m) { bf16* rowp = O + (size_t)(row0 + ai * 128 + m * 16) * DM + col0;
#pragma unroll
                for (int bj = 0; bj < 2; ++bj) { const pg8::f32x4 v0 = acc[ai][bj][m][0], v1 = acc[ai][bj][m][1];
                    v4u w; w.x = pk2(v0[0], v0[1]); w.y = pk2(v0[2], v0[3]); w.z = pk2(v1[0], v1[1]); w.w = pk2(v1[2], v1[3]);
                    *(v4u*)(rowp + bj * 128) = w; } }
    }
};
struct EpiRelu2 {
    static constexpr bool PERM = true, AFTER_DRAIN = false;
    bf16* O;
    __device__ __forceinline__ void operator()(const pg8::f32x4 (&acc)[2][2][4][2], const pg8::Unit& u, int wr, int wc, int fr, int fq) const {
        const int col0 = u.pn * 256 + wc * 32 + 8 * fq, row0 = u.pm * 256 + wr * 64 + fr;
#pragma unroll
        for (int ai = 0; ai < 2; ++ai)
#pragma unroll
            for (int m = 0; m < 4; ++m) { bf16* rowp = O + (size_t)(row0 + ai * 128 + m * 16) * DFF + col0;
#pragma unroll
                for (int bj = 0; bj < 2; ++bj) { float v[8];
#pragma unroll
                    for (int i = 0; i < 4; ++i) { float a = fmaxf(acc[ai][bj][m][0][i], 0.f), b = fmaxf(acc[ai][bj][m][1][i], 0.f); v[i] = a * a; v[4 + i] = b * b; }
                    *(v4u*)(rowp + bj * 128) = pack8(v); } }
    }
};
struct EpiResid {
    static constexpr bool PERM = true, AFTER_DRAIN = false;
    const float* xin; float* xout;
    __device__ __forceinline__ void operator()(const pg8::f32x4 (&acc)[2][2][4][2], const pg8::Unit& u, int wr, int wc, int fr, int fq) const {
        const int col0 = u.pn * 256 + wc * 32 + 8 * fq, row0 = u.pm * 256 + wr * 64 + fr;
#pragma unroll
        for (int ai = 0; ai < 2; ++ai)
#pragma unroll
            for (int m = 0; m < 4; ++m) { const size_t ro = (size_t)(row0 + ai * 128 + m * 16) * DM + col0;
#pragma unroll
                for (int bj = 0; bj < 2; ++bj) { const size_t o = ro + bj * 128;
                    const f32x4 a = *(const f32x4*)(xin + o), b = *(const f32x4*)(xin + o + 4);
                    f32x4 r0, r1;
#pragma unroll
                    for (int i = 0; i < 4; ++i) { r0[i] = a[i] + acc[ai][bj][m][0][i]; r1[i] = b[i] + acc[ai][bj][m][1][i]; }
                    *(f32x4*)(xout + o) = r0; *(f32x4*)(xout + o + 4) = r1; } }
    }
};
struct SchedGate {
    int G, c;
    __device__ __forceinline__ bool next(int i, pg8::Unit& u) const {
        const int tile = c + (i / 6) * G; if (tile >= 256) return false;
        const int s = i % 6, br = s >> 1, pm = tile >> 2, pn = tile & 3;
        if ((s & 1) == 0) { u.pm = pm; u.pn = br * 4 + pn; } else { u.pm = (1 + br) * 64 + pm; u.pn = (3 + br) * 4 + pn; }
        return true;
    }
    __device__ __forceinline__ void a_ready(const pg8::Unit&) const {}
    __device__ __forceinline__ void done(const pg8::Unit&) const {}
};
struct EpiGate {
    static constexpr bool PERM = true, AFTER_DRAIN = false;
    bf16* gsc; float* macc; bf16* merged;
    __device__ __forceinline__ void operator()(const pg8::f32x4 (&acc)[2][2][4][2], const pg8::Unit& u, int wr, int wc, int fr, int fq) const {
        const int j = u.pn >> 2, pn = u.pn & 3, pm = u.pm & 63;
        const int col0 = pn * 256 + wc * 32 + 8 * fq, row0 = pm * 256 + wr * 64 + fr;
#pragma unroll
        for (int ai = 0; ai < 2; ++ai)
#pragma unroll
            for (int m = 0; m < 4; ++m) { const size_t ro = (size_t)(row0 + ai * 128 + m * 16) * DM + col0;
#pragma unroll
                for (int bj = 0; bj < 2; ++bj) { const size_t o = ro + bj * 128; float v[8];
#pragma unroll
                    for (int i = 0; i < 4; ++i) { v[i] = acc[ai][bj][m][0][i]; v[4 + i] = acc[ai][bj][m][1][i]; }
                    if (j < 3) {
#pragma unroll
                        for (int i = 0; i < 8; ++i) v[i] = sigmoidf_(v[i]);
                        *(v4u*)(gsc + o) = pack8(v);
                    } else {
                        float g[8]; unpack8(*(const v4u*)(gsc + o), g);
#pragma unroll
                        for (int i = 0; i < 8; ++i) v[i] *= g[i];
                        if (j > 3) { const f32x4 a = *(const f32x4*)(macc + o), b = *(const f32x4*)(macc + o + 4);
#pragma unroll
                            for (int i = 0; i < 4; ++i) { v[i] += a[i]; v[4 + i] += b[i]; } }
                        if (j < 5) { *(f32x4*)(macc + o) = (f32x4){v[0], v[1], v[2], v[3]}; *(f32x4*)(macc + o + 4) = (f32x4){v[4], v[5], v[6], v[7]}; }
                        else *(v4u*)(merged + o) = pack8(v);
                    } } }
    }
};

__device__ __forceinline__ void transpose_item(const float* __restrict__ W, int ldw, bf16* __restrict__ WT, int K, int nblk, float* scr, int item, int lane) {
    const int kb = item / nblk, nb = item % nblk, k0 = 64 * kb, n0 = 32 * nb;
#pragma unroll 8
    for (int i = 0; i < 32; ++i) { const int kk = 2 * i + (lane >> 5); scr[kk * 33 + (lane & 31)] = W[(size_t)(k0 + kk) * ldw + n0 + (lane & 31)]; }
    LDS_WAIT();
    const int c = lane & 7;
#pragma unroll
    for (int j = 0; j < 4; ++j) { const int n = (lane >> 3) + 8 * j; const float* s = scr + (8 * c) * 33 + n;
        v4u o; o.x = pk2(s[0 * 33], s[1 * 33]); o.y = pk2(s[2 * 33], s[3 * 33]); o.z = pk2(s[4 * 33], s[5 * 33]); o.w = pk2(s[6 * 33], s[7 * 33]);
        *(v4u*)(WT + (size_t)(n0 + n) * K + k0 + 8 * c) = o; }
    LDS_WAIT();
}
__device__ __forceinline__ void rms_row_to_bf16(const float* xrow, const float* w, bf16* orow, int lane) {
    const f32x4* xr = (const f32x4*)xrow + lane; const f32x4* wr = (const f32x4*)w + lane;
    f32x4 v[4]; float s = 0.f;
#pragma unroll
    for (int j = 0; j < 4; ++j) { v[j] = xr[64 * j]; s += (v[j][0] * v[j][0] + v[j][1] * v[j][1]) + (v[j][2] * v[j][2] + v[j][3] * v[j][3]); }
    const float rstd = rsqrtf(wave_sum(s) * (1.f / DM) + EPS);
    unsigned long long* o8 = (unsigned long long*)orow + lane;
#pragma unroll
    for (int j = 0; j < 4; ++j) { const f32x4 ww = wr[64 * j];
        o8[64 * j] = (unsigned long long)pk2(v[j][0] * rstd * ww[0], v[j][1] * rstd * ww[1]) | ((unsigned long long)pk2(v[j][2] * rstd * ww[2], v[j][3] * rstd * ww[3]) << 32); }
}
__device__ __forceinline__ void phase0(unsigned char* lds, const Args& a, int l, const float* xin) {
    const int tid = opaque_tid(), lane = tid & 63, wave = tid >> 6, gw = blockIdx.x * NWAVES + wave, NGW = gridDim.x * NWAVES;
    bf16* Wreg = (bf16*)(a.ws + WS_W);
    const float* w_in = a.in[2] + (size_t)l * DM * IN_DIM;
    {
        float* scr = (float*)lds + wave * (64 * 33);
        const float* w_br = a.in[13] + (size_t)l * 3 * DM * DM; const float* w_out = a.in[14] + (size_t)l * DM * DM;
        const float* w_up = a.in[16] + (size_t)l * DM * DFF; const float* w_down = a.in[17] + (size_t)l * DFF * DM;
        constexpr int NSEG = 17, NIT = NSEG * 512 + 2048 + 2048;
        for (int it = gw; it < NIT; it += NGW) {
            if (it < NSEG * 512) {
                const int seg = it >> 9, r = it & 511;
                const float* W; int ldw; bf16* WT;
                if (seg < 13) {
                    const int co = seg == 0 ? 3072 : seg == 1 ? 4112 : seg == 2 ? 7184 : seg == 3 ? 0 : seg == 4 ? 1024 : seg == 5 ? 2048 : seg == 6 ? 5136 : seg == 7 ? 6160 : seg == 8 ? 8208 : seg == 9 ? 9232
                                 : 10272 + (seg - 10) * 1024;
                    W = w_in + co; ldw = IN_DIM; WT = Wreg + (size_t)seg * DM * DM;
                } else if (seg < 16) { W = w_br + (size_t)(seg - 13) * DM * DM; ldw = DM; WT = Wreg + W_G + (size_t)(3 + seg - 13) * DM * DM; }
                else { W = w_out; ldw = DM; WT = Wreg + W_OUT; }
                transpose_item(W, ldw, WT, DM, 32, scr, r, lane);
            } else if (it < NSEG * 512 + 2048) transpose_item(w_up, DFF, Wreg + W_UP, DM, 128, scr, it - NSEG * 512, lane);
            else transpose_item(w_down, DM, Wreg + W_DOWN, DFF, 32, scr, it - NSEG * 512 - 2048, lane);
        }
    }
    __syncthreads();
    {
        float* Ws = (float*)lds;
        for (int idx = tid; idx < 32 * DM; idx += NTHREADS) { const int k = idx >> 5, c = idx & 31; Ws[c * DM + k] = w_in[(size_t)k * IN_DIM + (c < 16 ? 4096 + c : 10256 + c - 16)]; }
        __syncthreads();
        const float* nw = a.in[1] + (size_t)l * DM;
        bf16* H = (bf16*)a.ws; float* small = (float*)(a.ws + WS_SMALL);
        float p0 = 0.f, p1 = 0.f;
        if (lane < 8) { p0 = __expf(a.in[4][l * 8 + lane]); p1 = a.in[5][l * 8 + lane]; }
        else if (lane >= 16 && lane < 32) { p0 = __expf(a.in[9][l * 16 + lane - 16]); p1 = a.in[10][l * 16 + lane - 16]; }
        for (int m = gw; m < MT; m += NGW) {
            const float* xrow = xin + (size_t)m * DM;
            float xv[16]; float s = 0.f;
#pragma unroll
            for (int i = 0; i < 16; ++i) { xv[i] = xrow[lane + 64 * i]; s += xv[i] * xv[i]; }
            const float rstd = rsqrtf(wave_sum(s) * (1.f / DM) + EPS);
            bf16* hrow = H + (size_t)m * DM;
#pragma unroll
            for (int i = 0; i < 16; ++i) { xv[i] = xv[i] * rstd * nw[lane + 64 * i]; hrow[lane + 64 * i] = (bf16)f2bf(xv[i]); }
            float mine = 0.f;
#pragma unroll 4
            for (int c = 0; c < 32; ++c) { float acc = 0.f;
#pragma unroll
                for (int i = 0; i < 16; ++i) acc += xv[i] * Ws[c * DM + lane + 64 * i];
                acc = wave_sum(acc); mine = (lane == c) ? acc : mine; }
            if (lane < 8) small[(size_t)m * 64 + lane] = -p0 * softplusf_(mine + p1);
            else if (lane < 16) small[(size_t)m * 64 + lane] = sigmoidf_(mine);
            else if (lane < 32) { const float dt = softplusf_(mine + p1); small[(size_t)m * 64 + lane] = dt; small[(size_t)m * 64 + lane + 16] = -p0 * dt; }
        }
    }
}

__device__ __forceinline__ void conv8(const bf16* p, int pos, const float* w, int wstride, const float* bias, float* out) {
    float acc[8];
#pragma unroll
    for (int i = 0; i < 8; ++i) acc[i] = bias ? bias[i] : 0.f;
#pragma unroll
    for (int j = 0; j < 4; ++j) { const int back = 3 - j;
        if (pos - back >= 0) { float xv[8]; unpack8(*(const v4u*)(p - (size_t)back * DM), xv);
            const f32x4 w0 = *(const f32x4*)(w + j * wstride), w1 = *(const f32x4*)(w + j * wstride + 4);
#pragma unroll
            for (int i = 0; i < 4; ++i) { acc[i] += xv[i] * w0[i]; acc[4 + i] += xv[4 + i] * w1[i]; } } }
#pragma unroll
    for (int i = 0; i < 8; ++i) out[i] = siluf_(acc[i]);
}

__device__ __forceinline__ void conv8r(const v4u (&raw)[4], const float* w, int wstride, const float* bias, float* out) {
    float acc[8];
#pragma unroll
    for (int i = 0; i < 8; ++i) acc[i] = bias ? bias[i] : 0.f;
#pragma unroll
    for (int j = 0; j < 4; ++j) { float xv[8]; unpack8(raw[j], xv);
        const f32x4 w0 = *(const f32x4*)(w + j * wstride), w1 = *(const f32x4*)(w + j * wstride + 4);
#pragma unroll
        for (int i = 0; i < 4; ++i) { acc[i] += xv[i] * w0[i]; acc[4 + i] += xv[4 + i] * w1[i]; } }
#pragma unroll
    for (int i = 0; i < 8; ++i) out[i] = siluf_(acc[i]);
}
#define LOAD4(dst, p, pos) do { _Pragma("unroll") for (int j_ = 0; j_ < 4; ++j_) { const int back_ = 3 - j_; \
        if ((pos) - back_ >= 0) dst[j_] = *(const v4u*)((p) - (size_t)back_ * DM); else dst[j_] = (v4u){0u, 0u, 0u, 0u}; } } while (0)

template <int K> __device__ __forceinline__ void mma16(f32x4& acc, const bf16* Ap, int lda, const bf16* Bp, int ldb, int fr, int fq) {
#pragma unroll
    for (int k = 0; k < K; k += 32) { const bf16x8 af = *(const bf16x8*)(Ap + fr * lda + k + fq * 8), bfv = *(const bf16x8*)(Bp + fr * ldb + k + fq * 8);
        acc = __builtin_amdgcn_mfma_f32_16x16x32_bf16(af, bfv, acc, 0, 0, 0); }
}
__device__ __forceinline__ void dn_item(unsigned char* lds, const Args& a, int l, int item) {
    constexpr int LDK = 136, LDJ = 40, LDL = 36;
    const int b = item >> 3, h = item & 7;
    bf16* kA = (bf16*)lds;
    bf16* qA = kA + 32 * LDK;
    bf16* qgA = qA + 32 * LDK;
    bf16* wA = qgA + 32 * LDK;
    bf16* kdT = wA + 32 * LDK;
    bf16* vnT = kdT + 128 * LDJ;
    bf16* attn = vnT + 128 * LDJ;
    bf16* ST = attn + 32 * LDJ;
    float* kf = (float*)(ST + 128 * LDK);
    float* vf = kf + 32 * 128;
    float* os = kf;
    float* Lm = vf + 32 * 128;
    float* gcs = Lm + 32 * LDL;
    float* betas = gcs + 32;
    float* cwL = betas + 32;
    const int tid = opaque_tid(), w = tid >> 6, lane = tid & 63, fr = lane & 15, fq = lane >> 4;
    bf16* base = (bf16*)a.ws;
    const bf16* Q = base + (size_t)B_DNQ * BUFE; const bf16* K = base + (size_t)B_DNK * BUFE; const bf16* V = base + (size_t)B_DNV * BUFE; bf16* G = base + (size_t)B_DNG * BUFE;
    const float* small = (const float*)(a.ws + WS_SMALL);
    const float* cw = a.in[3] + (size_t)l * 4 * 3072;
    const size_t rowbase = (size_t)b * SEQ;
    const int tq = tid >> 4, cq = tid & 15;
    const float* nwp = a.in[6] + l * 128 + cq * 8;
    f32x4 Sacc[8];
#pragma unroll
    for (int i = 0; i < 8; ++i) Sacc[i] = (f32x4){0.f, 0.f, 0.f, 0.f};
    for (int i = tid; i < 128 * LDK / 2; i += NTHREADS) ((unsigned*)ST)[i] = 0u;
    for (int i = tid; i < 4 * 384; i += NTHREADS) { const int j = i / 384, r = i % 384; cwL[i] = cw[j * 3072 + (r >> 7) * 1024 + h * 128 + (r & 127)]; }
    __syncthreads();
    v4u rq[4], rk[4], rv[4], rgate; float rg = 0.f, rbv = 0.f;
#define DN_LOADS(c_) do { const int t0_ = (c_) * 32, pos_ = t0_ + tq; const size_t off_ = (rowbase + pos_) * DM + h * 128 + cq * 8; \
        LOAD4(rq, Q + off_, pos_); LOAD4(rk, K + off_, pos_); LOAD4(rv, V + off_, pos_); rgate = *(const v4u*)(G + off_); \
        { const size_t r_ = rowbase + t0_ + (lane & 31); rg = small[r_ * 64 + h]; rbv = small[r_ * 64 + 8 + h]; } } while (0)
    DN_LOADS(0);
    for (int c = 0; c < SEQ / 32; ++c) {
        const int t0 = c * 32;
        float gcv = rg;
#pragma unroll
        for (int off = 1; off < 32; off <<= 1) { const float t = __shfl_up(gcv, off, 32); if ((lane & 31) >= off) gcv += t; }
        const float gc_last = __shfl(gcv, 31), gc_t = __shfl(gcv, tq), beta_t = __shfl(rbv, tq);
        const v4u gcur = rgate;
        {   float q8[8], k8[8], v8[8];
            conv8r(rq, cwL + cq * 8, 384, nullptr, q8);
            __builtin_amdgcn_sched_barrier(0);
            conv8r(rk, cwL + 128 + cq * 8, 384, nullptr, k8);
            __builtin_amdgcn_sched_barrier(0);
            conv8r(rv, cwL + 256 + cq * 8, 384, nullptr, v8);
            __builtin_amdgcn_sched_barrier(0);
            float sq = 0.f, sk = 0.f;
#pragma unroll
            for (int i = 0; i < 8; ++i) { sq += q8[i] * q8[i]; sk += k8[i] * k8[i]; }
            sq = red16(sq); sk = red16(sk);
            const float rqn = rsqrtf(sq + EPS) * 0.08838834764831845f, rkn = rsqrtf(sk + EPS);
            const float eg = __expf(gc_t), kb = beta_t * eg, kd = __expf(gc_last - gc_t);
            float t8[8];
#pragma unroll
            for (int i = 0; i < 8; ++i) { q8[i] *= rqn; k8[i] *= rkn; }
            *(v4u*)(kA + tq * LDK + cq * 8) = pack8(k8); *(v4u*)(qA + tq * LDK + cq * 8) = pack8(q8);
#pragma unroll
            for (int i = 0; i < 8; ++i) t8[i] = q8[i] * eg;
            *(v4u*)(qgA + tq * LDK + cq * 8) = pack8(t8);
            *(f32x4*)(kf + tq * 128 + cq * 8) = (f32x4){k8[0] * kb, k8[1] * kb, k8[2] * kb, k8[3] * kb}; *(f32x4*)(kf + tq * 128 + cq * 8 + 4) = (f32x4){k8[4] * kb, k8[5] * kb, k8[6] * kb, k8[7] * kb};
            *(f32x4*)(vf + tq * 128 + cq * 8) = (f32x4){v8[0] * beta_t, v8[1] * beta_t, v8[2] * beta_t, v8[3] * beta_t}; *(f32x4*)(vf + tq * 128 + cq * 8 + 4) = (f32x4){v8[4] * beta_t, v8[5] * beta_t, v8[6] * beta_t, v8[7] * beta_t};
#pragma unroll
            for (int i = 0; i < 8; ++i) kdT[(cq * 8 + i) * LDJ + tq] = (bf16)f2bf(k8[i] * kd);
        }
        if (tid < 32) { gcs[tid] = gcv; betas[tid] = rbv; }
        __syncthreads();
        if (c + 1 < SEQ / 32) DN_LOADS(c + 1);
        {   const int ww = w & 3, gi = ww >> 1, gj = ww & 1; f32x4 acc = {0.f, 0.f, 0.f, 0.f};
            mma16<128>(acc, (w < 4 ? kA : qA) + gi * 16 * LDK, LDK, kA + gj * 16 * LDK, LDK, fr, fq);
            const int jI = 16 * gj + fr; const float gj_ = gcs[jI];
#pragma unroll
            for (int jj = 0; jj < 4; ++jj) { const int iI = 16 * gi + 4 * fq + jj; const float dec = __expf(gcs[iI] - gj_);
                if (w < 4) Lm[iI * LDL + jI] = jI < iI ? betas[iI] * acc[jj] * dec : 0.f;
                else attn[iI * LDJ + jI] = (bf16)f2bf(jI <= iI ? acc[jj] * dec : 0.f); } }
        __syncthreads();
        if (tid < 256) { const int cc = tid & 127; const bool is_w = tid >= 128; const float* R = is_w ? kf : vf;
            float x[32];
#pragma unroll
            for (int i = 0; i < 32; ++i) { float a0 = R[i * 128 + cc], a1 = 0.f, a2 = 0.f, a3 = 0.f;
#pragma unroll
                for (int j4 = 0; j4 < (i + 3) / 4; ++j4) { const f32x4 l4 = *(const f32x4*)(Lm + i * LDL + j4 * 4);
                    if (j4 * 4 + 0 < i) a0 -= l4[0] * x[j4 * 4 + 0];
                    if (j4 * 4 + 1 < i) a1 -= l4[1] * x[j4 * 4 + 1];
                    if (j4 * 4 + 2 < i) a2 -= l4[2] * x[j4 * 4 + 2];
                    if (j4 * 4 + 3 < i) a3 -= l4[3] * x[j4 * 4 + 3]; }
                x[i] = (a0 + a1) + (a2 + a3); if ((i & 3) == 3) __builtin_amdgcn_sched_barrier(0); }
            if (is_w) {
#pragma unroll
                for (int i = 0; i < 32; ++i) wA[i * LDK + cc] = (bf16)f2bf(x[i]);
            } else {
#pragma unroll
                for (int i = 0; i < 32; ++i) vf[i * 128 + cc] = x[i];
            } }
        __syncthreads();
#pragma unroll
        for (int it = 0; it < 2; ++it) { f32x4 acc = {0.f, 0.f, 0.f, 0.f};
            mma16<128>(acc, wA + it * 16 * LDK, LDK, ST + w * 16 * LDK, LDK, fr, fq);
            float vn[4];
#pragma unroll
            for (int jj = 0; jj < 4; ++jj) vn[jj] = vf[(16 * it + 4 * fq + jj) * 128 + 16 * w + fr] - acc[jj];
            v2u pk; pk.x = pk2(vn[0], vn[1]); pk.y = pk2(vn[2], vn[3]);
            *(v2u*)(vnT + (16 * w + fr) * LDJ + 16 * it + 4 * fq) = pk; }
        __syncthreads();
#pragma unroll
        for (int it = 0; it < 2; ++it) { f32x4 acc = {0.f, 0.f, 0.f, 0.f};
            mma16<128>(acc, qgA + it * 16 * LDK, LDK, ST + w * 16 * LDK, LDK, fr, fq);
            mma16<32>(acc, attn + it * 16 * LDJ, LDJ, vnT + w * 16 * LDJ, LDJ, fr, fq);
#pragma unroll
            for (int jj = 0; jj < 4; ++jj) os[(16 * it + 4 * fq + jj) * 128 + 16 * w + fr] = acc[jj]; }
        {   const float dl = __expf(gc_last);
#pragma unroll
            for (int dt = 0; dt < 8; ++dt) { Sacc[dt] = Sacc[dt] * dl; mma16<32>(Sacc[dt], kdT + dt * 16 * LDJ, LDJ, vnT + w * 16 * LDJ, LDJ, fr, fq); } }
        __syncthreads();
#pragma unroll
        for (int dt = 0; dt < 8; ++dt) { v2u pk; pk.x = pk2(Sacc[dt][0], Sacc[dt][1]); pk.y = pk2(Sacc[dt][2], Sacc[dt][3]);
            *(v2u*)(ST + (16 * w + fr) * LDK + 16 * dt + 4 * fq) = pk; }
        {   const f32x4 o0 = *(const f32x4*)(os + tq * 128 + cq * 8), o1 = *(const f32x4*)(os + tq * 128 + cq * 8 + 4);
            float ss = (o0[0] * o0[0] + o0[1] * o0[1]) + (o0[2] * o0[2] + o0[3] * o0[3]) + (o1[0] * o1[0] + o1[1] * o1[1]) + (o1[2] * o1[2] + o1[3] * o1[3]);
            ss = red16(ss);
            const float r = rsqrtf(ss * (1.f / 128.f) + EPS);
            float g8[8], o8[8], nw8[8]; unpack8(gcur, g8);
            { const f32x4 n0 = *(const f32x4*)nwp, n1 = *(const f32x4*)(nwp + 4); nw8[0] = n0[0]; nw8[1] = n0[1]; nw8[2] = n0[2]; nw8[3] = n0[3]; nw8[4] = n1[0]; nw8[5] = n1[1]; nw8[6] = n1[2]; nw8[7] = n1[3]; }
#pragma unroll
            for (int i = 0; i < 4; ++i) { o8[i] = o0[i] * r * nw8[i] * siluf_(g8[i]); o8[4 + i] = o1[i] * r * nw8[4 + i] * siluf_(g8[4 + i]); }
            *(v4u*)(G + (rowbase + t0 + tq) * DM + h * 128 + cq * 8) = pack8(o8); }
        __syncthreads();
    }
#undef DN_LOADS
    __syncthreads();
}

__device__ __forceinline__ void ssm_item(unsigned char* lds, const Args& a, int l, int item) {
    constexpr int LDC = 136, LDX = 40;
    const int b = item >> 4, hd = item & 15, g = hd >> 2;
    bf16* Cs = (bf16*)lds;
    bf16* Bs = Cs + 32 * LDC;
    bf16* BT = Bs + 32 * LDC;
    bf16* xdtT = BT + 128 * LDX;
    bf16* xddT = xdtT + 64 * LDX;
    bf16* Wm = xddT + 64 * LDX;
    bf16* hB = Wm + 32 * LDX;
    float* xs = (float*)(hB + 64 * LDC);
    float* acs = xs + 32 * 64;
    const int tid = opaque_tid(), w = tid >> 6, lane = tid & 63, fr = lane & 15, fq = lane >> 4;
    bf16* base = (bf16*)a.ws;
    const bf16* X = base + (size_t)B_SSX * BUFE; const bf16* BC = base + (size_t)B_SSBC * BUFE; bf16* Z = base + (size_t)B_SSZ * BUFE;
    const float* small = (const float*)(a.ws + WS_SMALL);
    const float* cw = a.in[7] + (size_t)l * 4 * 2048; const float* cb = a.in[8] + (size_t)l * 2048;
    const float dskip = a.in[11][l * 16 + hd];
    const size_t rowbase = (size_t)b * SEQ;
    const int tq = tid >> 4, cq = tid & 15, tv = (tid >> 3) & 31, cv = tid & 7;
    const int it = w >> 2, pt = w & 3;
    f32x4 hacc[4];
#pragma unroll
    for (int i = 0; i < 4; ++i) hacc[i] = (f32x4){0.f, 0.f, 0.f, 0.f};
    for (int i = tid; i < 64 * LDC / 2; i += NTHREADS) ((unsigned*)hB)[i] = 0u;
    v4u rB[4], rC[4], rx[4]; float ra = 0.f, rdtv = 0.f; unsigned rz[4];
#define SSM_LOADS(c_) do { const int t0_ = (c_) * 32; { const int pos_ = t0_ + tq; const size_t ro_ = (rowbase + pos_) * DM; LOAD4(rB, BC + ro_ + g * 128 + cq * 8, pos_); LOAD4(rC, BC + ro_ + 512 + g * 128 + cq * 8, pos_); } \
        if (tid < 256) { const int pos_ = t0_ + tv; LOAD4(rx, X + (rowbase + pos_) * DM + hd * 64 + cv * 8, pos_); } \
        { const size_t r_ = rowbase + t0_ + (lane & 31); rdtv = small[r_ * 64 + 16 + hd]; ra = small[r_ * 64 + 32 + hd]; } \
        _Pragma("unroll") for (int jj_ = 0; jj_ < 4; ++jj_) rz[jj_] = Z[(rowbase + t0_ + 16 * it + 4 * fq + jj_) * DM + hd * 64 + 16 * pt + fr]; } while (0)
    SSM_LOADS(0);
    for (int c = 0; c < SEQ / 32; ++c) {
        const int t0 = c * 32;
        float acum = ra;
#pragma unroll
        for (int off = 1; off < 32; off <<= 1) { const float t = __shfl_up(acum, off, 32); if ((lane & 31) >= off) acum += t; }
        const float ac_last = __shfl(acum, 31);
        {   float o8[8];
            conv8r(rB, cw + 1024 + g * 128 + cq * 8, 2048, cb + 1024 + g * 128 + cq * 8, o8);
            *(v4u*)(Bs + tq * LDC + cq * 8) = pack8(o8);
#pragma unroll
            for (int i = 0; i < 8; ++i) BT[(cq * 8 + i) * LDX + tq] = (bf16)f2bf(o8[i]);
            conv8r(rC, cw + 1536 + g * 128 + cq * 8, 2048, cb + 1536 + g * 128 + cq * 8, o8);
            *(v4u*)(Cs + tq * LDC + cq * 8) = pack8(o8);
        }
        if (tid < 256) { float o8[8]; conv8r(rx, cw + hd * 64 + cv * 8, 2048, cb + hd * 64 + cv * 8, o8);
            const float dtv = __shfl(rdtv, tv), dd = dtv * __expf(ac_last - __shfl(acum, tv));
            *(f32x4*)(xs + tv * 64 + cv * 8) = (f32x4){o8[0], o8[1], o8[2], o8[3]}; *(f32x4*)(xs + tv * 64 + cv * 8 + 4) = (f32x4){o8[4], o8[5], o8[6], o8[7]};
#pragma unroll
            for (int i = 0; i < 8; ++i) { xdtT[(cv * 8 + i) * LDX + tv] = (bf16)f2bf(o8[i] * dtv); xddT[(cv * 8 + i) * LDX + tv] = (bf16)f2bf(o8[i] * dd); }
        }
        if (tid < 32) acs[tid] = acum;
        unsigned zr[4];
#pragma unroll
        for (int jj = 0; jj < 4; ++jj) zr[jj] = rz[jj];
        __syncthreads();
        if (c + 1 < SEQ / 32) SSM_LOADS(c + 1);
        if (w < 4) { const int gi = w >> 1, gj = w & 1; f32x4 acc = {0.f, 0.f, 0.f, 0.f};
            mma16<128>(acc, Cs + gi * 16 * LDC, LDC, Bs + gj * 16 * LDC, LDC, fr, fq);
            const int sI = 16 * gj + fr; const float as = acs[sI];
#pragma unroll
            for (int jj = 0; jj < 4; ++jj) { const int lI = 16 * gi + 4 * fq + jj; const float v = sI <= lI ? acc[jj] * __expf(acs[lI] - as) : 0.f; Wm[lI * LDX + sI] = (bf16)f2bf(v); } }
        __syncthreads();
        {   f32x4 a1 = {0.f, 0.f, 0.f, 0.f}, a2 = {0.f, 0.f, 0.f, 0.f};
            mma16<32>(a1, Wm + it * 16 * LDX, LDX, xdtT + pt * 16 * LDX, LDX, fr, fq);
            mma16<128>(a2, Cs + it * 16 * LDC, LDC, hB + pt * 16 * LDC, LDC, fr, fq);
            const int p = 16 * pt + fr;
#pragma unroll
            for (int jj = 0; jj < 4; ++jj) { const int lI = 16 * it + 4 * fq + jj;
                const float y = a1[jj] + __expf(acs[lI]) * a2[jj] + xs[lI * 64 + p] * dskip;
                Z[(rowbase + t0 + lI) * DM + hd * 64 + p] = (bf16)f2bf(y * siluf_(bf2f(zr[jj]))); }
            const float dl = __expf(ac_last);
#pragma unroll
            for (int p2 = 0; p2 < 4; ++p2) { hacc[p2] = hacc[p2] * dl; mma16<32>(hacc[p2], xddT + p2 * 16 * LDX, LDX, BT + w * 16 * LDX, LDX, fr, fq); }
        }
        __syncthreads();
#pragma unroll
        for (int p2 = 0; p2 < 4; ++p2)
#pragma unroll
            for (int jj = 0; jj < 4; ++jj) hB[(16 * p2 + 4 * fq + jj) * LDC + 16 * w + fr] = (bf16)f2bf(hacc[p2][jj]);
    }
#undef SSM_LOADS
    __syncthreads();
}

__device__ __forceinline__ void sb_item(unsigned char* lds, const Args& a, int b, int hd, int qi) {
    constexpr int LD = 72;
    bf16* Ks = (bf16*)lds; bf16* Vs = Ks + 2 * 64 * LD;
    const int tid = opaque_tid(), w = tid >> 6, lane = tid & 63, fr = lane & 15, fq = lane >> 4;
    bf16* base = (bf16*)a.ws;
    bf16* Qb = base + (size_t)B_SBQ * BUFE; const bf16* Kb = base + (size_t)B_SBK * BUFE; const bf16* Vb = base + (size_t)B_SBV * BUFE;
    const size_t rowbase = (size_t)b * SEQ;
    const int t0 = qi * 128, myq = t0 + w * 16 + fr, wmax = t0 + w * 16 + 15;
    bf16* qrow = Qb + (rowbase + myq) * DM + hd * 64;
    bf16x8 qf[2];
    qf[0] = *(const bf16x8*)(qrow + fq * 8); qf[1] = *(const bf16x8*)(qrow + 32 + fq * 8);
    f32x4 oacc[4];
#pragma unroll
    for (int i = 0; i < 4; ++i) oacc[i] = (f32x4){0.f, 0.f, 0.f, 0.f};
    float carry = 1.f;
    const int kr = tid >> 3, d8 = (tid & 7) * 8;
    v4u kreg, vreg;
    int kt = 2 * (qi + 1) - 1;
#define SB_LOAD(t) do { const size_t o_ = (rowbase + (size_t)(t) * 64 + kr) * DM + hd * 64 + d8; kreg = *(const v4u*)(Kb + o_); vreg = *(const v4u*)(Vb + o_); } while (0)
#define SB_STORE(bu) do { *(v4u*)(Ks + (bu) * 64 * LD + kr * LD + d8) = kreg; bf16* vd_ = Vs + (bu) * 64 * LD + d8 * LD + kr; \
        vd_[0] = (bf16)(vreg.x & 0xffffu); vd_[LD] = (bf16)(vreg.x >> 16); vd_[2 * LD] = (bf16)(vreg.y & 0xffffu); vd_[3 * LD] = (bf16)(vreg.y >> 16); \
        vd_[4 * LD] = (bf16)(vreg.z & 0xffffu); vd_[5 * LD] = (bf16)(vreg.z >> 16); vd_[6 * LD] = (bf16)(vreg.w & 0xffffu); vd_[7 * LD] = (bf16)(vreg.w >> 16); } while (0)
    SB_LOAD(kt); SB_STORE(0);
    __syncthreads();
    int cur = 0;
    for (; kt >= 0; --kt) {
        if (kt > 0) SB_LOAD(kt - 1);
        const int kbase = kt * 64;
        if (kbase <= wmax) {
            const bf16* Kc = Ks + cur * 64 * LD; const bf16* Vc = Vs + cur * 64 * LD;
            f32x4 z[4];
#pragma unroll
            for (int nt = 0; nt < 4; ++nt) { z[nt] = (f32x4){0.f, 0.f, 0.f, 0.f};
#pragma unroll
                for (int k2 = 0; k2 < 2; ++k2) { const bf16x8 af = *(const bf16x8*)(Kc + (nt * 16 + fr) * LD + k2 * 32 + fq * 8);
                    z[nt] = __builtin_amdgcn_mfma_f32_16x16x32_bf16(af, qf[k2], z[nt], 0, 0, 0); } }
            float kp[4][4], sg[4][4], T[4], tot[4], suf[4];
            const bool masked = kbase + 64 > t0 + w * 16;
#pragma unroll
            for (int nt = 0; nt < 4; ++nt) {
#pragma unroll
                for (int j = 0; j < 4; ++j) { const float z2 = z[nt][j] * 0.18033688011112042f;
                    const float ea = __builtin_amdgcn_exp2f(-fabsf(z2)), rc = __builtin_amdgcn_rcpf(1.f + ea); const bool pos = z2 >= 0.f;
                    sg[nt][j] = (pos ? 1.f : ea) * rc; kp[nt][j] = (pos ? ea : 1.f) * rc; }
                if (masked) {
#pragma unroll
                    for (int j = 0; j < 4; ++j) { const bool valid = kbase + nt * 16 + fq * 4 + j < myq; sg[nt][j] = valid ? sg[nt][j] : 0.f; kp[nt][j] = valid ? kp[nt][j] : 1.f; } }
                T[nt] = (kp[nt][0] * kp[nt][1]) * (kp[nt][2] * kp[nt][3]); }
#pragma unroll
            for (int nt = 0; nt < 4; ++nt) { const float p16 = __shfl_xor(T[nt], 16), s1 = T[nt] * p16, p32 = __shfl_xor(s1, 32); tot[nt] = s1 * p32;
                suf[nt] = fq == 0 ? p16 * p32 : fq == 1 ? p32 : fq == 2 ? p16 : 1.f; }
            float run = carry; float wv[4][4];
#pragma unroll
            for (int nt = 3; nt >= 0; --nt) { const float r3 = run * suf[nt], r2 = r3 * kp[nt][3], r1 = r2 * kp[nt][2], r0 = r1 * kp[nt][1];
                wv[nt][0] = sg[nt][0] * r0; wv[nt][1] = sg[nt][1] * r1; wv[nt][2] = sg[nt][2] * r2; wv[nt][3] = sg[nt][3] * r3;
                run *= tot[nt]; }
            carry = run;
#pragma unroll
            for (int kk = 0; kk < 2; ++kk) {
                v4u bw; bw.x = pk2(wv[2 * kk][0], wv[2 * kk][1]); bw.y = pk2(wv[2 * kk][2], wv[2 * kk][3]); bw.z = pk2(wv[2 * kk + 1][0], wv[2 * kk + 1][1]); bw.w = pk2(wv[2 * kk + 1][2], wv[2 * kk + 1][3]);
                const bf16x8 bfr = __builtin_bit_cast(bf16x8, bw);
#pragma unroll
                for (int mt = 0; mt < 4; ++mt) { const bf16* vp = Vc + (mt * 16 + fr) * LD + 32 * kk + 4 * fq;
                    const v2u lo = *(const v2u*)vp, hi = *(const v2u*)(vp + 16);
                    v4u av; av.x = lo.x; av.y = lo.y; av.z = hi.x; av.w = hi.y;
                    oacc[mt] = __builtin_amdgcn_mfma_f32_16x16x32_bf16(__builtin_bit_cast(bf16x8, av), bfr, oacc[mt], 0, 0, 0); }
            }
        }
        if (kt > 0) SB_STORE(cur ^ 1);
        __syncthreads();
        cur ^= 1;
    }
#undef SB_LOAD
#undef SB_STORE
#pragma unroll
    for (int mt = 0; mt < 4; ++mt) { v2u wq; wq.x = pk2(oacc[mt][0], oacc[mt][1]); wq.y = pk2(oacc[mt][2], oacc[mt][3]); *(v2u*)(qrow + mt * 16 + fq * 4) = wq; }
}

__device__ __forceinline__ void phase_mixers(unsigned char* lds, const Args& a, int l, unsigned long long& probe_acc) {
    unsigned* counter = (unsigned*)(a.ws + WS_CTL) + 64 * l;
    volatile unsigned* slot = (volatile unsigned*)(lds + LDS_BYTES - 64);
    constexpr unsigned NITEMS = 64 + 128 + 2048;
    for (;;) {
        if (threadIdx.x == 0) *slot = __hip_atomic_fetch_add(counter, 1u, __ATOMIC_RELAXED, __HIP_MEMORY_SCOPE_AGENT);
        __syncthreads();
        const unsigned item = *slot;
        __syncthreads();
        if (item >= NITEMS) break;
        PT0();
        if (item < 64) { dn_item(lds, a, l, (int)item); if (item == 0) PT1(9); }
        else if (item < 192) { ssm_item(lds, a, l, (int)item - 64); if (item == 64) PT1(10); }
        else { const int r = (int)item - 192, qi = 15 - (r >> 7), bh = r & 127; sb_item(lds, a, bh >> 4, bh & 15, qi); if (item == 192) PT1(11); }
    }
}

__device__ __forceinline__ void phase_norms(const Args& a, int l) {
    const int tid = opaque_tid(), lane = tid & 63, wave = tid >> 6, gw = blockIdx.x * NWAVES + wave, NGW = gridDim.x * NWAVES;
    bf16* base = (bf16*)a.ws;
    const bf16* Oraw = base + (size_t)B_DNV * BUFE; bf16* G = base + (size_t)B_DNG * BUFE; bf16* Y = base + (size_t)B_SSZ * BUFE;
    const float* dnw = a.in[6] + (size_t)l * 128 + (lane & 7) * 16; const float* snw = a.in[12] + (size_t)l * DM + lane * 16;
    float w1[16], w2[16];
#pragma unroll
    for (int i = 0; i < 16; ++i) { w1[i] = dnw[i]; w2[i] = snw[i]; }
    for (int m = gw; m < MT; m += NGW) {
        const size_t o = (size_t)m * DM + lane * 16;
        float v[16], s, r;
        unpack8(*(const v4u*)(Y + o), v); unpack8(*(const v4u*)(Y + o + 8), v + 8);
        s = 0.f;
#pragma unroll
        for (int i = 0; i < 16; ++i) s += v[i] * v[i];
        s = red16(s);
        r = rsqrtf(s * (1.f / 256.f) + EPS);
#pragma unroll
        for (int i = 0; i < 16; ++i) v[i] = v[i] * r * w2[i];
        *(v4u*)(Y + o) = pack8(v); *(v4u*)(Y + o + 8) = pack8(v + 8);
    }
}

__global__ void __launch_bounds__(NTHREADS, 2) hybrid_fwd(Args a) {
    extern __shared__ __attribute__((aligned(16))) unsigned char lds[];
    cg::grid_group grid = cg::this_grid();
    bf16* base = (bf16*)a.ws; bf16* Wreg = (bf16*)(a.ws + WS_W);
    PG8_LAS unsigned char* ldsl = (PG8_LAS unsigned char*)lds;
    unsigned long long probe_acc = 0ull;
    if (blockIdx.x == 0 && threadIdx.x < 2) __hip_atomic_store((unsigned*)(a.ws + WS_CTL) + 64 * threadIdx.x, 0u, __ATOMIC_RELAXED, __HIP_MEMORY_SCOPE_AGENT);
#pragma unroll 1
    for (int l = 0; l < 2; ++l) {
        asm volatile("" : "+s"(l));
        const float* xin = l == 0 ? a.in[0] : a.out;
        { PT0(); phase0(lds, a, l, xin);
        grid.sync(); PT1(0); }
        {   pg8::Gemm g{base, Wreg + W_IN, MT, 10240, DM}; pg8::StaticOrder S; S.init(MT, 10240, (int)gridDim.x, (int)blockIdx.x);
            EpiRoute E{base};
            PT0(); pg8::gemm_phase<EpiRoute, pg8::StaticOrder, false, true>(ldsl, g, S, E);
        grid.sync(); PT1(1); }
        { PT0(); phase_mixers(lds, a, l, probe_acc);
        grid.sync(); PT1(2); }
        { PT0(); phase_norms(a, l);
        grid.sync(); PT1(3); }
        {   pg8::Gemm g{base, Wreg + W_G, 4 * MT, 6144, DM}; SchedGate S{(int)gridDim.x, (int)blockIdx.x};
            EpiGate E{base + (size_t)B_SBK * BUFE, (float*)(base + (size_t)B_DNK * BUFE), base + (size_t)B_DNQ * BUFE};
            PT0(); pg8::gemm_phase<EpiGate, SchedGate, false, true>(ldsl, g, S, E);
        grid.sync(); PT1(4); }
        {   pg8::Gemm g{base + (size_t)B_DNQ * BUFE, Wreg + W_OUT, MT, DM, DM}; pg8::StaticOrder S; S.init(MT, DM, (int)gridDim.x, (int)blockIdx.x);
            EpiResid E{xin, a.out};
            PT0(); pg8::gemm_phase<EpiResid, pg8::StaticOrder, false, true>(ldsl, g, S, E);
        grid.sync(); PT1(5); }
        {   const float* nw = a.in[15] + (size_t)l * DM;
            const int tid = opaque_tid(), lane = tid & 63, gw = blockIdx.x * NWAVES + (tid >> 6), NGW = gridDim.x * NWAVES;
            PT0(); for (int m = gw; m < MT; m += NGW) rms_row_to_bf16(a.out + (size_t)m * DM, nw, base + (size_t)m * DM, lane);
        grid.sync(); PT1(6); }
        {   pg8::Gemm g{base, Wreg + W_UP, MT, DFF, DM}; pg8::StaticOrder S; S.init(MT, DFF, (int)gridDim.x, (int)blockIdx.x);
            EpiRelu2 E{base + (size_t)B_DNQ * BUFE};
            PT0(); pg8::gemm_phase<EpiRelu2, pg8::StaticOrder, false, true>(ldsl, g, S, E);
        grid.sync(); PT1(7); }
        {   pg8::Gemm g{base + (size_t)B_DNQ * BUFE, Wreg + W_DOWN, MT, DM, DFF}; pg8::StaticOrder S; S.init(MT, DM, (int)gridDim.x, (int)blockIdx.x);
            EpiResid E{a.out, a.out};
            PT0(); pg8::gemm_phase<EpiResid, pg8::StaticOrder, false, true>(ldsl, g, S, E);
        grid.sync(); PT1(8); }
    }
    {
        const float* nw = a.in[18];
        const int tid = opaque_tid(), lane = tid & 63, gw = blockIdx.x * NWAVES + (tid >> 6), NGW = gridDim.x * NWAVES;
        for (int m = gw; m < MT; m += NGW) {
            f32x4* xr = (f32x4*)(a.out + (size_t)m * DM) + lane; const f32x4* wr = (const f32x4*)nw + lane;
            f32x4 v[4]; float s = 0.f;
#pragma unroll
            for (int j = 0; j < 4; ++j) { v[j] = xr[64 * j]; s += (v[j][0] * v[j][0] + v[j][1] * v[j][1]) + (v[j][2] * v[j][2] + v[j][3] * v[j][3]); }
            const float rstd = rsqrtf(wave_sum(s) * (1.f / DM) + EPS);
#pragma unroll
            for (int j = 0; j < 4; ++j) { const f32x4 ww = wr[64 * j]; f32x4 r;
#pragma unroll
                for (int i = 0; i < 4; ++i) r[i] = v[j][i] * rstd * ww[i];
                xr[64 * j] = r; }
        }
    }
    if (PROBE_SEL) { const unsigned long long t0 = rt(); while (rt() - t0 < probe_acc) __builtin_amdgcn_s_sleep(8); }
}

extern "C" void kernel_launch(void* const* d_in, const int* in_sizes, int n_in, void* d_out, int out_size, void* d_ws, size_t ws_size, hipStream_t stream) {
    static int grid = 0;
    if (grid == 0) {
        if (n_in != 19 || out_size != MT * DM || ws_size < WS_NEED) { fprintf(stderr, "kernel_launch: unexpected shapes (n_in %d out %d ws %zu need %zu)\n", n_in, out_size, ws_size, (size_t)WS_NEED); grid = -1; return; }
        int dev = 0, cus = 0, per_cu = 0;
        hipGetDevice(&dev); hipDeviceGetAttribute(&cus, hipDeviceAttributeMultiprocessorCount, dev);
        if (hipFuncSetAttribute((const void*)hybrid_fwd, hipFuncAttributeMaxDynamicSharedMemorySize, LDS_BYTES) != hipSuccess) { fprintf(stderr, "kernel_launch: hipFuncSetAttribute failed\n"); grid = -1; return; }
        if (hipOccupancyMaxActiveBlocksPerMultiprocessor(&per_cu, (const void*)hybrid_fwd, NTHREADS, LDS_BYTES) != hipSuccess || per_cu < 1) { fprintf(stderr, "kernel_launch: occupancy query gave %d\n", per_cu); per_cu = 1; }
        (void)hipGetLastError();
        grid = cus * per_cu;
    }
    if (grid < 0) return;
    Args a{};
    for (int i = 0; i < 19; ++i) a.in[i] = (const float*)d_in[i];
    a.out = (float*)d_out; a.ws = (unsigned char*)d_ws;
    void* args[] = {&a};
    hipError_t e = hipLaunchCooperativeKernel((const void*)hybrid_fwd, dim3(grid), dim3(NTHREADS), args, LDS_BYTES, stream);
    if (e != hipSuccess) fprintf(stderr, "cooperative launch failed: %s (grid %d)\n", hipGetErrorString(e), grid);
}
```

```cpp
#include <hip/hip_runtime.h>
#include <hip/hip_cooperative_groups.h>
#include <cstdio>
#include <cstdint>
namespace cg = cooperative_groups;
__device__ __forceinline__ int opaque_tid() { int t = (int)threadIdx.x; asm volatile("" : "+v"(t)); return t; }
namespace pg8 {
#define PG8_LAS __attribute__((address_space(3)))
typedef unsigned short bf16_t;
typedef short bf16x8 __attribute__((ext_vector_type(8)));
typedef float f32x4 __attribute__((ext_vector_type(4)));
typedef unsigned u32x4 __attribute__((ext_vector_type(4)));
constexpr int BM = 256, BK = 64, HALF = 128, HTB = HALF * BK * 2  , STAGE_BYTES = 8 * HTB, NXCD = 8, WGM = 8;

__host__ __device__ __forceinline__ int lds_byte(int r, int c) { const int st = (r >> 4) * 2 + (c >> 5), rr = r & 15, cc = c & 31, ob = rr * 64 + cc * 2; return st * 1024 + (ob ^ (((ob >> 9) & 1) << 5)); }
__host__ __device__ __forceinline__ void stage_rc(int b, int& R, int& C) { const int st = b / 1024, sb = b % 1024, swz = sb ^ (((sb >> 9) & 1) << 5); R = (st >> 1) * 16 + swz / 64; C = (st & 1) * 32 + (swz % 64) / 2; }
__host__ __device__ __forceinline__ int perm32(int rho) { const int n = rho >> 4, i = rho & 15; return 8 * (i >> 2) + 4 * n + (i & 3); }

struct Unit { int pm, pn; };
struct Gemm { const bf16_t* A; const bf16_t* Bt; int M, N, K; };

struct StaticOrder {
    int nM, nN, nwg, G, c;
    __host__ __device__ void init(int M, int N, int G_, int c_) { nM = M / BM; nN = N / BM; nwg = nM * nN; G = G_; c = c_; }
    __host__ __device__ bool next(int i, Unit& u) const {
        const long L = (long)i * G + c; if (L >= nwg) return false;
        int wgid = (int)L; { const int q = nwg / NXCD, r = nwg % NXCD, xcd = wgid % NXCD, off = wgid / NXCD; wgid = (xcd < r ? xcd * (q + 1) : r * (q + 1) + (xcd - r) * q) + off; }
        const int nig = WGM * nN, gid = wgid / nig, fm = gid * WGM, gsz = (nM - fm) < WGM ? (nM - fm) : WGM;
        u.pm = fm + ((wgid % nig) % gsz); u.pn = (wgid % nig) / gsz; return true;
    }
    __device__ __forceinline__ void a_ready(const Unit&) const {}
    __device__ __forceinline__ void done(const Unit&) const {}
};
__device__ __forceinline__ unsigned cvt_pk_bf16(float lo, float hi) { unsigned r; asm volatile("v_cvt_pk_bf16_f32 %0, %1, %2" : "=v"(r) : "v"(lo), "v"(hi)); return r; }
template <class Epi, class Sched, bool ALIGN_EPI = false, bool SP2 = false>
__device__ __forceinline__ void gemm_phase(PG8_LAS unsigned char* lds, const Gemm g, const Sched& S, const Epi& E) {
    const int tid = opaque_tid(), wid = __builtin_amdgcn_readfirstlane(tid >> 6), lane = tid & 63, wr = wid >> 2, wc = wid & 3, fr = lane & 15, fq = lane >> 4;
    const int K = g.K, nt = K / BK;
    unsigned voffA[2], voffB[2];
#pragma unroll
    for (int i = 0; i < 2; ++i) { int R, C; stage_rc(tid * 16 + i * 8192, R, C); const int Rb = Epi::PERM ? ((R & ~31) + perm32(R & 31)) : R;
        voffA[i] = (unsigned)(R * K + C) * 2u; voffB[i] = (unsigned)(Rb * K + C) * 2u; }
    const size_t kstep = (size_t)(BK * 2);
    const size_t hstep = (size_t)HALF * K * 2;
    const size_t tstep = 2 * hstep;
    const unsigned ldsw = (unsigned)wid * 1024u;
    const int aoff = lds_byte(wr * 64 + fr, fq * 8), boff = lds_byte(wc * 32 + fr, fq * 8);
#define PG8_SA(b, h) (((b) * 2 + (h)) * HTB)
#define PG8_SB(b, h) ((4 + (b) * 2 + (h)) * HTB)
#define PG8_STAGE(bufoff, gbase, voff) do { _Pragma("unroll") for (int _i = 0; _i < 2; ++_i) \
        __builtin_amdgcn_global_load_lds((const unsigned*)((const char*)(gbase) + (voff)[_i]), (PG8_LAS unsigned*)(lds + (bufoff) + ldsw + _i * 8192), 16, 0, 0); } while (0)
#define PG8_LDA(dst, b, h) do { _Pragma("unroll") for (int m = 0; m < 4; ++m) _Pragma("unroll") for (int k = 0; k < 2; ++k) dst[m][k] = *(const PG8_LAS bf16x8*)(lds + PG8_SA(b, h) + aoff + m * 2048 + k * 1024); } while (0)
#define PG8_LDB(dst, b, h) do { _Pragma("unroll") for (int n = 0; n < 2; ++n) _Pragma("unroll") for (int k = 0; k < 2; ++k) dst[n][k] = *(const PG8_LAS bf16x8*)(lds + PG8_SB(b, h) + boff + n * 2048 + k * 1024); } while (0)
#define PG8_MMA(ai, bj, At, Bt) do { __builtin_amdgcn_s_setprio(1); _Pragma("unroll") for (int m = 0; m < 4; ++m) _Pragma("unroll") for (int n = 0; n < 2; ++n) _Pragma("unroll") for (int k = 0; k < 2; ++k) \
        acc[ai][bj][m][n] = __builtin_amdgcn_mfma_f32_16x16x32_bf16(Bt[n][k], At[m][k], acc[ai][bj][m][n], 0, 0, 0); __builtin_amdgcn_s_setprio(0); } while (0)
#define PG8_WAIT_V(n) asm volatile("s_waitcnt vmcnt(" #n ")" ::: "memory")
#define PG8_WAIT_L(n) asm volatile("s_waitcnt lgkmcnt(" #n ")" ::: "memory")
#define PG8_BAR __builtin_amdgcn_s_barrier()
#define PG8_SCHED __builtin_amdgcn_sched_barrier(0)
    Unit cur, nxt; int ui = 0;
    if (!S.next(0, cur)) return;
    f32x4 acc[2][2][4][2];
#pragma unroll
    for (int a = 0; a < 2; ++a)
#pragma unroll
        for (int b = 0; b < 2; ++b)
#pragma unroll
            for (int m = 0; m < 4; ++m)
#pragma unroll
                for (int n = 0; n < 2; ++n) acc[a][b][m][n] = (f32x4){0.f, 0.f, 0.f, 0.f};
    bf16x8 At[4][2], B0[2][2], B1[2][2];
    const char* cA = (const char*)g.A + (size_t)cur.pm * tstep; const char* cB = (const char*)g.Bt + (size_t)cur.pn * tstep;
    S.a_ready(cur);
    if constexpr (SP2) {
        PG8_STAGE(PG8_SB(0, 0), cB, voffB); PG8_STAGE(PG8_SB(0, 1), cB + hstep, voffB); PG8_STAGE(PG8_SA(0, 0), cA, voffA); PG8_STAGE(PG8_SA(0, 1), cA + hstep, voffA);
        if (wr == 1) PG8_BAR;
        PG8_WAIT_V(2); PG8_BAR;
        PG8_STAGE(PG8_SB(1, 0), cB + kstep, voffB); PG8_STAGE(PG8_SA(1, 0), cA + kstep, voffA); PG8_STAGE(PG8_SB(1, 1), cB + hstep + kstep, voffB);
        PG8_WAIT_V(6); PG8_BAR;
    } else {
        PG8_STAGE(PG8_SB(0, 0), cB, voffB); PG8_STAGE(PG8_SA(0, 0), cA, voffA); PG8_STAGE(PG8_SB(0, 1), cB + hstep, voffB); PG8_STAGE(PG8_SA(0, 1), cA + hstep, voffA);
        if (wr == 1) PG8_BAR;
        PG8_WAIT_V(4); PG8_BAR;
        PG8_STAGE(PG8_SB(1, 0), cB + kstep, voffB); PG8_STAGE(PG8_SA(1, 0), cA + kstep, voffA); PG8_STAGE(PG8_SB(1, 1), cB + hstep + kstep, voffB);
        PG8_WAIT_V(6); PG8_BAR;
    }
    for (;;) {
        const bool has_next = S.next(ui + 1, nxt);
        const char* nA = has_next ? (const char*)g.A + (size_t)nxt.pm * tstep : cA; const char* nB = has_next ? (const char*)g.Bt + (size_t)nxt.pn * tstep : cB;
        for (int t = 0; t < nt; t += 2) {
            const bool last = (t == nt - 2);
            const char* a1 = cA + (size_t)(t + 1) * kstep;
            const char* a2 = last ? nA : cA + (size_t)(t + 2) * kstep; const char* b2 = last ? nB : cB + (size_t)(t + 2) * kstep;
            const char* a3 = a2 + kstep; const char* b3 = b2 + kstep;
            if (last && has_next) S.a_ready(nxt);
            if constexpr (SP2) {
            PG8_LDB(B0, 0, 0); PG8_LDB(B1, 0, 1); PG8_SCHED; PG8_LDA(At, 0, 0); PG8_STAGE(PG8_SA(1, 1), a1 + hstep, voffA);
            PG8_WAIT_V(8); PG8_WAIT_L(0); PG8_BAR; PG8_MMA(0, 0, At, B0); PG8_MMA(0, 1, At, B1); PG8_BAR; PG8_SCHED;
            PG8_LDA(At, 0, 1); PG8_STAGE(PG8_SB(0, 0), b2, voffB); PG8_STAGE(PG8_SB(0, 1), b2 + hstep, voffB); PG8_STAGE(PG8_SA(0, 0), a2, voffA);
            PG8_WAIT_V(8); PG8_WAIT_L(0); PG8_BAR; PG8_MMA(1, 0, At, B0); PG8_MMA(1, 1, At, B1); PG8_BAR; PG8_SCHED;
            PG8_LDB(B0, 1, 0); PG8_LDB(B1, 1, 1); PG8_SCHED; PG8_LDA(At, 1, 0); PG8_STAGE(PG8_SA(0, 1), a2 + hstep, voffA);
            PG8_WAIT_V(8); PG8_WAIT_L(0); PG8_BAR; PG8_MMA(0, 0, At, B0); PG8_MMA(0, 1, At, B1); PG8_BAR; PG8_SCHED;
            PG8_LDA(At, 1, 1); PG8_STAGE(PG8_SB(1, 0), b3, voffB); PG8_STAGE(PG8_SB(1, 1), b3 + hstep, voffB); PG8_STAGE(PG8_SA(1, 0), a3, voffA);
            PG8_WAIT_V(8); PG8_WAIT_L(0); PG8_BAR; PG8_MMA(1, 0, At, B0); PG8_MMA(1, 1, At, B1); PG8_BAR; PG8_SCHED;
            } else {
            PG8_LDB(B0, 0, 0); PG8_SCHED; PG8_LDA(At, 0, 0); PG8_STAGE(PG8_SA(1, 1), a1 + hstep, voffA);
            PG8_WAIT_L(8); PG8_BAR; PG8_WAIT_L(0); PG8_MMA(0, 0, At, B0); PG8_BAR; PG8_SCHED;
            PG8_LDB(B1, 0, 1); PG8_STAGE(PG8_SB(0, 0), b2, voffB);
            PG8_BAR; PG8_WAIT_L(0); PG8_MMA(0, 1, At, B1); PG8_BAR;
            PG8_LDA(At, 0, 1); PG8_STAGE(PG8_SA(0, 0), a2, voffA);
            PG8_BAR; PG8_WAIT_L(0); PG8_MMA(1, 0, At, B0); PG8_BAR; PG8_SCHED;
            PG8_STAGE(PG8_SB(0, 1), b2 + hstep, voffB);
            PG8_WAIT_V(6); PG8_BAR; PG8_MMA(1, 1, At, B1); PG8_BAR;
            PG8_LDB(B0, 1, 0); PG8_SCHED; PG8_LDA(At, 1, 0); PG8_STAGE(PG8_SA(0, 1), a2 + hstep, voffA);
            PG8_WAIT_L(8); PG8_BAR; PG8_WAIT_L(0); PG8_MMA(0, 0, At, B0); PG8_BAR; PG8_SCHED;
            PG8_LDB(B1, 1, 1); PG8_STAGE(PG8_SB(1, 0), b3, voffB);
            PG8_BAR; PG8_WAIT_L(0); PG8_MMA(0, 1, At, B1); PG8_BAR;
            PG8_LDA(At, 1, 1); PG8_STAGE(PG8_SA(1, 0), a3, voffA);
            PG8_BAR; PG8_WAIT_L(0); PG8_MMA(1, 0, At, B0); PG8_BAR; PG8_SCHED;
            PG8_STAGE(PG8_SB(1, 1), b3 + hstep, voffB);
            PG8_WAIT_V(6); PG8_BAR; PG8_MMA(1, 1, At, B1); PG8_BAR;
            }
        }
        if constexpr (ALIGN_EPI) { if (wr == 0) PG8_BAR; }
        if constexpr (!Epi::AFTER_DRAIN) { E(acc, cur, wr, wc, fr, fq); S.done(cur); }
        if (!has_next) break;
#pragma unroll
        for (int a = 0; a < 2; ++a)
#pragma unroll
            for (int b = 0; b < 2; ++b)
#pragma unroll
                for (int m = 0; m < 4; ++m)
#pragma unroll
                    for (int n = 0; n < 2; ++n) acc[a][b][m][n] = (f32x4){0.f, 0.f, 0.f, 0.f};
        cur = nxt; cA = nA; cB = nB; ++ui;
        if constexpr (ALIGN_EPI) { if (wr == 1) PG8_BAR; }
    }
    PG8_WAIT_V(0);
    if constexpr (!ALIGN_EPI) { if (wr == 0) PG8_BAR; }
    PG8_BAR;
    if constexpr (Epi::AFTER_DRAIN) { E.fused(acc, cur, wr, wc, fr, fq, lds, wid, lane); S.done(cur); }
#undef PG8_SA
#undef PG8_SB
#undef PG8_STAGE
#undef PG8_LDA
#undef PG8_LDB
#undef PG8_MMA
#undef PG8_WAIT_V
#undef PG8_WAIT_L
#undef PG8_BAR
#undef PG8_SCHED
}
}

constexpr int NB = 8, SEQ = 2048, DM = 1024, MT = NB * SEQ, DFF = 4096, IN_DIM = 13344;
constexpr int NTHREADS = 512, NWAVES = 8, LDS_BYTES = 147456;
constexpr float EPS = 1e-6f;
typedef unsigned short bf16;
typedef unsigned v4u __attribute__((ext_vector_type(4)));
typedef unsigned v2u __attribute__((ext_vector_type(2)));
typedef float f32x4 __attribute__((ext_vector_type(4)));
typedef short bf16x8 __attribute__((ext_vector_type(8)));
enum { B_H = 0, B_DNG = 1, B_SBQ = 2, B_SSZ = 3, B_DNQ = 4, B_DNK = 5, B_DNV = 6, B_SBK = 7, B_SBV = 8, B_SSX = 9, B_SSBC = 10, NBUF = 11 };
constexpr size_t BUFE = (size_t)MT * DM;
constexpr size_t WS_W = NBUF * BUFE * 2;
constexpr size_t W_IN = 0, W_G = W_IN + (size_t)10240 * 1024, W_OUT = W_G + (size_t)6144 * 1024, W_UP = W_OUT + (size_t)1024 * 1024,
                 W_DOWN = W_UP + (size_t)4096 * 1024, W_END = W_DOWN + (size_t)4096 * 1024;
constexpr size_t WS_SMALL = WS_W + W_END * 2;
constexpr size_t WS_CTL = WS_SMALL + (size_t)MT * 64 * 4;
constexpr size_t WS_NEED = WS_CTL + 4096;

__device__ __forceinline__ float bf2f(unsigned u) { return __builtin_bit_cast(float, u << 16); }
__device__ __forceinline__ unsigned f2bf(float f) { unsigned u = __builtin_bit_cast(unsigned, f); return (u + 0x7fffu + ((u >> 16) & 1u)) >> 16; }
typedef float f32x2 __attribute__((ext_vector_type(2)));
typedef __bf16 bf16x2_t __attribute__((ext_vector_type(2)));
__device__ __forceinline__ unsigned pk2(float lo, float hi) { f32x2 v = {lo, hi}; return __builtin_bit_cast(unsigned, __builtin_convertvector(v, bf16x2_t)); }
__device__ __forceinline__ void unpack8(v4u r, float* o) {
    o[0] = bf2f(r.x & 0xffffu); o[1] = __builtin_bit_cast(float, r.x & 0xffff0000u); o[2] = bf2f(r.y & 0xffffu); o[3] = __builtin_bit_cast(float, r.y & 0xffff0000u);
    o[4] = bf2f(r.z & 0xffffu); o[5] = __builtin_bit_cast(float, r.z & 0xffff0000u); o[6] = bf2f(r.w & 0xffffu); o[7] = __builtin_bit_cast(float, r.w & 0xffff0000u);
}
__device__ __forceinline__ v4u pack8(const float* v) { v4u w; w.x = pk2(v[0], v[1]); w.y = pk2(v[2], v[3]); w.z = pk2(v[4], v[5]); w.w = pk2(v[6], v[7]); return w; }
__device__ __forceinline__ float sigmoidf_(float x) { return __builtin_amdgcn_rcpf(1.f + __expf(-x)); }
__device__ __forceinline__ float siluf_(float x) { return x * __builtin_amdgcn_rcpf(1.f + __expf(-x)); }
__device__ __forceinline__ float softplusf_(float x) { return fmaxf(x, 0.f) + log1pf(__expf(-fabsf(x))); }
template <int CTRL> __device__ __forceinline__ float dppf(float v) { return __builtin_bit_cast(float, __builtin_amdgcn_update_dpp(0, __builtin_bit_cast(int, v), CTRL, 0xF, 0xF, true)); }
__device__ __forceinline__ float red8(float v) { v += dppf<0xB1>(v); v += dppf<0x4E>(v); v += dppf<0x141>(v); return v; }
__device__ __forceinline__ float red16(float v) { v = red8(v); v += dppf<0x140>(v); return v; }
__device__ __forceinline__ float wave_sum(float v) {
#pragma unroll
    for (int o = 1; o < 64; o <<= 1) v += __shfl_xor(v, o);
    return v;
}
#define LDS_WAIT() asm volatile("s_waitcnt lgkmcnt(0)" ::: "memory")

struct Args { const float* in[19]; float* out; unsigned char* ws; };
#ifndef PROBE_SEL
#define PROBE_SEL 0
#endif
__device__ __forceinline__ unsigned long long rt() { return __builtin_amdgcn_s_memrealtime(); }
#define PT0() unsigned long long pt_ = PROBE_SEL ? rt() : 0ull
#define PT1(k) do { if (PROBE_SEL & (1 << (k))) probe_acc += rt() - pt_; } while (0)

struct EpiRoute {
    static constexpr bool PERM = true, AFTER_DRAIN = false;
    bf16* base;
    __device__ __forceinline__ void operator()(const pg8::f32x4 (&acc)[2][2][4][2], const pg8::Unit& u, int wr, int wc, int fr, int fq) const {
        bf16* O = base + (size_t)(1 + (u.pn >> 2)) * BUFE;
        const int col0 = (u.pn & 3) * 256 + wc * 32 + 8 * fq, row0 = u.pm * 256 + wr * 64 + fr;
#pragma unroll
        for (int ai = 0; ai < 2; ++ai)
#pragma unroll
            for (int m = 0; m < 4; ++m) { bf16* rowp = O + (size_t)(row0 + ai * 128 + m * 16) * DM + col0;
#pragma unroll
                for (int bj = 0; bj < 2; ++bj) { const pg8::f32x4 v0 = acc[ai][bj][m][0], v1 = acc[ai][bj][m][1];
                    v4u w; w.x = pk2(v0[0], v0[1]); w.y = pk2(v0[2], v0[3]); w.z = pk2(v1[0], v1[1]); w.w = pk2(v1[2], v1[3]);
                    *(v4u*)(rowp + bj * 128) = w; } }
    }
};
struct EpiRelu2 {
    static constexpr bool PERM = true, AFTER_DRAIN = false;
    bf16* O;
    __device__ __forceinline__ void operator()(const pg8::f32x4 (&acc)[2][2][4][2], const pg8::Unit& u, int wr, int wc, int fr, int fq) const {
        const int col0 = u.pn * 256 + wc * 32 + 8 * fq, row0 = u.pm * 256 + wr * 64 + fr;
#pragma unroll
        for (int ai = 0; ai < 2; ++ai)
#pragma unroll
            for (int m = 0; m < 4; ++m) { bf16* rowp = O + (size_t)(row0 + ai * 128 + m * 16) * DFF + col0;
#pragma unroll
                for (int bj = 0; bj < 2; ++bj) { float v[8];
#pragma unroll
                    for (int i = 0; i < 4; ++i) { float a = fmaxf(acc[ai][bj][m][0][i], 0.f), b = fmaxf(acc[ai][bj][m][1][i], 0.f); v[i] = a * a; v[4 + i] = b * b; }
                    *(v4u*)(rowp + bj * 128) = pack8(v); } }
    }
};
struct EpiResid {
    static constexpr bool PERM = true, AFTER_DRAIN = false;
    const float* xin; float* xout;
    __device__ __forceinline__ void operator()(const pg8::f32x4 (&acc)[2][2][4][2], const pg8::Unit& u, int wr, int wc, int fr, int fq) const {
        const int col0 = u.pn * 256 + wc * 32 + 8 * fq, row0 = u.pm * 256 + wr * 64 + fr;
#pragma unroll
        for (int ai = 0; ai < 2; ++ai)
#pragma unroll
            for (int m = 0; m < 4; ++m) { const size_t ro = (size_t)(row0 + ai * 128 + m * 16) * DM + col0;
#pragma unroll
                for (int bj = 0; bj < 2; ++bj) { const size_t o = ro + bj * 128;
                    const f32x4 a = *(const f32x4*)(xin + o), b = *(const f32x4*)(xin + o + 4);
                    f32x4 r0, r1;
#pragma unroll
                    for (int i = 0; i < 4; ++i) { r0[i] = a[i] + acc[ai][bj][m][0][i]; r1[i] = b[i] + acc[ai][bj][m][1][i]; }
                    *(f32x4*)(xout + o) = r0; *(f32x4*)(xout + o + 4) = r1; } }
    }
};
struct SchedGate {
    int G, c;
    __device__ __forceinline__ bool next(int i, pg8::Unit& u) const {
        const int tile = c + (i / 6) * G; if (tile >= 256) return false;
        const int s = i % 6, br = s >> 1, pm = tile >> 2, pn = tile & 3;
        if ((s & 1) == 0) { u.pm = pm; u.pn = br * 4 + pn; } else { u.pm = (1 + br) * 64 + pm; u.pn = (3 + br) * 4 + pn; }
        return true;
    }
    __device__ __forceinline__ void a_ready(const pg8::Unit&) const {}
    __device__ __forceinline__ void done(const pg8::Unit&) const {}
};
struct EpiGate {
    static constexpr bool PERM = true, AFTER_DRAIN = false;
    bf16* gsc; float* macc; bf16* merged;
    __device__ __forceinline__ void operator()(const pg8::f32x4 (&acc)[2][2][4][2], const pg8::Unit& u, int wr, int wc, int fr, int fq) const {
        const int j = u.pn >> 2, pn = u.pn & 3, pm = u.pm & 63;
        const int col0 = pn * 256 + wc * 32 + 8 * fq, row0 = pm * 256 + wr * 64 + fr;
#pragma unroll
        for (int ai = 0; ai < 2; ++ai)
#pragma unroll
            for (int m = 0; m < 4; ++m) { const size_t ro = (size_t)(row0 + ai * 128 + m * 16) * DM + col0;
#pragma unroll
                for (int bj = 0; bj < 2; ++bj) { const size_t o = ro + bj * 128; float v[8];
#pragma unroll
                    for (int i = 0; i < 4; ++i) { v[i] = acc[ai][bj][m][0][i]; v[4 + i] = acc[ai][bj][m][1][i]; }
                    if (j < 3) {
#pragma unroll
                        for (int i = 0; i < 8; ++i) v[i] = sigmoidf_(v[i]);
                        *(v4u*)(gsc + o) = pack8(v);
                    } else {
                        float g[8]; unpack8(*(const v4u*)(gsc + o), g);
#pragma unroll
                        for (int i = 0; i < 8; ++i) v[i] *= g[i];
                        if (j > 3) { const f32x4 a = *(const f32x4*)(macc + o), b = *(const f32x4*)(macc + o + 4);
#pragma unroll
                            for (int i = 0; i < 4; ++i) { v[i] += a[i]; v[4 + i] += b[i]; } }
                        if (j < 5) { *(f32x4*)(macc + o) = (f32x4){v[0], v[1], v[2], v[3]}; *(f32x4*)(macc + o + 4) = (f32x4){v[4], v[5], v[6], v[7]}; }
                        else *(v4u*)(merged + o) = pack8(v);
                    } } }
    }
};

__device__ __forceinline__ void transpose_item(const float* __restrict__ W, int ldw, bf16* __restrict__ WT, int K, int nblk, float* scr, int item, int lane) {
    const int kb = item / nblk, nb = item % nblk, k0 = 64 * kb, n0 = 32 * nb;
#pragma unroll 8
    for (int i = 0; i < 32; ++i) { const int kk = 2 * i + (lane >> 5); scr[kk * 33 + (lane & 31)] = W[(size_t)(k0 + kk) * ldw + n0 + (lane & 31)]; }
    LDS_WAIT();
    const int c = lane & 7;
#pragma unroll
    for (int j = 0; j < 4; ++j) { const int n = (lane >> 3) + 8 * j; const float* s = scr + (8 * c) * 33 + n;
        v4u o; o.x = pk2(s[0 * 33], s[1 * 33]); o.y = pk2(s[2 * 33], s[3 * 33]); o.z = pk2(s[4 * 33], s[5 * 33]); o.w = pk2(s[6 * 33], s[7 * 33]);
        *(v4u*)(WT + (size_t)(n0 + n) * K + k0 + 8 * c) = o; }
    LDS_WAIT();
}
__device__ __forceinline__ void rms_row_to_bf16(const float* xrow, const float* w, bf16* orow, int lane) {
    const f32x4* xr = (const f32x4*)xrow + lane; const f32x4* wr = (const f32x4*)w + lane;
    f32x4 v[4]; float s = 0.f;
#pragma unroll
    for (int j = 0; j < 4; ++j) { v[j] = xr[64 * j]; s += (v[j][0] * v[j][0] + v[j][1] * v[j][1]) + (v[j][2] * v[j][2] + v[j][3] * v[j][3]); }
    const float rstd = rsqrtf(wave_sum(s) * (1.f / DM) + EPS);
    unsigned long long* o8 = (unsigned long long*)orow + lane;
#pragma unroll
    for (int j = 0; j < 4; ++j) { const f32x4 ww = wr[64 * j];
        o8[64 * j] = (unsigned long long)pk2(v[j][0] * rstd * ww[0], v[j][1] * rstd * ww[1]) | ((unsigned long long)pk2(v[j][2] * rstd * ww[2], v[j][3] * rstd * ww[3]) << 32); }
}
__device__ __forceinline__ void phase0(unsigned char* lds, const Args& a, int l, const float* xin) {
    const int tid = opaque_tid(), lane = tid & 63, wave = tid >> 6, gw = blockIdx.x * NWAVES + wave, NGW = gridDim.x * NWAVES;
    bf16* Wreg = (bf16*)(a.ws + WS_W);
    const float* w_in = a.in[2] + (size_t)l * DM * IN_DIM;
    {
        float* scr = (float*)lds + wave * (64 * 33);
        const float* w_br = a.in[13] + (size_t)l * 3 * DM * DM; const float* w_out = a.in[14] + (size_t)l * DM * DM;
        const float* w_up = a.in[16] + (size_t)l * DM * DFF; const float* w_down = a.in[17] + (size_t)l * DFF * DM;
        constexpr int NSEG = 17, NIT = NSEG * 512 + 2048 + 2048;
        for (int it = gw; it < NIT; it += NGW) {
            if (it < NSEG * 512) {
                const int seg = it >> 9, r = it & 511;
                const float* W; int ldw; bf16* WT;
                if (seg < 13) {
                    const int co = seg == 0 ? 3072 : seg == 1 ? 4112 : seg == 2 ? 7184 : seg == 3 ? 0 : seg == 4 ? 1024 : seg == 5 ? 2048 : seg == 6 ? 5136 : seg == 7 ? 6160 : seg == 8 ? 8208 : seg == 9 ? 9232
                                 : 10272 + (seg - 10) * 1024;
                    W = w_in + co; ldw = IN_DIM; WT = Wreg + (size_t)seg * DM * DM;
                } else if (seg < 16) { W = w_br + (size_t)(seg - 13) * DM * DM; ldw = DM; WT = Wreg + W_G + (size_t)(3 + seg - 13) * DM * DM; }
                else { W = w_out; ldw = DM; WT = Wreg + W_OUT; }
                transpose_item(W, ldw, WT, DM, 32, scr, r, lane);
            } else if (it < NSEG * 512 + 2048) transpose_item(w_up, DFF, Wreg + W_UP, DM, 128, scr, it - NSEG * 512, lane);
            else transpose_item(w_down, DM, Wreg + W_DOWN, DFF, 32, scr, it - NSEG * 512 - 2048, lane);
        }
    }
    __syncthreads();
    {
        float* Ws = (float*)lds;
        for (int idx = tid; idx < 32 * DM; idx += NTHREADS) { const int k = idx >> 5, c = idx & 31; Ws[c * DM + k] = w_in[(size_t)k * IN_DIM + (c < 16 ? 4096 + c : 10256 + c - 16)]; }
        __syncthreads();
        const float* nw = a.in[1] + (size_t)l * DM;
        bf16* H = (bf16*)a.ws; float* small = (float*)(a.ws + WS_SMALL);
        float p0 = 0.f, p1 = 0.f;
        if (lane < 8) { p0 = __expf(a.in[4][l * 8 + lane]); p1 = a.in[5][l * 8 + lane]; }
        else if (lane >= 16 && lane < 32) { p0 = __expf(a.in[9][l * 16 + lane - 16]); p1 = a.in[10][l * 16 + lane - 16]; }
        for (int m = gw; m < MT; m += NGW) {
            const float* xrow = xin + (size_t)m * DM;
            float xv[16]; float s = 0.f;
#pragma unroll
            for (int i = 0; i < 16; ++i) { xv[i] = xrow[lane + 64 * i]; s += xv[i] * xv[i]; }
            const float rstd = rsqrtf(wave_sum(s) * (1.f / DM) + EPS);
            bf16* hrow = H + (size_t)m * DM;
#pragma unroll
            for (int i = 0; i < 16; ++i) { xv[i] = xv[i] * rstd * nw[lane + 64 * i]; hrow[lane + 64 * i] = (bf16)f2bf(xv[i]); }
            float mine = 0.f;
#pragma unroll 4
            for (int c = 0; c < 32; ++c) { float acc = 0.f;
#pragma unroll
                for (int i = 0; i < 16; ++i) acc += xv[i] * Ws[c * DM + lane + 64 * i];
                acc = wave_sum(acc); mine = (lane == c) ? acc : mine; }
            if (lane < 8) small[(size_t)m * 64 + lane] = -p0 * softplusf_(mine + p1);
            else if (lane < 16) small[(size_t)m * 64 + lane] = sigmoidf_(mine);
            else if (lane < 32) { const float dt = softplusf_(mine + p1); small[(size_t)m * 64 + lane] = dt; small[(size_t)m * 64 + lane + 16] = -p0 * dt; }
        }
    }
}

__device__ __forceinline__ void conv8(const bf16* p, int pos, const float* w, int wstride, const float* bias, float* out) {
    float acc[8];
#pragma unroll
    for (int i = 0; i < 8; ++i) acc[i] = bias ? bias[i] : 0.f;
#pragma unroll
    for (int j = 0; j < 4; ++j) { const int back = 3 - j;
        if (pos - back >= 0) { float xv[8]; unpack8(*(const v4u*)(p - (size_t)back * DM), xv);
            const f32x4 w0 = *(const f32x4*)(w + j * wstride), w1 = *(const f32x4*)(w + j * wstride + 4);
#pragma unroll
            for (int i = 0; i < 4; ++i) { acc[i] += xv[i] * w0[i]; acc[4 + i] += xv[4 + i] * w1[i]; } } }
#pragma unroll
    for (int i = 0; i < 8; ++i) out[i] = siluf_(acc[i]);
}

__device__ __forceinline__ void conv8r(const v4u (&raw)[4], const float* w, int wstride, const float* bias, float* out) {
    float acc[8];
#pragma unroll
    for (int i = 0; i < 8; ++i) acc[i] = bias ? bias[i] : 0.f;
#pragma unroll
    for (int j = 0; j < 4; ++j) { float xv[8]; unpack8(raw[j], xv);
        const f32x4 w0 = *(const f32x4*)(w + j * wstride), w1 = *(const f32x4*)(w + j * wstride + 4);
#pragma unroll
        for (int i = 0; i < 4; ++i) { acc[i] += xv[i] * w0[i]; acc[4 + i] += xv[4 + i] * w1[i]; } }
#pragma unroll
    for (int i = 0; i < 8; ++i) out[i] = siluf_(acc[i]);
}
#define LOAD4(dst, p, pos) do { _Pragma("unroll") for (int j_ = 0; j_ < 4; ++j_) { const int back_ = 3 - j_; const bool ok_ = (pos) - back_ >= 0; \
        const v4u t_ = *(const v4u*)((p) - (size_t)(ok_ ? back_ : 0) * DM); dst[j_] = ok_ ? t_ : (v4u){0u, 0u, 0u, 0u}; } } while (0)

template <int K> __device__ __forceinline__ void mma16(f32x4& acc, const bf16* Ap, int lda, const bf16* Bp, int ldb, int fr, int fq) {
    bf16x8 af[K / 32], bfv[K / 32];
#pragma unroll
    for (int k = 0; k < K / 32; ++k) { af[k] = *(const bf16x8*)(Ap + fr * lda + k * 32 + fq * 8); bfv[k] = *(const bf16x8*)(Bp + fr * ldb + k * 32 + fq * 8); }
#pragma unroll
    for (int k = 0; k < K / 32; ++k) acc = __builtin_amdgcn_mfma_f32_16x16x32_bf16(af[k], bfv[k], acc, 0, 0, 0);
}
__device__ __forceinline__ void dn_item(unsigned char* lds, const Args& a, int l, int item, unsigned long long& probe_acc) {
    constexpr int LDK = 136, LDJ = 40, LDL = 36;
    const int b = item >> 3, h = item & 7;
    bf16* kA = (bf16*)lds;
    bf16* qA = kA + 32 * LDK;
    bf16* qgA = qA + 32 * LDK;
    bf16* wA = qgA + 32 * LDK;
    bf16* kdT = wA + 32 * LDK;
    bf16* vnT = kdT + 128 * LDJ;
    bf16* attn = vnT + 128 * LDJ;
    bf16* ST = attn + 32 * LDJ;
    float* kf = (float*)(ST + 128 * LDK);
    float* vf = kf + 32 * 128;
    float* os = kf;
    float* Lm = vf + 32 * 128;
    float* gcs = Lm + 32 * LDL;
    float* betas = gcs + 32;
    float* cwL = betas + 32;
    const int tid = opaque_tid(), w = __builtin_amdgcn_readfirstlane(tid >> 6), lane = tid & 63, fr = lane & 15, fq = lane >> 4;
    bf16* base = (bf16*)a.ws;
    const bf16* Q = base + (size_t)B_DNQ * BUFE; const bf16* K = base + (size_t)B_DNK * BUFE; const bf16* V = base + (size_t)B_DNV * BUFE; bf16* G = base + (size_t)B_DNG * BUFE;
    const float* small = (const float*)(a.ws + WS_SMALL);
    const float* cw = a.in[3] + (size_t)l * 4 * 3072;
    const size_t rowbase = (size_t)b * SEQ;
    const int tq = tid >> 4, cq = tid & 15;
    const float* nwp = a.in[6] + l * 128 + cq * 8;
    f32x4 Sacc[8];
#pragma unroll
    for (int i = 0; i < 8; ++i) Sacc[i] = (f32x4){0.f, 0.f, 0.f, 0.f};
    for (int i = tid; i < 128 * LDK / 2; i += NTHREADS) ((unsigned*)ST)[i] = 0u;
    for (int i = tid; i < 4 * 384; i += NTHREADS) { const int j = i / 384, r = i % 384; cwL[i] = cw[j * 3072 + (r >> 7) * 1024 + h * 128 + (r & 127)]; }
    __syncthreads();
    v4u rq[4], rk[4], rv[4], rgate; float rg = 0.f, rbv = 0.f;
#define DN_LOADS(c_) do { const int t0_ = (c_) * 32, pos_ = t0_ + tq; const size_t off_ = (rowbase + pos_) * DM + h * 128 + cq * 8; \
        LOAD4(rq, Q + off_, pos_); LOAD4(rk, K + off_, pos_); LOAD4(rv, V + off_, pos_); rgate = *(const v4u*)(G + off_); \
        { const size_t r_ = rowbase + t0_ + (lane & 31); rg = small[r_ * 64 + h]; rbv = small[r_ * 64 + 8 + h]; } } while (0)
    DN_LOADS(0);
    for (int c = 0; c < SEQ / 32; ++c) {
        const int t0 = c * 32;
        unsigned long long tp_ = PROBE_SEL ? rt() : 0ull;
#define DPT(k) do { if (PROBE_SEL) { const unsigned long long tn_ = rt(); if ((PROBE_SEL & (1 << (k))) && item == 0) probe_acc += tn_ - tp_; tp_ = tn_; } } while (0)
        float gcv = rg;
#pragma unroll
        for (int off = 1; off < 32; off <<= 1) { const float t = __shfl_up(gcv, off, 32); if ((lane & 31) >= off) gcv += t; }
        const float gc_last = __shfl(gcv, 31), gc_t = __shfl(gcv, tq), beta_t = __shfl(rbv, tq);
        const v4u gcur = rgate;
        {   float q8[8], k8[8], v8[8];
            conv8r(rq, cwL + cq * 8, 384, nullptr, q8);
            __builtin_amdgcn_sched_barrier(0);
            conv8r(rk, cwL + 128 + cq * 8, 384, nullptr, k8);
            __builtin_amdgcn_sched_barrier(0);
            conv8r(rv, cwL + 256 + cq * 8, 384, nullptr, v8);
            __builtin_amdgcn_sched_barrier(0);
            float sq = 0.f, sk = 0.f;
#pragma unroll
            for (int i = 0; i < 8; ++i) { sq += q8[i] * q8[i]; sk += k8[i] * k8[i]; }
            sq = red16(sq); sk = red16(sk);
            const float rqn = rsqrtf(sq + EPS) * 0.08838834764831845f, rkn = rsqrtf(sk + EPS);
            const float eg = __expf(gc_t), kb = beta_t * eg, kd = __expf(gc_last - gc_t);
            float t8[8];
#pragma unroll
            for (int i = 0; i < 8; ++i) { q8[i] *= rqn; k8[i] *= rkn; }
            *(v4u*)(kA + tq * LDK + cq * 8) = pack8(k8); *(v4u*)(qA + tq * LDK + cq * 8) = pack8(q8);
#pragma unroll
            for (int i = 0; i < 8; ++i) t8[i] = q8[i] * eg;
            *(v4u*)(qgA + tq * LDK + cq * 8) = pack8(t8);
            *(f32x4*)(kf + tq * 128 + cq * 8) = (f32x4){k8[0] * kb, k8[1] * kb, k8[2] * kb, k8[3] * kb}; *(f32x4*)(kf + tq * 128 + cq * 8 + 4) = (f32x4){k8[4] * kb, k8[5] * kb, k8[6] * kb, k8[7] * kb};
            *(f32x4*)(vf + tq * 128 + cq * 8) = (f32x4){v8[0] * beta_t, v8[1] * beta_t, v8[2] * beta_t, v8[3] * beta_t}; *(f32x4*)(vf + tq * 128 + cq * 8 + 4) = (f32x4){v8[4] * beta_t, v8[5] * beta_t, v8[6] * beta_t, v8[7] * beta_t};
#pragma unroll
            for (int i = 0; i < 8; ++i) kdT[(cq * 8 + i) * LDJ + tq] = (bf16)f2bf(k8[i] * kd);
        }
        if (tid < 32) { gcs[tid] = gcv; betas[tid] = rbv; }
        __syncthreads();
        DPT(12);
        if (c + 1 < SEQ / 32) DN_LOADS(c + 1);
        {   const int ww = w & 3, gi = ww >> 1, gj = ww & 1; f32x4 acc = {0.f, 0.f, 0.f, 0.f};
            const int jI = 16 * gj + fr, i0 = 16 * gi + 4 * fq;
            const float gj_ = gcs[jI]; const f32x4 gi4 = *(const f32x4*)(gcs + i0), bi4 = *(const f32x4*)(betas + i0);
            mma16<128>(acc, (w < 4 ? kA : qA) + gi * 16 * LDK, LDK, kA + gj * 16 * LDK, LDK, fr, fq);
            if (w < 4) {
#pragma unroll
                for (int jj = 0; jj < 4; ++jj) Lm[(i0 + jj) * LDL + jI] = jI < i0 + jj ? bi4[jj] * acc[jj] * __expf(gi4[jj] - gj_) : 0.f;
            } else {
#pragma unroll
                for (int jj = 0; jj < 4; ++jj) attn[(i0 + jj) * LDJ + jI] = (bf16)f2bf(jI <= i0 + jj ? acc[jj] * __expf(gi4[jj] - gj_) : 0.f);
            } }
        __syncthreads();
        DPT(13);
        if (w < 4) { const int cc = tid & 127; const bool is_w = w >= 2; const float* R = is_w ? kf : vf;
            float x[32];
#pragma unroll
            for (int i = 0; i < 32; ++i) x[i] = R[i * 128 + cc];
            f32x4 Lb[2][8];
            Lb[1][0] = *(const f32x4*)(Lm + 1 * LDL);
#pragma unroll
            for (int i = 1; i < 32; ++i) {
                if (i + 1 < 32) {
#pragma unroll
                    for (int j4 = 0; j4 < (i + 4) / 4; ++j4) Lb[(i + 1) & 1][j4] = *(const f32x4*)(Lm + (i + 1) * LDL + j4 * 4); }
                float a0 = x[i], a1 = 0.f, a2 = 0.f, a3 = 0.f;
#pragma unroll
                for (int j4 = 0; j4 < (i + 3) / 4; ++j4) { const f32x4 l4 = Lb[i & 1][j4];
                    if (j4 * 4 + 0 < i) a0 -= l4[0] * x[j4 * 4 + 0];
                    if (j4 * 4 + 1 < i) a1 -= l4[1] * x[j4 * 4 + 1];
                    if (j4 * 4 + 2 < i) a2 -= l4[2] * x[j4 * 4 + 2];
                    if (j4 * 4 + 3 < i) a3 -= l4[3] * x[j4 * 4 + 3]; }
                x[i] = (a0 + a1) + (a2 + a3); }
            if (is_w) {
#pragma unroll
                for (int i = 0; i < 32; ++i) wA[i * LDK + cc] = (bf16)f2bf(x[i]);
            } else {
#pragma unroll
                for (int i = 0; i < 32; ++i) vf[i * 128 + cc] = x[i];
            } }
        __syncthreads();
        DPT(14);
#pragma unroll
        for (int it = 0; it < 2; ++it) { f32x4 acc = {0.f, 0.f, 0.f, 0.f};
            mma16<128>(acc, wA + it * 16 * LDK, LDK, ST + w * 16 * LDK, LDK, fr, fq);
            float vn[4];
#pragma unroll
            for (int jj = 0; jj < 4; ++jj) vn[jj] = vf[(16 * it + 4 * fq + jj) * 128 + 16 * w + fr] - acc[jj];
            v2u pk; pk.x = pk2(vn[0], vn[1]); pk.y = pk2(vn[2], vn[3]);
            *(v2u*)(vnT + (16 * w + fr) * LDJ + 16 * it + 4 * fq) = pk; }
        __syncthreads();
#pragma unroll
        for (int it = 0; it < 2; ++it) { f32x4 acc = {0.f, 0.f, 0.f, 0.f};
            mma16<128>(acc, qgA + it * 16 * LDK, LDK, ST + w * 16 * LDK, LDK, fr, fq);
            mma16<32>(acc, attn + it * 16 * LDJ, LDJ, vnT + w * 16 * LDJ, LDJ, fr, fq);
#pragma unroll
            for (int jj = 0; jj < 4; ++jj) os[(16 * it + 4 * fq + jj) * 128 + 16 * w + fr] = acc[jj]; }
        {   const float dl = __expf(gc_last);
#pragma unroll
            for (int dt = 0; dt < 8; ++dt) { Sacc[dt] = Sacc[dt] * dl; mma16<32>(Sacc[dt], kdT + dt * 16 * LDJ, LDJ, vnT + w * 16 * LDJ, LDJ, fr, fq); } }
        __syncthreads();
#pragma unroll
        for (int dt = 0; dt < 8; ++dt) { v2u pk; pk.x = pk2(Sacc[dt][0], Sacc[dt][1]); pk.y = pk2(Sacc[dt][2], Sacc[dt][3]);
            *(v2u*)(ST + (16 * w + fr) * LDK + 16 * dt + 4 * fq) = pk; }
        {   const f32x4 o0 = *(const f32x4*)(os + tq * 128 + cq * 8), o1 = *(const f32x4*)(os + tq * 128 + cq * 8 + 4);
            float ss = (o0[0] * o0[0] + o0[1] * o0[1]) + (o0[2] * o0[2] + o0[3] * o0[3]) + (o1[0] * o1[0] + o1[1] * o1[1]) + (o1[2] * o1[2] + o1[3] * o1[3]);
            ss = red16(ss);
            const float r = rsqrtf(ss * (1.f / 128.f) + EPS);
            float g8[8], o8[8], nw8[8]; unpack8(gcur, g8);
            { const f32x4 n0 = *(const f32x4*)nwp, n1 = *(const f32x4*)(nwp + 4); nw8[0] = n0[0]; nw8[1] = n0[1]; nw8[2] = n0[2]; nw8[3] = n0[3]; nw8[4] = n1[0]; nw8[5] = n1[1]; nw8[6] = n1[2]; nw8[7] = n1[3]; }
#pragma unroll
            for (int i = 0; i < 4; ++i) { o8[i] = o0[i] * r * nw8[i] * siluf_(g8[i]); o8[4 + i] = o1[i] * r * nw8[4 + i] * siluf_(g8[4 + i]); }
            *(v4u*)(G + (rowbase + t0 + tq) * DM + h * 128 + cq * 8) = pack8(o8); }
        __syncthreads();
        DPT(15);
    }
#undef DPT
#undef DN_LOADS
    __syncthreads();
}

__device__ __forceinline__ void ssm_item(unsigned char* lds, const Args& a, int l, int item) {
    constexpr int LDC = 136, LDX = 40;
    const int b = item >> 4, hd = item & 15, g = hd >> 2;
    bf16* Cs = (bf16*)lds;
    bf16* Bs = Cs + 32 * LDC;
    bf16* BT = Bs + 32 * LDC;
    bf16* xdtT = BT + 128 * LDX;
    bf16* xddT = xdtT + 64 * LDX;
    bf16* Wm = xddT + 64 * LDX;
    bf16* hB = Wm + 32 * LDX;
    float* xs = (float*)(hB + 64 * LDC);
    float* acs = xs + 32 * 64;
    const int tid = opaque_tid(), w = __builtin_amdgcn_readfirstlane(tid >> 6), lane = tid & 63, fr = lane & 15, fq = lane >> 4;
    bf16* base = (bf16*)a.ws;
    const bf16* X = base + (size_t)B_SSX * BUFE; const bf16* BC = base + (size_t)B_SSBC * BUFE; bf16* Z = base + (size_t)B_SSZ * BUFE;
    const float* small = (const float*)(a.ws + WS_SMALL);
    const float* cw = a.in[7] + (size_t)l * 4 * 2048; const float* cb = a.in[8] + (size_t)l * 2048;
    const float dskip = a.in[11][l * 16 + hd];
    const size_t rowbase = (size_t)b * SEQ;
    const int tq = tid >> 4, cq = tid & 15, tv = (tid >> 3) & 31, cv = tid & 7;
    const int it = w >> 2, pt = w & 3;
    f32x4 hacc[4];
#pragma unroll
    for (int i = 0; i < 4; ++i) hacc[i] = (f32x4){0.f, 0.f, 0.f, 0.f};
    for (int i = tid; i < 64 * LDC / 2; i += NTHREADS) ((unsigned*)hB)[i] = 0u;
    v4u rB[4], rC[4], rx[4]; float ra = 0.f, rdtv = 0.f; unsigned rz[4];
#define SSM_LOADS(c_) do { const int t0_ = (c_) * 32; { const int pos_ = t0_ + tq; const size_t ro_ = (rowbase + pos_) * DM; LOAD4(rB, BC + ro_ + g * 128 + cq * 8, pos_); LOAD4(rC, BC + ro_ + 512 + g * 128 + cq * 8, pos_); } \
        if (tid < 256) { const int pos_ = t0_ + tv; LOAD4(rx, X + (rowbase + pos_) * DM + hd * 64 + cv * 8, pos_); } \
        { const size_t r_ = rowbase + t0_ + (lane & 31); rdtv = small[r_ * 64 + 16 + hd]; ra = small[r_ * 64 + 32 + hd]; } \
        _Pragma("unroll") for (int jj_ = 0; jj_ < 4; ++jj_) rz[jj_] = Z[(rowbase + t0_ + 16 * it + 4 * fq + jj_) * DM + hd * 64 + 16 * pt + fr]; } while (0)
    SSM_LOADS(0);
    for (int c = 0; c < SEQ / 32; ++c) {
        const int t0 = c * 32;
        float acum = ra;
#pragma unroll
        for (int off = 1; off < 32; off <<= 1) { const float t = __shfl_up(acum, off, 32); if ((lane & 31) >= off) acum += t; }
        const float ac_last = __shfl(acum, 31);
        {   float o8[8];
            conv8r(rB, cw + 1024 + g * 128 + cq * 8, 2048, cb + 1024 + g * 128 + cq * 8, o8);
            *(v4u*)(Bs + tq * LDC + cq * 8) = pack8(o8);
#pragma unroll
            for (int i = 0; i < 8; ++i) BT[(cq * 8 + i) * LDX + tq] = (bf16)f2bf(o8[i]);
            conv8r(rC, cw + 1536 + g * 128 + cq * 8, 2048, cb + 1536 + g * 128 + cq * 8, o8);
            *(v4u*)(Cs + tq * LDC + cq * 8) = pack8(o8);
        }
        if (w < 4) { float o8[8]; conv8r(rx, cw + hd * 64 + cv * 8, 2048, cb + hd * 64 + cv * 8, o8);
            const float dtv = __shfl(rdtv, tv), dd = dtv * __expf(ac_last - __shfl(acum, tv));
            *(f32x4*)(xs + tv * 64 + cv * 8) = (f32x4){o8[0], o8[1], o8[2], o8[3]}; *(f32x4*)(xs + tv * 64 + cv * 8 + 4) = (f32x4){o8[4], o8[5], o8[6], o8[7]};
#pragma unroll
            for (int i = 0; i < 8; ++i) { xdtT[(cv * 8 + i) * LDX + tv] = (bf16)f2bf(o8[i] * dtv); xddT[(cv * 8 + i) * LDX + tv] = (bf16)f2bf(o8[i] * dd); }
        }
        if (tid < 32) acs[tid] = acum;
        unsigned zr[4];
#pragma unroll
        for (int jj = 0; jj < 4; ++jj) zr[jj] = rz[jj];
        __syncthreads();
        if (c + 1 < SEQ / 32) SSM_LOADS(c + 1);
        if (w < 4) { const int gi = w >> 1, gj = w & 1; f32x4 acc = {0.f, 0.f, 0.f, 0.f};
            mma16<128>(acc, Cs + gi * 16 * LDC, LDC, Bs + gj * 16 * LDC, LDC, fr, fq);
            const int sI = 16 * gj + fr; const float as = acs[sI];
#pragma unroll
            for (int jj = 0; jj < 4; ++jj) { const int lI = 16 * gi + 4 * fq + jj; const float v = sI <= lI ? acc[jj] * __expf(acs[lI] - as) : 0.f; Wm[lI * LDX + sI] = (bf16)f2bf(v); } }
        __syncthreads();
        {   f32x4 a1 = {0.f, 0.f, 0.f, 0.f}, a2 = {0.f, 0.f, 0.f, 0.f};
            mma16<32>(a1, Wm + it * 16 * LDX, LDX, xdtT + pt * 16 * LDX, LDX, fr, fq);
            mma16<128>(a2, Cs + it * 16 * LDC, LDC, hB + pt * 16 * LDC, LDC, fr, fq);
            const int p = 16 * pt + fr;
#pragma unroll
            for (int jj = 0; jj < 4; ++jj) { const int lI = 16 * it + 4 * fq + jj;
                const float y = a1[jj] + __expf(acs[lI]) * a2[jj] + xs[lI * 64 + p] * dskip;
                Z[(rowbase + t0 + lI) * DM + hd * 64 + p] = (bf16)f2bf(y * siluf_(bf2f(zr[jj]))); }
            const float dl = __expf(ac_last);
#pragma unroll
            for (int p2 = 0; p2 < 4; ++p2) { hacc[p2] = hacc[p2] * dl; mma16<32>(hacc[p2], xddT + p2 * 16 * LDX, LDX, BT + w * 16 * LDX, LDX, fr, fq); }
        }
        __syncthreads();
#pragma unroll
        for (int p2 = 0; p2 < 4; ++p2)
#pragma unroll
            for (int jj = 0; jj < 4; ++jj) hB[(16 * p2 + 4 * fq + jj) * LDC + 16 * w + fr] = (bf16)f2bf(hacc[p2][jj]);
    }
#undef SSM_LOADS
    __syncthreads();
}

__device__ __forceinline__ void sb_item(unsigned char* lds, const Args& a, int b, int hd, int qi) {
    constexpr int LD = 72;
    bf16* Ks = (bf16*)lds; bf16* Vs = Ks + 2 * 64 * LD;
    volatile unsigned* alive = (volatile unsigned*)(Vs + 2 * 64 * LD);
    const int tid = opaque_tid(), w = __builtin_amdgcn_readfirstlane(tid >> 6), lane = tid & 63, fr = lane & 15, fq = lane >> 4;
    bf16* base = (bf16*)a.ws;
    bf16* Qb = base + (size_t)B_SBQ * BUFE; const bf16* Kb = base + (size_t)B_SBK * BUFE; const bf16* Vb = base + (size_t)B_SBV * BUFE;
    const size_t rowbase = (size_t)b * SEQ;
    const int t0 = qi * 128, myq = t0 + w * 16 + fr, wmax = t0 + w * 16 + 15;
    bf16* qrow = Qb + (rowbase + myq) * DM + hd * 64;
    bf16x8 qf[2];
    qf[0] = *(const bf16x8*)(qrow + fq * 8); qf[1] = *(const bf16x8*)(qrow + 32 + fq * 8);
    f32x4 oacc[4];
#pragma unroll
    for (int i = 0; i < 4; ++i) oacc[i] = (f32x4){0.f, 0.f, 0.f, 0.f};
    float carry = 1.f;
    const int kr = tid >> 3, d8 = (tid & 7) * 8;
    v4u kreg, vreg;
    int kt = 2 * (qi + 1) - 1;
#define SB_LOAD(t) do { const size_t o_ = (rowbase + (size_t)(t) * 64 + kr) * DM + hd * 64 + d8; kreg = *(const v4u*)(Kb + o_); vreg = *(const v4u*)(Vb + o_); } while (0)
#define SB_STORE(bu) do { *(v4u*)(Ks + (bu) * 64 * LD + kr * LD + d8) = kreg; bf16* vd_ = Vs + (bu) * 64 * LD + d8 * LD + kr; \
        vd_[0] = (bf16)(vreg.x & 0xffffu); vd_[LD] = (bf16)(vreg.x >> 16); vd_[2 * LD] = (bf16)(vreg.y & 0xffffu); vd_[3 * LD] = (bf16)(vreg.y >> 16); \
        vd_[4 * LD] = (bf16)(vreg.z & 0xffffu); vd_[5 * LD] = (bf16)(vreg.z >> 16); vd_[6 * LD] = (bf16)(vreg.w & 0xffffu); vd_[7 * LD] = (bf16)(vreg.w >> 16); } while (0)
    SB_LOAD(kt); SB_STORE(0);
    __syncthreads();
    int cur = 0;
    for (; kt >= 0; --kt) {
        if (kt > 0) SB_LOAD(kt - 1);
        const int kbase = kt * 64;
        if (kbase <= wmax) {
            const bf16* Kc = Ks + cur * 64 * LD; const bf16* Vc = Vs + cur * 64 * LD;
            f32x4 z[4];
#pragma unroll
            for (int nt = 0; nt < 4; ++nt) { z[nt] = (f32x4){0.f, 0.f, 0.f, 0.f};
#pragma unroll
                for (int k2 = 0; k2 < 2; ++k2) { const bf16x8 af = *(const bf16x8*)(Kc + (nt * 16 + fr) * LD + k2 * 32 + fq * 8);
                    z[nt] = __builtin_amdgcn_mfma_f32_16x16x32_bf16(af, qf[k2], z[nt], 0, 0, 0); } }
            float kp[4][4], sg[4][4], T[4], tot[4], suf[4];
            const bool masked = kbase + 64 > t0 + w * 16;
#pragma unroll
            for (int nt = 0; nt < 4; ++nt) {
#pragma unroll
                for (int j = 0; j < 4; ++j) { const float z2 = z[nt][j] * 0.18033688011112042f;
                    const float ea = __builtin_amdgcn_exp2f(-fabsf(z2)), rc = __builtin_amdgcn_rcpf(1.f + ea); const bool pos = z2 >= 0.f;
                    sg[nt][j] = (pos ? 1.f : ea) * rc; kp[nt][j] = (pos ? ea : 1.f) * rc; }
                if (masked) {
#pragma unroll
                    for (int j = 0; j < 4; ++j) { const bool valid = kbase + nt * 16 + fq * 4 + j < myq; sg[nt][j] = valid ? sg[nt][j] : 0.f; kp[nt][j] = valid ? kp[nt][j] : 1.f; } }
                T[nt] = (kp[nt][0] * kp[nt][1]) * (kp[nt][2] * kp[nt][3]); }
#pragma unroll
            for (int nt = 0; nt < 4; ++nt) { const float p16 = __shfl_xor(T[nt], 16), s1 = T[nt] * p16, p32 = __shfl_xor(s1, 32); tot[nt] = s1 * p32;
                suf[nt] = fq == 0 ? p16 * p32 : fq == 1 ? p32 : fq == 2 ? p16 : 1.f; }
            float run = carry; float wv[4][4];
#pragma unroll
            for (int nt = 3; nt >= 0; --nt) { const float r3 = run * suf[nt], r2 = r3 * kp[nt][3], r1 = r2 * kp[nt][2], r0 = r1 * kp[nt][1];
                wv[nt][0] = sg[nt][0] * r0; wv[nt][1] = sg[nt][1] * r1; wv[nt][2] = sg[nt][2] * r2; wv[nt][3] = sg[nt][3] * r3;
                run *= tot[nt]; }
            carry = run;
#pragma unroll
            for (int kk = 0; kk < 2; ++kk) {
                v4u bw; bw.x = pk2(wv[2 * kk][0], wv[2 * kk][1]); bw.y = pk2(wv[2 * kk][2], wv[2 * kk][3]); bw.z = pk2(wv[2 * kk + 1][0], wv[2 * kk + 1][1]); bw.w = pk2(wv[2 * kk + 1][2], wv[2 * kk + 1][3]);
                const bf16x8 bfr = __builtin_bit_cast(bf16x8, bw);
#pragma unroll
                for (int mt = 0; mt < 4; ++mt) { const bf16* vp = Vc + (mt * 16 + fr) * LD + 32 * kk + 4 * fq;
                    const v2u lo = *(const v2u*)vp, hi = *(const v2u*)(vp + 16);
                    v4u av; av.x = lo.x; av.y = lo.y; av.z = hi.x; av.w = hi.y;
                    oacc[mt] = __builtin_amdgcn_mfma_f32_16x16x32_bf16(__builtin_bit_cast(bf16x8, av), bfr, oacc[mt], 0, 0, 0); }
            }
        }
        {   const bool any_alive = __ballot(carry != 0.f) != 0ull;
            if (lane == 0) alive[cur * 8 + w] = any_alive ? 1u : 0u; }
        if (kt > 0) SB_STORE(cur ^ 1);
        __syncthreads();
        unsigned al = 0u;
#pragma unroll
        for (int i = 0; i < 8; ++i) al |= alive[cur * 8 + i];
        if (al == 0u) break;
        cur ^= 1;
    }
#undef SB_LOAD
#undef SB_STORE
#pragma unroll
    for (int mt = 0; mt < 4; ++mt) { v2u wq; wq.x = pk2(oacc[mt][0], oacc[mt][1]); wq.y = pk2(oacc[mt][2], oacc[mt][3]); *(v2u*)(qrow + mt * 16 + fq * 4) = wq; }
}

__device__ __forceinline__ void phase_mixers(unsigned char* lds, const Args& a, int l, unsigned long long& probe_acc) {
    unsigned* counter = (unsigned*)(a.ws + WS_CTL) + 64 * l;
    volatile unsigned* slot = (volatile unsigned*)(lds + LDS_BYTES - 64);
    constexpr unsigned NITEMS = 64 + 128 + 2048;
    for (;;) {
        if (threadIdx.x == 0) *slot = __hip_atomic_fetch_add(counter, 1u, __ATOMIC_RELAXED, __HIP_MEMORY_SCOPE_AGENT);
        __syncthreads();
        const unsigned item = *slot;
        __syncthreads();
        if (item >= NITEMS) break;
        PT0();
        if (item < 64) { dn_item(lds, a, l, (int)item, probe_acc); if (item == 0) PT1(9); }
        else if (item < 192) { ssm_item(lds, a, l, (int)item - 64); if (item == 64) PT1(10); }
        else { const int r = (int)item - 192, qi = 15 - (r >> 7), bh = r & 127; sb_item(lds, a, bh >> 4, bh & 15, qi); if (item == 192) PT1(11); }
    }
}

__device__ __forceinline__ void phase_norms(const Args& a, int l) {
    const int tid = opaque_tid(), lane = tid & 63, wave = tid >> 6, gw = blockIdx.x * NWAVES + wave, NGW = gridDim.x * NWAVES;
    bf16* base = (bf16*)a.ws;
    const bf16* Oraw = base + (size_t)B_DNV * BUFE; bf16* G = base + (size_t)B_DNG * BUFE; bf16* Y = base + (size_t)B_SSZ * BUFE;
    const float* dnw = a.in[6] + (size_t)l * 128 + (lane & 7) * 16; const float* snw = a.in[12] + (size_t)l * DM + lane * 16;
    float w1[16], w2[16];
#pragma unroll
    for (int i = 0; i < 16; ++i) { w1[i] = dnw[i]; w2[i] = snw[i]; }
    for (int m = gw; m < MT; m += NGW) {
        const size_t o = (size_t)m * DM + lane * 16;
        float v[16], s, r;
        unpack8(*(const v4u*)(Y + o), v); unpack8(*(const v4u*)(Y + o + 8), v + 8);
        s = 0.f;
#pragma unroll
        for (int i = 0; i < 16; ++i) s += v[i] * v[i];
        s = red16(s);
        r = rsqrtf(s * (1.f / 256.f) + EPS);
#pragma unroll
        for (int i = 0; i < 16; ++i) v[i] = v[i] * r * w2[i];
        *(v4u*)(Y + o) = pack8(v); *(v4u*)(Y + o + 8) = pack8(v + 8);
    }
}

__global__ void __launch_bounds__(NTHREADS, 2) hybrid_fwd(Args a) {
    extern __shared__ __attribute__((aligned(16))) unsigned char lds[];
    cg::grid_group grid = cg::this_grid();
    bf16* base = (bf16*)a.ws; bf16* Wreg = (bf16*)(a.ws + WS_W);
    PG8_LAS unsigned char* ldsl = (PG8_LAS unsigned char*)lds;
    unsigned long long probe_acc = 0ull;
    if (blockIdx.x == 0 && threadIdx.x < 2) __hip_atomic_store((unsigned*)(a.ws + WS_CTL) + 64 * threadIdx.x, 0u, __ATOMIC_RELAXED, __HIP_MEMORY_SCOPE_AGENT);
#pragma unroll 1
    for (int l = 0; l < 2; ++l) {
        asm volatile("" : "+s"(l));
        const float* xin = l == 0 ? a.in[0] : a.out;
        { PT0(); phase0(lds, a, l, xin);
        grid.sync(); PT1(0); }
        {   pg8::Gemm g{base, Wreg + W_IN, MT, 10240, DM}; pg8::StaticOrder S; S.init(MT, 10240, (int)gridDim.x, (int)blockIdx.x);
            EpiRoute E{base};
            PT0(); pg8::gemm_phase<EpiRoute, pg8::StaticOrder, false, true>(ldsl, g, S, E);
        grid.sync(); PT1(1); }
        { PT0(); phase_mixers(lds, a, l, probe_acc);
        grid.sync(); PT1(2); }
        { PT0(); phase_norms(a, l);
        grid.sync(); PT1(3); }
        {   pg8::Gemm g{base, Wreg + W_G, 4 * MT, 6144, DM}; SchedGate S{(int)gridDim.x, (int)blockIdx.x};
            EpiGate E{base + (size_t)B_SBK * BUFE, (float*)(base + (size_t)B_DNK * BUFE), base + (size_t)B_DNQ * BUFE};
            PT0(); pg8::gemm_phase<EpiGate, SchedGate, false, true>(ldsl, g, S, E);
        grid.sync(); PT1(4); }
        {   pg8::Gemm g{base + (size_t)B_DNQ * BUFE, Wreg + W_OUT, MT, DM, DM}; pg8::StaticOrder S; S.init(MT, DM, (int)gridDim.x, (int)blockIdx.x);
            EpiResid E{xin, a.out};
            PT0(); pg8::gemm_phase<EpiResid, pg8::StaticOrder, false, true>(ldsl, g, S, E);
        grid.sync(); PT1(5); }
        {   const float* nw = a.in[15] + (size_t)l * DM;
            const int tid = opaque_tid(), lane = tid & 63, gw = blockIdx.x * NWAVES + (tid >> 6), NGW = gridDim.x * NWAVES;
            PT0(); for (int m = gw; m < MT; m += NGW) rms_row_to_bf16(a.out + (size_t)m * DM, nw, base + (size_t)m * DM, lane);
        grid.sync(); PT1(6); }
        {   pg8::Gemm g{base, Wreg + W_UP, MT, DFF, DM}; pg8::StaticOrder S; S.init(MT, DFF, (int)gridDim.x, (int)blockIdx.x);
            EpiRelu2 E{base + (size_t)B_DNQ * BUFE};
            PT0(); pg8::gemm_phase<EpiRelu2, pg8::StaticOrder, false, true>(ldsl, g, S, E);
        grid.sync(); PT1(7); }
        {   pg8::Gemm g{base + (size_t)B_DNQ * BUFE, Wreg + W_DOWN, MT, DM, DFF}; pg8::StaticOrder S; S.init(MT, DM, (int)gridDim.x, (int)blockIdx.x);
            EpiResid E{a.out, a.out};
            PT0(); pg8::gemm_phase<EpiResid, pg8::StaticOrder, false, true>(ldsl, g, S, E);
        grid.sync(); PT1(8); }
    }
    {
        const float* nw = a.in[18];
        const int tid = opaque_tid(), lane = tid & 63, gw = blockIdx.x * NWAVES + (tid >> 6), NGW = gridDim.x * NWAVES;
        for (int m = gw; m < MT; m += NGW) {
            f32x4* xr = (f32x4*)(a.out + (size_t)m * DM) + lane; const f32x4* wr = (const f32x4*)nw + lane;
            f32x4 v[4]; float s = 0.f;
#pragma unroll
            for (int j = 0; j < 4; ++j) { v[j] = xr[64 * j]; s += (v[j][0] * v[j][0] + v[j][1] * v[j][1]) + (v[j][2] * v[j][2] + v[j][3] * v[j][3]); }
            const float rstd = rsqrtf(wave_sum(s) * (1.f / DM) + EPS);
#pragma unroll
            for (int j = 0; j < 4; ++j) { const f32x4 ww = wr[64 * j]; f32x4 r;
#pragma unroll
                for (int i = 0; i < 4; ++i) r[i] = v[j][i] * rstd * ww[i];
                xr[64 * j] = r; }
        }
    }
    if (PROBE_SEL) { const unsigned long long t0 = rt(); while (rt() - t0 < probe_acc) __builtin_amdgcn_s_sleep(8); }
}

extern "C" void kernel_launch(void* const* d_in, const int* in_sizes, int n_in, void* d_out, int out_size, void* d_ws, size_t ws_size, hipStream_t stream) {
    static int grid = 0;
    if (grid == 0) {
        if (n_in != 19 || out_size != MT * DM || ws_size < WS_NEED) { fprintf(stderr, "kernel_launch: unexpected shapes (n_in %d out %d ws %zu need %zu)\n", n_in, out_size, ws_size, (size_t)WS_NEED); grid = -1; return; }
        int dev = 0, cus = 0, per_cu = 0;
        hipGetDevice(&dev); hipDeviceGetAttribute(&cus, hipDeviceAttributeMultiprocessorCount, dev);
        if (hipFuncSetAttribute((const void*)hybrid_fwd, hipFuncAttributeMaxDynamicSharedMemorySize, LDS_BYTES) != hipSuccess) { fprintf(stderr, "kernel_launch: hipFuncSetAttribute failed\n"); grid = -1; return; }
        if (hipOccupancyMaxActiveBlocksPerMultiprocessor(&per_cu, (const void*)hybrid_fwd, NTHREADS, LDS_BYTES) != hipSuccess || per_cu < 1) { fprintf(stderr, "kernel_launch: occupancy query gave %d\n", per_cu); per_cu = 1; }
        (void)hipGetLastError();
        grid = cus * per_cu;
    }
    if (grid < 0) return;
    Args a{};
    for (int i = 0; i < 19; ++i) a.in[i] = (const float*)d_in[i];
    a.out = (float*)d_out; a.ws = (unsigned char*)d_ws;
    void* args[] = {&a};
    hipError_t e = hipLaunchCooperativeKernel((const void*)hybrid_fwd, dim3(grid), dim3(NTHREADS), args, LDS_BYTES, stream);
    if (e != hipSuccess) fprintf(stderr, "cooperative launch failed: %s (grid %d)\n", hipGetErrorString(e), grid);
}
```

```cpp
#include <hip/hip_runtime.h>
#include <hip/hip_cooperative_groups.h>
#include <cstdio>
#include <cstdint>
namespace cg = cooperative_groups;
__device__ __forceinline__ int opaque_tid() { int t = (int)threadIdx.x; asm volatile("" : "+v"(t)); return t; }
namespace pg8 {
#define PG8_LAS __attribute__((address_space(3)))
typedef unsigned short bf16_t;
typedef short bf16x8 __attribute__((ext_vector_type(8)));
typedef float f32x4 __attribute__((ext_vector_type(4)));
typedef unsigned u32x4 __attribute__((ext_vector_type(4)));
constexpr int BM = 256, BK = 64, HALF = 128, HTB = HALF * BK * 2  , STAGE_BYTES = 8 * HTB, NXCD = 8, WGM = 8;

__host__ __device__ __forceinline__ int lds_byte(int r, int c) { const int st = (r >> 4) * 2 + (c >> 5), rr = r & 15, cc = c & 31, ob = rr * 64 + cc * 2; return st * 1024 + (ob ^ (((ob >> 9) & 1) << 5)); }
__host__ __device__ __forceinline__ void stage_rc(int b, int& R, int& C) { const int st = b / 1024, sb = b % 1024, swz = sb ^ (((sb >> 9) & 1) << 5); R = (st >> 1) * 16 + swz / 64; C = (st & 1) * 32 + (swz % 64) / 2; }
__host__ __device__ __forceinline__ int perm32(int rho) { const int n = rho >> 4, i = rho & 15; return 8 * (i >> 2) + 4 * n + (i & 3); }

struct Unit { int pm, pn; };
struct Gemm { const bf16_t* A; const bf16_t* Bt; int M, N, K; };

struct StaticOrder {
    int nM, nN, nwg, G, c;
    __host__ __device__ void init(int M, int N, int G_, int c_) { nM = M / BM; nN = N / BM; nwg = nM * nN; G = G_; c = c_; }
    __host__ __device__ bool next(int i, Unit& u) const {
        const long L = (long)i * G + c; if (L >= nwg) return false;
        int wgid = (int)L; { const int q = nwg / NXCD, r = nwg % NXCD, xcd = wgid % NXCD, off = wgid / NXCD; wgid = (xcd < r ? xcd * (q + 1) : r * (q + 1) + (xcd - r) * q) + off; }
        const int nig = WGM * nN, gid = wgid / nig, fm = gid * WGM, gsz = (nM - fm) < WGM ? (nM - fm) : WGM;
        u.pm = fm + ((wgid % nig) % gsz); u.pn = (wgid % nig) / gsz; return true;
    }
    __device__ __forceinline__ void a_ready(const Unit&) const {}
    __device__ __forceinline__ void done(const Unit&) const {}
};
__device__ __forceinline__ unsigned cvt_pk_bf16(float lo, float hi) { unsigned r; asm volatile("v_cvt_pk_bf16_f32 %0, %1, %2" : "=v"(r) : "v"(lo), "v"(hi)); return r; }
template <class Epi, class Sched, bool ALIGN_EPI = false, bool SP2 = false>
__device__ __forceinline__ void gemm_phase(PG8_LAS unsigned char* lds, const Gemm g, const Sched& S, const Epi& E) {
    const int tid = opaque_tid(), wid = __builtin_amdgcn_readfirstlane(tid >> 6), lane = tid & 63, wr = wid >> 2, wc = wid & 3, fr = lane & 15, fq = lane >> 4;
    const int K = g.K, nt = K / BK;
    unsigned voffA[2], voffB[2];
#pragma unroll
    for (int i = 0; i < 2; ++i) { int R, C; stage_rc(tid * 16 + i * 8192, R, C); const int Rb = Epi::PERM ? ((R & ~31) + perm32(R & 31)) : R;
        voffA[i] = (unsigned)(R * K + C) * 2u; voffB[i] = (unsigned)(Rb * K + C) * 2u; }
    const size_t kstep = (size_t)(BK * 2);
    const size_t hstep = (size_t)HALF * K * 2;
    const size_t tstep = 2 * hstep;
    const unsigned ldsw = (unsigned)wid * 1024u;
    const int aoff = lds_byte(wr * 64 + fr, fq * 8), boff = lds_byte(wc * 32 + fr, fq * 8);
#define PG8_SA(b, h) (((b) * 2 + (h)) * HTB)
#define PG8_SB(b, h) ((4 + (b) * 2 + (h)) * HTB)
#define PG8_STAGE(bufoff, gbase, voff) do { _Pragma("unroll") for (int _i = 0; _i < 2; ++_i) \
        __builtin_amdgcn_global_load_lds((const unsigned*)((const char*)(gbase) + (voff)[_i]), (PG8_LAS unsigned*)(lds + (bufoff) + ldsw + _i * 8192), 16, 0, 0); } while (0)
#define PG8_LDA(dst, b, h) do { _Pragma("unroll") for (int m = 0; m < 4; ++m) _Pragma("unroll") for (int k = 0; k < 2; ++k) dst[m][k] = *(const PG8_LAS bf16x8*)(lds + PG8_SA(b, h) + aoff + m * 2048 + k * 1024); } while (0)
#define PG8_LDB(dst, b, h) do { _Pragma("unroll") for (int n = 0; n < 2; ++n) _Pragma("unroll") for (int k = 0; k < 2; ++k) dst[n][k] = *(const PG8_LAS bf16x8*)(lds + PG8_SB(b, h) + boff + n * 2048 + k * 1024); } while (0)
#define PG8_MMA(ai, bj, At, Bt) do { __builtin_amdgcn_s_setprio(1); _Pragma("unroll") for (int m = 0; m < 4; ++m) _Pragma("unroll") for (int n = 0; n < 2; ++n) _Pragma("unroll") for (int k = 0; k < 2; ++k) \
        acc[ai][bj][m][n] = __builtin_amdgcn_mfma_f32_16x16x32_bf16(Bt[n][k], At[m][k], acc[ai][bj][m][n], 0, 0, 0); __builtin_amdgcn_s_setprio(0); } while (0)
#define PG8_WAIT_V(n) asm volatile("s_waitcnt vmcnt(" #n ")" ::: "memory")
#define PG8_WAIT_L(n) asm volatile("s_waitcnt lgkmcnt(" #n ")" ::: "memory")
#define PG8_BAR __builtin_amdgcn_s_barrier()
#define PG8_SCHED __builtin_amdgcn_sched_barrier(0)
    Unit cur, nxt; int ui = 0;
    if (!S.next(0, cur)) return;
    f32x4 acc[2][2][4][2];
#pragma unroll
    for (int a = 0; a < 2; ++a)
#pragma unroll
        for (int b = 0; b < 2; ++b)
#pragma unroll
            for (int m = 0; m < 4; ++m)
#pragma unroll
                for (int n = 0; n < 2; ++n) acc[a][b][m][n] = (f32x4){0.f, 0.f, 0.f, 0.f};
    bf16x8 At[4][2], B0[2][2], B1[2][2];
    const char* cA = (const char*)g.A + (size_t)cur.pm * tstep; const char* cB = (const char*)g.Bt + (size_t)cur.pn * tstep;
    S.a_ready(cur);
    if constexpr (SP2) {
        PG8_STAGE(PG8_SB(0, 0), cB, voffB); PG8_STAGE(PG8_SB(0, 1), cB + hstep, voffB); PG8_STAGE(PG8_SA(0, 0), cA, voffA); PG8_STAGE(PG8_SA(0, 1), cA + hstep, voffA);
        if (wr == 1) PG8_BAR;
        PG8_WAIT_V(2); PG8_BAR;
        PG8_STAGE(PG8_SB(1, 0), cB + kstep, voffB); PG8_STAGE(PG8_SA(1, 0), cA + kstep, voffA); PG8_STAGE(PG8_SB(1, 1), cB + hstep + kstep, voffB);
        PG8_WAIT_V(6); PG8_BAR;
    } else {
        PG8_STAGE(PG8_SB(0, 0), cB, voffB); PG8_STAGE(PG8_SA(0, 0), cA, voffA); PG8_STAGE(PG8_SB(0, 1), cB + hstep, voffB); PG8_STAGE(PG8_SA(0, 1), cA + hstep, voffA);
        if (wr == 1) PG8_BAR;
        PG8_WAIT_V(4); PG8_BAR;
        PG8_STAGE(PG8_SB(1, 0), cB + kstep, voffB); PG8_STAGE(PG8_SA(1, 0), cA + kstep, voffA); PG8_STAGE(PG8_SB(1, 1), cB + hstep + kstep, voffB);
        PG8_WAIT_V(6); PG8_BAR;
    }
    for (;;) {
        const bool has_next = S.next(ui + 1, nxt);
        const char* nA = has_next ? (const char*)g.A + (size_t)nxt.pm * tstep : cA; const char* nB = has_next ? (const char*)g.Bt + (size_t)nxt.pn * tstep : cB;
        for (int t = 0; t < nt; t += 2) {
            const bool last = (t == nt - 2);
            const char* a1 = cA + (size_t)(t + 1) * kstep;
            const char* a2 = last ? nA : cA + (size_t)(t + 2) * kstep; const char* b2 = last ? nB : cB + (size_t)(t + 2) * kstep;
            const char* a3 = a2 + kstep; const char* b3 = b2 + kstep;
            if (last && has_next) S.a_ready(nxt);
            if constexpr (SP2) {
            PG8_LDB(B0, 0, 0); PG8_LDB(B1, 0, 1); PG8_SCHED; PG8_LDA(At, 0, 0); PG8_STAGE(PG8_SA(1, 1), a1 + hstep, voffA);
            PG8_WAIT_V(8); PG8_WAIT_L(0); PG8_BAR; PG8_MMA(0, 0, At, B0); PG8_MMA(0, 1, At, B1); PG8_BAR; PG8_SCHED;
            PG8_LDA(At, 0, 1); PG8_STAGE(PG8_SB(0, 0), b2, voffB); PG8_STAGE(PG8_SB(0, 1), b2 + hstep, voffB); PG8_STAGE(PG8_SA(0, 0), a2, voffA);
            PG8_WAIT_V(8); PG8_WAIT_L(0); PG8_BAR; PG8_MMA(1, 0, At, B0); PG8_MMA(1, 1, At, B1); PG8_BAR; PG8_SCHED;
            PG8_LDB(B0, 1, 0); PG8_LDB(B1, 1, 1); PG8_SCHED; PG8_LDA(At, 1, 0); PG8_STAGE(PG8_SA(0, 1), a2 + hstep, voffA);
            PG8_WAIT_V(8); PG8_WAIT_L(0); PG8_BAR; PG8_MMA(0, 0, At, B0); PG8_MMA(0, 1, At, B1); PG8_BAR; PG8_SCHED;
            PG8_LDA(At, 1, 1); PG8_STAGE(PG8_SB(1, 0), b3, voffB); PG8_STAGE(PG8_SB(1, 1), b3 + hstep, voffB); PG8_STAGE(PG8_SA(1, 0), a3, voffA);
            PG8_WAIT_V(8); PG8_WAIT_L(0); PG8_BAR; PG8_MMA(1, 0, At, B0); PG8_MMA(1, 1, At, B1); PG8_BAR; PG8_SCHED;
            } else {
            PG8_LDB(B0, 0, 0); PG8_SCHED; PG8_LDA(At, 0, 0); PG8_STAGE(PG8_SA(1, 1), a1 + hstep, voffA);
            PG8_WAIT_L(8); PG8_BAR; PG8_WAIT_L(0); PG8_MMA(0, 0, At, B0); PG8_BAR; PG8_SCHED;
            PG8_LDB(B1, 0, 1); PG8_STAGE(PG8_SB(0, 0), b2, voffB);
            PG8_BAR; PG8_WAIT_L(0); PG8_MMA(0, 1, At, B1); PG8_BAR;
            PG8_LDA(At, 0, 1); PG8_STAGE(PG8_SA(0, 0), a2, voffA);
            PG8_BAR; PG8_WAIT_L(0); PG8_MMA(1, 0, At, B0); PG8_BAR; PG8_SCHED;
            PG8_STAGE(PG8_SB(0, 1), b2 + hstep, voffB);
            PG8_WAIT_V(6); PG8_BAR; PG8_MMA(1, 1, At, B1); PG8_BAR;
            PG8_LDB(B0, 1, 0); PG8_SCHED; PG8_LDA(At, 1, 0); PG8_STAGE(PG8_SA(0, 1), a2 + hstep, voffA);
            PG8_WAIT_L(8); PG8_BAR; PG8_WAIT_L(0); PG8_MMA(0, 0, At, B0); PG8_BAR; PG8_SCHED;
            PG8_LDB(B1, 1, 1); PG8_STAGE(PG8_SB(1, 0), b3, voffB);
            PG8_BAR; PG8_WAIT_L(0); PG8_MMA(0, 1, At, B1); PG8_BAR;
            PG8_LDA(At, 1, 1); PG8_STAGE(PG8_SA(1, 0), a3, voffA);
            PG8_BAR; PG8_WAIT_L(0); PG8_MMA(1, 0, At, B0); PG8_BAR; PG8_SCHED;
            PG8_STAGE(PG8_SB(1, 1), b3 + hstep, voffB);
            PG8_WAIT_V(6); PG8_BAR; PG8_MMA(1, 1, At, B1); PG8_BAR;
            }
        }
        if constexpr (ALIGN_EPI) { if (wr == 0) PG8_BAR; }
        if constexpr (!Epi::AFTER_DRAIN) { E(acc, cur, wr, wc, fr, fq); S.done(cur); }
        if (!has_next) break;
#pragma unroll
        for (int a = 0; a < 2; ++a)
#pragma unroll
            for (int b = 0; b < 2; ++b)
#pragma unroll
                for (int m = 0; m < 4; ++m)
#pragma unroll
                    for (int n = 0; n < 2; ++n) acc[a][b][m][n] = (f32x4){0.f, 0.f, 0.f, 0.f};
        cur = nxt; cA = nA; cB = nB; ++ui;
        if constexpr (ALIGN_EPI) { if (wr == 1) PG8_BAR; }
    }
    PG8_WAIT_V(0);
    if constexpr (!ALIGN_EPI) { if (wr == 0) PG8_BAR; }
    PG8_BAR;
    if constexpr (Epi::AFTER_DRAIN) { E.fused(acc, cur, wr, wc, fr, fq, lds, wid, lane); S.done(cur); }
#undef PG8_SA
#undef PG8_SB
#undef PG8_STAGE
#undef PG8_LDA
#undef PG8_LDB
#undef PG8_MMA
#undef PG8_WAIT_V
#undef PG8_WAIT_L
#undef PG8_BAR
#undef PG8_SCHED
}
}

constexpr int NB = 8, SEQ = 2048, DM = 1024, MT = NB * SEQ, DFF = 4096, IN_DIM = 13344;
constexpr int NTHREADS = 512, NWAVES = 8, LDS_BYTES = 147456;
constexpr float EPS = 1e-6f;
typedef unsigned short bf16;
typedef unsigned v4u __attribute__((ext_vector_type(4)));
typedef unsigned v2u __attribute__((ext_vector_type(2)));
typedef float f32x4 __attribute__((ext_vector_type(4)));
typedef short bf16x8 __attribute__((ext_vector_type(8)));
enum { B_H = 0, B_DNG = 1, B_SBQ = 2, B_SSZ = 3, B_DNQ = 4, B_DNK = 5, B_DNV = 6, B_SBK = 7, B_SBV = 8, B_SSX = 9, B_SSBC = 10, NBUF = 11 };
constexpr size_t BUFE = (size_t)MT * DM;
constexpr size_t WS_W = NBUF * BUFE * 2;
constexpr size_t W_IN = 0, W_G = W_IN + (size_t)10496 * 1024, W_OUT = W_G + (size_t)6144 * 1024, W_UP = W_OUT + (size_t)1024 * 1024,
                 W_DOWN = W_UP + (size_t)4096 * 1024, W_END = W_DOWN + (size_t)4096 * 1024;
constexpr size_t WS_SMALL = WS_W + W_END * 2;
constexpr size_t WS_CTL = WS_SMALL + (size_t)MT * 64 * 4;
constexpr size_t WS_BAR = WS_CTL + 4096;
constexpr size_t CTL_BYTES = 4096 + 16384;
constexpr size_t WS_NEED = WS_CTL + CTL_BYTES;

__device__ __forceinline__ float bf2f(unsigned u) { return __builtin_bit_cast(float, u << 16); }
__device__ __forceinline__ unsigned f2bf(float f) { unsigned u = __builtin_bit_cast(unsigned, f); return (u + 0x7fffu + ((u >> 16) & 1u)) >> 16; }
typedef float f32x2 __attribute__((ext_vector_type(2)));
typedef __bf16 bf16x2_t __attribute__((ext_vector_type(2)));
__device__ __forceinline__ unsigned pk2(float lo, float hi) { f32x2 v = {lo, hi}; return __builtin_bit_cast(unsigned, __builtin_convertvector(v, bf16x2_t)); }
__device__ __forceinline__ void unpack8(v4u r, float* o) {
    o[0] = bf2f(r.x & 0xffffu); o[1] = __builtin_bit_cast(float, r.x & 0xffff0000u); o[2] = bf2f(r.y & 0xffffu); o[3] = __builtin_bit_cast(float, r.y & 0xffff0000u);
    o[4] = bf2f(r.z & 0xffffu); o[5] = __builtin_bit_cast(float, r.z & 0xffff0000u); o[6] = bf2f(r.w & 0xffffu); o[7] = __builtin_bit_cast(float, r.w & 0xffff0000u);
}
__device__ __forceinline__ v4u pack8(const float* v) { v4u w; w.x = pk2(v[0], v[1]); w.y = pk2(v[2], v[3]); w.z = pk2(v[4], v[5]); w.w = pk2(v[6], v[7]); return w; }
__device__ __forceinline__ float sigmoidf_(float x) { return __builtin_amdgcn_rcpf(1.f + __expf(-x)); }
__device__ __forceinline__ float siluf_(float x) { return x * __builtin_amdgcn_rcpf(1.f + __expf(-x)); }
__device__ __forceinline__ float softplusf_(float x) { return fmaxf(x, 0.f) + log1pf(__expf(-fabsf(x))); }
template <int CTRL> __device__ __forceinline__ float dppf(float v) { return __builtin_bit_cast(float, __builtin_amdgcn_update_dpp(0, __builtin_bit_cast(int, v), CTRL, 0xF, 0xF, true)); }
__device__ __forceinline__ float red8(float v) { v += dppf<0xB1>(v); v += dppf<0x4E>(v); v += dppf<0x141>(v); return v; }
__device__ __forceinline__ float red16(float v) { v = red8(v); v += dppf<0x140>(v); return v; }
__device__ __forceinline__ float wave_sum(float v) {
#pragma unroll
    for (int o = 1; o < 64; o <<= 1) v += __shfl_xor(v, o);
    return v;
}
#define LDS_WAIT() asm volatile("s_waitcnt lgkmcnt(0)" ::: "memory")

struct Args { const float* in[19]; float* out; unsigned char* ws; };
typedef const __attribute__((address_space(4))) Args& CArgsR;
__device__ __forceinline__ const __attribute__((address_space(4))) Args* kargs() { unsigned long long v = (unsigned long long)__builtin_amdgcn_kernarg_segment_ptr(); asm volatile("" : "+s"(v)); return (const __attribute__((address_space(4))) Args*)v; }
#ifndef PROBE_SEL
#define PROBE_SEL 0
#endif
__device__ __forceinline__ unsigned long long rt() { return __builtin_amdgcn_s_memrealtime(); }
#define PT0() unsigned long long pt_ = PROBE_SEL ? rt() : 0ull
#define PT1(k) do { if (PROBE_SEL & (1 << (k))) probe_acc += rt() - pt_; } while (0)

struct EpiRoute {
    static constexpr bool PERM = true, AFTER_DRAIN = false;
    bf16* base; float* small; const float* dn_alog; const float* dn_dtb; const float* ss_alog; const float* ss_dtb;
    __device__ __forceinline__ void operator()(const pg8::f32x4 (&acc)[2][2][4][2], const pg8::Unit& u, int wr, int wc, int fr, int fq) const {
        const int row0 = u.pm * 256 + wr * 64 + fr;
        if (u.pn == 40) {
            if (wc != 0) return;
            float p0[8], p1[8];
#pragma unroll
            for (int i = 0; i < 8; ++i) { p0[i] = 0.f; p1[i] = 0.f; }
            if (fq == 0) {
#pragma unroll
                for (int i = 0; i < 8; ++i) { p0[i] = __expf(dn_alog[i]); p1[i] = dn_dtb[i]; }
            } else if (fq >= 2) {
#pragma unroll
                for (int i = 0; i < 8; ++i) { p0[i] = __expf(ss_alog[(fq - 2) * 8 + i]); p1[i] = ss_dtb[(fq - 2) * 8 + i]; }
            }
#pragma unroll
            for (int ai = 0; ai < 2; ++ai)
#pragma unroll
                for (int m = 0; m < 4; ++m) { float* sp = small + (size_t)(row0 + ai * 128 + m * 16) * 64; float v[8];
#pragma unroll
                    for (int i = 0; i < 4; ++i) { v[i] = acc[ai][0][m][0][i]; v[4 + i] = acc[ai][0][m][1][i]; }
                    if (fq == 0) {
#pragma unroll
                        for (int i = 0; i < 8; ++i) sp[i] = -p0[i] * softplusf_(v[i] + p1[i]);
                    } else if (fq == 1) {
#pragma unroll
                        for (int i = 0; i < 8; ++i) sp[8 + i] = sigmoidf_(v[i]);
                    } else {
#pragma unroll
                        for (int i = 0; i < 8; ++i) { const float dt = softplusf_(v[i] + p1[i]); sp[16 + (fq - 2) * 8 + i] = dt; sp[32 + (fq - 2) * 8 + i] = -p0[i] * dt; }
                    } }
            return;
        }
        bf16* O = base + (size_t)(1 + (u.pn >> 2)) * BUFE;
        const int col0 = (u.pn & 3) * 256 + wc * 32 + 8 * fq;
#pragma unroll
        for (int ai = 0; ai < 2; ++ai)
#pragma unroll
            for (int m = 0; m < 4; ++m) { bf16* rowp = O + (size_t)(row0 + ai * 128 + m * 16) * DM + col0;
#pragma unroll
                for (int bj = 0; bj < 2; ++bj) { const pg8::f32x4 v0 = acc[ai][bj][m][0], v1 = acc[ai][bj][m][1];
                    v4u w; w.x = pk2(v0[0], v0[1]); w.y = pk2(v0[2], v0[3]); w.z = pk2(v1[0], v1[1]); w.w = pk2(v1[2], v1[3]);
                    *(v4u*)(rowp + bj * 128) = w; } }
    }
};
struct EpiRelu2 {
    static constexpr bool PERM = true, AFTER_DRAIN = false;
    bf16* O;
    __device__ __forceinline__ void operator()(const pg8::f32x4 (&acc)[2][2][4][2], const pg8::Unit& u, int wr, int wc, int fr, int fq) const {
        const int col0 = u.pn * 256 + wc * 32 + 8 * fq, row0 = u.pm * 256 + wr * 64 + fr;
#pragma unroll
        for (int ai = 0; ai < 2; ++ai)
#pragma unroll
            for (int m = 0; m < 4; ++m) { bf16* rowp = O + (size_t)(row0 + ai * 128 + m * 16) * DFF + col0;
#pragma unroll
                for (int bj = 0; bj < 2; ++bj) { float v[8];
#pragma unroll
                    for (int i = 0; i < 4; ++i) { float a = fmaxf(acc[ai][bj][m][0][i], 0.f), b = fmaxf(acc[ai][bj][m][1][i], 0.f); v[i] = a * a; v[4 + i] = b * b; }
                    *(v4u*)(rowp + bj * 128) = pack8(v); } }
    }
};
struct EpiResid {
    static constexpr bool PERM = true, AFTER_DRAIN = false;
    const float* xin; float* xout;
    __device__ __forceinline__ void operator()(const pg8::f32x4 (&acc)[2][2][4][2], const pg8::Unit& u, int wr, int wc, int fr, int fq) const {
        const int col0 = u.pn * 256 + wc * 32 + 8 * fq, row0 = u.pm * 256 + wr * 64 + fr;
#pragma unroll
        for (int ai = 0; ai < 2; ++ai)
#pragma unroll
            for (int m = 0; m < 4; ++m) { const size_t ro = (size_t)(row0 + ai * 128 + m * 16) * DM + col0;
#pragma unroll
                for (int bj = 0; bj < 2; ++bj) { const size_t o = ro + bj * 128;
                    const f32x4 a = *(const f32x4*)(xin + o), b = *(const f32x4*)(xin + o + 4);
                    f32x4 r0, r1;
#pragma unroll
                    for (int i = 0; i < 4; ++i) { r0[i] = a[i] + acc[ai][bj][m][0][i]; r1[i] = b[i] + acc[ai][bj][m][1][i]; }
                    *(f32x4*)(xout + o) = r0; *(f32x4*)(xout + o + 4) = r1; } }
    }
};
struct SchedGate {
    int G, c;
    __device__ __forceinline__ bool next(int i, pg8::Unit& u) const {
        const int tile = c + (i / 6) * G; if (tile >= 256) return false;
        const int s = i % 6, br = s >> 1, pm = tile >> 2, pn = tile & 3;
        if ((s & 1) == 0) { u.pm = pm; u.pn = br * 4 + pn; } else { u.pm = (1 + br) * 64 + pm; u.pn = (3 + br) * 4 + pn; }
        return true;
    }
    __device__ __forceinline__ void a_ready(const pg8::Unit&) const {}
    __device__ __forceinline__ void done(const pg8::Unit&) const {}
};
struct EpiGate {
    static constexpr bool PERM = true, AFTER_DRAIN = false;
    bf16* gsc; float* macc; bf16* merged;
    __device__ __forceinline__ void operator()(const pg8::f32x4 (&acc)[2][2][4][2], const pg8::Unit& u, int wr, int wc, int fr, int fq) const {
        const int j = u.pn >> 2, pn = u.pn & 3, pm = u.pm & 63;
        const int col0 = pn * 256 + wc * 32 + 8 * fq, row0 = pm * 256 + wr * 64 + fr;
#pragma unroll
        for (int ai = 0; ai < 2; ++ai)
#pragma unroll
            for (int m = 0; m < 4; ++m) { const size_t ro = (size_t)(row0 + ai * 128 + m * 16) * DM + col0;
#pragma unroll
                for (int bj = 0; bj < 2; ++bj) { const size_t o = ro + bj * 128; float v[8];
#pragma unroll
                    for (int i = 0; i < 4; ++i) { v[i] = acc[ai][bj][m][0][i]; v[4 + i] = acc[ai][bj][m][1][i]; }
                    if (j < 3) {
#pragma unroll
                        for (int i = 0; i < 8; ++i) v[i] = sigmoidf_(v[i]);
                        *(v4u*)(gsc + o) = pack8(v);
                    } else {
                        float g[8]; unpack8(*(const v4u*)(gsc + o), g);
#pragma unroll
                        for (int i = 0; i < 8; ++i) v[i] *= g[i];
                        if (j > 3) { const f32x4 a = *(const f32x4*)(macc + o), b = *(const f32x4*)(macc + o + 4);
#pragma unroll
                            for (int i = 0; i < 4; ++i) { v[i] += a[i]; v[4 + i] += b[i]; } }
                        if (j < 5) { *(f32x4*)(macc + o) = (f32x4){v[0], v[1], v[2], v[3]}; *(f32x4*)(macc + o + 4) = (f32x4){v[4], v[5], v[6], v[7]}; }
                        else *(v4u*)(merged + o) = pack8(v);
                    } } }
    }
};

__device__ __forceinline__ void transpose_item(const float* __restrict__ W, const float* __restrict__ W2, int ldw, bf16* __restrict__ WT, int K, int nblk, float* scr, int item, int lane) {
    const int kb = item / nblk, nb = item % nblk, k0 = 64 * kb, n0 = 32 * nb;
    const float* src = ((lane & 31) < 16 ? W : W2) + (size_t)(k0 + (lane >> 5)) * ldw + n0 + (lane & 31);
    float t[32];
#pragma unroll
    for (int i = 0; i < 32; ++i) t[i] = src[(size_t)(2 * i) * ldw];
#pragma unroll
    for (int i = 0; i < 32; ++i) scr[(2 * i + (lane >> 5)) * 33 + (lane & 31)] = t[i];
    LDS_WAIT();
    const int c = lane & 7;
#pragma unroll
    for (int j = 0; j < 4; ++j) { const int n = (lane >> 3) + 8 * j; const float* s = scr + (8 * c) * 33 + n;
        v4u o; o.x = pk2(s[0 * 33], s[1 * 33]); o.y = pk2(s[2 * 33], s[3 * 33]); o.z = pk2(s[4 * 33], s[5 * 33]); o.w = pk2(s[6 * 33], s[7 * 33]);
        *(v4u*)(WT + (size_t)(n0 + n) * K + k0 + 8 * c) = o; }
    LDS_WAIT();
}
__device__ __forceinline__ void rms_row_to_bf16(const float* xrow, const float* w, bf16* orow, int lane) {
    const f32x4* xr = (const f32x4*)xrow + lane; const f32x4* wr = (const f32x4*)w + lane;
    f32x4 v[4]; float s = 0.f;
#pragma unroll
    for (int j = 0; j < 4; ++j) { v[j] = xr[64 * j]; s += (v[j][0] * v[j][0] + v[j][1] * v[j][1]) + (v[j][2] * v[j][2] + v[j][3] * v[j][3]); }
    const float rstd = rsqrtf(wave_sum(s) * (1.f / DM) + EPS);
    unsigned long long* o8 = (unsigned long long*)orow + lane;
#pragma unroll
    for (int j = 0; j < 4; ++j) { const f32x4 ww = wr[64 * j];
        o8[64 * j] = (unsigned long long)pk2(v[j][0] * rstd * ww[0], v[j][1] * rstd * ww[1]) | ((unsigned long long)pk2(v[j][2] * rstd * ww[2], v[j][3] * rstd * ww[3]) << 32); }
}
__device__ __forceinline__ void phase0(unsigned char* lds, CArgsR a, int l, const float* xin) {
    const int tid = opaque_tid(), lane = tid & 63, wave = tid >> 6, gw = blockIdx.x * NWAVES + wave, NGW = gridDim.x * NWAVES;
    bf16* Wreg = (bf16*)(a.ws + WS_W);
    const float* w_in = a.in[2] + (size_t)l * DM * IN_DIM;
    {
        float* scr = (float*)lds + wave * (64 * 33);
        const float* w_br = a.in[13] + (size_t)l * 3 * DM * DM; const float* w_out = a.in[14] + (size_t)l * DM * DM;
        const float* w_up = a.in[16] + (size_t)l * DM * DFF; const float* w_down = a.in[17] + (size_t)l * DFF * DM;
        constexpr int NSEG = 17, NIT = NSEG * 512 + 2048 + 2048 + 16;
        for (int it = gw; it < NIT; it += NGW) {
            if (it < NSEG * 512) {
                const int seg = it >> 9, r = it & 511;
                const float* W; int ldw; bf16* WT;
                if (seg < 13) {
                    const int co = seg == 0 ? 3072 : seg == 1 ? 4112 : seg == 2 ? 7184 : seg == 3 ? 0 : seg == 4 ? 1024 : seg == 5 ? 2048 : seg == 6 ? 5136 : seg == 7 ? 6160 : seg == 8 ? 8208 : seg == 9 ? 9232
                                 : 10272 + (seg - 10) * 1024;
                    W = w_in + co; ldw = IN_DIM; WT = seg < 10 ? Wreg + (size_t)seg * DM * DM : Wreg + W_G + (size_t)(seg - 10) * DM * DM;
                } else if (seg < 16) { W = w_br + (size_t)(seg - 13) * DM * DM; ldw = DM; WT = Wreg + W_G + (size_t)(3 + seg - 13) * DM * DM; }
                else { W = w_out; ldw = DM; WT = Wreg + W_OUT; }
                transpose_item(W, W, ldw, WT, DM, 32, scr, r, lane);
            } else if (it < NSEG * 512 + 2048) transpose_item(w_up, w_up, DFF, Wreg + W_UP, DM, 128, scr, it - NSEG * 512, lane);
            else if (it < NSEG * 512 + 4096) transpose_item(w_down, w_down, DM, Wreg + W_DOWN, DFF, 32, scr, it - NSEG * 512 - 2048, lane);
            else transpose_item(w_in + 4096, w_in + 10256 - 16, IN_DIM, Wreg + (size_t)10240 * DM, DM, 1, scr, it - NSEG * 512 - 4096, lane);
        }
        v4u* zp = (v4u*)(Wreg + (size_t)10272 * DM);
        for (int i = blockIdx.x * NTHREADS + tid; i < 224 * DM / 8; i += gridDim.x * NTHREADS) zp[i] = (v4u){0u, 0u, 0u, 0u};
    }
    {   const float* nw = a.in[1] + (size_t)l * DM; bf16* H = (bf16*)a.ws;
        for (int m = gw; m < MT; m += NGW) rms_row_to_bf16(xin + (size_t)m * DM, nw, H + (size_t)m * DM, lane); }
}

__device__ __forceinline__ void conv8(const bf16* p, int pos, const float* w, int wstride, const float* bias, float* out) {
    float acc[8];
#pragma unroll
    for (int i = 0; i < 8; ++i) acc[i] = bias ? bias[i] : 0.f;
#pragma unroll
    for (int j = 0; j < 4; ++j) { const int back = 3 - j;
        if (pos - back >= 0) { float xv[8]; unpack8(*(const v4u*)(p - (size_t)back * DM), xv);
            const f32x4 w0 = *(const f32x4*)(w + j * wstride), w1 = *(const f32x4*)(w + j * wstride + 4);
#pragma unroll
            for (int i = 0; i < 4; ++i) { acc[i] += xv[i] * w0[i]; acc[4 + i] += xv[4 + i] * w1[i]; } } }
#pragma unroll
    for (int i = 0; i < 8; ++i) out[i] = siluf_(acc[i]);
}

__device__ __forceinline__ void conv8r(const v4u (&raw)[4], const float* w, int wstride, const float* bias, float* out) {
    float acc[8];
#pragma unroll
    for (int i = 0; i < 8; ++i) acc[i] = bias ? bias[i] : 0.f;
#pragma unroll
    for (int j = 0; j < 4; ++j) { float xv[8]; unpack8(raw[j], xv);
        const f32x4 w0 = *(const f32x4*)(w + j * wstride), w1 = *(const f32x4*)(w + j * wstride + 4);
#pragma unroll
        for (int i = 0; i < 4; ++i) { acc[i] += xv[i] * w0[i]; acc[4 + i] += xv[4 + i] * w1[i]; } }
#pragma unroll
    for (int i = 0; i < 8; ++i) out[i] = siluf_(acc[i]);
}
#define LOAD4(dst, p, pos) do { _Pragma("unroll") for (int j_ = 0; j_ < 4; ++j_) { const int back_ = 3 - j_; const bool ok_ = (pos) - back_ >= 0; \
        const v4u t_ = *(const v4u*)((p) - (size_t)(ok_ ? back_ : 0) * DM); dst[j_] = ok_ ? t_ : (v4u){0u, 0u, 0u, 0u}; } } while (0)

template <int K> __device__ __forceinline__ void mma16(f32x4& acc, const bf16* Ap, int lda, const bf16* Bp, int ldb, int fr, int fq) {
    bf16x8 af[K / 32], bfv[K / 32];
#pragma unroll
    for (int k = 0; k < K / 32; ++k) { af[k] = *(const bf16x8*)(Ap + fr * lda + k * 32 + fq * 8); bfv[k] = *(const bf16x8*)(Bp + fr * ldb + k * 32 + fq * 8); }
#pragma unroll
    for (int k = 0; k < K / 32; ++k) acc = __builtin_amdgcn_mfma_f32_16x16x32_bf16(af[k], bfv[k], acc, 0, 0, 0);
}
__device__ __forceinline__ void dn_item(unsigned char* lds, CArgsR a, int l, int item, unsigned long long& probe_acc) {
    constexpr int LDK = 136, LDJ = 40, LDL = 36;
    const int b = item >> 3, h = item & 7;
    bf16* kA = (bf16*)lds;
    bf16* qA = kA + 32 * LDK;
    bf16* qgA = qA + 32 * LDK;
    bf16* wA = qgA + 32 * LDK;
    bf16* kdT = wA + 32 * LDK;
    bf16* vnT = kdT + 128 * LDJ;
    bf16* attn = vnT + 128 * LDJ;
    bf16* ST = attn + 32 * LDJ;
    float* kf = (float*)(ST + 128 * LDK);
    float* vf = kf + 32 * 128;
    float* os = kf;
    float* Lm = vf + 32 * 128;
    float* gcs = Lm + 32 * LDL;
    float* betas = gcs + 32;
    float* cwL = betas + 32;
    const int tid = opaque_tid(), w = __builtin_amdgcn_readfirstlane(tid >> 6), lane = tid & 63, fr = lane & 15, fq = lane >> 4;
    bf16* base = (bf16*)a.ws;
    const bf16* Q = base + (size_t)B_DNQ * BUFE; const bf16* K = base + (size_t)B_DNK * BUFE; const bf16* V = base + (size_t)B_DNV * BUFE; bf16* G = base + (size_t)B_DNG * BUFE;
    const float* small = (const float*)(a.ws + WS_SMALL);
    const float* cw = a.in[3] + (size_t)l * 4 * 3072;
    const size_t rowbase = (size_t)b * SEQ;
    const int tq = tid >> 4, cq = tid & 15;
    const float* nwp = a.in[6] + l * 128 + cq * 8;
    f32x4 Sacc[8];
#pragma unroll
    for (int i = 0; i < 8; ++i) Sacc[i] = (f32x4){0.f, 0.f, 0.f, 0.f};
    for (int i = tid; i < 128 * LDK / 2; i += NTHREADS) ((unsigned*)ST)[i] = 0u;
    for (int i = tid; i < 4 * 384; i += NTHREADS) { const int j = i / 384, r = i % 384; cwL[i] = cw[j * 3072 + (r >> 7) * 1024 + h * 128 + (r & 127)]; }
    __syncthreads();
    v4u rq[4], rk[4], rv[4], rgate; float rg = 0.f, rbv = 0.f;
#define DN_LOADS(c_) do { const int t0_ = (c_) * 32, pos_ = t0_ + tq; const size_t off_ = (rowbase + pos_) * DM + h * 128 + cq * 8; \
        LOAD4(rq, Q + off_, pos_); LOAD4(rk, K + off_, pos_); LOAD4(rv, V + off_, pos_); rgate = *(const v4u*)(G + off_); \
        { const size_t r_ = rowbase + t0_ + (lane & 31); rg = small[r_ * 64 + h]; rbv = small[r_ * 64 + 8 + h]; } } while (0)
    DN_LOADS(0);
    for (int c = 0; c < SEQ / 32; ++c) {
        const int t0 = c * 32;
        unsigned long long tp_ = PROBE_SEL ? rt() : 0ull;
#define DPT(k) do { if (PROBE_SEL) { const unsigned long long tn_ = rt(); if ((PROBE_SEL & (1 << (k))) && item == 0) probe_acc += tn_ - tp_; tp_ = tn_; } } while (0)
        float gcv = rg;
#pragma unroll
        for (int off = 1; off < 32; off <<= 1) { const float t = __shfl_up(gcv, off, 32); if ((lane & 31) >= off) gcv += t; }
        const float gc_last = __shfl(gcv, 31), gc_t = __shfl(gcv, tq), beta_t = __shfl(rbv, tq);
        const v4u gcur = rgate;
        {   float q8[8], k8[8], v8[8];
            conv8r(rq, cwL + cq * 8, 384, nullptr, q8);
            __builtin_amdgcn_sched_barrier(0);
            conv8r(rk, cwL + 128 + cq * 8, 384, nullptr, k8);
            __builtin_amdgcn_sched_barrier(0);
            conv8r(rv, cwL + 256 + cq * 8, 384, nullptr, v8);
            __builtin_amdgcn_sched_barrier(0);
            float sq = 0.f, sk = 0.f;
#pragma unroll
            for (int i = 0; i < 8; ++i) { sq += q8[i] * q8[i]; sk += k8[i] * k8[i]; }
            sq = red16(sq); sk = red16(sk);
            const float rqn = rsqrtf(sq + EPS) * 0.08838834764831845f, rkn = rsqrtf(sk + EPS);
            const float eg = __expf(gc_t), kb = beta_t * eg, kd = __expf(gc_last - gc_t);
            float t8[8];
#pragma unroll
            for (int i = 0; i < 8; ++i) { q8[i] *= rqn; k8[i] *= rkn; }
            *(v4u*)(kA + tq * LDK + cq * 8) = pack8(k8); *(v4u*)(qA + tq * LDK + cq * 8) = pack8(q8);
#pragma unroll
            for (int i = 0; i < 8; ++i) t8[i] = q8[i] * eg;
            *(v4u*)(qgA + tq * LDK + cq * 8) = pack8(t8);
            *(f32x4*)(kf + tq * 128 + cq * 8) = (f32x4){k8[0] * kb, k8[1] * kb, k8[2] * kb, k8[3] * kb}; *(f32x4*)(kf + tq * 128 + cq * 8 + 4) = (f32x4){k8[4] * kb, k8[5] * kb, k8[6] * kb, k8[7] * kb};
            *(f32x4*)(vf + tq * 128 + cq * 8) = (f32x4){v8[0] * beta_t, v8[1] * beta_t, v8[2] * beta_t, v8[3] * beta_t}; *(f32x4*)(vf + tq * 128 + cq * 8 + 4) = (f32x4){v8[4] * beta_t, v8[5] * beta_t, v8[6] * beta_t, v8[7] * beta_t};
#pragma unroll
            for (int i = 0; i < 8; ++i) kdT[(cq * 8 + i) * LDJ + tq] = (bf16)f2bf(k8[i] * kd);
        }
        if (tid < 32) { gcs[tid] = gcv; betas[tid] = rbv; }
        __syncthreads();
        DPT(12);
        if (c + 1 < SEQ / 32) DN_LOADS(c + 1);
        {   const int ww = w & 3, gi = ww >> 1, gj = ww & 1; f32x4 acc = {0.f, 0.f, 0.f, 0.f};
            const int jI = 16 * gj + fr, i0 = 16 * gi + 4 * fq;
            const float gj_ = gcs[jI]; const f32x4 gi4 = *(const f32x4*)(gcs + i0), bi4 = *(const f32x4*)(betas + i0);
            mma16<128>(acc, (w < 4 ? kA : qA) + gi * 16 * LDK, LDK, kA + gj * 16 * LDK, LDK, fr, fq);
            if (w < 4) {
#pragma unroll
                for (int jj = 0; jj < 4; ++jj) Lm[(i0 + jj) * LDL + jI] = jI < i0 + jj ? bi4[jj] * acc[jj] * __expf(gi4[jj] - gj_) : 0.f;
            } else {
#pragma unroll
                for (int jj = 0; jj < 4; ++jj) attn[(i0 + jj) * LDJ + jI] = (bf16)f2bf(jI <= i0 + jj ? acc[jj] * __expf(gi4[jj] - gj_) : 0.f);
            } }
        __syncthreads();
        DPT(13);
        if (w < 4) { const int cc = tid & 127; const bool is_w = w >= 2; const float* R = is_w ? kf : vf;
            float x[32];
#pragma unroll
            for (int i = 0; i < 32; ++i) x[i] = R[i * 128 + cc];
            f32x4 Lb[2][8];
            Lb[1][0] = *(const f32x4*)(Lm + 1 * LDL);
#pragma unroll
            for (int i = 1; i < 32; ++i) {
                if (i + 1 < 32) {
#pragma unroll
                    for (int j4 = 0; j4 < (i + 4) / 4; ++j4) Lb[(i + 1) & 1][j4] = *(const f32x4*)(Lm + (i + 1) * LDL + j4 * 4); }
                float a0 = x[i], a1 = 0.f, a2 = 0.f, a3 = 0.f;
#pragma unroll
                for (int j4 = 0; j4 < (i + 3) / 4; ++j4) { const f32x4 l4 = Lb[i & 1][j4];
                    if (j4 * 4 + 0 < i) a0 -= l4[0] * x[j4 * 4 + 0];
                    if (j4 * 4 + 1 < i) a1 -= l4[1] * x[j4 * 4 + 1];
                    if (j4 * 4 + 2 < i) a2 -= l4[2] * x[j4 * 4 + 2];
                    if (j4 * 4 + 3 < i) a3 -= l4[3] * x[j4 * 4 + 3]; }
                x[i] = (a0 + a1) + (a2 + a3); }
            if (is_w) {
#pragma unroll
                for (int i = 0; i < 32; ++i) wA[i * LDK + cc] = (bf16)f2bf(x[i]);
            } else {
#pragma unroll
                for (int i = 0; i < 32; ++i) vf[i * 128 + cc] = x[i];
            } }
        __syncthreads();
        DPT(14);
#pragma unroll
        for (int it = 0; it < 2; ++it) { f32x4 acc = {0.f, 0.f, 0.f, 0.f};
            mma16<128>(acc, wA + it * 16 * LDK, LDK, ST + w * 16 * LDK, LDK, fr, fq);
            float vn[4];
#pragma unroll
            for (int jj = 0; jj < 4; ++jj) vn[jj] = vf[(16 * it + 4 * fq + jj) * 128 + 16 * w + fr] - acc[jj];
            v2u pk; pk.x = pk2(vn[0], vn[1]); pk.y = pk2(vn[2], vn[3]);
            *(v2u*)(vnT + (16 * w + fr) * LDJ + 16 * it + 4 * fq) = pk; }
        __syncthreads();
#pragma unroll
        for (int it = 0; it < 2; ++it) { f32x4 acc = {0.f, 0.f, 0.f, 0.f};
            mma16<128>(acc, qgA + it * 16 * LDK, LDK, ST + w * 16 * LDK, LDK, fr, fq);
            mma16<32>(acc, attn + it * 16 * LDJ, LDJ, vnT + w * 16 * LDJ, LDJ, fr, fq);
#pragma unroll
            for (int jj = 0; jj < 4; ++jj) os[(16 * it + 4 * fq + jj) * 128 + 16 * w + fr] = acc[jj]; }
        {   const float dl = __expf(gc_last);
#pragma unroll
            for (int dt = 0; dt < 8; ++dt) { Sacc[dt] = Sacc[dt] * dl; mma16<32>(Sacc[dt], kdT + dt * 16 * LDJ, LDJ, vnT + w * 16 * LDJ, LDJ, fr, fq); } }
        __syncthreads();
#pragma unroll
        for (int dt = 0; dt < 8; ++dt) { v2u pk; pk.x = pk2(Sacc[dt][0], Sacc[dt][1]); pk.y = pk2(Sacc[dt][2], Sacc[dt][3]);
            *(v2u*)(ST + (16 * w + fr) * LDK + 16 * dt + 4 * fq) = pk; }
        {   const f32x4 o0 = *(const f32x4*)(os + tq * 128 + cq * 8), o1 = *(const f32x4*)(os + tq * 128 + cq * 8 + 4);
            float ss = (o0[0] * o0[0] + o0[1] * o0[1]) + (o0[2] * o0[2] + o0[3] * o0[3]) + (o1[0] * o1[0] + o1[1] * o1[1]) + (o1[2] * o1[2] + o1[3] * o1[3]);
            ss = red16(ss);
            const float r = rsqrtf(ss * (1.f / 128.f) + EPS);
            float g8[8], o8[8], nw8[8]; unpack8(gcur, g8);
            { const f32x4 n0 = *(const f32x4*)nwp, n1 = *(const f32x4*)(nwp + 4); nw8[0] = n0[0]; nw8[1] = n0[1]; nw8[2] = n0[2]; nw8[3] = n0[3]; nw8[4] = n1[0]; nw8[5] = n1[1]; nw8[6] = n1[2]; nw8[7] = n1[3]; }
#pragma unroll
            for (int i = 0; i < 4; ++i) { o8[i] = o0[i] * r * nw8[i] * siluf_(g8[i]); o8[4 + i] = o1[i] * r * nw8[4 + i] * siluf_(g8[4 + i]); }
            *(v4u*)(G + (rowbase + t0 + tq) * DM + h * 128 + cq * 8) = pack8(o8); }
        __syncthreads();
        DPT(15);
    }
#undef DPT
#undef DN_LOADS
    __syncthreads();
}

__device__ __forceinline__ void ssm_item(unsigned char* lds, CArgsR a, int l, int item) {
    constexpr int LDC = 136, LDX = 40;
    const int b = item >> 4, hd = item & 15, g = hd >> 2;
    bf16* Cs = (bf16*)lds;
    bf16* Bs = Cs + 32 * LDC;
    bf16* BT = Bs + 32 * LDC;
    bf16* xdtT = BT + 128 * LDX;
    bf16* xddT = xdtT + 64 * LDX;
    bf16* Wm = xddT + 64 * LDX;
    bf16* hB = Wm + 32 * LDX;
    float* xs = (float*)(hB + 64 * LDC);
    float* acs = xs + 32 * 64;
    const int tid = opaque_tid(), w = __builtin_amdgcn_readfirstlane(tid >> 6), lane = tid & 63, fr = lane & 15, fq = lane >> 4;
    bf16* base = (bf16*)a.ws;
    const bf16* X = base + (size_t)B_SSX * BUFE; const bf16* BC = base + (size_t)B_SSBC * BUFE; bf16* Z = base + (size_t)B_SSZ * BUFE;
    const float* small = (const float*)(a.ws + WS_SMALL);
    const float* cw = a.in[7] + (size_t)l * 4 * 2048; const float* cb = a.in[8] + (size_t)l * 2048;
    const float dskip = a.in[11][l * 16 + hd];
    const size_t rowbase = (size_t)b * SEQ;
    const int tq = tid >> 4, cq = tid & 15, tv = (tid >> 3) & 31, cv = tid & 7;
    const int it = w >> 2, pt = w & 3;
    f32x4 hacc[4];
#pragma unroll
    for (int i = 0; i < 4; ++i) hacc[i] = (f32x4){0.f, 0.f, 0.f, 0.f};
    for (int i = tid; i < 64 * LDC / 2; i += NTHREADS) ((unsigned*)hB)[i] = 0u;
    v4u rB[4], rC[4], rx[4]; float ra = 0.f, rdtv = 0.f; unsigned rz[4];
#define SSM_LOADS(c_) do { const int t0_ = (c_) * 32; { const int pos_ = t0_ + tq; const size_t ro_ = (rowbase + pos_) * DM; LOAD4(rB, BC + ro_ + g * 128 + cq * 8, pos_); LOAD4(rC, BC + ro_ + 512 + g * 128 + cq * 8, pos_); } \
        if (tid < 256) { const int pos_ = t0_ + tv; LOAD4(rx, X + (rowbase + pos_) * DM + hd * 64 + cv * 8, pos_); } \
        { const size_t r_ = rowbase + t0_ + (lane & 31); rdtv = small[r_ * 64 + 16 + hd]; ra = small[r_ * 64 + 32 + hd]; } \
        _Pragma("unroll") for (int jj_ = 0; jj_ < 4; ++jj_) rz[jj_] = Z[(rowbase + t0_ + 16 * it + 4 * fq + jj_) * DM + hd * 64 + 16 * pt + fr]; } while (0)
    SSM_LOADS(0);
    for (int c = 0; c < SEQ / 32; ++c) {
        const int t0 = c * 32;
        float acum = ra;
#pragma unroll
        for (int off = 1; off < 32; off <<= 1) { const float t = __shfl_up(acum, off, 32); if ((lane & 31) >= off) acum += t; }
        const float ac_last = __shfl(acum, 31);
        {   float o8[8];
            conv8r(rB, cw + 1024 + g * 128 + cq * 8, 2048, cb + 1024 + g * 128 + cq * 8, o8);
            *(v4u*)(Bs + tq * LDC + cq * 8) = pack8(o8);
#pragma unroll
            for (int i = 0; i < 8; ++i) BT[(cq * 8 + i) * LDX + tq] = (bf16)f2bf(o8[i]);
            conv8r(rC, cw + 1536 + g * 128 + cq * 8, 2048, cb + 1536 + g * 128 + cq * 8, o8);
            *(v4u*)(Cs + tq * LDC + cq * 8) = pack8(o8);
        }
        if (w < 4) { float o8[8]; conv8r(rx, cw + hd * 64 + cv * 8, 2048, cb + hd * 64 + cv * 8, o8);
            const float dtv = __shfl(rdtv, tv), dd = dtv * __expf(ac_last - __shfl(acum, tv));
            *(f32x4*)(xs + tv * 64 + cv * 8) = (f32x4){o8[0], o8[1], o8[2], o8[3]}; *(f32x4*)(xs + tv * 64 + cv * 8 + 4) = (f32x4){o8[4], o8[5], o8[6], o8[7]};
#pragma unroll
            for (int i = 0; i < 8; ++i) { xdtT[(cv * 8 + i) * LDX + tv] = (bf16)f2bf(o8[i] * dtv); xddT[(cv * 8 + i) * LDX + tv] = (bf16)f2bf(o8[i] * dd); }
        }
        if (tid < 32) acs[tid] = acum;
        unsigned zr[4];
#pragma unroll
        for (int jj = 0; jj < 4; ++jj) zr[jj] = rz[jj];
        __syncthreads();
        if (c + 1 < SEQ / 32) SSM_LOADS(c + 1);
        if (w < 4) { const int gi = w >> 1, gj = w & 1; f32x4 acc = {0.f, 0.f, 0.f, 0.f};
            mma16<128>(acc, Cs + gi * 16 * LDC, LDC, Bs + gj * 16 * LDC, LDC, fr, fq);
            const int sI = 16 * gj + fr; const float as = acs[sI];
#pragma unroll
            for (int jj = 0; jj < 4; ++jj) { const int lI = 16 * gi + 4 * fq + jj; const float v = sI <= lI ? acc[jj] * __expf(acs[lI] - as) : 0.f; Wm[lI * LDX + sI] = (bf16)f2bf(v); } }
        __syncthreads();
        {   f32x4 a1 = {0.f, 0.f, 0.f, 0.f}, a2 = {0.f, 0.f, 0.f, 0.f};
            mma16<32>(a1, Wm + it * 16 * LDX, LDX, xdtT + pt * 16 * LDX, LDX, fr, fq);
            mma16<128>(a2, Cs + it * 16 * LDC, LDC, hB + pt * 16 * LDC, LDC, fr, fq);
            const int p = 16 * pt + fr;
#pragma unroll
            for (int jj = 0; jj < 4; ++jj) { const int lI = 16 * it + 4 * fq + jj;
                const float y = a1[jj] + __expf(acs[lI]) * a2[jj] + xs[lI * 64 + p] * dskip;
                Z[(rowbase + t0 + lI) * DM + hd * 64 + p] = (bf16)f2bf(y * siluf_(bf2f(zr[jj]))); }
            const float dl = __expf(ac_last);
#pragma unroll
            for (int p2 = 0; p2 < 4; ++p2) { hacc[p2] = hacc[p2] * dl; mma16<32>(hacc[p2], xddT + p2 * 16 * LDX, LDX, BT + w * 16 * LDX, LDX, fr, fq); }
        }
        __syncthreads();
#pragma unroll
        for (int p2 = 0; p2 < 4; ++p2)
#pragma unroll
            for (int jj = 0; jj < 4; ++jj) hB[(16 * p2 + 4 * fq + jj) * LDC + 16 * w + fr] = (bf16)f2bf(hacc[p2][jj]);
    }
#undef SSM_LOADS
    __syncthreads();
}

__device__ __forceinline__ void sb_item(unsigned char* lds, CArgsR a, int b, int hd, int qi) {
    constexpr int LD = 72;
    bf16* Ks = (bf16*)lds; bf16* Vs = Ks + 2 * 64 * LD;
    volatile unsigned* alive = (volatile unsigned*)(Vs + 2 * 64 * LD);
    const int tid = opaque_tid(), w = __builtin_amdgcn_readfirstlane(tid >> 6), lane = tid & 63, fr = lane & 15, fq = lane >> 4;
    bf16* base = (bf16*)a.ws;
    bf16* Qb = base + (size_t)B_SBQ * BUFE; const bf16* Kb = base + (size_t)B_SBK * BUFE; const bf16* Vb = base + (size_t)B_SBV * BUFE;
    const size_t rowbase = (size_t)b * SEQ;
    const int t0 = qi * 128, myq = t0 + w * 16 + fr, wmax = t0 + w * 16 + 15;
    bf16* qrow = Qb + (rowbase + myq) * DM + hd * 64;
    bf16x8 qf[2];
    qf[0] = *(const bf16x8*)(qrow + fq * 8); qf[1] = *(const bf16x8*)(qrow + 32 + fq * 8);
    f32x4 oacc[4];
#pragma unroll
    for (int i = 0; i < 4; ++i) oacc[i] = (f32x4){0.f, 0.f, 0.f, 0.f};
    float carry = 1.f;
    const int kr = tid >> 3, d8 = (tid & 7) * 8;
    v4u kreg, vreg;
    int kt = 2 * (qi + 1) - 1;
#define SB_LOAD(t) do { const size_t o_ = (rowbase + (size_t)(t) * 64 + kr) * DM + hd * 64 + d8; kreg = *(const v4u*)(Kb + o_); vreg = *(const v4u*)(Vb + o_); } while (0)
#define SB_STORE(bu) do { *(v4u*)(Ks + (bu) * 64 * LD + kr * LD + d8) = kreg; bf16* vd_ = Vs + (bu) * 64 * LD + d8 * LD + kr; \
        vd_[0] = (bf16)(vreg.x & 0xffffu); vd_[LD] = (bf16)(vreg.x >> 16); vd_[2 * LD] = (bf16)(vreg.y & 0xffffu); vd_[3 * LD] = (bf16)(vreg.y >> 16); \
        vd_[4 * LD] = (bf16)(vreg.z & 0xffffu); vd_[5 * LD] = (bf16)(vreg.z >> 16); vd_[6 * LD] = (bf16)(vreg.w & 0xffffu); vd_[7 * LD] = (bf16)(vreg.w >> 16); } while (0)
    SB_LOAD(kt); SB_STORE(0);
    __syncthreads();
    int cur = 0;
    for (; kt >= 0; --kt) {
        if (kt > 0) SB_LOAD(kt - 1);
        const int kbase = kt * 64;
        if (kbase <= wmax) {
            const bf16* Kc = Ks + cur * 64 * LD; const bf16* Vc = Vs + cur * 64 * LD;
            f32x4 z[4];
#pragma unroll
            for (int nt = 0; nt < 4; ++nt) { z[nt] = (f32x4){0.f, 0.f, 0.f, 0.f};
#pragma unroll
                for (int k2 = 0; k2 < 2; ++k2) { const bf16x8 af = *(const bf16x8*)(Kc + (nt * 16 + fr) * LD + k2 * 32 + fq * 8);
                    z[nt] = __builtin_amdgcn_mfma_f32_16x16x32_bf16(af, qf[k2], z[nt], 0, 0, 0); } }
            float kp[4][4], sg[4][4], T[4], tot[4], suf[4];
            const bool masked = kbase + 64 > t0 + w * 16;
#pragma unroll
            for (int nt = 0; nt < 4; ++nt) {
#pragma unroll
                for (int j = 0; j < 4; ++j) { const float z2 = z[nt][j] * 0.18033688011112042f;
                    const float ea = __builtin_amdgcn_exp2f(-fabsf(z2)), rc = __builtin_amdgcn_rcpf(1.f + ea); const bool pos = z2 >= 0.f;
                    sg[nt][j] = (pos ? 1.f : ea) * rc; kp[nt][j] = (pos ? ea : 1.f) * rc; }
                if (masked) {
#pragma unroll
                    for (int j = 0; j < 4; ++j) { const bool valid = kbase + nt * 16 + fq * 4 + j < myq; sg[nt][j] = valid ? sg[nt][j] : 0.f; kp[nt][j] = valid ? kp[nt][j] : 1.f; } }
                T[nt] = (kp[nt][0] * kp[nt][1]) * (kp[nt][2] * kp[nt][3]); }
#pragma unroll
            for (int nt = 0; nt < 4; ++nt) { const float p16 = __shfl_xor(T[nt], 16), s1 = T[nt] * p16, p32 = __shfl_xor(s1, 32); tot[nt] = s1 * p32;
                suf[nt] = fq == 0 ? p16 * p32 : fq == 1 ? p32 : fq == 2 ? p16 : 1.f; }
            float run = carry; float wv[4][4];
#pragma unroll
            for (int nt = 3; nt >= 0; --nt) { const float r3 = run * suf[nt], r2 = r3 * kp[nt][3], r1 = r2 * kp[nt][2], r0 = r1 * kp[nt][1];
                wv[nt][0] = sg[nt][0] * r0; wv[nt][1] = sg[nt][1] * r1; wv[nt][2] = sg[nt][2] * r2; wv[nt][3] = sg[nt][3] * r3;
                run *= tot[nt]; }
            carry = run;
#pragma unroll
            for (int kk = 0; kk < 2; ++kk) {
                v4u bw; bw.x = pk2(wv[2 * kk][0], wv[2 * kk][1]); bw.y = pk2(wv[2 * kk][2], wv[2 * kk][3]); bw.z = pk2(wv[2 * kk + 1][0], wv[2 * kk + 1][1]); bw.w = pk2(wv[2 * kk + 1][2], wv[2 * kk + 1][3]);
                const bf16x8 bfr = __builtin_bit_cast(bf16x8, bw);
#pragma unroll
                for (int mt = 0; mt < 4; ++mt) { const bf16* vp = Vc + (mt * 16 + fr) * LD + 32 * kk + 4 * fq;
                    const v2u lo = *(const v2u*)vp, hi = *(const v2u*)(vp + 16);
                    v4u av; av.x = lo.x; av.y = lo.y; av.z = hi.x; av.w = hi.y;
                    oacc[mt] = __builtin_amdgcn_mfma_f32_16x16x32_bf16(__builtin_bit_cast(bf16x8, av), bfr, oacc[mt], 0, 0, 0); }
            }
        }
        {   const bool any_alive = __ballot(carry != 0.f) != 0ull;
            if (lane == 0) alive[cur * 8 + w] = any_alive ? 1u : 0u; }
        if (kt > 0) SB_STORE(cur ^ 1);
        __syncthreads();
        unsigned al = 0u;
#pragma unroll
        for (int i = 0; i < 8; ++i) al |= alive[cur * 8 + i];
        if (al == 0u) break;
        cur ^= 1;
    }
#undef SB_LOAD
#undef SB_STORE
#pragma unroll
    for (int mt = 0; mt < 4; ++mt) { v2u wq; wq.x = pk2(oacc[mt][0], oacc[mt][1]); wq.y = pk2(oacc[mt][2], oacc[mt][3]); *(v2u*)(qrow + mt * 16 + fq * 4) = wq; }
}

__device__ __forceinline__ void phase_mixers(unsigned char* lds, CArgsR a, int l, unsigned long long& probe_acc) {
    unsigned* counter = (unsigned*)(a.ws + WS_CTL) + 64 * l;
    volatile unsigned* slot = (volatile unsigned*)(lds + LDS_BYTES - 64);
    constexpr unsigned NITEMS = 64 + 128 + 2048;
    for (;;) {
        if (threadIdx.x == 0) *slot = __hip_atomic_fetch_add(counter, 1u, __ATOMIC_RELAXED, __HIP_MEMORY_SCOPE_AGENT);
        __syncthreads();
        const unsigned item = *slot;
        __syncthreads();
        if (item >= NITEMS) break;
        PT0();
        if (item < 64) { dn_item(lds, a, l, (int)item, probe_acc); if (item == 0) PT1(9); }
        else if (item < 192) { ssm_item(lds, a, l, (int)item - 64); if (item == 64) PT1(10); }
        else { const int r = (int)item - 192, qi = 15 - (r >> 7), bh = r & 127; sb_item(lds, a, bh >> 4, bh & 15, qi); if (item == 192) PT1(11); }
    }
}

__device__ __forceinline__ void phase_norms(CArgsR a, int l) {
    const int tid = opaque_tid(), lane = tid & 63, wave = tid >> 6, gw = blockIdx.x * NWAVES + wave, NGW = gridDim.x * NWAVES;
    bf16* base = (bf16*)a.ws;
    const bf16* Oraw = base + (size_t)B_DNV * BUFE; bf16* G = base + (size_t)B_DNG * BUFE; bf16* Y = base + (size_t)B_SSZ * BUFE;
    const float* dnw = a.in[6] + (size_t)l * 128 + (lane & 7) * 16; const float* snw = a.in[12] + (size_t)l * DM + lane * 16;
    float w1[16], w2[16];
#pragma unroll
    for (int i = 0; i < 16; ++i) { w1[i] = dnw[i]; w2[i] = snw[i]; }
    for (int m = gw; m < MT; m += NGW) {
        const size_t o = (size_t)m * DM + lane * 16;
        float v[16], s, r;
        unpack8(*(const v4u*)(Y + o), v); unpack8(*(const v4u*)(Y + o + 8), v + 8);
        s = 0.f;
#pragma unroll
        for (int i = 0; i < 16; ++i) s += v[i] * v[i];
        s = red16(s);
        r = rsqrtf(s * (1.f / 256.f) + EPS);
#pragma unroll
        for (int i = 0; i < 16; ++i) v[i] = v[i] * r * w2[i];
        *(v4u*)(Y + o) = pack8(v); *(v4u*)(Y + o + 8) = pack8(v + 8);
    }
}

#define LAS __attribute__((address_space(3)))
#define XB_TMO      128
#define XB_XCNT(j)  (256  + 64 * (j))
#define XB_XSUB(j)  (1280 + 64 * (j))
#define XB_XGEN(j)  (2304 + 64 * (j))
#define XB_TOP      3328
#define XB_TOPGEN   3392
#define XCD_BAR_WORDS 3456
#define XB_SPIN_CAP (1u << 18)

__device__ __forceinline__ unsigned xb_ld(unsigned* p)              { return __hip_atomic_load(p, __ATOMIC_RELAXED, __HIP_MEMORY_SCOPE_AGENT); }
__device__ __forceinline__ unsigned xb_add(unsigned* p, unsigned v) { return __hip_atomic_fetch_add(p, v, __ATOMIC_RELAXED, __HIP_MEMORY_SCOPE_AGENT); }
__device__ __forceinline__ unsigned xb_xcc_id() { return (unsigned)__builtin_amdgcn_s_getreg((3 << 11) | 20) & 0xFu; }
#define XB_SPIN(cond, bar) do { unsigned _sp = 0; while (cond) { __builtin_amdgcn_s_sleep(1); \
    if ((++_sp & 255u) == 0u) { if (xb_ld(&(bar)[XB_TMO])) break; if (_sp > XB_SPIN_CAP) { atomicAdd(&(bar)[XB_TMO], 1u); break; } } } } while (0)

struct XcdBarrier {
    unsigned* bar; unsigned x;
    volatile LAS unsigned* st;
};

__device__ __forceinline__ XcdBarrier xcd_barrier_post(unsigned* bar, volatile LAS unsigned* st) {
    XcdBarrier b; b.bar = bar; b.x = xb_xcc_id(); b.st = st;
    if (threadIdx.x == 0) (void)xb_add(&bar[XB_XCNT(b.x)], 1u);
    return b;
}
__device__ __forceinline__ void xcd_barrier_complete(unsigned* bar, unsigned x, unsigned& nloc, unsigned& nx) {
    const unsigned G = gridDim.x * gridDim.y * gridDim.z;
    unsigned sum, cnt, mine, sp = 0u;
    for (;;) {
        sum = 0u; cnt = 0u; mine = 0u;
#pragma unroll
        for (unsigned j = 0; j < 16; ++j) { const unsigned c = xb_ld(&bar[XB_XCNT(j)]); sum += c; cnt += (c > 0u) ? 1u : 0u; mine = (j == x) ? c : mine; }
        if (sum == G) break;
        __builtin_amdgcn_s_sleep(1);
        if ((++sp & 255u) == 0u) { if (xb_ld(&bar[XB_TMO])) break; if (sp > XB_SPIN_CAP) { atomicAdd(&bar[XB_TMO], 1u); break; } }
    }
    nloc = mine > 0u ? mine : 1u; nx = cnt > 0u ? cnt : 1u;
}

__device__ __forceinline__ void xcd_barrier(const XcdBarrier& b) {
    asm volatile("s_waitcnt vmcnt(0)" ::: "memory");
    __syncthreads();
    if (threadIdx.x == 0) {
        unsigned* bar = b.bar;
        __builtin_amdgcn_s_waitcnt(0);
        unsigned nloc = b.st[0], nx = b.st[1];
        if (nloc == 0u) { xcd_barrier_complete(bar, b.x, nloc, nx); b.st[0] = nloc; b.st[1] = nx; }
        const unsigned old = xb_add(&bar[XB_XSUB(b.x)], 1u);
        const unsigned gen = old / nloc;
        if (old + 1u == (gen + 1u) * nloc) {
            __builtin_amdgcn_fence(__ATOMIC_RELEASE, "agent");
            asm volatile("s_waitcnt vmcnt(0)" ::: "memory");
            const unsigned og = xb_add(&bar[XB_TOP], 1u);
            const unsigned tg = og / nx;
            if (og + 1u == (tg + 1u) * nx) xb_add(&bar[XB_TOPGEN], 1u);
            else XB_SPIN(xb_ld(&bar[XB_TOPGEN]) == tg, bar);
            __builtin_amdgcn_fence(__ATOMIC_ACQUIRE, "agent");
            xb_add(&bar[XB_XGEN(b.x)], 1u);
            asm volatile("s_waitcnt vmcnt(0)" ::: "memory");
        } else {
            XB_SPIN(xb_ld(&bar[XB_XGEN(b.x)]) == gen, bar);
            __builtin_amdgcn_fence(__ATOMIC_ACQUIRE, "agent");
            asm volatile("s_waitcnt vmcnt(0)" ::: "memory");
        }
    }
    __syncthreads();
}

__global__ void __launch_bounds__(NTHREADS, 2) hybrid_fwd(Args a_unused) {
    extern __shared__ __attribute__((aligned(16))) unsigned char lds[];
    cg::grid_group grid = cg::this_grid();
    PG8_LAS unsigned char* ldsl = (PG8_LAS unsigned char*)lds;
    unsigned long long probe_acc = 0ull;
#define A_ (*kargs())
    volatile LAS unsigned* bst = (volatile LAS unsigned*)((LAS unsigned char*)lds + LDS_BYTES - 32);
    if (threadIdx.x == 0) { bst[0] = 0u; bst[1] = 0u; }
    __syncthreads();
    const XcdBarrier bar = xcd_barrier_post((unsigned*)(a_unused.ws + WS_BAR), bst);
#pragma unroll 1
    for (int l = 0; l < 2; ++l) {
        asm volatile("" : "+s"(l));
        {   CArgsR a = A_; const float* xin = l == 0 ? a.in[0] : a.out;
            PT0(); phase0(lds, a, l, xin);
        if (l == 0) grid.sync(); else xcd_barrier(bar); PT1(0); }
        {   CArgsR a = A_; bf16* base = (bf16*)a.ws; bf16* Wreg = (bf16*)(a.ws + WS_W);
            pg8::Gemm g{base, Wreg + W_IN, MT, 10496, DM}; pg8::StaticOrder S; S.init(MT, 10496, (int)gridDim.x, (int)blockIdx.x);
            EpiRoute E{base, (float*)(a.ws + WS_SMALL), a.in[4] + l * 8, a.in[5] + l * 8, a.in[9] + l * 16, a.in[10] + l * 16};
            PT0(); pg8::gemm_phase<EpiRoute, pg8::StaticOrder, false, true>(ldsl, g, S, E);
        xcd_barrier(bar); PT1(1); }
        { PT0(); phase_mixers(lds, A_, l, probe_acc);
        xcd_barrier(bar); PT1(2); }
        { PT0(); phase_norms(A_, l);
        xcd_barrier(bar); PT1(3); }
        {   CArgsR a = A_; bf16* base = (bf16*)a.ws; bf16* Wreg = (bf16*)(a.ws + WS_W);
            pg8::Gemm g{base, Wreg + W_G, 4 * MT, 6144, DM}; SchedGate S{(int)gridDim.x, (int)blockIdx.x};
            EpiGate E{base + (size_t)B_SBK * BUFE, (float*)(base + (size_t)B_DNK * BUFE), base + (size_t)B_DNQ * BUFE};
            PT0(); pg8::gemm_phase<EpiGate, SchedGate, false, true>(ldsl, g, S, E);
        xcd_barrier(bar); PT1(4); }
        {   CArgsR a = A_; bf16* base = (bf16*)a.ws; bf16* Wreg = (bf16*)(a.ws + WS_W); const float* xin = l == 0 ? a.in[0] : a.out;
            pg8::Gemm g{base + (size_t)B_DNQ * BUFE, Wreg + W_OUT, MT, DM, DM}; pg8::StaticOrder S; S.init(MT, DM, (int)gridDim.x, (int)blockIdx.x);
            EpiResid E{xin, a.out};
            PT0(); pg8::gemm_phase<EpiResid, pg8::StaticOrder, false, true>(ldsl, g, S, E);
        xcd_barrier(bar); PT1(5); }
        {   CArgsR a = A_; bf16* base = (bf16*)a.ws; const float* nw = a.in[15] + (size_t)l * DM; const float* xo = a.out;
            const int tid = opaque_tid(), lane = tid & 63, gw = blockIdx.x * NWAVES + (tid >> 6), NGW = gridDim.x * NWAVES;
            PT0(); for (int m = gw; m < MT; m += NGW) rms_row_to_bf16(xo + (size_t)m * DM, nw, base + (size_t)m * DM, lane);
        xcd_barrier(bar); PT1(6); }
        {   CArgsR a = A_; bf16* base = (bf16*)a.ws; bf16* Wreg = (bf16*)(a.ws + WS_W);
            pg8::Gemm g{base, Wreg + W_UP, MT, DFF, DM}; pg8::StaticOrder S; S.init(MT, DFF, (int)gridDim.x, (int)blockIdx.x);
            EpiRelu2 E{base + (size_t)B_DNQ * BUFE};
            PT0(); pg8::gemm_phase<EpiRelu2, pg8::StaticOrder, false, true>(ldsl, g, S, E);
        xcd_barrier(bar); PT1(7); }
        {   CArgsR a = A_; bf16* base = (bf16*)a.ws; bf16* Wreg = (bf16*)(a.ws + WS_W);
            pg8::Gemm g{base + (size_t)B_DNQ * BUFE, Wreg + W_DOWN, MT, DM, DFF}; pg8::StaticOrder S; S.init(MT, DM, (int)gridDim.x, (int)blockIdx.x);
            EpiResid E{a.out, a.out};
            PT0(); pg8::gemm_phase<EpiResid, pg8::StaticOrder, false, true>(ldsl, g, S, E);
        xcd_barrier(bar); PT1(8); }
    }
    {
        CArgsR a = A_; const float* nw = a.in[18]; float* xo = a.out;
        const int tid = opaque_tid(), lane = tid & 63, gw = blockIdx.x * NWAVES + (tid >> 6), NGW = gridDim.x * NWAVES;
        for (int m = gw; m < MT; m += NGW) {
            f32x4* xr = (f32x4*)(xo + (size_t)m * DM) + lane; const f32x4* wr = (const f32x4*)nw + lane;
            f32x4 v[4]; float s = 0.f;
#pragma unroll
            for (int j = 0; j < 4; ++j) { v[j] = xr[64 * j]; s += (v[j][0] * v[j][0] + v[j][1] * v[j][1]) + (v[j][2] * v[j][2] + v[j][3] * v[j][3]); }
            const float rstd = rsqrtf(wave_sum(s) * (1.f / DM) + EPS);
#pragma unroll
            for (int j = 0; j < 4; ++j) { const f32x4 ww = wr[64 * j]; f32x4 r;
#pragma unroll
                for (int i = 0; i < 4; ++i) r[i] = v[j][i] * rstd * ww[i];
                xr[64 * j] = r; }
        }
    }
#undef A_
    if (PROBE_SEL) { const unsigned long long t0 = rt(); while (rt() - t0 < probe_acc) __builtin_amdgcn_s_sleep(8); }
}

extern "C" void kernel_launch(void* const* d_in, const int* in_sizes, int n_in, void* d_out, int out_size, void* d_ws, size_t ws_size, hipStream_t stream) {
    static int grid = 0;
    if (grid == 0) {
        if (n_in != 19 || out_size != MT * DM || ws_size < WS_NEED) { fprintf(stderr, "kernel_launch: unexpected shapes (n_in %d out %d ws %zu need %zu)\n", n_in, out_size, ws_size, (size_t)WS_NEED); grid = -1; return; }
        int dev = 0, cus = 0, per_cu = 0;
        hipGetDevice(&dev); hipDeviceGetAttribute(&cus, hipDeviceAttributeMultiprocessorCount, dev);
        if (hipFuncSetAttribute((const void*)hybrid_fwd, hipFuncAttributeMaxDynamicSharedMemorySize, LDS_BYTES) != hipSuccess) { fprintf(stderr, "kernel_launch: hipFuncSetAttribute failed\n"); grid = -1; return; }
        if (hipOccupancyMaxActiveBlocksPerMultiprocessor(&per_cu, (const void*)hybrid_fwd, NTHREADS, LDS_BYTES) != hipSuccess || per_cu < 1) { fprintf(stderr, "kernel_launch: occupancy query gave %d\n", per_cu); per_cu = 1; }
        (void)hipGetLastError();
        grid = cus * per_cu;
    }
    if (grid < 0) return;
    if (hipMemsetAsync((char*)d_ws + WS_CTL, 0, CTL_BYTES, stream) != hipSuccess) { fprintf(stderr, "kernel_launch: memset of the control words failed\n"); return; }
    Args a{};
    for (int i = 0; i < 19; ++i) a.in[i] = (const float*)d_in[i];
    a.out = (float*)d_out; a.ws = (unsigned char*)d_ws;
    void* args[] = {&a};
    hipError_t e = hipLaunchCooperativeKernel((const void*)hybrid_fwd, dim3(grid), dim3(NTHREADS), args, LDS_BYTES, stream);
    if (e != hipSuccess) fprintf(stderr, "cooperative launch failed: %s (grid %d)\n", hipGetErrorString(e), grid);
}
```

```cpp
#include <hip/hip_runtime.h>
#include <hip/hip_cooperative_groups.h>
#include <cstdio>
#include <cstdint>
namespace cg = cooperative_groups;
__device__ __forceinline__ int opaque_tid() { int t = (int)threadIdx.x; asm volatile("" : "+v"(t)); return t; }
namespace pg8 {
#define PG8_LAS __attribute__((address_space(3)))
typedef unsigned short bf16_t;
typedef short bf16x8 __attribute__((ext_vector_type(8)));
typedef float f32x4 __attribute__((ext_vector_type(4)));
typedef unsigned u32x4 __attribute__((ext_vector_type(4)));
constexpr int BM = 256, BK = 64, HALF = 128, HTB = HALF * BK * 2  , STAGE_BYTES = 8 * HTB, NXCD = 8, WGM = 8;

__host__ __device__ __forceinline__ int lds_byte(int r, int c) { const int st = (r >> 4) * 2 + (c >> 5), rr = r & 15, cc = c & 31, ob = rr * 64 + cc * 2; return st * 1024 + (ob ^ (((ob >> 9) & 1) << 5)); }
__host__ __device__ __forceinline__ void stage_rc(int b, int& R, int& C) { const int st = b / 1024, sb = b % 1024, swz = sb ^ (((sb >> 9) & 1) << 5); R = (st >> 1) * 16 + swz / 64; C = (st & 1) * 32 + (swz % 64) / 2; }
__host__ __device__ __forceinline__ int perm32(int rho) { const int n = rho >> 4, i = rho & 15; return 8 * (i >> 2) + 4 * n + (i & 3); }

struct Unit { int pm, pn; };
struct Gemm { const bf16_t* A; const bf16_t* Bt; int M, N, K; };

struct StaticOrder {
    int nM, nN, nwg, G, c;
    __host__ __device__ void init(int M, int N, int G_, int c_) { nM = M / BM; nN = N / BM; nwg = nM * nN; G = G_; c = c_; }
    __host__ __device__ bool next(int i, Unit& u) const {
        const long L = (long)i * G + c; if (L >= nwg) return false;
        int wgid = (int)L; { const int q = nwg / NXCD, r = nwg % NXCD, xcd = wgid % NXCD, off = wgid / NXCD; wgid = (xcd < r ? xcd * (q + 1) : r * (q + 1) + (xcd - r) * q) + off; }
        const int nig = WGM * nN, gid = wgid / nig, fm = gid * WGM, gsz = (nM - fm) < WGM ? (nM - fm) : WGM;
        u.pm = fm + ((wgid % nig) % gsz); u.pn = (wgid % nig) / gsz; return true;
    }
    __device__ __forceinline__ void a_ready(const Unit&) const {}
    __device__ __forceinline__ void done(const Unit&) const {}
};
__device__ __forceinline__ unsigned cvt_pk_bf16(float lo, float hi) { unsigned r; asm volatile("v_cvt_pk_bf16_f32 %0, %1, %2" : "=v"(r) : "v"(lo), "v"(hi)); return r; }
template <class Epi, class Sched, bool ALIGN_EPI = false, bool SP2 = false>
__device__ __forceinline__ void gemm_phase(PG8_LAS unsigned char* lds, const Gemm g, const Sched& S, const Epi& E) {
    const int tid = opaque_tid(), wid = __builtin_amdgcn_readfirstlane(tid >> 6), lane = tid & 63, wr = wid >> 2, wc = wid & 3, fr = lane & 15, fq = lane >> 4;
    const int K = g.K, nt = K / BK;
    unsigned voffA[2], voffB[2];
#pragma unroll
    for (int i = 0; i < 2; ++i) { int R, C; stage_rc(tid * 16 + i * 8192, R, C); const int Rb = Epi::PERM ? ((R & ~31) + perm32(R & 31)) : R;
        voffA[i] = (unsigned)(R * K + C) * 2u; voffB[i] = (unsigned)(Rb * K + C) * 2u; }
    const size_t kstep = (size_t)(BK * 2);
    const size_t hstep = (size_t)HALF * K * 2;
    const size_t tstep = 2 * hstep;
    const unsigned ldsw = (unsigned)wid * 1024u;
    const int aoff = lds_byte(wr * 64 + fr, fq * 8), boff = lds_byte(wc * 32 + fr, fq * 8);
#define PG8_SA(b, h) (((b) * 2 + (h)) * HTB)
#define PG8_SB(b, h) ((4 + (b) * 2 + (h)) * HTB)
#define PG8_STAGE(bufoff, gbase, voff) do { _Pragma("unroll") for (int _i = 0; _i < 2; ++_i) \
        __builtin_amdgcn_global_load_lds((const unsigned*)((const char*)(gbase) + (voff)[_i]), (PG8_LAS unsigned*)(lds + (bufoff) + ldsw + _i * 8192), 16, 0, 0); } while (0)
#define PG8_LDA(dst, b, h) do { _Pragma("unroll") for (int m = 0; m < 4; ++m) _Pragma("unroll") for (int k = 0; k < 2; ++k) dst[m][k] = *(const PG8_LAS bf16x8*)(lds + PG8_SA(b, h) + aoff + m * 2048 + k * 1024); } while (0)
#define PG8_LDB(dst, b, h) do { _Pragma("unroll") for (int n = 0; n < 2; ++n) _Pragma("unroll") for (int k = 0; k < 2; ++k) dst[n][k] = *(const PG8_LAS bf16x8*)(lds + PG8_SB(b, h) + boff + n * 2048 + k * 1024); } while (0)
#define PG8_MMA(ai, bj, At, Bt) do { __builtin_amdgcn_s_setprio(1); _Pragma("unroll") for (int m = 0; m < 4; ++m) _Pragma("unroll") for (int n = 0; n < 2; ++n) _Pragma("unroll") for (int k = 0; k < 2; ++k) \
        acc[ai][bj][m][n] = __builtin_amdgcn_mfma_f32_16x16x32_bf16(Bt[n][k], At[m][k], acc[ai][bj][m][n], 0, 0, 0); __builtin_amdgcn_s_setprio(0); } while (0)
#define PG8_WAIT_V(n) asm volatile("s_waitcnt vmcnt(" #n ")" ::: "memory")
#define PG8_WAIT_L(n) asm volatile("s_waitcnt lgkmcnt(" #n ")" ::: "memory")
#define PG8_BAR __builtin_amdgcn_s_barrier()
#define PG8_SCHED __builtin_amdgcn_sched_barrier(0)
    Unit cur, nxt; int ui = 0;
    if (!S.next(0, cur)) return;
    f32x4 acc[2][2][4][2];
#pragma unroll
    for (int a = 0; a < 2; ++a)
#pragma unroll
        for (int b = 0; b < 2; ++b)
#pragma unroll
            for (int m = 0; m < 4; ++m)
#pragma unroll
                for (int n = 0; n < 2; ++n) acc[a][b][m][n] = (f32x4){0.f, 0.f, 0.f, 0.f};
    bf16x8 At[4][2], B0[2][2], B1[2][2];
    const char* cA = (const char*)g.A + (size_t)cur.pm * tstep; const char* cB = (const char*)g.Bt + (size_t)cur.pn * tstep;
    S.a_ready(cur);
    if constexpr (SP2) {
        PG8_STAGE(PG8_SB(0, 0), cB, voffB); PG8_STAGE(PG8_SB(0, 1), cB + hstep, voffB); PG8_STAGE(PG8_SA(0, 0), cA, voffA); PG8_STAGE(PG8_SA(0, 1), cA + hstep, voffA);
        if (wr == 1) PG8_BAR;
        PG8_WAIT_V(2); PG8_BAR;
        PG8_STAGE(PG8_SB(1, 0), cB + kstep, voffB); PG8_STAGE(PG8_SA(1, 0), cA + kstep, voffA); PG8_STAGE(PG8_SB(1, 1), cB + hstep + kstep, voffB);
        PG8_WAIT_V(6); PG8_BAR;
    } else {
        PG8_STAGE(PG8_SB(0, 0), cB, voffB); PG8_STAGE(PG8_SA(0, 0), cA, voffA); PG8_STAGE(PG8_SB(0, 1), cB + hstep, voffB); PG8_STAGE(PG8_SA(0, 1), cA + hstep, voffA);
        if (wr == 1) PG8_BAR;
        PG8_WAIT_V(4); PG8_BAR;
        PG8_STAGE(PG8_SB(1, 0), cB + kstep, voffB); PG8_STAGE(PG8_SA(1, 0), cA + kstep, voffA); PG8_STAGE(PG8_SB(1, 1), cB + hstep + kstep, voffB);
        PG8_WAIT_V(6); PG8_BAR;
    }
    for (;;) {
        const bool has_next = S.next(ui + 1, nxt);
        const char* nA = has_next ? (const char*)g.A + (size_t)nxt.pm * tstep : cA; const char* nB = has_next ? (const char*)g.Bt + (size_t)nxt.pn * tstep : cB;
        for (int t = 0; t < nt; t += 2) {
            const bool last = (t == nt - 2);
            const char* a1 = cA + (size_t)(t + 1) * kstep;
            const char* a2 = last ? nA : cA + (size_t)(t + 2) * kstep; const char* b2 = last ? nB : cB + (size_t)(t + 2) * kstep;
            const char* a3 = a2 + kstep; const char* b3 = b2 + kstep;
            if (last && has_next) S.a_ready(nxt);
            if constexpr (SP2) {
            PG8_LDB(B0, 0, 0); PG8_LDB(B1, 0, 1); PG8_SCHED; PG8_LDA(At, 0, 0); PG8_STAGE(PG8_SA(1, 1), a1 + hstep, voffA);
            PG8_WAIT_V(8); PG8_WAIT_L(0); PG8_BAR; PG8_MMA(0, 0, At, B0); PG8_MMA(0, 1, At, B1); PG8_BAR; PG8_SCHED;
            PG8_LDA(At, 0, 1); PG8_STAGE(PG8_SB(0, 0), b2, voffB); PG8_STAGE(PG8_SB(0, 1), b2 + hstep, voffB); PG8_STAGE(PG8_SA(0, 0), a2, voffA);
            PG8_WAIT_V(8); PG8_WAIT_L(0); PG8_BAR; PG8_MMA(1, 0, At, B0); PG8_MMA(1, 1, At, B1); PG8_BAR; PG8_SCHED;
            PG8_LDB(B0, 1, 0); PG8_LDB(B1, 1, 1); PG8_SCHED; PG8_LDA(At, 1, 0); PG8_STAGE(PG8_SA(0, 1), a2 + hstep, voffA);
            PG8_WAIT_V(8); PG8_WAIT_L(0); PG8_BAR; PG8_MMA(0, 0, At, B0); PG8_MMA(0, 1, At, B1); PG8_BAR; PG8_SCHED;
            PG8_LDA(At, 1, 1); PG8_STAGE(PG8_SB(1, 0), b3, voffB); PG8_STAGE(PG8_SB(1, 1), b3 + hstep, voffB); PG8_STAGE(PG8_SA(1, 0), a3, voffA);
            PG8_WAIT_V(8); PG8_WAIT_L(0); PG8_BAR; PG8_MMA(1, 0, At, B0); PG8_MMA(1, 1, At, B1); PG8_BAR; PG8_SCHED;
            } else {
            PG8_LDB(B0, 0, 0); PG8_SCHED; PG8_LDA(At, 0, 0); PG8_STAGE(PG8_SA(1, 1), a1 + hstep, voffA);
            PG8_WAIT_L(8); PG8_BAR; PG8_WAIT_L(0); PG8_MMA(0, 0, At, B0); PG8_BAR; PG8_SCHED;
            PG8_LDB(B1, 0, 1); PG8_STAGE(PG8_SB(0, 0), b2, voffB);
            PG8_BAR; PG8_WAIT_L(0); PG8_MMA(0, 1, At, B1); PG8_BAR;
            PG8_LDA(At, 0, 1); PG8_STAGE(PG8_SA(0, 0), a2, voffA);
            PG8_BAR; PG8_WAIT_L(0); PG8_MMA(1, 0, At, B0); PG8_BAR; PG8_SCHED;
            PG8_STAGE(PG8_SB(0, 1), b2 + hstep, voffB);
            PG8_WAIT_V(6); PG8_BAR; PG8_MMA(1, 1, At, B1); PG8_BAR;
            PG8_LDB(B0, 1, 0); PG8_SCHED; PG8_LDA(At, 1, 0); PG8_STAGE(PG8_SA(0, 1), a2 + hstep, voffA);
            PG8_WAIT_L(8); PG8_BAR; PG8_WAIT_L(0); PG8_MMA(0, 0, At, B0); PG8_BAR; PG8_SCHED;
            PG8_LDB(B1, 1, 1); PG8_STAGE(PG8_SB(1, 0), b3, voffB);
            PG8_BAR; PG8_WAIT_L(0); PG8_MMA(0, 1, At, B1); PG8_BAR;
            PG8_LDA(At, 1, 1); PG8_STAGE(PG8_SA(1, 0), a3, voffA);
            PG8_BAR; PG8_WAIT_L(0); PG8_MMA(1, 0, At, B0); PG8_BAR; PG8_SCHED;
            PG8_STAGE(PG8_SB(1, 1), b3 + hstep, voffB);
            PG8_WAIT_V(6); PG8_BAR; PG8_MMA(1, 1, At, B1); PG8_BAR;
            }
        }
        if constexpr (ALIGN_EPI) { if (wr == 0) PG8_BAR; }
        if constexpr (!Epi::AFTER_DRAIN) { E(acc, cur, wr, wc, fr, fq); S.done(cur); }
        if (!has_next) break;
#pragma unroll
        for (int a = 0; a < 2; ++a)
#pragma unroll
            for (int b = 0; b < 2; ++b)
#pragma unroll
                for (int m = 0; m < 4; ++m)
#pragma unroll
                    for (int n = 0; n < 2; ++n) acc[a][b][m][n] = (f32x4){0.f, 0.f, 0.f, 0.f};
        cur = nxt; cA = nA; cB = nB; ++ui;
        if constexpr (ALIGN_EPI) { if (wr == 1) PG8_BAR; }
    }
    PG8_WAIT_V(0);
    if constexpr (!ALIGN_EPI) { if (wr == 0) PG8_BAR; }
    PG8_BAR;
    if constexpr (Epi::AFTER_DRAIN) { E.fused(acc, cur, wr, wc, fr, fq, lds, wid, lane); S.done(cur); }
#undef PG8_SA
#undef PG8_SB
#undef PG8_STAGE
#undef PG8_LDA
#undef PG8_LDB
#undef PG8_MMA
#undef PG8_WAIT_V
#undef PG8_WAIT_L
#undef PG8_BAR
#undef PG8_SCHED
}
}

constexpr int NB = 8, SEQ = 2048, DM = 1024, MT = NB * SEQ, DFF = 4096, IN_DIM = 13344;
constexpr int NTHREADS = 512, NWAVES = 8, LDS_BYTES = 147456;
constexpr float EPS = 1e-6f;
typedef unsigned short bf16;
typedef unsigned v4u __attribute__((ext_vector_type(4)));
typedef unsigned v2u __attribute__((ext_vector_type(2)));
typedef float f32x4 __attribute__((ext_vector_type(4)));
typedef short bf16x8 __attribute__((ext_vector_type(8)));
enum { B_H = 0, B_DNG = 1, B_SBQ = 2, B_SSZ = 3, B_DNQ = 4, B_DNK = 5, B_DNV = 6, B_SBK = 7, B_SBV = 8, B_SSX = 9, B_SSBC = 10, NBUF = 11 };
constexpr size_t BUFE = (size_t)MT * DM;
constexpr size_t WS_W = NBUF * BUFE * 2;
constexpr size_t W_IN = 0, W_G = W_IN + (size_t)10240 * 1024, W_OUT = W_G + (size_t)6144 * 1024, W_UP = W_OUT + (size_t)1024 * 1024,
                 W_DOWN = W_UP + (size_t)4096 * 1024, W_END = W_DOWN + (size_t)4096 * 1024;
constexpr size_t WS_SMALL = WS_W + W_END * 2;
constexpr size_t WS_CTL = WS_SMALL + (size_t)MT * 64 * 4;
constexpr size_t WS_BAR = WS_CTL + 4096;
constexpr size_t CTL_BYTES = 4096 + 16384;
constexpr size_t WS_NEED = WS_CTL + CTL_BYTES;

__device__ __forceinline__ float bf2f(unsigned u) { return __builtin_bit_cast(float, u << 16); }
__device__ __forceinline__ unsigned f2bf(float f) { unsigned u = __builtin_bit_cast(unsigned, f); return (u + 0x7fffu + ((u >> 16) & 1u)) >> 16; }
typedef float f32x2 __attribute__((ext_vector_type(2)));
typedef __bf16 bf16x2_t __attribute__((ext_vector_type(2)));
__device__ __forceinline__ unsigned pk2(float lo, float hi) { f32x2 v = {lo, hi}; return __builtin_bit_cast(unsigned, __builtin_convertvector(v, bf16x2_t)); }
__device__ __forceinline__ void unpack8(v4u r, float* o) {
    o[0] = bf2f(r.x & 0xffffu); o[1] = __builtin_bit_cast(float, r.x & 0xffff0000u); o[2] = bf2f(r.y & 0xffffu); o[3] = __builtin_bit_cast(float, r.y & 0xffff0000u);
    o[4] = bf2f(r.z & 0xffffu); o[5] = __builtin_bit_cast(float, r.z & 0xffff0000u); o[6] = bf2f(r.w & 0xffffu); o[7] = __builtin_bit_cast(float, r.w & 0xffff0000u);
}
__device__ __forceinline__ v4u pack8(const float* v) { v4u w; w.x = pk2(v[0], v[1]); w.y = pk2(v[2], v[3]); w.z = pk2(v[4], v[5]); w.w = pk2(v[6], v[7]); return w; }
__device__ __forceinline__ float sigmoidf_(float x) { return __builtin_amdgcn_rcpf(1.f + __expf(-x)); }
__device__ __forceinline__ float siluf_(float x) { return x * __builtin_amdgcn_rcpf(1.f + __expf(-x)); }
__device__ __forceinline__ float softplusf_(float x) { return fmaxf(x, 0.f) + log1pf(__expf(-fabsf(x))); }
template <int CTRL> __device__ __forceinline__ float dppf(float v) { return __builtin_bit_cast(float, __builtin_amdgcn_update_dpp(0, __builtin_bit_cast(int, v), CTRL, 0xF, 0xF, true)); }
__device__ __forceinline__ float red8(float v) { v += dppf<0xB1>(v); v += dppf<0x4E>(v); v += dppf<0x141>(v); return v; }
__device__ __forceinline__ float red16(float v) { v = red8(v); v += dppf<0x140>(v); return v; }
__device__ __forceinline__ float wave_sum(float v) {
#pragma unroll
    for (int o = 1; o < 64; o <<= 1) v += __shfl_xor(v, o);
    return v;
}
#define LDS_WAIT() asm volatile("s_waitcnt lgkmcnt(0)" ::: "memory")

struct Args { const float* in[19]; float* out; unsigned char* ws; };
typedef const __attribute__((address_space(4))) Args& CArgsR;
__device__ __forceinline__ const __attribute__((address_space(4))) Args* kargs() { unsigned long long v = (unsigned long long)__builtin_amdgcn_kernarg_segment_ptr(); asm volatile("" : "+s"(v)); return (const __attribute__((address_space(4))) Args*)v; }
#ifndef PROBE_SEL
#define PROBE_SEL 0
#endif
__device__ __forceinline__ unsigned long long rt() { return __builtin_amdgcn_s_memrealtime(); }
#define PT0() unsigned long long pt_ = PROBE_SEL ? rt() : 0ull
#define PT1(k) do { if (PROBE_SEL & (1 << (k))) probe_acc += rt() - pt_; } while (0)

struct EpiRoute {
    static constexpr bool PERM = true, AFTER_DRAIN = false;
    bf16* base;
    __device__ __forceinline__ void operator()(const pg8::f32x4 (&acc)[2][2][4][2], const pg8::Unit& u, int wr, int wc, int fr, int fq) const {
        bf16* O = base + (size_t)(1 + (u.pn >> 2)) * BUFE;
        const int col0 = (u.pn & 3) * 256 + wc * 32 + 8 * fq, row0 = u.pm * 256 + wr * 64 + fr;
#pragma unroll
        for (int ai = 0; ai < 2; ++ai)
#pragma unroll
            for (int m = 0; m < 4; ++m) { bf16* rowp = O + (size_t)(row0 + ai * 128 + m * 16) * DM + col0;
#pragma unroll
                for (int bj = 0; bj < 2; ++bj) { const pg8::f32x4 v0 = acc[ai][bj][m][0], v1 = acc[ai][bj][m][1];
                    v4u w; w.x = pk2(v0[0], v0[1]); w.y = pk2(v0[2], v0[3]); w.z = pk2(v1[0], v1[1]); w.w = pk2(v1[2], v1[3]);
                    *(v4u*)(rowp + bj * 128) = w; } }
    }
};
struct EpiRelu2 {
    static constexpr bool PERM = true, AFTER_DRAIN = false;
    bf16* O;
    __device__ __forceinline__ void operator()(const pg8::f32x4 (&acc)[2][2][4][2], const pg8::Unit& u, int wr, int wc, int fr, int fq) const {
        const int col0 = u.pn * 256 + wc * 32 + 8 * fq, row0 = u.pm * 256 + wr * 64 + fr;
#pragma unroll
        for (int ai = 0; ai < 2; ++ai)
#pragma unroll
            for (int m = 0; m < 4; ++m) { bf16* rowp = O + (size_t)(row0 + ai * 128 + m * 16) * DFF + col0;
#pragma unroll
                for (int bj = 0; bj < 2; ++bj) { float v[8];
#pragma unroll
                    for (int i = 0; i < 4; ++i) { float a = fmaxf(acc[ai][bj][m][0][i], 0.f), b = fmaxf(acc[ai][bj][m][1][i], 0.f); v[i] = a * a; v[4 + i] = b * b; }
                    *(v4u*)(rowp + bj * 128) = pack8(v); } }
    }
};
struct EpiResid {
    static constexpr bool PERM = true, AFTER_DRAIN = false;
    const float* xin; float* xout;
    __device__ __forceinline__ void operator()(const pg8::f32x4 (&acc)[2][2][4][2], const pg8::Unit& u, int wr, int wc, int fr, int fq) const {
        const int col0 = u.pn * 256 + wc * 32 + 8 * fq, row0 = u.pm * 256 + wr * 64 + fr;
#pragma unroll
        for (int ai = 0; ai < 2; ++ai)
#pragma unroll
            for (int m = 0; m < 4; ++m) { const size_t ro = (size_t)(row0 + ai * 128 + m * 16) * DM + col0;
#pragma unroll
                for (int bj = 0; bj < 2; ++bj) { const size_t o = ro + bj * 128;
                    const f32x4 a = *(const f32x4*)(xin + o), b = *(const f32x4*)(xin + o + 4);
                    f32x4 r0, r1;
#pragma unroll
                    for (int i = 0; i < 4; ++i) { r0[i] = a[i] + acc[ai][bj][m][0][i]; r1[i] = b[i] + acc[ai][bj][m][1][i]; }
                    *(f32x4*)(xout + o) = r0; *(f32x4*)(xout + o + 4) = r1; } }
    }
};
struct SchedGate {
    int G, c;
    __device__ __forceinline__ bool next(int i, pg8::Unit& u) const {
        const int tile = c + (i / 6) * G; if (tile >= 256) return false;
        const int s = i % 6, br = s >> 1, pm = tile >> 2, pn = tile & 3;
        if ((s & 1) == 0) { u.pm = pm; u.pn = br * 4 + pn; } else { u.pm = (1 + br) * 64 + pm; u.pn = (3 + br) * 4 + pn; }
        return true;
    }
    __device__ __forceinline__ void a_ready(const pg8::Unit&) const {}
    __device__ __forceinline__ void done(const pg8::Unit&) const {}
};
struct EpiGate {
    static constexpr bool PERM = true, AFTER_DRAIN = false;
    bf16* gsc; float* macc; bf16* merged;
    __device__ __forceinline__ void operator()(const pg8::f32x4 (&acc)[2][2][4][2], const pg8::Unit& u, int wr, int wc, int fr, int fq) const {
        const int j = u.pn >> 2, pn = u.pn & 3, pm = u.pm & 63;
        const int col0 = pn * 256 + wc * 32 + 8 * fq, row0 = pm * 256 + wr * 64 + fr;
#pragma unroll
        for (int ai = 0; ai < 2; ++ai)
#pragma unroll
            for (int m = 0; m < 4; ++m) { const size_t ro = (size_t)(row0 + ai * 128 + m * 16) * DM + col0;
#pragma unroll
                for (int bj = 0; bj < 2; ++bj) { const size_t o = ro + bj * 128; float v[8];
#pragma unroll
                    for (int i = 0; i < 4; ++i) { v[i] = acc[ai][bj][m][0][i]; v[4 + i] = acc[ai][bj][m][1][i]; }
                    if (j < 3) {
#pragma unroll
                        for (int i = 0; i < 8; ++i) v[i] = sigmoidf_(v[i]);
                        *(v4u*)(gsc + o) = pack8(v);
                    } else {
                        float g[8]; unpack8(*(const v4u*)(gsc + o), g);
#pragma unroll
                        for (int i = 0; i < 8; ++i) v[i] *= g[i];
                        if (j > 3) { const f32x4 a = *(const f32x4*)(macc + o), b = *(const f32x4*)(macc + o + 4);
#pragma unroll
                            for (int i = 0; i < 4; ++i) { v[i] += a[i]; v[4 + i] += b[i]; } }
                        if (j < 5) { *(f32x4*)(macc + o) = (f32x4){v[0], v[1], v[2], v[3]}; *(f32x4*)(macc + o + 4) = (f32x4){v[4], v[5], v[6], v[7]}; }
                        else *(v4u*)(merged + o) = pack8(v);
                    } } }
    }
};

__device__ __forceinline__ void transpose_item(const float* __restrict__ W, const float* __restrict__ W2, int ldw, bf16* __restrict__ WT, int K, int nblk, float* scr, int item, int lane) {
    const int kb = item / nblk, nb = item % nblk, k0 = 64 * kb, n0 = 32 * nb;
    const float* src = ((lane & 31) < 16 ? W : W2) + (size_t)(k0 + (lane >> 5)) * ldw + n0 + (lane & 31);
    float t[32];
#pragma unroll
    for (int i = 0; i < 32; ++i) t[i] = src[(size_t)(2 * i) * ldw];
#pragma unroll
    for (int i = 0; i < 32; ++i) scr[(2 * i + (lane >> 5)) * 33 + (lane & 31)] = t[i];
    LDS_WAIT();
    const int c = lane & 7;
#pragma unroll
    for (int j = 0; j < 4; ++j) { const int n = (lane >> 3) + 8 * j; const float* s = scr + (8 * c) * 33 + n;
        v4u o; o.x = pk2(s[0 * 33], s[1 * 33]); o.y = pk2(s[2 * 33], s[3 * 33]); o.z = pk2(s[4 * 33], s[5 * 33]); o.w = pk2(s[6 * 33], s[7 * 33]);
        *(v4u*)(WT + (size_t)(n0 + n) * K + k0 + 8 * c) = o; }
    LDS_WAIT();
}
__device__ __forceinline__ void rms_row_to_bf16(const float* xrow, const float* w, bf16* orow, int lane) {
    const f32x4* xr = (const f32x4*)xrow + lane; const f32x4* wr = (const f32x4*)w + lane;
    f32x4 v[4]; float s = 0.f;
#pragma unroll
    for (int j = 0; j < 4; ++j) { v[j] = xr[64 * j]; s += (v[j][0] * v[j][0] + v[j][1] * v[j][1]) + (v[j][2] * v[j][2] + v[j][3] * v[j][3]); }
    const float rstd = rsqrtf(wave_sum(s) * (1.f / DM) + EPS);
    unsigned long long* o8 = (unsigned long long*)orow + lane;
#pragma unroll
    for (int j = 0; j < 4; ++j) { const f32x4 ww = wr[64 * j];
        o8[64 * j] = (unsigned long long)pk2(v[j][0] * rstd * ww[0], v[j][1] * rstd * ww[1]) | ((unsigned long long)pk2(v[j][2] * rstd * ww[2], v[j][3] * rstd * ww[3]) << 32); }
}
__device__ __forceinline__ void phase0(unsigned char* lds, CArgsR a, int l, const float* xin) {
    constexpr int LDW = 1032;
    const int tid = opaque_tid(), lane = tid & 63, wave = __builtin_amdgcn_readfirstlane(tid >> 6), gw = blockIdx.x * NWAVES + wave, NGW = gridDim.x * NWAVES;
    bf16* Wreg = (bf16*)(a.ws + WS_W);
    const float* w_in = a.in[2] + (size_t)l * DM * IN_DIM;
    {
        float* scr = (float*)lds + wave * (64 * 33);
        const float* w_br = a.in[13] + (size_t)l * 3 * DM * DM; const float* w_out = a.in[14] + (size_t)l * DM * DM;
        const float* w_up = a.in[16] + (size_t)l * DM * DFF; const float* w_down = a.in[17] + (size_t)l * DFF * DM;
        constexpr int NSEG = 17, NIT = NSEG * 512 + 2048 + 2048;
        for (int it = gw; it < NIT; it += NGW) {
            if (it < NSEG * 512) {
                const int seg = it >> 9, r = it & 511;
                const float* W; int ldw; bf16* WT;
                if (seg < 13) {
                    const int co = seg == 0 ? 3072 : seg == 1 ? 4112 : seg == 2 ? 7184 : seg == 3 ? 0 : seg == 4 ? 1024 : seg == 5 ? 2048 : seg == 6 ? 5136 : seg == 7 ? 6160 : seg == 8 ? 8208 : seg == 9 ? 9232
                                 : 10272 + (seg - 10) * 1024;
                    W = w_in + co; ldw = IN_DIM; WT = seg < 10 ? Wreg + (size_t)seg * DM * DM : Wreg + W_G + (size_t)(seg - 10) * DM * DM;
                } else if (seg < 16) { W = w_br + (size_t)(seg - 13) * DM * DM; ldw = DM; WT = Wreg + W_G + (size_t)(3 + seg - 13) * DM * DM; }
                else { W = w_out; ldw = DM; WT = Wreg + W_OUT; }
                transpose_item(W, W, ldw, WT, DM, 32, scr, r, lane);
            } else if (it < NSEG * 512 + 2048) transpose_item(w_up, w_up, DFF, Wreg + W_UP, DM, 128, scr, it - NSEG * 512, lane);
            else transpose_item(w_down, w_down, DM, Wreg + W_DOWN, DFF, 32, scr, it - NSEG * 512 - 2048, lane);
        }
    }
    __syncthreads();
    bf16* WsT = (bf16*)lds;
    for (int idx = tid; idx < 32 * DM; idx += NTHREADS) { const int k = idx >> 5, c = idx & 31; WsT[c * LDW + k] = (bf16)f2bf(w_in[(size_t)k * IN_DIM + (c < 16 ? 4096 + c : 10256 + c - 16)]); }
    __syncthreads();
    {   const float* nw = a.in[1] + (size_t)l * DM; bf16* H = (bf16*)a.ws; float* small = (float*)(a.ws + WS_SMALL);
        const int fr = lane & 15, fq = lane >> 4;
        const float pa0 = __expf(a.in[4][l * 8 + (fr & 7)]), pb0 = a.in[5][l * 8 + (fr & 7)], pa1 = __expf(a.in[9][l * 16 + fr]), pb1 = a.in[10][l * 16 + fr];
        for (int g8 = gw; g8 < MT / 8; g8 += NGW) {
            const int r0 = g8 * 8;
#pragma unroll 1
            for (int r = 0; r < 8; ++r) rms_row_to_bf16(xin + (size_t)(r0 + r) * DM, nw, H + (size_t)(r0 + r) * DM, lane);
            asm volatile("s_waitcnt vmcnt(0)" ::: "memory");
            f32x4 c0 = {0.f, 0.f, 0.f, 0.f}, c1 = {0.f, 0.f, 0.f, 0.f};
            const bf16* ap = H + (size_t)(r0 + (fr & 7)) * DM + fq * 8;
#pragma unroll
            for (int kb = 0; kb < 4; ++kb) { bf16x8 af[8];
#pragma unroll
                for (int k = 0; k < 8; ++k) af[k] = *(const bf16x8*)(ap + (kb * 8 + k) * 32);
#pragma unroll
                for (int k = 0; k < 8; ++k) { const bf16x8 b0 = *(const bf16x8*)(WsT + fr * LDW + (kb * 8 + k) * 32 + fq * 8), b1 = *(const bf16x8*)(WsT + (16 + fr) * LDW + (kb * 8 + k) * 32 + fq * 8);
                    c0 = __builtin_amdgcn_mfma_f32_16x16x32_bf16(af[k], b0, c0, 0, 0, 0); c1 = __builtin_amdgcn_mfma_f32_16x16x32_bf16(af[k], b1, c1, 0, 0, 0); } }
            if (fq < 2) {
#pragma unroll
                for (int jj = 0; jj < 4; ++jj) { float* sp = small + (size_t)(r0 + 4 * fq + jj) * 64;
                    sp[fr] = fr < 8 ? -pa0 * softplusf_(c0[jj] + pb0) : sigmoidf_(c0[jj]);
                    const float dt = softplusf_(c1[jj] + pb1); sp[16 + fr] = dt; sp[32 + fr] = -pa1 * dt; } }
        }
    }
}

__device__ __forceinline__ void conv8(const bf16* p, int pos, const float* w, int wstride, const float* bias, float* out) {
    float acc[8];
#pragma unroll
    for (int i = 0; i < 8; ++i) acc[i] = bias ? bias[i] : 0.f;
#pragma unroll
    for (int j = 0; j < 4; ++j) { const int back = 3 - j;
        if (pos - back >= 0) { float xv[8]; unpack8(*(const v4u*)(p - (size_t)back * DM), xv);
            const f32x4 w0 = *(const f32x4*)(w + j * wstride), w1 = *(const f32x4*)(w + j * wstride + 4);
#pragma unroll
            for (int i = 0; i < 4; ++i) { acc[i] += xv[i] * w0[i]; acc[4 + i] += xv[4 + i] * w1[i]; } } }
#pragma unroll
    for (int i = 0; i < 8; ++i) out[i] = siluf_(acc[i]);
}

__device__ __forceinline__ void conv8r(const v4u (&raw)[4], const float* w, int wstride, const float* bias, float* out) {
    float acc[8];
#pragma unroll
    for (int i = 0; i < 8; ++i) acc[i] = bias ? bias[i] : 0.f;
#pragma unroll
    for (int j = 0; j < 4; ++j) { float xv[8]; unpack8(raw[j], xv);
        const f32x4 w0 = *(const f32x4*)(w + j * wstride), w1 = *(const f32x4*)(w + j * wstride + 4);
#pragma unroll
        for (int i = 0; i < 4; ++i) { acc[i] += xv[i] * w0[i]; acc[4 + i] += xv[4 + i] * w1[i]; } }
#pragma unroll
    for (int i = 0; i < 8; ++i) out[i] = siluf_(acc[i]);
}
#define LOAD4(dst, p, pos) do { _Pragma("unroll") for (int j_ = 0; j_ < 4; ++j_) { const int back_ = 3 - j_; const bool ok_ = (pos) - back_ >= 0; \
        const v4u t_ = *(const v4u*)((p) - (size_t)(ok_ ? back_ : 0) * DM); dst[j_] = ok_ ? t_ : (v4u){0u, 0u, 0u, 0u}; } } while (0)

template <int K> __device__ __forceinline__ void mma16(f32x4& acc, const bf16* Ap, int lda, const bf16* Bp, int ldb, int fr, int fq) {
    bf16x8 af[K / 32], bfv[K / 32];
#pragma unroll
    for (int k = 0; k < K / 32; ++k) { af[k] = *(const bf16x8*)(Ap + fr * lda + k * 32 + fq * 8); bfv[k] = *(const bf16x8*)(Bp + fr * ldb + k * 32 + fq * 8); }
#pragma unroll
    for (int k = 0; k < K / 32; ++k) acc = __builtin_amdgcn_mfma_f32_16x16x32_bf16(af[k], bfv[k], acc, 0, 0, 0);
}
__device__ __forceinline__ void dn_item(unsigned char* lds, CArgsR a, int l, int item, unsigned long long& probe_acc) {
    constexpr int LDK = 136, LDJ = 40, LDL = 36;
    const int b = item >> 3, h = item & 7;
    bf16* kA = (bf16*)lds;
    bf16* qA = kA + 32 * LDK;
    bf16* qgA = qA + 32 * LDK;
    bf16* wA = qgA + 32 * LDK;
    bf16* kdT = wA + 32 * LDK;
    bf16* vnT = kdT + 128 * LDJ;
    bf16* attn = vnT + 128 * LDJ;
    bf16* ST = attn + 32 * LDJ;
    float* kf = (float*)(ST + 128 * LDK);
    float* vf = kf + 32 * 128;
    float* os = kf;
    float* Lm = vf + 32 * 128;
    float* gcs = Lm + 32 * LDL;
    float* betas = gcs + 32;
    float* cwL = betas + 32;
    const int tid = opaque_tid(), w = __builtin_amdgcn_readfirstlane(tid >> 6), lane = tid & 63, fr = lane & 15, fq = lane >> 4;
    bf16* base = (bf16*)a.ws;
    const bf16* Q = base + (size_t)B_DNQ * BUFE; const bf16* K = base + (size_t)B_DNK * BUFE; const bf16* V = base + (size_t)B_DNV * BUFE; bf16* G = base + (size_t)B_DNG * BUFE;
    const float* small = (const float*)(a.ws + WS_SMALL);
    const float* cw = a.in[3] + (size_t)l * 4 * 3072;
    const size_t rowbase = (size_t)b * SEQ;
    const int tq = tid >> 4, cq = tid & 15;
    const float* nwp = a.in[6] + l * 128 + cq * 8;
    f32x4 Sacc[8];
#pragma unroll
    for (int i = 0; i < 8; ++i) Sacc[i] = (f32x4){0.f, 0.f, 0.f, 0.f};
    for (int i = tid; i < 128 * LDK / 2; i += NTHREADS) ((unsigned*)ST)[i] = 0u;
    for (int i = tid; i < 4 * 384; i += NTHREADS) { const int j = i / 384, r = i % 384; cwL[i] = cw[j * 3072 + (r >> 7) * 1024 + h * 128 + (r & 127)]; }
    __syncthreads();
    v4u rq[4], rk[4], rv[4], rgate; float rg = 0.f, rbv = 0.f;
#define DN_LOADS(c_) do { const int t0_ = (c_) * 32, pos_ = t0_ + tq; const size_t off_ = (rowbase + pos_) * DM + h * 128 + cq * 8; \
        LOAD4(rq, Q + off_, pos_); LOAD4(rk, K + off_, pos_); LOAD4(rv, V + off_, pos_); rgate = *(const v4u*)(G + off_); \
        { const size_t r_ = rowbase + t0_ + (lane & 31); rg = small[r_ * 64 + h]; rbv = small[r_ * 64 + 8 + h]; } } while (0)
    DN_LOADS(0);
    for (int c = 0; c < SEQ / 32; ++c) {
        const int t0 = c * 32;
        unsigned long long tp_ = PROBE_SEL ? rt() : 0ull;
#define DPT(k) do { if (PROBE_SEL) { const unsigned long long tn_ = rt(); if ((PROBE_SEL & (1 << (k))) && item == 0) probe_acc += tn_ - tp_; tp_ = tn_; } } while (0)
        float gcv = rg;
#pragma unroll
        for (int off = 1; off < 32; off <<= 1) { const float t = __shfl_up(gcv, off, 32); if ((lane & 31) >= off) gcv += t; }
        const float gc_last = __shfl(gcv, 31), gc_t = __shfl(gcv, tq), beta_t = __shfl(rbv, tq);
        const v4u gcur = rgate;
        {   float q8[8], k8[8], v8[8];
            conv8r(rq, cwL + cq * 8, 384, nullptr, q8);
            __builtin_amdgcn_sched_barrier(0);
            conv8r(rk, cwL + 128 + cq * 8, 384, nullptr, k8);
            __builtin_amdgcn_sched_barrier(0);
            conv8r(rv, cwL + 256 + cq * 8, 384, nullptr, v8);
            __builtin_amdgcn_sched_barrier(0);
            float sq = 0.f, sk = 0.f;
#pragma unroll
            for (int i = 0; i < 8; ++i) { sq += q8[i] * q8[i]; sk += k8[i] * k8[i]; }
            sq = red16(sq); sk = red16(sk);
            const float rqn = rsqrtf(sq + EPS) * 0.08838834764831845f, rkn = rsqrtf(sk + EPS);
            const float eg = __expf(gc_t), kb = beta_t * eg, kd = __expf(gc_last - gc_t);
            float t8[8];
#pragma unroll
            for (int i = 0; i < 8; ++i) { q8[i] *= rqn; k8[i] *= rkn; }
            *(v4u*)(kA + tq * LDK + cq * 8) = pack8(k8); *(v4u*)(qA + tq * LDK + cq * 8) = pack8(q8);
#pragma unroll
            for (int i = 0; i < 8; ++i) t8[i] = q8[i] * eg;
            *(v4u*)(qgA + tq * LDK + cq * 8) = pack8(t8);
            *(f32x4*)(kf + tq * 128 + cq * 8) = (f32x4){k8[0] * kb, k8[1] * kb, k8[2] * kb, k8[3] * kb}; *(f32x4*)(kf + tq * 128 + cq * 8 + 4) = (f32x4){k8[4] * kb, k8[5] * kb, k8[6] * kb, k8[7] * kb};
            *(f32x4*)(vf + tq * 128 + cq * 8) = (f32x4){v8[0] * beta_t, v8[1] * beta_t, v8[2] * beta_t, v8[3] * beta_t}; *(f32x4*)(vf + tq * 128 + cq * 8 + 4) = (f32x4){v8[4] * beta_t, v8[5] * beta_t, v8[6] * beta_t, v8[7] * beta_t};
#pragma unroll
            for (int i = 0; i < 8; ++i) kdT[(cq * 8 + i) * LDJ + tq] = (bf16)f2bf(k8[i] * kd);
        }
        if (tid < 32) { gcs[tid] = gcv; betas[tid] = rbv; }
        __syncthreads();
        DPT(12);
        if (c + 1 < SEQ / 32) DN_LOADS(c + 1);
        {   const int ww = w & 3, gi = ww >> 1, gj = ww & 1; f32x4 acc = {0.f, 0.f, 0.f, 0.f};
            const int jI = 16 * gj + fr, i0 = 16 * gi + 4 * fq;
            const float gj_ = gcs[jI]; const f32x4 gi4 = *(const f32x4*)(gcs + i0), bi4 = *(const f32x4*)(betas + i0);
            mma16<128>(acc, (w < 4 ? kA : qA) + gi * 16 * LDK, LDK, kA + gj * 16 * LDK, LDK, fr, fq);
            if (w < 4) {
#pragma unroll
                for (int jj = 0; jj < 4; ++jj) Lm[(i0 + jj) * LDL + jI] = jI < i0 + jj ? bi4[jj] * acc[jj] * __expf(gi4[jj] - gj_) : 0.f;
            } else {
#pragma unroll
                for (int jj = 0; jj < 4; ++jj) attn[(i0 + jj) * LDJ + jI] = (bf16)f2bf(jI <= i0 + jj ? acc[jj] * __expf(gi4[jj] - gj_) : 0.f);
            } }
        __syncthreads();
        DPT(13);
        if (w < 4) { const int cc = tid & 127; const bool is_w = w >= 2; const float* R = is_w ? kf : vf;
            float x[32];
#pragma unroll
            for (int i = 0; i < 32; ++i) x[i] = R[i * 128 + cc];
            f32x4 Lb[2][8];
            Lb[1][0] = *(const f32x4*)(Lm + 1 * LDL);
#pragma unroll
            for (int i = 1; i < 32; ++i) {
                if (i + 1 < 32) {
#pragma unroll
                    for (int j4 = 0; j4 < (i + 4) / 4; ++j4) Lb[(i + 1) & 1][j4] = *(const f32x4*)(Lm + (i + 1) * LDL + j4 * 4); }
                float a0 = x[i], a1 = 0.f, a2 = 0.f, a3 = 0.f;
#pragma unroll
                for (int j4 = 0; j4 < (i + 3) / 4; ++j4) { const f32x4 l4 = Lb[i & 1][j4];
                    if (j4 * 4 + 0 < i) a0 -= l4[0] * x[j4 * 4 + 0];
                    if (j4 * 4 + 1 < i) a1 -= l4[1] * x[j4 * 4 + 1];
                    if (j4 * 4 + 2 < i) a2 -= l4[2] * x[j4 * 4 + 2];
                    if (j4 * 4 + 3 < i) a3 -= l4[3] * x[j4 * 4 + 3]; }
                x[i] = (a0 + a1) + (a2 + a3); }
            if (is_w) {
#pragma unroll
                for (int i = 0; i < 32; ++i) wA[i * LDK + cc] = (bf16)f2bf(x[i]);
            } else {
#pragma unroll
                for (int i = 0; i < 32; ++i) vf[i * 128 + cc] = x[i];
            } }
        __syncthreads();
        DPT(14);
#pragma unroll
        for (int it = 0; it < 2; ++it) { f32x4 acc = {0.f, 0.f, 0.f, 0.f};
            mma16<128>(acc, wA + it * 16 * LDK, LDK, ST + w * 16 * LDK, LDK, fr, fq);
            float vn[4];
#pragma unroll
            for (int jj = 0; jj < 4; ++jj) vn[jj] = vf[(16 * it + 4 * fq + jj) * 128 + 16 * w + fr] - acc[jj];
            v2u pk; pk.x = pk2(vn[0], vn[1]); pk.y = pk2(vn[2], vn[3]);
            *(v2u*)(vnT + (16 * w + fr) * LDJ + 16 * it + 4 * fq) = pk; }
        __syncthreads();
#pragma unroll
        for (int it = 0; it < 2; ++it) { f32x4 acc = {0.f, 0.f, 0.f, 0.f};
            mma16<128>(acc, qgA + it * 16 * LDK, LDK, ST + w * 16 * LDK, LDK, fr, fq);
            mma16<32>(acc, attn + it * 16 * LDJ, LDJ, vnT + w * 16 * LDJ, LDJ, fr, fq);
#pragma unroll
            for (int jj = 0; jj < 4; ++jj) os[(16 * it + 4 * fq + jj) * 128 + 16 * w + fr] = acc[jj]; }
        {   const float dl = __expf(gc_last);
#pragma unroll
            for (int dt = 0; dt < 8; ++dt) { Sacc[dt] = Sacc[dt] * dl; mma16<32>(Sacc[dt], kdT + dt * 16 * LDJ, LDJ, vnT + w * 16 * LDJ, LDJ, fr, fq); } }
        __syncthreads();
#pragma unroll
        for (int dt = 0; dt < 8; ++dt) { v2u pk; pk.x = pk2(Sacc[dt][0], Sacc[dt][1]); pk.y = pk2(Sacc[dt][2], Sacc[dt][3]);
            *(v2u*)(ST + (16 * w + fr) * LDK + 16 * dt + 4 * fq) = pk; }
        {   const f32x4 o0 = *(const f32x4*)(os + tq * 128 + cq * 8), o1 = *(const f32x4*)(os + tq * 128 + cq * 8 + 4);
            float ss = (o0[0] * o0[0] + o0[1] * o0[1]) + (o0[2] * o0[2] + o0[3] * o0[3]) + (o1[0] * o1[0] + o1[1] * o1[1]) + (o1[2] * o1[2] + o1[3] * o1[3]);
            ss = red16(ss);
            const float r = rsqrtf(ss * (1.f / 128.f) + EPS);
            float g8[8], o8[8], nw8[8]; unpack8(gcur, g8);
            { const f32x4 n0 = *(const f32x4*)nwp, n1 = *(const f32x4*)(nwp + 4); nw8[0] = n0[0]; nw8[1] = n0[1]; nw8[2] = n0[2]; nw8[3] = n0[3]; nw8[4] = n1[0]; nw8[5] = n1[1]; nw8[6] = n1[2]; nw8[7] = n1[3]; }
#pragma unroll
            for (int i = 0; i < 4; ++i) { o8[i] = o0[i] * r * nw8[i] * siluf_(g8[i]); o8[4 + i] = o1[i] * r * nw8[4 + i] * siluf_(g8[4 + i]); }
            *(v4u*)(G + (rowbase + t0 + tq) * DM + h * 128 + cq * 8) = pack8(o8); }
        __syncthreads();
        DPT(15);
    }
#undef DPT
#undef DN_LOADS
    __syncthreads();
}

__device__ __forceinline__ void ssm_item(unsigned char* lds, CArgsR a, int l, int item) {
    constexpr int LDC = 136, LDX = 40;
    const int b = item >> 4, hd = item & 15, g = hd >> 2;
    bf16* Cs = (bf16*)lds;
    bf16* Bs = Cs + 32 * LDC;
    bf16* BT = Bs + 32 * LDC;
    bf16* xdtT = BT + 128 * LDX;
    bf16* xddT = xdtT + 64 * LDX;
    bf16* Wm = xddT + 64 * LDX;
    bf16* hB = Wm + 32 * LDX;
    float* xs = (float*)(hB + 64 * LDC);
    float* acs = xs + 32 * 64;
    const int tid = opaque_tid(), w = __builtin_amdgcn_readfirstlane(tid >> 6), lane = tid & 63, fr = lane & 15, fq = lane >> 4;
    bf16* base = (bf16*)a.ws;
    const bf16* X = base + (size_t)B_SSX * BUFE; const bf16* BC = base + (size_t)B_SSBC * BUFE; bf16* Z = base + (size_t)B_SSZ * BUFE;
    const float* small = (const float*)(a.ws + WS_SMALL);
    const float* cw = a.in[7] + (size_t)l * 4 * 2048; const float* cb = a.in[8] + (size_t)l * 2048;
    const float dskip = a.in[11][l * 16 + hd];
    const size_t rowbase = (size_t)b * SEQ;
    const int tq = tid >> 4, cq = tid & 15, tv = (tid >> 3) & 31, cv = tid & 7;
    const int it = w >> 2, pt = w & 3;
    f32x4 hacc[4];
#pragma unroll
    for (int i = 0; i < 4; ++i) hacc[i] = (f32x4){0.f, 0.f, 0.f, 0.f};
    for (int i = tid; i < 64 * LDC / 2; i += NTHREADS) ((unsigned*)hB)[i] = 0u;
    v4u rB[4], rC[4], rx[4]; float ra = 0.f, rdtv = 0.f; unsigned rz[4];
#define SSM_LOADS(c_) do { const int t0_ = (c_) * 32; { const int pos_ = t0_ + tq; const size_t ro_ = (rowbase + pos_) * DM; LOAD4(rB, BC + ro_ + g * 128 + cq * 8, pos_); LOAD4(rC, BC + ro_ + 512 + g * 128 + cq * 8, pos_); } \
        if (tid < 256) { const int pos_ = t0_ + tv; LOAD4(rx, X + (rowbase + pos_) * DM + hd * 64 + cv * 8, pos_); } \
        { const size_t r_ = rowbase + t0_ + (lane & 31); rdtv = small[r_ * 64 + 16 + hd]; ra = small[r_ * 64 + 32 + hd]; } \
        _Pragma("unroll") for (int jj_ = 0; jj_ < 4; ++jj_) rz[jj_] = Z[(rowbase + t0_ + 16 * it + 4 * fq + jj_) * DM + hd * 64 + 16 * pt + fr]; } while (0)
    SSM_LOADS(0);
    for (int c = 0; c < SEQ / 32; ++c) {
        const int t0 = c * 32;
        float acum = ra;
#pragma unroll
        for (int off = 1; off < 32; off <<= 1) { const float t = __shfl_up(acum, off, 32); if ((lane & 31) >= off) acum += t; }
        const float ac_last = __shfl(acum, 31);
        {   float o8[8];
            conv8r(rB, cw + 1024 + g * 128 + cq * 8, 2048, cb + 1024 + g * 128 + cq * 8, o8);
            *(v4u*)(Bs + tq * LDC + cq * 8) = pack8(o8);
#pragma unroll
            for (int i = 0; i < 8; ++i) BT[(cq * 8 + i) * LDX + tq] = (bf16)f2bf(o8[i]);
            conv8r(rC, cw + 1536 + g * 128 + cq * 8, 2048, cb + 1536 + g * 128 + cq * 8, o8);
            *(v4u*)(Cs + tq * LDC + cq * 8) = pack8(o8);
        }
        if (w < 4) { float o8[8]; conv8r(rx, cw + hd * 64 + cv * 8, 2048, cb + hd * 64 + cv * 8, o8);
            const float dtv = __shfl(rdtv, tv), dd = dtv * __expf(ac_last - __shfl(acum, tv));
            *(f32x4*)(xs + tv * 64 + cv * 8) = (f32x4){o8[0], o8[1], o8[2], o8[3]}; *(f32x4*)(xs + tv * 64 + cv * 8 + 4) = (f32x4){o8[4], o8[5], o8[6], o8[7]};
#pragma unroll
            for (int i = 0; i < 8; ++i) { xdtT[(cv * 8 + i) * LDX + tv] = (bf16)f2bf(o8[i] * dtv); xddT[(cv * 8 + i) * LDX + tv] = (bf16)f2bf(o8[i] * dd); }
        }
        if (tid < 32) acs[tid] = acum;
        unsigned zr[4];
#pragma unroll
        for (int jj = 0; jj < 4; ++jj) zr[jj] = rz[jj];
        __syncthreads();
        if (c + 1 < SEQ / 32) SSM_LOADS(c + 1);
        if (w < 4) { const int gi = w >> 1, gj = w & 1; f32x4 acc = {0.f, 0.f, 0.f, 0.f};
            mma16<128>(acc, Cs + gi * 16 * LDC, LDC, Bs + gj * 16 * LDC, LDC, fr, fq);
            const int sI = 16 * gj + fr; const float as = acs[sI];
#pragma unroll
            for (int jj = 0; jj < 4; ++jj) { const int lI = 16 * gi + 4 * fq + jj; const float v = sI <= lI ? acc[jj] * __expf(acs[lI] - as) : 0.f; Wm[lI * LDX + sI] = (bf16)f2bf(v); } }
        __syncthreads();
        {   f32x4 a1 = {0.f, 0.f, 0.f, 0.f}, a2 = {0.f, 0.f, 0.f, 0.f};
            mma16<32>(a1, Wm + it * 16 * LDX, LDX, xdtT + pt * 16 * LDX, LDX, fr, fq);
            mma16<128>(a2, Cs + it * 16 * LDC, LDC, hB + pt * 16 * LDC, LDC, fr, fq);
            const int p = 16 * pt + fr;
#pragma unroll
            for (int jj = 0; jj < 4; ++jj) { const int lI = 16 * it + 4 * fq + jj;
                const float y = a1[jj] + __expf(acs[lI]) * a2[jj] + xs[lI * 64 + p] * dskip;
                Z[(rowbase + t0 + lI) * DM + hd * 64 + p] = (bf16)f2bf(y * siluf_(bf2f(zr[jj]))); }
            const float dl = __expf(ac_last);
#pragma unroll
            for (int p2 = 0; p2 < 4; ++p2) { hacc[p2] = hacc[p2] * dl; mma16<32>(hacc[p2], xddT + p2 * 16 * LDX, LDX, BT + w * 16 * LDX, LDX, fr, fq); }
        }
        __syncthreads();
#pragma unroll
        for (int p2 = 0; p2 < 4; ++p2)
#pragma unroll
            for (int jj = 0; jj < 4; ++jj) hB[(16 * p2 + 4 * fq + jj) * LDC + 16 * w + fr] = (bf16)f2bf(hacc[p2][jj]);
    }
#undef SSM_LOADS
    __syncthreads();
}

__device__ __forceinline__ void sb_item(unsigned char* lds, CArgsR a, int b, int hd, int qi) {
    constexpr int LD = 72;
    bf16* Ks = (bf16*)lds; bf16* Vs = Ks + 2 * 64 * LD;
    volatile unsigned* alive = (volatile unsigned*)(Vs + 2 * 64 * LD);
    const int tid = opaque_tid(), w = __builtin_amdgcn_readfirstlane(tid >> 6), lane = tid & 63, fr = lane & 15, fq = lane >> 4;
    bf16* base = (bf16*)a.ws;
    bf16* Qb = base + (size_t)B_SBQ * BUFE; const bf16* Kb = base + (size_t)B_SBK * BUFE; const bf16* Vb = base + (size_t)B_SBV * BUFE;
    const size_t rowbase = (size_t)b * SEQ;
    const int t0 = qi * 128, myq = t0 + w * 16 + fr, wmax = t0 + w * 16 + 15;
    bf16* qrow = Qb + (rowbase + myq) * DM + hd * 64;
    bf16x8 qf[2];
    qf[0] = *(const bf16x8*)(qrow + fq * 8); qf[1] = *(const bf16x8*)(qrow + 32 + fq * 8);
    f32x4 oacc[4];
#pragma unroll
    for (int i = 0; i < 4; ++i) oacc[i] = (f32x4){0.f, 0.f, 0.f, 0.f};
    float carry = 1.f;
    const int kr = tid >> 3, d8 = (tid & 7) * 8;
    v4u kreg, vreg;
    int kt = 2 * (qi + 1) - 1;
#define SB_LOAD(t) do { const size_t o_ = (rowbase + (size_t)(t) * 64 + kr) * DM + hd * 64 + d8; kreg = *(const v4u*)(Kb + o_); vreg = *(const v4u*)(Vb + o_); } while (0)
#define SB_STORE(bu) do { *(v4u*)(Ks + (bu) * 64 * LD + kr * LD + d8) = kreg; bf16* vd_ = Vs + (bu) * 64 * LD + d8 * LD + kr; \
        vd_[0] = (bf16)(vreg.x & 0xffffu); vd_[LD] = (bf16)(vreg.x >> 16); vd_[2 * LD] = (bf16)(vreg.y & 0xffffu); vd_[3 * LD] = (bf16)(vreg.y >> 16); \
        vd_[4 * LD] = (bf16)(vreg.z & 0xffffu); vd_[5 * LD] = (bf16)(vreg.z >> 16); vd_[6 * LD] = (bf16)(vreg.w & 0xffffu); vd_[7 * LD] = (bf16)(vreg.w >> 16); } while (0)
    SB_LOAD(kt); SB_STORE(0);
    __syncthreads();
    int cur = 0;
    for (; kt >= 0; --kt) {
        if (kt > 0) SB_LOAD(kt - 1);
        const int kbase = kt * 64;
        if (kbase <= wmax) {
            const bf16* Kc = Ks + cur * 64 * LD; const bf16* Vc = Vs + cur * 64 * LD;
            f32x4 z[4];
#pragma unroll
            for (int nt = 0; nt < 4; ++nt) { z[nt] = (f32x4){0.f, 0.f, 0.f, 0.f};
#pragma unroll
                for (int k2 = 0; k2 < 2; ++k2) { const bf16x8 af = *(const bf16x8*)(Kc + (nt * 16 + fr) * LD + k2 * 32 + fq * 8);
                    z[nt] = __builtin_amdgcn_mfma_f32_16x16x32_bf16(af, qf[k2], z[nt], 0, 0, 0); } }
            float kp[4][4], sg[4][4], T[4], tot[4], suf[4];
            const bool masked = kbase + 64 > t0 + w * 16;
#pragma unroll
            for (int nt = 0; nt < 4; ++nt) {
#pragma unroll
                for (int j = 0; j < 4; ++j) { const float z2 = z[nt][j] * 0.18033688011112042f;
                    const float ea = __builtin_amdgcn_exp2f(-fabsf(z2)), rc = __builtin_amdgcn_rcpf(1.f + ea); const bool pos = z2 >= 0.f;
                    sg[nt][j] = (pos ? 1.f : ea) * rc; kp[nt][j] = (pos ? ea : 1.f) * rc; }
                if (masked) {
#pragma unroll
                    for (int j = 0; j < 4; ++j) { const bool valid = kbase + nt * 16 + fq * 4 + j < myq; sg[nt][j] = valid ? sg[nt][j] : 0.f; kp[nt][j] = valid ? kp[nt][j] : 1.f; } }
                T[nt] = (kp[nt][0] * kp[nt][1]) * (kp[nt][2] * kp[nt][3]); }
#pragma unroll
            for (int nt = 0; nt < 4; ++nt) { const float p16 = __shfl_xor(T[nt], 16), s1 = T[nt] * p16, p32 = __shfl_xor(s1, 32); tot[nt] = s1 * p32;
                suf[nt] = fq == 0 ? p16 * p32 : fq == 1 ? p32 : fq == 2 ? p16 : 1.f; }
            float run = carry; float wv[4][4];
#pragma unroll
            for (int nt = 3; nt >= 0; --nt) { const float r3 = run * suf[nt], r2 = r3 * kp[nt][3], r1 = r2 * kp[nt][2], r0 = r1 * kp[nt][1];
                wv[nt][0] = sg[nt][0] * r0; wv[nt][1] = sg[nt][1] * r1; wv[nt][2] = sg[nt][2] * r2; wv[nt][3] = sg[nt][3] * r3;
                run *= tot[nt]; }
            carry = run;
#pragma unroll
            for (int kk = 0; kk < 2; ++kk) {
                v4u bw; bw.x = pk2(wv[2 * kk][0], wv[2 * kk][1]); bw.y = pk2(wv[2 * kk][2], wv[2 * kk][3]); bw.z = pk2(wv[2 * kk + 1][0], wv[2 * kk + 1][1]); bw.w = pk2(wv[2 * kk + 1][2], wv[2 * kk + 1][3]);
                const bf16x8 bfr = __builtin_bit_cast(bf16x8, bw);
#pragma unroll
                for (int mt = 0; mt < 4; ++mt) { const bf16* vp = Vc + (mt * 16 + fr) * LD + 32 * kk + 4 * fq;
                    const v2u lo = *(const v2u*)vp, hi = *(const v2u*)(vp + 16);
                    v4u av; av.x = lo.x; av.y = lo.y; av.z = hi.x; av.w = hi.y;
                    oacc[mt] = __builtin_amdgcn_mfma_f32_16x16x32_bf16(__builtin_bit_cast(bf16x8, av), bfr, oacc[mt], 0, 0, 0); }
            }
        }
        {   const bool any_alive = __ballot(carry != 0.f) != 0ull;
            if (lane == 0) alive[cur * 8 + w] = any_alive ? 1u : 0u; }
        if (kt > 0) SB_STORE(cur ^ 1);
        __syncthreads();
        unsigned al = 0u;
#pragma unroll
        for (int i = 0; i < 8; ++i) al |= alive[cur * 8 + i];
        if (al == 0u) break;
        cur ^= 1;
    }
#undef SB_LOAD
#undef SB_STORE
#pragma unroll
    for (int mt = 0; mt < 4; ++mt) { v2u wq; wq.x = pk2(oacc[mt][0], oacc[mt][1]); wq.y = pk2(oacc[mt][2], oacc[mt][3]); *(v2u*)(qrow + mt * 16 + fq * 4) = wq; }
}

__device__ __forceinline__ void phase_mixers(unsigned char* lds, CArgsR a, int l, unsigned long long& probe_acc) {
    unsigned* counter = (unsigned*)(a.ws + WS_CTL) + 64 * l;
    volatile unsigned* slot = (volatile unsigned*)(lds + LDS_BYTES - 64);
    constexpr unsigned NITEMS = 64 + 128 + 2048;
    for (;;) {
        if (threadIdx.x == 0) *slot = __hip_atomic_fetch_add(counter, 1u, __ATOMIC_RELAXED, __HIP_MEMORY_SCOPE_AGENT);
        __syncthreads();
        const unsigned item = *slot;
        __syncthreads();
        if (item >= NITEMS) break;
        PT0();
        if (item < 64) { dn_item(lds, a, l, (int)item, probe_acc); if (item == 0) PT1(9); }
        else if (item < 192) { ssm_item(lds, a, l, (int)item - 64); if (item == 64) PT1(10); }
        else { const int r = (int)item - 192, qi = 15 - (r >> 7), bh = r & 127; sb_item(lds, a, bh >> 4, bh & 15, qi); if (item == 192) PT1(11); }
    }
}

__device__ __forceinline__ void phase_norms(CArgsR a, int l) {
    const int tid = opaque_tid(), lane = tid & 63, wave = tid >> 6, gw = blockIdx.x * NWAVES + wave, NGW = gridDim.x * NWAVES;
    bf16* base = (bf16*)a.ws;
    const bf16* Oraw = base + (size_t)B_DNV * BUFE; bf16* G = base + (size_t)B_DNG * BUFE; bf16* Y = base + (size_t)B_SSZ * BUFE;
    const float* dnw = a.in[6] + (size_t)l * 128 + (lane & 7) * 16; const float* snw = a.in[12] + (size_t)l * DM + lane * 16;
    float w1[16], w2[16];
#pragma unroll
    for (int i = 0; i < 16; ++i) { w1[i] = dnw[i]; w2[i] = snw[i]; }
    for (int m = gw; m < MT; m += NGW) {
        const size_t o = (size_t)m * DM + lane * 16;
        float v[16], s, r;
        unpack8(*(const v4u*)(Y + o), v); unpack8(*(const v4u*)(Y + o + 8), v + 8);
        s = 0.f;
#pragma unroll
        for (int i = 0; i < 16; ++i) s += v[i] * v[i];
        s = red16(s);
        r = rsqrtf(s * (1.f / 256.f) + EPS);
#pragma unroll
        for (int i = 0; i < 16; ++i) v[i] = v[i] * r * w2[i];
        *(v4u*)(Y + o) = pack8(v); *(v4u*)(Y + o + 8) = pack8(v + 8);
    }
}

#define LAS __attribute__((address_space(3)))
#define XB_TMO      128
#define XB_XCNT(j)  (256  + 64 * (j))
#define XB_XSUB(j)  (1280 + 64 * (j))
#define XB_XGEN(j)  (2304 + 64 * (j))
#define XB_TOP      3328
#define XB_TOPGEN   3392
#define XCD_BAR_WORDS 3456
#define XB_SPIN_CAP (1u << 18)

__device__ __forceinline__ unsigned xb_ld(unsigned* p)              { return __hip_atomic_load(p, __ATOMIC_RELAXED, __HIP_MEMORY_SCOPE_AGENT); }
__device__ __forceinline__ unsigned xb_add(unsigned* p, unsigned v) { return __hip_atomic_fetch_add(p, v, __ATOMIC_RELAXED, __HIP_MEMORY_SCOPE_AGENT); }
__device__ __forceinline__ unsigned xb_xcc_id() { return (unsigned)__builtin_amdgcn_s_getreg((3 << 11) | 20) & 0xFu; }
#define XB_SPIN(cond, bar) do { unsigned _sp = 0; while (cond) { __builtin_amdgcn_s_sleep(1); \
    if ((++_sp & 255u) == 0u) { if (xb_ld(&(bar)[XB_TMO])) break; if (_sp > XB_SPIN_CAP) { atomicAdd(&(bar)[XB_TMO], 1u); break; } } } } while (0)

struct XcdBarrier {
    unsigned* bar; unsigned x;
    volatile LAS unsigned* st;
};

__device__ __forceinline__ XcdBarrier xcd_barrier_post(unsigned* bar, volatile LAS unsigned* st) {
    XcdBarrier b; b.bar = bar; b.x = xb_xcc_id(); b.st = st;
    if (threadIdx.x == 0) (void)xb_add(&bar[XB_XCNT(b.x)], 1u);
    return b;
}
__device__ __forceinline__ void xcd_barrier_complete(unsigned* bar, unsigned x, unsigned& nloc, unsigned& nx) {
    const unsigned G = gridDim.x * gridDim.y * gridDim.z;
    unsigned sum, cnt, mine, sp = 0u;
    for (;;) {
        sum = 0u; cnt = 0u; mine = 0u;
#pragma unroll
        for (unsigned j = 0; j < 16; ++j) { const unsigned c = xb_ld(&bar[XB_XCNT(j)]); sum += c; cnt += (c > 0u) ? 1u : 0u; mine = (j == x) ? c : mine; }
        if (sum == G) break;
        __builtin_amdgcn_s_sleep(1);
        if ((++sp & 255u) == 0u) { if (xb_ld(&bar[XB_TMO])) break; if (sp > XB_SPIN_CAP) { atomicAdd(&bar[XB_TMO], 1u); break; } }
    }
    nloc = mine > 0u ? mine : 1u; nx = cnt > 0u ? cnt : 1u;
}

__device__ __forceinline__ void xcd_barrier(const XcdBarrier& b) {
    asm volatile("s_waitcnt vmcnt(0)" ::: "memory");
    __syncthreads();
    if (threadIdx.x == 0) {
        unsigned* bar = b.bar;
        __builtin_amdgcn_s_waitcnt(0);
        unsigned nloc = b.st[0], nx = b.st[1];
        if (nloc == 0u) { xcd_barrier_complete(bar, b.x, nloc, nx); b.st[0] = nloc; b.st[1] = nx; }
        const unsigned old = xb_add(&bar[XB_XSUB(b.x)], 1u);
        const unsigned gen = old / nloc;
        if (old + 1u == (gen + 1u) * nloc) {
            __builtin_amdgcn_fence(__ATOMIC_RELEASE, "agent");
            asm volatile("s_waitcnt vmcnt(0)" ::: "memory");
            const unsigned og = xb_add(&bar[XB_TOP], 1u);
            const unsigned tg = og / nx;
            if (og + 1u == (tg + 1u) * nx) xb_add(&bar[XB_TOPGEN], 1u);
            else XB_SPIN(xb_ld(&bar[XB_TOPGEN]) == tg, bar);
            __builtin_amdgcn_fence(__ATOMIC_ACQUIRE, "agent");
            xb_add(&bar[XB_XGEN(b.x)], 1u);
            asm volatile("s_waitcnt vmcnt(0)" ::: "memory");
        } else {
            XB_SPIN(xb_ld(&bar[XB_XGEN(b.x)]) == gen, bar);
            __builtin_amdgcn_fence(__ATOMIC_ACQUIRE, "agent");
            asm volatile("s_waitcnt vmcnt(0)" ::: "memory");
        }
    }
    __syncthreads();
}

__global__ void __launch_bounds__(NTHREADS, 2) hybrid_fwd(Args a_unused) {
    extern __shared__ __attribute__((aligned(16))) unsigned char lds[];
    cg::grid_group grid = cg::this_grid();
    PG8_LAS unsigned char* ldsl = (PG8_LAS unsigned char*)lds;
    unsigned long long probe_acc = 0ull;
#define A_ (*kargs())
    volatile LAS unsigned* bst = (volatile LAS unsigned*)((LAS unsigned char*)lds + LDS_BYTES - 32);
    if (threadIdx.x == 0) { bst[0] = 0u; bst[1] = 0u; }
    __syncthreads();
    const XcdBarrier bar = xcd_barrier_post((unsigned*)(a_unused.ws + WS_BAR), bst);
#pragma unroll 1
    for (int l = 0; l < 2; ++l) {
        asm volatile("" : "+s"(l));
        {   CArgsR a = A_; const float* xin = l == 0 ? a.in[0] : a.out;
            PT0(); phase0(lds, a, l, xin);
        if (l == 0) grid.sync(); else xcd_barrier(bar); PT1(0); }
        {   CArgsR a = A_; bf16* base = (bf16*)a.ws; bf16* Wreg = (bf16*)(a.ws + WS_W);
            pg8::Gemm g{base, Wreg + W_IN, MT, 10240, DM}; pg8::StaticOrder S; S.init(MT, 10240, (int)gridDim.x, (int)blockIdx.x);
            EpiRoute E{base};
            PT0(); pg8::gemm_phase<EpiRoute, pg8::StaticOrder, true, true>(ldsl, g, S, E);
        xcd_barrier(bar); PT1(1); }
        { PT0(); phase_mixers(lds, A_, l, probe_acc);
        xcd_barrier(bar); PT1(2); }
        { PT0(); phase_norms(A_, l);
        xcd_barrier(bar); PT1(3); }
        {   CArgsR a = A_; bf16* base = (bf16*)a.ws; bf16* Wreg = (bf16*)(a.ws + WS_W);
            pg8::Gemm g{base, Wreg + W_G, 4 * MT, 6144, DM}; SchedGate S{(int)gridDim.x, (int)blockIdx.x};
            EpiGate E{base + (size_t)B_SBK * BUFE, (float*)(base + (size_t)B_DNK * BUFE), base + (size_t)B_DNQ * BUFE};
            PT0(); pg8::gemm_phase<EpiGate, SchedGate, true, true>(ldsl, g, S, E);
        xcd_barrier(bar); PT1(4); }
        {   CArgsR a = A_; bf16* base = (bf16*)a.ws; bf16* Wreg = (bf16*)(a.ws + WS_W); const float* xin = l == 0 ? a.in[0] : a.out;
            pg8::Gemm g{base + (size_t)B_DNQ * BUFE, Wreg + W_OUT, MT, DM, DM}; pg8::StaticOrder S; S.init(MT, DM, (int)gridDim.x, (int)blockIdx.x);
            EpiResid E{xin, a.out};
            PT0(); pg8::gemm_phase<EpiResid, pg8::StaticOrder, false, true>(ldsl, g, S, E);
        xcd_barrier(bar); PT1(5); }
        {   CArgsR a = A_; bf16* base = (bf16*)a.ws; const float* nw = a.in[15] + (size_t)l * DM; const float* xo = a.out;
            const int tid = opaque_tid(), lane = tid & 63, gw = blockIdx.x * NWAVES + (tid >> 6), NGW = gridDim.x * NWAVES;
            PT0(); for (int m = gw; m < MT; m += NGW) rms_row_to_bf16(xo + (size_t)m * DM, nw, base + (size_t)m * DM, lane);
        xcd_barrier(bar); PT1(6); }
        {   CArgsR a = A_; bf16* base = (bf16*)a.ws; bf16* Wreg = (bf16*)(a.ws + WS_W);
            pg8::Gemm g{base, Wreg + W_UP, MT, DFF, DM}; pg8::StaticOrder S; S.init(MT, DFF, (int)gridDim.x, (int)blockIdx.x);
            EpiRelu2 E{base + (size_t)B_DNQ * BUFE};
            PT0(); pg8::gemm_phase<EpiRelu2, pg8::StaticOrder, true, true>(ldsl, g, S, E);
        xcd_barrier(bar); PT1(7); }
        {   CArgsR a = A_; bf16* base = (bf16*)a.ws; bf16* Wreg = (bf16*)(a.ws + WS_W);
            pg8::Gemm g{base + (size_t)B_DNQ * BUFE, Wreg + W_DOWN, MT, DM, DFF}; pg8::StaticOrder S; S.init(MT, DM, (int)gridDim.x, (int)blockIdx.x);
            EpiResid E{a.out, a.out};
            PT0(); pg8::gemm_phase<EpiResid, pg8::StaticOrder, false, true>(ldsl, g, S, E);
        xcd_barrier(bar); PT1(8); }
    }
    {
        CArgsR a = A_; const float* nw = a.in[18]; float* xo = a.out;
        const int tid = opaque_tid(), lane = tid & 63, gw = blockIdx.x * NWAVES + (tid >> 6), NGW = gridDim.x * NWAVES;
        for (int m = gw; m < MT; m += NGW) {
            f32x4* xr = (f32x4*)(xo + (size_t)m * DM) + lane; const f32x4* wr = (const f32x4*)nw + lane;
            f32x4 v[4]; float s = 0.f;
#pragma unroll
            for (int j = 0; j < 4; ++j) { v[j] = xr[64 * j]; s += (v[j][0] * v[j][0] + v[j][1] * v[j][1]) + (v[j][2] * v[j][2] + v[j][3] * v[j][3]); }
            const float rstd = rsqrtf(wave_sum(s) * (1.f / DM) + EPS);
#pragma unroll
            for (int j = 0; j < 4; ++j) { const f32x4 ww = wr[64 * j]; f32x4 r;
#pragma unroll
                for (int i = 0; i < 4; ++i) r[i] = v[j][i] * rstd * ww[i];
                xr[64 * j] = r; }
        }
    }
#undef A_
    if (PROBE_SEL) { const unsigned long long t0 = rt(); while (rt() - t0 < probe_acc) __builtin_amdgcn_s_sleep(8); }
}

extern "C" void kernel_launch(void* const* d_in, const int* in_sizes, int n_in, void* d_out, int out_size, void* d_ws, size_t ws_size, hipStream_t stream) {
    static int grid = 0;
    if (grid == 0) {
        if (n_in != 19 || out_size != MT * DM || ws_size < WS_NEED) { fprintf(stderr, "kernel_launch: unexpected shapes (n_in %d out %d ws %zu need %zu)\n", n_in, out_size, ws_size, (size_t)WS_NEED); grid = -1; return; }
        int dev = 0, cus = 0, per_cu = 0;
        hipGetDevice(&dev); hipDeviceGetAttribute(&cus, hipDeviceAttributeMultiprocessorCount, dev);
        if (hipFuncSetAttribute((const void*)hybrid_fwd, hipFuncAttributeMaxDynamicSharedMemorySize, LDS_BYTES) != hipSuccess) { fprintf(stderr, "kernel_launch: hipFuncSetAttribute failed\n"); grid = -1; return; }
        if (hipOccupancyMaxActiveBlocksPerMultiprocessor(&per_cu, (const void*)hybrid_fwd, NTHREADS, LDS_BYTES) != hipSuccess || per_cu < 1) { fprintf(stderr, "kernel_launch: occupancy query gave %d\n", per_cu); per_cu = 1; }
        (void)hipGetLastError();
        grid = cus * per_cu;
    }
    if (grid < 0) return;
    if (hipMemsetAsync((char*)d_ws + WS_CTL, 0, CTL_BYTES, stream) != hipSuccess) { fprintf(stderr, "kernel_launch: memset of the control words failed\n"); return; }
    Args a{};
    for (int i = 0; i < 19; ++i) a.in[i] = (const float*)d_in[i];
    a.out = (float*)d_out; a.ws = (unsigned char*)d_ws;
    void* args[] = {&a};
    hipError_t e = hipLaunchCooperativeKernel((const void*)hybrid_fwd, dim3(grid), dim3(NTHREADS), args, LDS_BYTES, stream);
    if (e != hipSuccess) fprintf(stderr, "cooperative launch failed: %s (grid %d)\n", hipGetErrorString(e), grid);
}
```

```cpp
#include <hip/hip_runtime.h>
#include <hip/hip_cooperative_groups.h>
#include <cstdio>
#include <cstdint>
namespace cg = cooperative_groups;
__device__ __forceinline__ int opaque_tid() { int t = (int)threadIdx.x; asm volatile("" : "+v"(t)); return t; }
namespace pg8 {
#define PG8_LAS __attribute__((address_space(3)))
typedef unsigned short bf16_t;
typedef short bf16x8 __attribute__((ext_vector_type(8)));
typedef float f32x4 __attribute__((ext_vector_type(4)));
typedef unsigned u32x4 __attribute__((ext_vector_type(4)));
constexpr int BM = 256, BK = 64, HALF = 128, HTB = HALF * BK * 2  , STAGE_BYTES = 8 * HTB, NXCD = 8, WGM = 8;

__host__ __device__ __forceinline__ int lds_byte(int r, int c) { const int st = (r >> 4) * 2 + (c >> 5), rr = r & 15, cc = c & 31, ob = rr * 64 + cc * 2; return st * 1024 + (ob ^ (((ob >> 9) & 1) << 5)); }
__host__ __device__ __forceinline__ void stage_rc(int b, int& R, int& C) { const int st = b / 1024, sb = b % 1024, swz = sb ^ (((sb >> 9) & 1) << 5); R = (st >> 1) * 16 + swz / 64; C = (st & 1) * 32 + (swz % 64) / 2; }
__host__ __device__ __forceinline__ int perm32(int rho) { const int n = rho >> 4, i = rho & 15; return 8 * (i >> 2) + 4 * n + (i & 3); }

struct Unit { int pm, pn; };
struct Gemm { const bf16_t* A; const bf16_t* Bt; int M, N, K; };

struct StaticOrder {
    int nM, nN, nwg, G, c;
    __host__ __device__ void init(int M, int N, int G_, int c_) { nM = M / BM; nN = N / BM; nwg = nM * nN; G = G_; c = c_; }
    __host__ __device__ bool next(int i, Unit& u) const {
        const long L = (long)i * G + c; if (L >= nwg) return false;
        int wgid = (int)L; { const int q = nwg / NXCD, r = nwg % NXCD, xcd = wgid % NXCD, off = wgid / NXCD; wgid = (xcd < r ? xcd * (q + 1) : r * (q + 1) + (xcd - r) * q) + off; }
        const int nig = WGM * nN, gid = wgid / nig, fm = gid * WGM, gsz = (nM - fm) < WGM ? (nM - fm) : WGM;
        u.pm = fm + ((wgid % nig) % gsz); u.pn = (wgid % nig) / gsz; return true;
    }
    __device__ __forceinline__ void a_ready(const Unit&) const {}
    __device__ __forceinline__ void done(const Unit&) const {}
};
__device__ __forceinline__ unsigned cvt_pk_bf16(float lo, float hi) { unsigned r; asm volatile("v_cvt_pk_bf16_f32 %0, %1, %2" : "=v"(r) : "v"(lo), "v"(hi)); return r; }
template <class Epi, class Sched, bool ALIGN_EPI = false, bool SP2 = false>
__device__ __forceinline__ void gemm_phase(PG8_LAS unsigned char* lds, const Gemm g, const Sched& S, const Epi& E) {
    const int tid = opaque_tid(), wid = __builtin_amdgcn_readfirstlane(tid >> 6), lane = tid & 63, wr = wid >> 2, wc = wid & 3, fr = lane & 15, fq = lane >> 4;
    const int K = g.K, nt = K / BK;
    unsigned voffA[2], voffB[2];
#pragma unroll
    for (int i = 0; i < 2; ++i) { int R, C; stage_rc(tid * 16 + i * 8192, R, C); const int Rb = Epi::PERM ? ((R & ~31) + perm32(R & 31)) : R;
        voffA[i] = (unsigned)(R * K + C) * 2u; voffB[i] = (unsigned)(Rb * K + C) * 2u; }
    const size_t kstep = (size_t)(BK * 2);
    const size_t hstep = (size_t)HALF * K * 2;
    const size_t tstep = 2 * hstep;
    const unsigned ldsw = (unsigned)wid * 1024u;
    const int aoff = lds_byte(wr * 64 + fr, fq * 8), boff = lds_byte(wc * 32 + fr, fq * 8);
#define PG8_SA(b, h) (((b) * 2 + (h)) * HTB)
#define PG8_SB(b, h) ((4 + (b) * 2 + (h)) * HTB)
#define PG8_STAGE(bufoff, gbase, voff) do { _Pragma("unroll") for (int _i = 0; _i < 2; ++_i) \
        __builtin_amdgcn_global_load_lds((const unsigned*)((const char*)(gbase) + (voff)[_i]), (PG8_LAS unsigned*)(lds + (bufoff) + ldsw + _i * 8192), 16, 0, 0); } while (0)
#define PG8_LDA(dst, b, h) do { _Pragma("unroll") for (int m = 0; m < 4; ++m) _Pragma("unroll") for (int k = 0; k < 2; ++k) dst[m][k] = *(const PG8_LAS bf16x8*)(lds + PG8_SA(b, h) + aoff + m * 2048 + k * 1024); } while (0)
#define PG8_LDB(dst, b, h) do { _Pragma("unroll") for (int n = 0; n < 2; ++n) _Pragma("unroll") for (int k = 0; k < 2; ++k) dst[n][k] = *(const PG8_LAS bf16x8*)(lds + PG8_SB(b, h) + boff + n * 2048 + k * 1024); } while (0)
#define PG8_MMA(ai, bj, At, Bt) do { __builtin_amdgcn_s_setprio(1); _Pragma("unroll") for (int m = 0; m < 4; ++m) _Pragma("unroll") for (int n = 0; n < 2; ++n) _Pragma("unroll") for (int k = 0; k < 2; ++k) \
        acc[ai][bj][m][n] = __builtin_amdgcn_mfma_f32_16x16x32_bf16(Bt[n][k], At[m][k], acc[ai][bj][m][n], 0, 0, 0); __builtin_amdgcn_s_setprio(0); } while (0)
#define PG8_WAIT_V(n) asm volatile("s_waitcnt vmcnt(" #n ")" ::: "memory")
#define PG8_WAIT_L(n) asm volatile("s_waitcnt lgkmcnt(" #n ")" ::: "memory")
#define PG8_BAR __builtin_amdgcn_s_barrier()
#define PG8_SCHED __builtin_amdgcn_sched_barrier(0)
    Unit cur, nxt; int ui = 0;
    if (!S.next(0, cur)) return;
    f32x4 acc[2][2][4][2];
#pragma unroll
    for (int a = 0; a < 2; ++a)
#pragma unroll
        for (int b = 0; b < 2; ++b)
#pragma unroll
            for (int m = 0; m < 4; ++m)
#pragma unroll
                for (int n = 0; n < 2; ++n) acc[a][b][m][n] = (f32x4){0.f, 0.f, 0.f, 0.f};
    bf16x8 At[4][2], B0[2][2], B1[2][2];
    const char* cA = (const char*)g.A + (size_t)cur.pm * tstep; const char* cB = (const char*)g.Bt + (size_t)cur.pn * tstep;
    S.a_ready(cur);
    if constexpr (SP2) {
        PG8_STAGE(PG8_SB(0, 0), cB, voffB); PG8_STAGE(PG8_SB(0, 1), cB + hstep, voffB); PG8_STAGE(PG8_SA(0, 0), cA, voffA); PG8_STAGE(PG8_SA(0, 1), cA + hstep, voffA);
        if (wr == 1) PG8_BAR;
        PG8_WAIT_V(2); PG8_BAR;
        PG8_STAGE(PG8_SB(1, 0), cB + kstep, voffB); PG8_STAGE(PG8_SA(1, 0), cA + kstep, voffA); PG8_STAGE(PG8_SB(1, 1), cB + hstep + kstep, voffB);
        PG8_WAIT_V(6); PG8_BAR;
    } else {
        PG8_STAGE(PG8_SB(0, 0), cB, voffB); PG8_STAGE(PG8_SA(0, 0), cA, voffA); PG8_STAGE(PG8_SB(0, 1), cB + hstep, voffB); PG8_STAGE(PG8_SA(0, 1), cA + hstep, voffA);
        if (wr == 1) PG8_BAR;
        PG8_WAIT_V(4); PG8_BAR;
        PG8_STAGE(PG8_SB(1, 0), cB + kstep, voffB); PG8_STAGE(PG8_SA(1, 0), cA + kstep, voffA); PG8_STAGE(PG8_SB(1, 1), cB + hstep + kstep, voffB);
        PG8_WAIT_V(6); PG8_BAR;
    }
    for (;;) {
        const bool has_next = S.next(ui + 1, nxt);
        const char* nA = has_next ? (const char*)g.A + (size_t)nxt.pm * tstep : cA; const char* nB = has_next ? (const char*)g.Bt + (size_t)nxt.pn * tstep : cB;
        for (int t = 0; t < nt; t += 2) {
            const bool last = (t == nt - 2);
            const char* a1 = cA + (size_t)(t + 1) * kstep;
            const char* a2 = last ? nA : cA + (size_t)(t + 2) * kstep; const char* b2 = last ? nB : cB + (size_t)(t + 2) * kstep;
            const char* a3 = a2 + kstep; const char* b3 = b2 + kstep;
            if (last && has_next) S.a_ready(nxt);
            if constexpr (SP2) {
            PG8_LDB(B0, 0, 0); PG8_LDB(B1, 0, 1); PG8_SCHED; PG8_LDA(At, 0, 0); PG8_STAGE(PG8_SA(1, 1), a1 + hstep, voffA);
            PG8_WAIT_V(8); PG8_WAIT_L(0); PG8_BAR; PG8_MMA(0, 0, At, B0); PG8_MMA(0, 1, At, B1); PG8_BAR; PG8_SCHED;
            PG8_LDA(At, 0, 1); PG8_STAGE(PG8_SB(0, 0), b2, voffB); PG8_STAGE(PG8_SB(0, 1), b2 + hstep, voffB); PG8_STAGE(PG8_SA(0, 0), a2, voffA);
            PG8_WAIT_V(8); PG8_WAIT_L(0); PG8_BAR; PG8_MMA(1, 0, At, B0); PG8_MMA(1, 1, At, B1); PG8_BAR; PG8_SCHED;
            PG8_LDB(B0, 1, 0); PG8_LDB(B1, 1, 1); PG8_SCHED; PG8_LDA(At, 1, 0); PG8_STAGE(PG8_SA(0, 1), a2 + hstep, voffA);
            PG8_WAIT_V(8); PG8_WAIT_L(0); PG8_BAR; PG8_MMA(0, 0, At, B0); PG8_MMA(0, 1, At, B1); PG8_BAR; PG8_SCHED;
            PG8_LDA(At, 1, 1); PG8_STAGE(PG8_SB(1, 0), b3, voffB); PG8_STAGE(PG8_SB(1, 1), b3 + hstep, voffB); PG8_STAGE(PG8_SA(1, 0), a3, voffA);
            PG8_WAIT_V(8); PG8_WAIT_L(0); PG8_BAR; PG8_MMA(1, 0, At, B0); PG8_MMA(1, 1, At, B1); PG8_BAR; PG8_SCHED;
            } else {
            PG8_LDB(B0, 0, 0); PG8_SCHED; PG8_LDA(At, 0, 0); PG8_STAGE(PG8_SA(1, 1), a1 + hstep, voffA);
            PG8_WAIT_L(8); PG8_BAR; PG8_WAIT_L(0); PG8_MMA(0, 0, At, B0); PG8_BAR; PG8_SCHED;
            PG8_LDB(B1, 0, 1); PG8_STAGE(PG8_SB(0, 0), b2, voffB);
            PG8_BAR; PG8_WAIT_L(0); PG8_MMA(0, 1, At, B1); PG8_BAR;
            PG8_LDA(At, 0, 1); PG8_STAGE(PG8_SA(0, 0), a2, voffA);
            PG8_BAR; PG8_WAIT_L(0); PG8_MMA(1, 0, At, B0); PG8_BAR; PG8_SCHED;
            PG8_STAGE(PG8_SB(0, 1), b2 + hstep, voffB);
            PG8_WAIT_V(6); PG8_BAR; PG8_MMA(1, 1, At, B1); PG8_BAR;
            PG8_LDB(B0, 1, 0); PG8_SCHED; PG8_LDA(At, 1, 0); PG8_STAGE(PG8_SA(0, 1), a2 + hstep, voffA);
            PG8_WAIT_L(8); PG8_BAR; PG8_WAIT_L(0); PG8_MMA(0, 0, At, B0); PG8_BAR; PG8_SCHED;
            PG8_LDB(B1, 1, 1); PG8_STAGE(PG8_SB(1, 0), b3, voffB);
            PG8_BAR; PG8_WAIT_L(0); PG8_MMA(0, 1, At, B1); PG8_BAR;
            PG8_LDA(At, 1, 1); PG8_STAGE(PG8_SA(1, 0), a3, voffA);
            PG8_BAR; PG8_WAIT_L(0); PG8_MMA(1, 0, At, B0); PG8_BAR; PG8_SCHED;
            PG8_STAGE(PG8_SB(1, 1), b3 + hstep, voffB);
            PG8_WAIT_V(6); PG8_BAR; PG8_MMA(1, 1, At, B1); PG8_BAR;
            }
        }
        if constexpr (ALIGN_EPI) { if (wr == 0) PG8_BAR; }
        if constexpr (!Epi::AFTER_DRAIN) { E(acc, cur, wr, wc, fr, fq); S.done(cur); }
        if (!has_next) break;
#pragma unroll
        for (int a = 0; a < 2; ++a)
#pragma unroll
            for (int b = 0; b < 2; ++b)
#pragma unroll
                for (int m = 0; m < 4; ++m)
#pragma unroll
                    for (int n = 0; n < 2; ++n) acc[a][b][m][n] = (f32x4){0.f, 0.f, 0.f, 0.f};
        cur = nxt; cA = nA; cB = nB; ++ui;
        if constexpr (ALIGN_EPI) { if (wr == 1) PG8_BAR; }
    }
    PG8_WAIT_V(0);
    if constexpr (!ALIGN_EPI) { if (wr == 0) PG8_BAR; }
    PG8_BAR;
    if constexpr (Epi::AFTER_DRAIN) { E.fused(acc, cur, wr, wc, fr, fq, lds, wid, lane); S.done(cur); }
#undef PG8_SA
#undef PG8_SB
#undef PG8_STAGE
#undef PG8_LDA
#undef PG8_LDB
#undef PG8_MMA
#undef PG8_WAIT_V
#undef PG8_WAIT_L
#undef PG8_BAR
#undef PG8_SCHED
}
}

constexpr int NB = 8, SEQ = 2048, DM = 1024, MT = NB * SEQ, DFF = 4096, IN_DIM = 13344;
constexpr int NTHREADS = 512, NWAVES = 8, LDS_BYTES = 147456;
constexpr float EPS = 1e-6f;
typedef unsigned short bf16;
typedef unsigned v4u __attribute__((ext_vector_type(4)));
typedef unsigned v2u __attribute__((ext_vector_type(2)));
typedef float f32x4 __attribute__((ext_vector_type(4)));
typedef short bf16x8 __attribute__((ext_vector_type(8)));
enum { B_H = 0, B_DNG = 1, B_SBQ = 2, B_SSZ = 3, B_DNQ = 4, B_DNK = 5, B_DNV = 6, B_SBK = 7, B_SBV = 8, B_SSX = 9, B_SSBC = 10, NBUF = 11 };
constexpr size_t BUFE = (size_t)MT * DM;
constexpr size_t WS_W = NBUF * BUFE * 2;
constexpr size_t W_IN = 0, W_G = W_IN + (size_t)10240 * 1024, W_OUT = W_G + (size_t)6144 * 1024, W_UP = W_OUT + (size_t)1024 * 1024,
                 W_DOWN = W_UP + (size_t)4096 * 1024, W_END = W_DOWN + (size_t)4096 * 1024;
constexpr size_t WS_SMALL = WS_W + W_END * 2;
constexpr size_t WS_CTL = WS_SMALL + (size_t)MT * 64 * 4;
constexpr size_t WS_BAR = WS_CTL + 4096;
constexpr size_t CTL_BYTES = 4096 + 16384;
constexpr size_t WS_NEED = WS_CTL + CTL_BYTES;

__device__ __forceinline__ float bf2f(unsigned u) { return __builtin_bit_cast(float, u << 16); }
__device__ __forceinline__ unsigned f2bf(float f) { unsigned u = __builtin_bit_cast(unsigned, f); return (u + 0x7fffu + ((u >> 16) & 1u)) >> 16; }
typedef float f32x2 __attribute__((ext_vector_type(2)));
typedef __bf16 bf16x2_t __attribute__((ext_vector_type(2)));
__device__ __forceinline__ unsigned pk2(float lo, float hi) { f32x2 v = {lo, hi}; return __builtin_bit_cast(unsigned, __builtin_convertvector(v, bf16x2_t)); }
__device__ __forceinline__ void unpack8(v4u r, float* o) {
    o[0] = bf2f(r.x & 0xffffu); o[1] = __builtin_bit_cast(float, r.x & 0xffff0000u); o[2] = bf2f(r.y & 0xffffu); o[3] = __builtin_bit_cast(float, r.y & 0xffff0000u);
    o[4] = bf2f(r.z & 0xffffu); o[5] = __builtin_bit_cast(float, r.z & 0xffff0000u); o[6] = bf2f(r.w & 0xffffu); o[7] = __builtin_bit_cast(float, r.w & 0xffff0000u);
}
__device__ __forceinline__ v4u pack8(const float* v) { v4u w; w.x = pk2(v[0], v[1]); w.y = pk2(v[2], v[3]); w.z = pk2(v[4], v[5]); w.w = pk2(v[6], v[7]); return w; }
__device__ __forceinline__ float sigmoidf_(float x) { return __builtin_amdgcn_rcpf(1.f + __expf(-x)); }
__device__ __forceinline__ float siluf_(float x) { return x * __builtin_amdgcn_rcpf(1.f + __expf(-x)); }
__device__ __forceinline__ float softplusf_(float x) { return fmaxf(x, 0.f) + log1pf(__expf(-fabsf(x))); }
template <int CTRL> __device__ __forceinline__ float dppf(float v) { return __builtin_bit_cast(float, __builtin_amdgcn_update_dpp(0, __builtin_bit_cast(int, v), CTRL, 0xF, 0xF, true)); }
__device__ __forceinline__ float red8(float v) { v += dppf<0xB1>(v); v += dppf<0x4E>(v); v += dppf<0x141>(v); return v; }
__device__ __forceinline__ float red16(float v) { v = red8(v); v += dppf<0x140>(v); return v; }
__device__ __forceinline__ float wave_sum(float v) {
#pragma unroll
    for (int o = 1; o < 64; o <<= 1) v += __shfl_xor(v, o);
    return v;
}
#define LDS_WAIT() asm volatile("s_waitcnt lgkmcnt(0)" ::: "memory")

struct Args { const float* in[19]; float* out; unsigned char* ws; };
typedef const __attribute__((address_space(4))) Args& CArgsR;
__device__ __forceinline__ const __attribute__((address_space(4))) Args* kargs() { unsigned long long v = (unsigned long long)__builtin_amdgcn_kernarg_segment_ptr(); asm volatile("" : "+s"(v)); return (const __attribute__((address_space(4))) Args*)v; }
#ifndef PROBE_SEL
#define PROBE_SEL 0
#endif
__device__ __forceinline__ unsigned long long rt() { return __builtin_amdgcn_s_memrealtime(); }
#define PT0() unsigned long long pt_ = PROBE_SEL ? rt() : 0ull
#define PT1(k) do { if (PROBE_SEL & (1 << (k))) probe_acc += rt() - pt_; } while (0)

struct EpiRoute {
    static constexpr bool PERM = true, AFTER_DRAIN = false;
    bf16* base;
    __device__ __forceinline__ void operator()(const pg8::f32x4 (&acc)[2][2][4][2], const pg8::Unit& u, int wr, int wc, int fr, int fq) const {
        bf16* O = base + (size_t)(1 + (u.pn >> 2)) * BUFE;
        const int col0 = (u.pn & 3) * 256 + wc * 32 + 8 * fq, row0 = u.pm * 256 + wr * 64 + fr;
#pragma unroll
        for (int ai = 0; ai < 2; ++ai)
#pragma unroll
            for (int m = 0; m < 4; ++m) { bf16* rowp = O + (size_t)(row0 + ai * 128 + m * 16) * DM + col0;
#pragma unroll
                for (int bj = 0; bj < 2; ++bj) { const pg8::f32x4 v0 = acc[ai][bj][m][0], v1 = acc[ai][bj][m][1];
                    v4u w; w.x = pk2(v0[0], v0[1]); w.y = pk2(v0[2], v0[3]); w.z = pk2(v1[0], v1[1]); w.w = pk2(v1[2], v1[3]);
                    *(v4u*)(rowp + bj * 128) = w; } }
    }
};
struct EpiRelu2 {
    static constexpr bool PERM = true, AFTER_DRAIN = false;
    bf16* O;
    __device__ __forceinline__ void operator()(const pg8::f32x4 (&acc)[2][2][4][2], const pg8::Unit& u, int wr, int wc, int fr, int fq) const {
        const int col0 = u.pn * 256 + wc * 32 + 8 * fq, row0 = u.pm * 256 + wr * 64 + fr;
#pragma unroll
        for (int ai = 0; ai < 2; ++ai)
#pragma unroll
            for (int m = 0; m < 4; ++m) { bf16* rowp = O + (size_t)(row0 + ai * 128 + m * 16) * DFF + col0;
#pragma unroll
                for (int bj = 0; bj < 2; ++bj) { float v[8];
#pragma unroll
                    for (int i = 0; i < 4; ++i) { float a = fmaxf(acc[ai][bj][m][0][i], 0.f), b = fmaxf(acc[ai][bj][m][1][i], 0.f); v[i] = a * a; v[4 + i] = b * b; }
                    *(v4u*)(rowp + bj * 128) = pack8(v); } }
    }
};
struct EpiResid {
    static constexpr bool PERM = true, AFTER_DRAIN = false;
    const float* xin; float* xout;
    __device__ __forceinline__ void operator()(const pg8::f32x4 (&acc)[2][2][4][2], const pg8::Unit& u, int wr, int wc, int fr, int fq) const {
        const int col0 = u.pn * 256 + wc * 32 + 8 * fq, row0 = u.pm * 256 + wr * 64 + fr;
#pragma unroll
        for (int ai = 0; ai < 2; ++ai)
#pragma unroll
            for (int m = 0; m < 4; ++m) { const size_t ro = (size_t)(row0 + ai * 128 + m * 16) * DM + col0;
#pragma unroll
                for (int bj = 0; bj < 2; ++bj) { const size_t o = ro + bj * 128;
                    const f32x4 a = *(const f32x4*)(xin + o), b = *(const f32x4*)(xin + o + 4);
                    f32x4 r0, r1;
#pragma unroll
                    for (int i = 0; i < 4; ++i) { r0[i] = a[i] + acc[ai][bj][m][0][i]; r1[i] = b[i] + acc[ai][bj][m][1][i]; }
                    *(f32x4*)(xout + o) = r0; *(f32x4*)(xout + o + 4) = r1; } }
    }
};
struct SchedGate {
    int G, c;
    __device__ __forceinline__ bool next(int i, pg8::Unit& u) const {
        const int tile = c + (i / 6) * G; if (tile >= 256) return false;
        const int s = i % 6, br = s >> 1, pm = tile >> 2, pn = tile & 3;
        if ((s & 1) == 0) { u.pm = pm; u.pn = br * 4 + pn; } else { u.pm = (1 + br) * 64 + pm; u.pn = (3 + br) * 4 + pn; }
        return true;
    }
    __device__ __forceinline__ void a_ready(const pg8::Unit&) const {}
    __device__ __forceinline__ void done(const pg8::Unit&) const {}
};
struct EpiGate {
    static constexpr bool PERM = true, AFTER_DRAIN = false;
    bf16* gsc; float* macc; bf16* merged;
    __device__ __forceinline__ void operator()(const pg8::f32x4 (&acc)[2][2][4][2], const pg8::Unit& u, int wr, int wc, int fr, int fq) const {
        const int j = u.pn >> 2, pn = u.pn & 3, pm = u.pm & 63;
        const int col0 = pn * 256 + wc * 32 + 8 * fq, row0 = pm * 256 + wr * 64 + fr;
#pragma unroll
        for (int ai = 0; ai < 2; ++ai)
#pragma unroll
            for (int m = 0; m < 4; ++m) { const size_t ro = (size_t)(row0 + ai * 128 + m * 16) * DM + col0;
#pragma unroll
                for (int bj = 0; bj < 2; ++bj) { const size_t o = ro + bj * 128; float v[8];
#pragma unroll
                    for (int i = 0; i < 4; ++i) { v[i] = acc[ai][bj][m][0][i]; v[4 + i] = acc[ai][bj][m][1][i]; }
                    if (j < 3) {
#pragma unroll
                        for (int i = 0; i < 8; ++i) v[i] = sigmoidf_(v[i]);
                        *(v4u*)(gsc + o) = pack8(v);
                    } else {
                        float g[8]; unpack8(*(const v4u*)(gsc + o), g);
#pragma unroll
                        for (int i = 0; i < 8; ++i) v[i] *= g[i];
                        if (j > 3) { const f32x4 a = *(const f32x4*)(macc + o), b = *(const f32x4*)(macc + o + 4);
#pragma unroll
                            for (int i = 0; i < 4; ++i) { v[i] += a[i]; v[4 + i] += b[i]; } }
                        if (j < 5) { *(f32x4*)(macc + o) = (f32x4){v[0], v[1], v[2], v[3]}; *(f32x4*)(macc + o + 4) = (f32x4){v[4], v[5], v[6], v[7]}; }
                        else *(v4u*)(merged + o) = pack8(v);
                    } } }
    }
};

__device__ __forceinline__ void transpose_item(const float* __restrict__ W, const float* __restrict__ W2, int ldw, bf16* __restrict__ WT, int K, int nblk, float* scr, int item, int lane) {
    const int kb = item / nblk, nb = item % nblk, k0 = 64 * kb, n0 = 32 * nb;
    const float* src = ((lane & 31) < 16 ? W : W2) + (size_t)(k0 + (lane >> 5)) * ldw + n0 + (lane & 31);
    float t[32];
#pragma unroll
    for (int i = 0; i < 32; ++i) t[i] = src[(size_t)(2 * i) * ldw];
#pragma unroll
    for (int i = 0; i < 32; ++i) scr[(2 * i + (lane >> 5)) * 33 + (lane & 31)] = t[i];
    LDS_WAIT();
    const int c = lane & 7;
#pragma unroll
    for (int j = 0; j < 4; ++j) { const int n = (lane >> 3) + 8 * j; const float* s = scr + (8 * c) * 33 + n;
        v4u o; o.x = pk2(s[0 * 33], s[1 * 33]); o.y = pk2(s[2 * 33], s[3 * 33]); o.z = pk2(s[4 * 33], s[5 * 33]); o.w = pk2(s[6 * 33], s[7 * 33]);
        *(v4u*)(WT + (size_t)(n0 + n) * K + k0 + 8 * c) = o; }
    LDS_WAIT();
}
__device__ __forceinline__ void rms_row_to_bf16(const float* xrow, const float* w, bf16* orow, int lane) {
    const f32x4* xr = (const f32x4*)xrow + lane; const f32x4* wr = (const f32x4*)w + lane;
    f32x4 v[4]; float s = 0.f;
#pragma unroll
    for (int j = 0; j < 4; ++j) { v[j] = xr[64 * j]; s += (v[j][0] * v[j][0] + v[j][1] * v[j][1]) + (v[j][2] * v[j][2] + v[j][3] * v[j][3]); }
    const float rstd = rsqrtf(wave_sum(s) * (1.f / DM) + EPS);
    unsigned long long* o8 = (unsigned long long*)orow + lane;
#pragma unroll
    for (int j = 0; j < 4; ++j) { const f32x4 ww = wr[64 * j];
        o8[64 * j] = (unsigned long long)pk2(v[j][0] * rstd * ww[0], v[j][1] * rstd * ww[1]) | ((unsigned long long)pk2(v[j][2] * rstd * ww[2], v[j][3] * rstd * ww[3]) << 32); }
}
__device__ __forceinline__ void phase0(unsigned char* lds, CArgsR a, int l, const float* xin) {
    constexpr int LDW = 1032;
    const int tid = opaque_tid(), lane = tid & 63, wave = __builtin_amdgcn_readfirstlane(tid >> 6), gw = blockIdx.x * NWAVES + wave, NGW = gridDim.x * NWAVES;
    bf16* Wreg = (bf16*)(a.ws + WS_W);
    const float* w_in = a.in[2] + (size_t)l * DM * IN_DIM;
    {
        float* scr = (float*)lds + wave * (64 * 33);
        const float* w_br = a.in[13] + (size_t)l * 3 * DM * DM; const float* w_out = a.in[14] + (size_t)l * DM * DM;
        const float* w_up = a.in[16] + (size_t)l * DM * DFF; const float* w_down = a.in[17] + (size_t)l * DFF * DM;
        constexpr int NSEG = 17, NIT = NSEG * 512 + 2048 + 2048;
        for (int it = gw; it < NIT; it += NGW) {
            if (it < NSEG * 512) {
                const int seg = it >> 9, r = it & 511;
                const float* W; int ldw; bf16* WT;
                if (seg < 13) {
                    const int co = seg == 0 ? 3072 : seg == 1 ? 4112 : seg == 2 ? 7184 : seg == 3 ? 0 : seg == 4 ? 1024 : seg == 5 ? 2048 : seg == 6 ? 5136 : seg == 7 ? 6160 : seg == 8 ? 8208 : seg == 9 ? 9232
                                 : 10272 + (seg - 10) * 1024;
                    W = w_in + co; ldw = IN_DIM; WT = seg < 10 ? Wreg + (size_t)seg * DM * DM : Wreg + W_G + (size_t)(seg - 10) * DM * DM;
                } else if (seg < 16) { W = w_br + (size_t)(seg - 13) * DM * DM; ldw = DM; WT = Wreg + W_G + (size_t)(3 + seg - 13) * DM * DM; }
                else { W = w_out; ldw = DM; WT = Wreg + W_OUT; }
                transpose_item(W, W, ldw, WT, DM, 32, scr, r, lane);
            } else if (it < NSEG * 512 + 2048) transpose_item(w_up, w_up, DFF, Wreg + W_UP, DM, 128, scr, it - NSEG * 512, lane);
            else transpose_item(w_down, w_down, DM, Wreg + W_DOWN, DFF, 32, scr, it - NSEG * 512 - 2048, lane);
        }
    }
    __syncthreads();
    bf16* WsT = (bf16*)lds;
    for (int idx = tid; idx < 32 * DM; idx += NTHREADS) { const int k = idx >> 5, c = idx & 31; WsT[c * LDW + k] = (bf16)f2bf(w_in[(size_t)k * IN_DIM + (c < 16 ? 4096 + c : 10256 + c - 16)]); }
    __syncthreads();
    {   const float* nw = a.in[1] + (size_t)l * DM; bf16* H = (bf16*)a.ws; float* small = (float*)(a.ws + WS_SMALL);
        const int fr = lane & 15, fq = lane >> 4;
        const float pa0 = __expf(a.in[4][l * 8 + (fr & 7)]), pb0 = a.in[5][l * 8 + (fr & 7)], pa1 = __expf(a.in[9][l * 16 + fr]), pb1 = a.in[10][l * 16 + fr];
        for (int g8 = gw; g8 < MT / 8; g8 += NGW) {
            const int r0 = g8 * 8;
#pragma unroll 1
            for (int r = 0; r < 8; ++r) rms_row_to_bf16(xin + (size_t)(r0 + r) * DM, nw, H + (size_t)(r0 + r) * DM, lane);
            asm volatile("s_waitcnt vmcnt(0)" ::: "memory");
            f32x4 c0 = {0.f, 0.f, 0.f, 0.f}, c1 = {0.f, 0.f, 0.f, 0.f};
            const bf16* ap = H + (size_t)(r0 + (fr & 7)) * DM + fq * 8;
#pragma unroll
            for (int kb = 0; kb < 4; ++kb) { bf16x8 af[8];
#pragma unroll
                for (int k = 0; k < 8; ++k) af[k] = *(const bf16x8*)(ap + (kb * 8 + k) * 32);
#pragma unroll
                for (int k = 0; k < 8; ++k) { const bf16x8 b0 = *(const bf16x8*)(WsT + fr * LDW + (kb * 8 + k) * 32 + fq * 8), b1 = *(const bf16x8*)(WsT + (16 + fr) * LDW + (kb * 8 + k) * 32 + fq * 8);
                    c0 = __builtin_amdgcn_mfma_f32_16x16x32_bf16(af[k], b0, c0, 0, 0, 0); c1 = __builtin_amdgcn_mfma_f32_16x16x32_bf16(af[k], b1, c1, 0, 0, 0); } }
            if (fq < 2) {
#pragma unroll
                for (int jj = 0; jj < 4; ++jj) { float* sp = small + (size_t)(r0 + 4 * fq + jj) * 64;
                    sp[fr] = fr < 8 ? -pa0 * softplusf_(c0[jj] + pb0) : sigmoidf_(c0[jj]);
                    const float dt = softplusf_(c1[jj] + pb1); sp[16 + fr] = dt; sp[32 + fr] = -pa1 * dt; } }
        }
    }
}

__device__ __forceinline__ void conv8(const bf16* p, int pos, const float* w, int wstride, const float* bias, float* out) {
    float acc[8];
#pragma unroll
    for (int i = 0; i < 8; ++i) acc[i] = bias ? bias[i] : 0.f;
#pragma unroll
    for (int j = 0; j < 4; ++j) { const int back = 3 - j;
        if (pos - back >= 0) { float xv[8]; unpack8(*(const v4u*)(p - (size_t)back * DM), xv);
            const f32x4 w0 = *(const f32x4*)(w + j * wstride), w1 = *(const f32x4*)(w + j * wstride + 4);
#pragma unroll
            for (int i = 0; i < 4; ++i) { acc[i] += xv[i] * w0[i]; acc[4 + i] += xv[4 + i] * w1[i]; } } }
#pragma unroll
    for (int i = 0; i < 8; ++i) out[i] = siluf_(acc[i]);
}

__device__ __forceinline__ void conv8r(const v4u (&raw)[4], const float* w, int wstride, const float* bias, float* out) {
    float acc[8];
#pragma unroll
    for (int i = 0; i < 8; ++i) acc[i] = bias ? bias[i] : 0.f;
#pragma unroll
    for (int j = 0; j < 4; ++j) { float xv[8]; unpack8(raw[j], xv);
        const f32x4 w0 = *(const f32x4*)(w + j * wstride), w1 = *(const f32x4*)(w + j * wstride + 4);
#pragma unroll
        for (int i = 0; i < 4; ++i) { acc[i] += xv[i] * w0[i]; acc[4 + i] += xv[4 + i] * w1[i]; } }
#pragma unroll
    for (int i = 0; i < 8; ++i) out[i] = siluf_(acc[i]);
}
#define LOAD4(dst, p, pos) do { _Pragma("unroll") for (int j_ = 0; j_ < 4; ++j_) { const int back_ = 3 - j_; const bool ok_ = (pos) - back_ >= 0; \
        const v4u t_ = *(const v4u*)((p) - (size_t)(ok_ ? back_ : 0) * DM); dst[j_] = ok_ ? t_ : (v4u){0u, 0u, 0u, 0u}; } } while (0)

template <int K> __device__ __forceinline__ void mma16(f32x4& acc, const bf16* Ap, int lda, const bf16* Bp, int ldb, int fr, int fq) {
    bf16x8 af[K / 32], bfv[K / 32];
#pragma unroll
    for (int k = 0; k < K / 32; ++k) { af[k] = *(const bf16x8*)(Ap + fr * lda + k * 32 + fq * 8); bfv[k] = *(const bf16x8*)(Bp + fr * ldb + k * 32 + fq * 8); }
#pragma unroll
    for (int k = 0; k < K / 32; ++k) acc = __builtin_amdgcn_mfma_f32_16x16x32_bf16(af[k], bfv[k], acc, 0, 0, 0);
}
__device__ __forceinline__ void dn_item(unsigned char* lds, CArgsR a, int l, int item, unsigned long long& probe_acc) {
    constexpr int LDK = 136, LDJ = 40, LDL = 36;
    const int b = item >> 3, h = item & 7;
    bf16* kA = (bf16*)lds;
    bf16* qA = kA + 32 * LDK;
    bf16* qgA = qA + 32 * LDK;
    bf16* wA = qgA + 32 * LDK;
    bf16* kdT = wA + 32 * LDK;
    bf16* vnT = kdT + 128 * LDJ;
    bf16* attn = vnT + 128 * LDJ;
    bf16* ST = attn + 32 * LDJ;
    float* kf = (float*)(ST + 128 * LDK);
    float* vf = kf + 32 * 128;
    float* os = kf;
    float* Lm = vf + 32 * 128;
    float* gcs = Lm + 32 * LDL;
    float* betas = gcs + 32;
    float* cwL = betas + 32;
    const int tid = opaque_tid(), w = __builtin_amdgcn_readfirstlane(tid >> 6), lane = tid & 63, fr = lane & 15, fq = lane >> 4;
    bf16* base = (bf16*)a.ws;
    const bf16* Q = base + (size_t)B_DNQ * BUFE; const bf16* K = base + (size_t)B_DNK * BUFE; const bf16* V = base + (size_t)B_DNV * BUFE; bf16* G = base + (size_t)B_DNG * BUFE;
    const float* small = (const float*)(a.ws + WS_SMALL);
    const float* cw = a.in[3] + (size_t)l * 4 * 3072;
    const size_t rowbase = (size_t)b * SEQ;
    const int tq = tid >> 4, cq = tid & 15;
    const float* nwp = a.in[6] + l * 128 + cq * 8;
    f32x4 Sacc[8];
#pragma unroll
    for (int i = 0; i < 8; ++i) Sacc[i] = (f32x4){0.f, 0.f, 0.f, 0.f};
    for (int i = tid; i < 128 * LDK / 2; i += NTHREADS) ((unsigned*)ST)[i] = 0u;
    for (int i = tid; i < 4 * 384; i += NTHREADS) { const int j = i / 384, r = i % 384; cwL[i] = cw[j * 3072 + (r >> 7) * 1024 + h * 128 + (r & 127)]; }
    __syncthreads();
    const int ta = ((tid - 256) >> 4) & 15;
    v4u rqa[4], rka[4], rva[4], rqb[4], rkb[4], rvb[4]; float rg = 0.f, rbv = 0.f;
    v4u Pv[2];
    Pv[0] = Pv[1] = (v4u){0u, 0u, 0u, 0u};
#define DN_LOADS_RAW(c_, half_) do { const int pos_ = (c_) * 32 + ta + 16 * (half_); const size_t off_ = (rowbase + pos_) * DM + h * 128 + cq * 8; LOAD4(rqa, Q + off_, pos_); LOAD4(rka, K + off_, pos_); LOAD4(rva, V + off_, pos_); } while (0)
#define DN_LOADS_RAWB(c_) do { const int pos_ = (c_) * 32 + ta + 16; const size_t off_ = (rowbase + pos_) * DM + h * 128 + cq * 8; LOAD4(rqb, Q + off_, pos_); LOAD4(rkb, K + off_, pos_); LOAD4(rvb, V + off_, pos_); } while (0)
#define DN_LOADS_SMALL(c_) do { const int t0_ = (c_) * 32; \
        { const size_t r_ = rowbase + t0_ + (lane & 31); rg = small[r_ * 64 + h]; rbv = small[r_ * 64 + 8 + h]; } } while (0)
#define DN_CONV(rq_, rk_, rv_, slot_) do { const float* cw_ = cwL + cq * 8; asm volatile("" : "+v"(cw_)); \
        { float o8_[8]; conv8r(rq_, cw_, 384, nullptr, o8_); float ss_ = 0.f; _Pragma("unroll") for (int i_ = 0; i_ < 8; ++i_) ss_ += o8_[i_] * o8_[i_]; \
          ss_ = red16(ss_); const float rn_ = rsqrtf(ss_ + EPS) * 0.08838834764831845f; _Pragma("unroll") for (int i_ = 0; i_ < 8; ++i_) o8_[i_] *= rn_; *(v4u*)(qA + (ta + 16 * (slot_)) * LDK + cq * 8) = pack8(o8_); } \
        __builtin_amdgcn_sched_barrier(0); \
        { float o8_[8]; conv8r(rk_, cw_ + 128, 384, nullptr, o8_); float ss_ = 0.f; _Pragma("unroll") for (int i_ = 0; i_ < 8; ++i_) ss_ += o8_[i_] * o8_[i_]; \
          ss_ = red16(ss_); const float rn_ = rsqrtf(ss_ + EPS); _Pragma("unroll") for (int i_ = 0; i_ < 8; ++i_) o8_[i_] *= rn_; *(v4u*)(kA + (ta + 16 * (slot_)) * LDK + cq * 8) = pack8(o8_); } \
        __builtin_amdgcn_sched_barrier(0); \
        { float o8_[8]; conv8r(rv_, cw_ + 256, 384, nullptr, o8_); Pv[slot_] = pack8(o8_); } \
        __builtin_amdgcn_sched_barrier(0); } while (0)
    if (w >= 4) { DN_LOADS_RAW(0, 0); DN_CONV(rqa, rka, rva, 0); DN_LOADS_RAW(0, 1); DN_CONV(rqa, rka, rva, 1); }
    DN_LOADS_SMALL(0);
    for (int c = 0; c < SEQ / 32; ++c) {
        const int t0 = c * 32;
        unsigned long long tp_ = PROBE_SEL ? rt() : 0ull;
#define DPT(k) do { if (PROBE_SEL) { const unsigned long long tn_ = rt(); if ((PROBE_SEL & (1 << (k))) && item == 0) probe_acc += tn_ - tp_; tp_ = tn_; } } while (0)
        float gcv = rg;
#pragma unroll
        for (int off = 1; off < 32; off <<= 1) { const float t = __shfl_up(gcv, off, 32); if ((lane & 31) >= off) gcv += t; }
        const float gc_last = __shfl(gcv, 31);
        if (w >= 4) {
#pragma unroll
            for (int s2 = 0; s2 < 2; ++s2) { const int tt = ta + 16 * s2;
                const float gc_t = __shfl(gcv, tt), beta_t = __shfl(rbv, tt);
                float q8[8], k8[8], v8[8], t8[8];
                unpack8(*(const v4u*)(qA + tt * LDK + cq * 8), q8); unpack8(*(const v4u*)(kA + tt * LDK + cq * 8), k8); unpack8(Pv[s2], v8);
                const float eg = __expf(gc_t), kb = beta_t * eg, kd = __expf(gc_last - gc_t);
#pragma unroll
                for (int i = 0; i < 8; ++i) t8[i] = q8[i] * eg;
                *(v4u*)(qgA + tt * LDK + cq * 8) = pack8(t8);
                *(f32x4*)(kf + tt * 128 + cq * 8) = (f32x4){k8[0] * kb, k8[1] * kb, k8[2] * kb, k8[3] * kb}; *(f32x4*)(kf + tt * 128 + cq * 8 + 4) = (f32x4){k8[4] * kb, k8[5] * kb, k8[6] * kb, k8[7] * kb};
                *(f32x4*)(vf + tt * 128 + cq * 8) = (f32x4){v8[0] * beta_t, v8[1] * beta_t, v8[2] * beta_t, v8[3] * beta_t}; *(f32x4*)(vf + tt * 128 + cq * 8 + 4) = (f32x4){v8[4] * beta_t, v8[5] * beta_t, v8[6] * beta_t, v8[7] * beta_t};
#pragma unroll
                for (int i = 0; i < 8; ++i) kdT[(cq * 8 + i) * LDJ + tt] = (bf16)f2bf(k8[i] * kd);
            }
        }
        if (tid < 32) { gcs[tid] = gcv; betas[tid] = rbv; }
        __syncthreads();
        DPT(12);
        if (w >= 4 && c + 1 < SEQ / 32) DN_LOADS_RAW(c + 1, 0);
        {   const int ww = w & 3, gi = ww >> 1, gj = ww & 1; f32x4 acc = {0.f, 0.f, 0.f, 0.f};
            const int jI = 16 * gj + fr, i0 = 16 * gi + 4 * fq;
            const float gj_ = gcs[jI]; const f32x4 gi4 = *(const f32x4*)(gcs + i0), bi4 = *(const f32x4*)(betas + i0);
            mma16<128>(acc, (w < 4 ? kA : qA) + gi * 16 * LDK, LDK, kA + gj * 16 * LDK, LDK, fr, fq);
            if (w < 4) {
#pragma unroll
                for (int jj = 0; jj < 4; ++jj) Lm[(i0 + jj) * LDL + jI] = jI < i0 + jj ? bi4[jj] * acc[jj] * __expf(gi4[jj] - gj_) : 0.f;
            } else {
#pragma unroll
                for (int jj = 0; jj < 4; ++jj) attn[(i0 + jj) * LDJ + jI] = (bf16)f2bf(jI <= i0 + jj ? acc[jj] * __expf(gi4[jj] - gj_) : 0.f);
            } }
        __syncthreads();
        DPT(13);
        if (w < 4) { const int cc = tid & 127; const bool is_w = w >= 2; const float* R = is_w ? kf : vf;
            float x[32];
#pragma unroll
            for (int i = 0; i < 32; ++i) x[i] = R[i * 128 + cc];
            f32x4 Lb[2][8];
            Lb[1][0] = *(const f32x4*)(Lm + 1 * LDL);
#pragma unroll
            for (int i = 1; i < 32; ++i) {
                if (i + 1 < 32) {
#pragma unroll
                    for (int j4 = 0; j4 < (i + 4) / 4; ++j4) Lb[(i + 1) & 1][j4] = *(const f32x4*)(Lm + (i + 1) * LDL + j4 * 4); }
                float a0 = x[i], a1 = 0.f, a2 = 0.f, a3 = 0.f;
#pragma unroll
                for (int j4 = 0; j4 < (i + 3) / 4; ++j4) { const f32x4 l4 = Lb[i & 1][j4];
                    if (j4 * 4 + 0 < i) a0 -= l4[0] * x[j4 * 4 + 0];
                    if (j4 * 4 + 1 < i) a1 -= l4[1] * x[j4 * 4 + 1];
                    if (j4 * 4 + 2 < i) a2 -= l4[2] * x[j4 * 4 + 2];
                    if (j4 * 4 + 3 < i) a3 -= l4[3] * x[j4 * 4 + 3]; }
                x[i] = (a0 + a1) + (a2 + a3); }
            if (is_w) {
#pragma unroll
                for (int i = 0; i < 32; ++i) wA[i * LDK + cc] = (bf16)f2bf(x[i]);
            } else {
#pragma unroll
                for (int i = 0; i < 32; ++i) vf[i * 128 + cc] = x[i];
            } }
        else if (c + 1 < SEQ / 32) { DN_LOADS_RAWB(c + 1); __builtin_amdgcn_sched_barrier(0); DN_CONV(rqa, rka, rva, 0); DN_CONV(rqb, rkb, rvb, 1); }
        __syncthreads();
        DPT(14);
        if (c + 1 < SEQ / 32) DN_LOADS_SMALL(c + 1);
        const v4u gcur = *(const v4u*)(G + (rowbase + t0 + tq) * DM + h * 128 + cq * 8);
#pragma unroll
        for (int it = 0; it < 2; ++it) { f32x4 acc = {0.f, 0.f, 0.f, 0.f};
            mma16<128>(acc, wA + it * 16 * LDK, LDK, ST + w * 16 * LDK, LDK, fr, fq);
            float vn[4];
#pragma unroll
            for (int jj = 0; jj < 4; ++jj) vn[jj] = vf[(16 * it + 4 * fq + jj) * 128 + 16 * w + fr] - acc[jj];
            v2u pk; pk.x = pk2(vn[0], vn[1]); pk.y = pk2(vn[2], vn[3]);
            *(v2u*)(vnT + (16 * w + fr) * LDJ + 16 * it + 4 * fq) = pk; }
        __syncthreads();
#pragma unroll
        for (int it = 0; it < 2; ++it) { f32x4 acc = {0.f, 0.f, 0.f, 0.f};
            mma16<128>(acc, qgA + it * 16 * LDK, LDK, ST + w * 16 * LDK, LDK, fr, fq);
            mma16<32>(acc, attn + it * 16 * LDJ, LDJ, vnT + w * 16 * LDJ, LDJ, fr, fq);
#pragma unroll
            for (int jj = 0; jj < 4; ++jj) os[(16 * it + 4 * fq + jj) * 128 + 16 * w + fr] = acc[jj]; }
        {   const float dl = __expf(gc_last);
#pragma unroll
            for (int dt = 0; dt < 8; ++dt) { Sacc[dt] = Sacc[dt] * dl; mma16<32>(Sacc[dt], kdT + dt * 16 * LDJ, LDJ, vnT + w * 16 * LDJ, LDJ, fr, fq); } }
        __syncthreads();
#pragma unroll
        for (int dt = 0; dt < 8; ++dt) { v2u pk; pk.x = pk2(Sacc[dt][0], Sacc[dt][1]); pk.y = pk2(Sacc[dt][2], Sacc[dt][3]);
            *(v2u*)(ST + (16 * w + fr) * LDK + 16 * dt + 4 * fq) = pk; }
        {   const f32x4 o0 = *(const f32x4*)(os + tq * 128 + cq * 8), o1 = *(const f32x4*)(os + tq * 128 + cq * 8 + 4);
            float ss = (o0[0] * o0[0] + o0[1] * o0[1]) + (o0[2] * o0[2] + o0[3] * o0[3]) + (o1[0] * o1[0] + o1[1] * o1[1]) + (o1[2] * o1[2] + o1[3] * o1[3]);
            ss = red16(ss);
            const float r = rsqrtf(ss * (1.f / 128.f) + EPS);
            float g8[8], o8[8], nw8[8]; unpack8(gcur, g8);
            { const f32x4 n0 = *(const f32x4*)nwp, n1 = *(const f32x4*)(nwp + 4); nw8[0] = n0[0]; nw8[1] = n0[1]; nw8[2] = n0[2]; nw8[3] = n0[3]; nw8[4] = n1[0]; nw8[5] = n1[1]; nw8[6] = n1[2]; nw8[7] = n1[3]; }
#pragma unroll
            for (int i = 0; i < 4; ++i) { o8[i] = o0[i] * r * nw8[i] * siluf_(g8[i]); o8[4 + i] = o1[i] * r * nw8[4 + i] * siluf_(g8[4 + i]); }
            *(v4u*)(G + (rowbase + t0 + tq) * DM + h * 128 + cq * 8) = pack8(o8); }
        __syncthreads();
        DPT(15);
    }
#undef DPT
#undef DN_LOADS_RAW
#undef DN_LOADS_RAWB
#undef DN_LOADS_SMALL
#undef DN_CONV
    __syncthreads();
}

__device__ __forceinline__ void ssm_item(unsigned char* lds, CArgsR a, int l, int item) {
    constexpr int LDC = 136, LDX = 40;
    const int b = item >> 4, hd = item & 15, g = hd >> 2;
    bf16* Cs = (bf16*)lds;
    bf16* Bs = Cs + 32 * LDC;
    bf16* BT = Bs + 32 * LDC;
    bf16* xdtT = BT + 128 * LDX;
    bf16* xddT = xdtT + 64 * LDX;
    bf16* Wm = xddT + 64 * LDX;
    bf16* hB = Wm + 32 * LDX;
    float* xs = (float*)(hB + 64 * LDC);
    float* acs = xs + 32 * 64;
    const int tid = opaque_tid(), w = __builtin_amdgcn_readfirstlane(tid >> 6), lane = tid & 63, fr = lane & 15, fq = lane >> 4;
    bf16* base = (bf16*)a.ws;
    const bf16* X = base + (size_t)B_SSX * BUFE; const bf16* BC = base + (size_t)B_SSBC * BUFE; bf16* Z = base + (size_t)B_SSZ * BUFE;
    const float* small = (const float*)(a.ws + WS_SMALL);
    const float* cw = a.in[7] + (size_t)l * 4 * 2048; const float* cb = a.in[8] + (size_t)l * 2048;
    const float dskip = a.in[11][l * 16 + hd];
    const size_t rowbase = (size_t)b * SEQ;
    const int tq = tid >> 4, cq = tid & 15, tv = (tid >> 3) & 31, cv = tid & 7;
    const int it = w >> 2, pt = w & 3;
    f32x4 hacc[4];
#pragma unroll
    for (int i = 0; i < 4; ++i) hacc[i] = (f32x4){0.f, 0.f, 0.f, 0.f};
    for (int i = tid; i < 64 * LDC / 2; i += NTHREADS) ((unsigned*)hB)[i] = 0u;
    v4u rB[4], rC[4], rx[4]; float ra = 0.f, rdtv = 0.f; unsigned rz[4];
#define SSM_LOADS(c_) do { const int t0_ = (c_) * 32; { const int pos_ = t0_ + tq; const size_t ro_ = (rowbase + pos_) * DM; LOAD4(rB, BC + ro_ + g * 128 + cq * 8, pos_); LOAD4(rC, BC + ro_ + 512 + g * 128 + cq * 8, pos_); } \
        if (tid < 256) { const int pos_ = t0_ + tv; LOAD4(rx, X + (rowbase + pos_) * DM + hd * 64 + cv * 8, pos_); } \
        { const size_t r_ = rowbase + t0_ + (lane & 31); rdtv = small[r_ * 64 + 16 + hd]; ra = small[r_ * 64 + 32 + hd]; } \
        _Pragma("unroll") for (int jj_ = 0; jj_ < 4; ++jj_) rz[jj_] = Z[(rowbase + t0_ + 16 * it + 4 * fq + jj_) * DM + hd * 64 + 16 * pt + fr]; } while (0)
    SSM_LOADS(0);
    for (int c = 0; c < SEQ / 32; ++c) {
        const int t0 = c * 32;
        float acum = ra;
#pragma unroll
        for (int off = 1; off < 32; off <<= 1) { const float t = __shfl_up(acum, off, 32); if ((lane & 31) >= off) acum += t; }
        const float ac_last = __shfl(acum, 31);
        {   float o8[8];
            conv8r(rB, cw + 1024 + g * 128 + cq * 8, 2048, cb + 1024 + g * 128 + cq * 8, o8);
            *(v4u*)(Bs + tq * LDC + cq * 8) = pack8(o8);
#pragma unroll
            for (int i = 0; i < 8; ++i) BT[(cq * 8 + i) * LDX + tq] = (bf16)f2bf(o8[i]);
            conv8r(rC, cw + 1536 + g * 128 + cq * 8, 2048, cb + 1536 + g * 128 + cq * 8, o8);
            *(v4u*)(Cs + tq * LDC + cq * 8) = pack8(o8);
        }
        if (w < 4) { float o8[8]; conv8r(rx, cw + hd * 64 + cv * 8, 2048, cb + hd * 64 + cv * 8, o8);
            const float dtv = __shfl(rdtv, tv), dd = dtv * __expf(ac_last - __shfl(acum, tv));
            *(f32x4*)(xs + tv * 64 + cv * 8) = (f32x4){o8[0], o8[1], o8[2], o8[3]}; *(f32x4*)(xs + tv * 64 + cv * 8 + 4) = (f32x4){o8[4], o8[5], o8[6], o8[7]};
#pragma unroll
            for (int i = 0; i < 8; ++i) { xdtT[(cv * 8 + i) * LDX + tv] = (bf16)f2bf(o8[i] * dtv); xddT[(cv * 8 + i) * LDX + tv] = (bf16)f2bf(o8[i] * dd); }
        }
        if (tid < 32) acs[tid] = acum;
        unsigned zr[4];
#pragma unroll
        for (int jj = 0; jj < 4; ++jj) zr[jj] = rz[jj];
        __syncthreads();
        if (c + 1 < SEQ / 32) SSM_LOADS(c + 1);
        if (w < 4) { const int gi = w >> 1, gj = w & 1; f32x4 acc = {0.f, 0.f, 0.f, 0.f};
            mma16<128>(acc, Cs + gi * 16 * LDC, LDC, Bs + gj * 16 * LDC, LDC, fr, fq);
            const int sI = 16 * gj + fr; const float as = acs[sI];
#pragma unroll
            for (int jj = 0; jj < 4; ++jj) { const int lI = 16 * gi + 4 * fq + jj; const float v = sI <= lI ? acc[jj] * __expf(acs[lI] - as) : 0.f; Wm[lI * LDX + sI] = (bf16)f2bf(v); } }
        __syncthreads();
        {   f32x4 a1 = {0.f, 0.f, 0.f, 0.f}, a2 = {0.f, 0.f, 0.f, 0.f};
            mma16<32>(a1, Wm + it * 16 * LDX, LDX, xdtT + pt * 16 * LDX, LDX, fr, fq);
            mma16<128>(a2, Cs + it * 16 * LDC, LDC, hB + pt * 16 * LDC, LDC, fr, fq);
            const int p = 16 * pt + fr;
#pragma unroll
            for (int jj = 0; jj < 4; ++jj) { const int lI = 16 * it + 4 * fq + jj;
                const float y = a1[jj] + __expf(acs[lI]) * a2[jj] + xs[lI * 64 + p] * dskip;
                Z[(rowbase + t0 + lI) * DM + hd * 64 + p] = (bf16)f2bf(y * siluf_(bf2f(zr[jj]))); }
            const float dl = __expf(ac_last);
#pragma unroll
            for (int p2 = 0; p2 < 4; ++p2) { hacc[p2] = hacc[p2] * dl; mma16<32>(hacc[p2], xddT + p2 * 16 * LDX, LDX, BT + w * 16 * LDX, LDX, fr, fq); }
        }
        __syncthreads();
#pragma unroll
        for (int p2 = 0; p2 < 4; ++p2)
#pragma unroll
            for (int jj = 0; jj < 4; ++jj) hB[(16 * p2 + 4 * fq + jj) * LDC + 16 * w + fr] = (bf16)f2bf(hacc[p2][jj]);
    }
#undef SSM_LOADS
    __syncthreads();
}

__device__ __forceinline__ void sb_item(unsigned char* lds, CArgsR a, int b, int hd, int qi) {
    constexpr int LD = 72;
    bf16* Ks = (bf16*)lds; bf16* Vs = Ks + 2 * 64 * LD;
    volatile unsigned* alive = (volatile unsigned*)(Vs + 2 * 64 * LD);
    const int tid = opaque_tid(), w = __builtin_amdgcn_readfirstlane(tid >> 6), lane = tid & 63, fr = lane & 15, fq = lane >> 4;
    bf16* base = (bf16*)a.ws;
    bf16* Qb = base + (size_t)B_SBQ * BUFE; const bf16* Kb = base + (size_t)B_SBK * BUFE; const bf16* Vb = base + (size_t)B_SBV * BUFE;
    const size_t rowbase = (size_t)b * SEQ;
    const int t0 = qi * 128, myq = t0 + w * 16 + fr, wmax = t0 + w * 16 + 15;
    bf16* qrow = Qb + (rowbase + myq) * DM + hd * 64;
    bf16x8 qf[2];
    qf[0] = *(const bf16x8*)(qrow + fq * 8); qf[1] = *(const bf16x8*)(qrow + 32 + fq * 8);
    f32x4 oacc[4];
#pragma unroll
    for (int i = 0; i < 4; ++i) oacc[i] = (f32x4){0.f, 0.f, 0.f, 0.f};
    float carry = 1.f;
    const int kr = tid >> 3, d8 = (tid & 7) * 8;
    v4u kreg, vreg;
    int kt = 2 * (qi + 1) - 1;
#define SB_LOAD(t) do { const size_t o_ = (rowbase + (size_t)(t) * 64 + kr) * DM + hd * 64 + d8; kreg = *(const v4u*)(Kb + o_); vreg = *(const v4u*)(Vb + o_); } while (0)
#define SB_STORE(bu) do { *(v4u*)(Ks + (bu) * 64 * LD + kr * LD + d8) = kreg; bf16* vd_ = Vs + (bu) * 64 * LD + d8 * LD + kr; \
        vd_[0] = (bf16)(vreg.x & 0xffffu); vd_[LD] = (bf16)(vreg.x >> 16); vd_[2 * LD] = (bf16)(vreg.y & 0xffffu); vd_[3 * LD] = (bf16)(vreg.y >> 16); \
        vd_[4 * LD] = (bf16)(vreg.z & 0xffffu); vd_[5 * LD] = (bf16)(vreg.z >> 16); vd_[6 * LD] = (bf16)(vreg.w & 0xffffu); vd_[7 * LD] = (bf16)(vreg.w >> 16); } while (0)
    SB_LOAD(kt); SB_STORE(0);
    __syncthreads();
    int cur = 0;
    for (; kt >= 0; --kt) {
        if (kt > 0) SB_LOAD(kt - 1);
        const int kbase = kt * 64;
        if (kbase <= wmax) {
            const bf16* Kc = Ks + cur * 64 * LD; const bf16* Vc = Vs + cur * 64 * LD;
            f32x4 z[4];
#pragma unroll
            for (int nt = 0; nt < 4; ++nt) { z[nt] = (f32x4){0.f, 0.f, 0.f, 0.f};
#pragma unroll
                for (int k2 = 0; k2 < 2; ++k2) { const bf16x8 af = *(const bf16x8*)(Kc + (nt * 16 + fr) * LD + k2 * 32 + fq * 8);
                    z[nt] = __builtin_amdgcn_mfma_f32_16x16x32_bf16(af, qf[k2], z[nt], 0, 0, 0); } }
            float kp[4][4], sg[4][4], T[4], tot[4], suf[4];
            const bool masked = kbase + 64 > t0 + w * 16;
#pragma unroll
            for (int nt = 0; nt < 4; ++nt) {
#pragma unroll
                for (int j = 0; j < 4; ++j) { const float z2 = z[nt][j] * 0.18033688011112042f;
                    const float ea = __builtin_amdgcn_exp2f(-fabsf(z2)), rc = __builtin_amdgcn_rcpf(1.f + ea); const bool pos = z2 >= 0.f;
                    sg[nt][j] = (pos ? 1.f : ea) * rc; kp[nt][j] = (pos ? ea : 1.f) * rc; }
                if (masked) {
#pragma unroll
                    for (int j = 0; j < 4; ++j) { const bool valid = kbase + nt * 16 + fq * 4 + j < myq; sg[nt][j] = valid ? sg[nt][j] : 0.f; kp[nt][j] = valid ? kp[nt][j] : 1.f; } }
                T[nt] = (kp[nt][0] * kp[nt][1]) * (kp[nt][2] * kp[nt][3]); }
#pragma unroll
            for (int nt = 0; nt < 4; ++nt) { const float p16 = __shfl_xor(T[nt], 16), s1 = T[nt] * p16, p32 = __shfl_xor(s1, 32); tot[nt] = s1 * p32;
                suf[nt] = fq == 0 ? p16 * p32 : fq == 1 ? p32 : fq == 2 ? p16 : 1.f; }
            float run = carry; float wv[4][4];
#pragma unroll
            for (int nt = 3; nt >= 0; --nt) { const float r3 = run * suf[nt], r2 = r3 * kp[nt][3], r1 = r2 * kp[nt][2], r0 = r1 * kp[nt][1];
                wv[nt][0] = sg[nt][0] * r0; wv[nt][1] = sg[nt][1] * r1; wv[nt][2] = sg[nt][2] * r2; wv[nt][3] = sg[nt][3] * r3;
                run *= tot[nt]; }
            carry = run;
#pragma unroll
            for (int kk = 0; kk < 2; ++kk) {
                v4u bw; bw.x = pk2(wv[2 * kk][0], wv[2 * kk][1]); bw.y = pk2(wv[2 * kk][2], wv[2 * kk][3]); bw.z = pk2(wv[2 * kk + 1][0], wv[2 * kk + 1][1]); bw.w = pk2(wv[2 * kk + 1][2], wv[2 * kk + 1][3]);
                const bf16x8 bfr = __builtin_bit_cast(bf16x8, bw);
#pragma unroll
                for (int mt = 0; mt < 4; ++mt) { const bf16* vp = Vc + (mt * 16 + fr) * LD + 32 * kk + 4 * fq;
                    const v2u lo = *(const v2u*)vp, hi = *(const v2u*)(vp + 16);
                    v4u av; av.x = lo.x; av.y = lo.y; av.z = hi.x; av.w = hi.y;
                    oacc[mt] = __builtin_amdgcn_mfma_f32_16x16x32_bf16(__builtin_bit_cast(bf16x8, av), bfr, oacc[mt], 0, 0, 0); }
            }
        }
        {   const bool any_alive = __ballot(carry != 0.f) != 0ull;
            if (lane == 0) alive[cur * 8 + w] = any_alive ? 1u : 0u; }
        if (kt > 0) SB_STORE(cur ^ 1);
        __syncthreads();
        unsigned al = 0u;
#pragma unroll
        for (int i = 0; i < 8; ++i) al |= alive[cur * 8 + i];
        if (al == 0u) break;
        cur ^= 1;
    }
#undef SB_LOAD
#undef SB_STORE
#pragma unroll
    for (int mt = 0; mt < 4; ++mt) { v2u wq; wq.x = pk2(oacc[mt][0], oacc[mt][1]); wq.y = pk2(oacc[mt][2], oacc[mt][3]); *(v2u*)(qrow + mt * 16 + fq * 4) = wq; }
}

__device__ __forceinline__ void phase_mixers(unsigned char* lds, CArgsR a, int l, unsigned long long& probe_acc) {
    unsigned* counter = (unsigned*)(a.ws + WS_CTL) + 64 * l;
    volatile unsigned* slot = (volatile unsigned*)(lds + LDS_BYTES - 64);
    constexpr unsigned NITEMS = 64 + 128 + 2048;
    for (;;) {
        if (threadIdx.x == 0) *slot = __hip_atomic_fetch_add(counter, 1u, __ATOMIC_RELAXED, __HIP_MEMORY_SCOPE_AGENT);
        __syncthreads();
        const unsigned item = *slot;
        __syncthreads();
        if (item >= NITEMS) break;
        PT0();
        if (item < 64) { dn_item(lds, a, l, (int)item, probe_acc); if (item == 0) PT1(9); }
        else if (item < 192) { ssm_item(lds, a, l, (int)item - 64); if (item == 64) PT1(10); }
        else { const int r = (int)item - 192, qi = 15 - (r >> 7), bh = r & 127; sb_item(lds, a, bh >> 4, bh & 15, qi); if (item == 192) PT1(11); }
    }
}

__device__ __forceinline__ void phase_norms(CArgsR a, int l) {
    const int tid = opaque_tid(), lane = tid & 63, wave = tid >> 6, gw = blockIdx.x * NWAVES + wave, NGW = gridDim.x * NWAVES;
    bf16* base = (bf16*)a.ws;
    const bf16* Oraw = base + (size_t)B_DNV * BUFE; bf16* G = base + (size_t)B_DNG * BUFE; bf16* Y = base + (size_t)B_SSZ * BUFE;
    const float* dnw = a.in[6] + (size_t)l * 128 + (lane & 7) * 16; const float* snw = a.in[12] + (size_t)l * DM + lane * 16;
    float w1[16], w2[16];
#pragma unroll
    for (int i = 0; i < 16; ++i) { w1[i] = dnw[i]; w2[i] = snw[i]; }
    for (int m = gw; m < MT; m += NGW) {
        const size_t o = (size_t)m * DM + lane * 16;
        float v[16], s, r;
        unpack8(*(const v4u*)(Y + o), v); unpack8(*(const v4u*)(Y + o + 8), v + 8);
        s = 0.f;
#pragma unroll
        for (int i = 0; i < 16; ++i) s += v[i] * v[i];
        s = red16(s);
        r = rsqrtf(s * (1.f / 256.f) + EPS);
#pragma unroll
        for (int i = 0; i < 16; ++i) v[i] = v[i] * r * w2[i];
        *(v4u*)(Y + o) = pack8(v); *(v4u*)(Y + o + 8) = pack8(v + 8);
    }
}

#define LAS __attribute__((address_space(3)))
#define XB_TMO      128
#define XB_XCNT(j)  (256  + 64 * (j))
#define XB_XSUB(j)  (1280 + 64 * (j))
#define XB_XGEN(j)  (2304 + 64 * (j))
#define XB_TOP      3328
#define XB_TOPGEN   3392
#define XCD_BAR_WORDS 3456
#define XB_SPIN_CAP (1u << 18)

__device__ __forceinline__ unsigned xb_ld(unsigned* p)              { return __hip_atomic_load(p, __ATOMIC_RELAXED, __HIP_MEMORY_SCOPE_AGENT); }
__device__ __forceinline__ unsigned xb_add(unsigned* p, unsigned v) { return __hip_atomic_fetch_add(p, v, __ATOMIC_RELAXED, __HIP_MEMORY_SCOPE_AGENT); }
__device__ __forceinline__ unsigned xb_xcc_id() { return (unsigned)__builtin_amdgcn_s_getreg((3 << 11) | 20) & 0xFu; }
#define XB_SPIN(cond, bar) do { unsigned _sp = 0; while (cond) { __builtin_amdgcn_s_sleep(1); \
    if ((++_sp & 255u) == 0u) { if (xb_ld(&(bar)[XB_TMO])) break; if (_sp > XB_SPIN_CAP) { atomicAdd(&(bar)[XB_TMO], 1u); break; } } } } while (0)

struct XcdBarrier {
    unsigned* bar; unsigned x;
    volatile LAS unsigned* st;
};

__device__ __forceinline__ XcdBarrier xcd_barrier_post(unsigned* bar, volatile LAS unsigned* st) {
    XcdBarrier b; b.bar = bar; b.x = xb_xcc_id(); b.st = st;
    if (threadIdx.x == 0) (void)xb_add(&bar[XB_XCNT(b.x)], 1u);
    return b;
}
__device__ __forceinline__ void xcd_barrier_complete(unsigned* bar, unsigned x, unsigned& nloc, unsigned& nx) {
    const unsigned G = gridDim.x * gridDim.y * gridDim.z;
    unsigned sum, cnt, mine, sp = 0u;
    for (;;) {
        sum = 0u; cnt = 0u; mine = 0u;
#pragma unroll
        for (unsigned j = 0; j < 16; ++j) { const unsigned c = xb_ld(&bar[XB_XCNT(j)]); sum += c; cnt += (c > 0u) ? 1u : 0u; mine = (j == x) ? c : mine; }
        if (sum == G) break;
        __builtin_amdgcn_s_sleep(1);
        if ((++sp & 255u) == 0u) { if (xb_ld(&bar[XB_TMO])) break; if (sp > XB_SPIN_CAP) { atomicAdd(&bar[XB_TMO], 1u); break; } }
    }
    nloc = mine > 0u ? mine : 1u; nx = cnt > 0u ? cnt : 1u;
}

__device__ __forceinline__ void xcd_barrier(const XcdBarrier& b) {
    asm volatile("s_waitcnt vmcnt(0)" ::: "memory");
    __syncthreads();
    if (threadIdx.x == 0) {
        unsigned* bar = b.bar;
        __builtin_amdgcn_s_waitcnt(0);
        unsigned nloc = b.st[0], nx = b.st[1];
        if (nloc == 0u) { xcd_barrier_complete(bar, b.x, nloc, nx); b.st[0] = nloc; b.st[1] = nx; }
        const unsigned old = xb_add(&bar[XB_XSUB(b.x)], 1u);
        const unsigned gen = old / nloc;
        if (old + 1u == (gen + 1u) * nloc) {
            __builtin_amdgcn_fence(__ATOMIC_RELEASE, "agent");
            asm volatile("s_waitcnt vmcnt(0)" ::: "memory");
            const unsigned og = xb_add(&bar[XB_TOP], 1u);
            const unsigned tg = og / nx;
            if (og + 1u == (tg + 1u) * nx) xb_add(&bar[XB_TOPGEN], 1u);
            else XB_SPIN(xb_ld(&bar[XB_TOPGEN]) == tg, bar);
            __builtin_amdgcn_fence(__ATOMIC_ACQUIRE, "agent");
            xb_add(&bar[XB_XGEN(b.x)], 1u);
            asm volatile("s_waitcnt vmcnt(0)" ::: "memory");
        } else {
            XB_SPIN(xb_ld(&bar[XB_XGEN(b.x)]) == gen, bar);
            __builtin_amdgcn_fence(__ATOMIC_ACQUIRE, "agent");
            asm volatile("s_waitcnt vmcnt(0)" ::: "memory");
        }
    }
    __syncthreads();
}

__global__ void __launch_bounds__(NTHREADS, 2) hybrid_fwd(Args a_unused) {
    extern __shared__ __attribute__((aligned(16))) unsigned char lds[];
    cg::grid_group grid = cg::this_grid();
    PG8_LAS unsigned char* ldsl = (PG8_LAS unsigned char*)lds;
    unsigned long long probe_acc = 0ull;
#define A_ (*kargs())
    volatile LAS unsigned* bst = (volatile LAS unsigned*)((LAS unsigned char*)lds + LDS_BYTES - 32);
    if (threadIdx.x == 0) { bst[0] = 0u; bst[1] = 0u; }
    __syncthreads();
    const XcdBarrier bar = xcd_barrier_post((unsigned*)(a_unused.ws + WS_BAR), bst);
#pragma unroll 1
    for (int l = 0; l < 2; ++l) {
        asm volatile("" : "+s"(l));
        {   CArgsR a = A_; const float* xin = l == 0 ? a.in[0] : a.out;
            PT0(); phase0(lds, a, l, xin);
        if (l == 0) grid.sync(); else xcd_barrier(bar); PT1(0); }
        {   CArgsR a = A_; bf16* base = (bf16*)a.ws; bf16* Wreg = (bf16*)(a.ws + WS_W);
            pg8::Gemm g{base, Wreg + W_IN, MT, 10240, DM}; pg8::StaticOrder S; S.init(MT, 10240, (int)gridDim.x, (int)blockIdx.x);
            EpiRoute E{base};
            PT0(); pg8::gemm_phase<EpiRoute, pg8::StaticOrder, true, true>(ldsl, g, S, E);
        xcd_barrier(bar); PT1(1); }
        { PT0(); phase_mixers(lds, A_, l, probe_acc);
        xcd_barrier(bar); PT1(2); }
        { PT0(); phase_norms(A_, l);
        xcd_barrier(bar); PT1(3); }
        {   CArgsR a = A_; bf16* base = (bf16*)a.ws; bf16* Wreg = (bf16*)(a.ws + WS_W);
            pg8::Gemm g{base, Wreg + W_G, 4 * MT, 6144, DM}; SchedGate S{(int)gridDim.x, (int)blockIdx.x};
            EpiGate E{base + (size_t)B_SBK * BUFE, (float*)(base + (size_t)B_DNK * BUFE), base + (size_t)B_DNQ * BUFE};
            PT0(); pg8::gemm_phase<EpiGate, SchedGate, true, true>(ldsl, g, S, E);
        xcd_barrier(bar); PT1(4); }
        {   CArgsR a = A_; bf16* base = (bf16*)a.ws; bf16* Wreg = (bf16*)(a.ws + WS_W); const float* xin = l == 0 ? a.in[0] : a.out;
            pg8::Gemm g{base + (size_t)B_DNQ * BUFE, Wreg + W_OUT, MT, DM, DM}; pg8::StaticOrder S; S.init(MT, DM, (int)gridDim.x, (int)blockIdx.x);
            EpiResid E{xin, a.out};
            PT0(); pg8::gemm_phase<EpiResid, pg8::StaticOrder, false, true>(ldsl, g, S, E);
        xcd_barrier(bar); PT1(5); }
        {   CArgsR a = A_; bf16* base = (bf16*)a.ws; const float* nw = a.in[15] + (size_t)l * DM; const float* xo = a.out;
            const int tid = opaque_tid(), lane = tid & 63, gw = blockIdx.x * NWAVES + (tid >> 6), NGW = gridDim.x * NWAVES;
            PT0(); for (int m = gw; m < MT; m += NGW) rms_row_to_bf16(xo + (size_t)m * DM, nw, base + (size_t)m * DM, lane);
        xcd_barrier(bar); PT1(6); }
        {   CArgsR a = A_; bf16* base = (bf16*)a.ws; bf16* Wreg = (bf16*)(a.ws + WS_W);
            pg8::Gemm g{base, Wreg + W_UP, MT, DFF, DM}; pg8::StaticOrder S; S.init(MT, DFF, (int)gridDim.x, (int)blockIdx.x);
            EpiRelu2 E{base + (size_t)B_DNQ * BUFE};
            PT0(); pg8::gemm_phase<EpiRelu2, pg8::StaticOrder, true, true>(ldsl, g, S, E);
        xcd_barrier(bar); PT1(7); }
        {   CArgsR a = A_; bf16* base = (bf16*)a.ws; bf16* Wreg = (bf16*)(a.ws + WS_W);
            pg8::Gemm g{base + (size_t)B_DNQ * BUFE, Wreg + W_DOWN, MT, DM, DFF}; pg8::StaticOrder S; S.init(MT, DM, (int)gridDim.x, (int)blockIdx.x);
            EpiResid E{a.out, a.out};
            PT0(); pg8::gemm_phase<EpiResid, pg8::StaticOrder, false, true>(ldsl, g, S, E);
        xcd_barrier(bar); PT1(8); }
    }
    {
        CArgsR a = A_; const float* nw = a.in[18]; float* xo = a.out;
        const int tid = opaque_tid(), lane = tid & 63, gw = blockIdx.x * NWAVES + (tid >> 6), NGW = gridDim.x * NWAVES;
        for (int m = gw; m < MT; m += NGW) {
            f32x4* xr = (f32x4*)(xo + (size_t)m * DM) + lane; const f32x4* wr = (const f32x4*)nw + lane;
            f32x4 v[4]; float s = 0.f;
#pragma unroll
            for (int j = 0; j < 4; ++j) { v[j] = xr[64 * j]; s += (v[j][0] * v[j][0] + v[j][1] * v[j][1]) + (v[j][2] * v[j][2] + v[j][3] * v[j][3]); }
            const float rstd = rsqrtf(wave_sum(s) * (1.f / DM) + EPS);
#pragma unroll
            for (int j = 0; j < 4; ++j) { const f32x4 ww = wr[64 * j]; f32x4 r;
#pragma unroll
                for (int i = 0; i < 4; ++i) r[i] = v[j][i] * rstd * ww[i];
                xr[64 * j] = r; }
        }
    }
#undef A_
    if (PROBE_SEL) { const unsigned long long t0 = rt(); while (rt() - t0 < probe_acc) __builtin_amdgcn_s_sleep(8); }
}

extern "C" void kernel_launch(void* const* d_in, const int* in_sizes, int n_in, void* d_out, int out_size, void* d_ws, size_t ws_size, hipStream_t stream) {
    static int grid = 0;
    if (grid == 0) {
        if (n_in != 19 || out_size != MT * DM || ws_size < WS_NEED) { fprintf(stderr, "kernel_launch: unexpected shapes (n_in %d out %d ws %zu need %zu)\n", n_in, out_size, ws_size, (size_t)WS_NEED); grid = -1; return; }
        int dev = 0, cus = 0, per_cu = 0;
        hipGetDevice(&dev); hipDeviceGetAttribute(&cus, hipDeviceAttributeMultiprocessorCount, dev);
        if (hipFuncSetAttribute((const void*)hybrid_fwd, hipFuncAttributeMaxDynamicSharedMemorySize, LDS_BYTES) != hipSuccess) { fprintf(stderr, "kernel_launch: hipFuncSetAttribute failed\n"); grid = -1; return; }
        if (hipOccupancyMaxActiveBlocksPerMultiprocessor(&per_cu, (const void*)hybrid_fwd, NTHREADS, LDS_BYTES) != hipSuccess || per_cu < 1) { fprintf(stderr, "kernel_launch: occupancy query gave %d\n", per_cu); per_cu = 1; }
        (void)hipGetLastError();
        grid = cus * per_cu;
    }
    if (grid < 0) return;
    if (hipMemsetAsync((char*)d_ws + WS_CTL, 0, CTL_BYTES, stream) != hipSuccess) { fprintf(stderr, "kernel_launch: memset of the control words failed\n"); return; }
    Args a{};
    for (int i = 0; i < 19; ++i) a.in[i] = (const float*)d_in[i];
    a.out = (float*)d_out; a.ws = (unsigned char*)d_ws;
    void* args[] = {&a};
    hipError_t e = hipLaunchCooperativeKernel((const void*)hybrid_fwd, dim3(grid), dim3(NTHREADS), args, LDS_BYTES, stream);
    if (e != hipSuccess) fprintf(stderr, "cooperative launch failed: %s (grid %d)\n", hipGetErrorString(e), grid);
}
```

```cpp
#include <hip/hip_runtime.h>
#include <hip/hip_cooperative_groups.h>
#include <cstdio>
#include <cstdint>
namespace cg = cooperative_groups;
__device__ __forceinline__ int opaque_tid() { int t = (int)threadIdx.x; asm volatile("" : "+v"(t)); return t; }
namespace pg8 {
#define PG8_LAS __attribute__((address_space(3)))
typedef unsigned short bf16_t;
typedef short bf16x8 __attribute__((ext_vector_type(8)));
typedef float f32x4 __attribute__((ext_vector_type(4)));
typedef unsigned u32x4 __attribute__((ext_vector_type(4)));
constexpr int BM = 256, BK = 64, HALF = 128, HTB = HALF * BK * 2  , STAGE_BYTES = 8 * HTB, NXCD = 8, WGM = 8;

__host__ __device__ __forceinline__ int lds_byte(int r, int c) { const int st = (r >> 4) * 2 + (c >> 5), rr = r & 15, cc = c & 31, ob = rr * 64 + cc * 2; return st * 1024 + (ob ^ (((ob >> 9) & 1) << 5)); }
__host__ __device__ __forceinline__ void stage_rc(int b, int& R, int& C) { const int st = b / 1024, sb = b % 1024, swz = sb ^ (((sb >> 9) & 1) << 5); R = (st >> 1) * 16 + swz / 64; C = (st & 1) * 32 + (swz % 64) / 2; }
__host__ __device__ __forceinline__ int perm32(int rho) { const int n = rho >> 4, i = rho & 15; return 8 * (i >> 2) + 4 * n + (i & 3); }

struct Unit { int pm, pn; };
struct Gemm { const bf16_t* A; const bf16_t* Bt; int M, N, K; };

struct StaticOrder {
    int nM, nN, nwg, G, c;
    __host__ __device__ void init(int M, int N, int G_, int c_) { nM = M / BM; nN = N / BM; nwg = nM * nN; G = G_; c = c_; }
    __host__ __device__ bool next(int i, Unit& u) const {
        const long L = (long)i * G + c; if (L >= nwg) return false;
        int wgid = (int)L; { const int q = nwg / NXCD, r = nwg % NXCD, xcd = wgid % NXCD, off = wgid / NXCD; wgid = (xcd < r ? xcd * (q + 1) : r * (q + 1) + (xcd - r) * q) + off; }
        const int nig = WGM * nN, gid = wgid / nig, fm = gid * WGM, gsz = (nM - fm) < WGM ? (nM - fm) : WGM;
        u.pm = fm + ((wgid % nig) % gsz); u.pn = (wgid % nig) / gsz; return true;
    }
    __device__ __forceinline__ void a_ready(const Unit&) const {}
    __device__ __forceinline__ void done(const Unit&) const {}
};
__device__ __forceinline__ unsigned cvt_pk_bf16(float lo, float hi) { unsigned r; asm volatile("v_cvt_pk_bf16_f32 %0, %1, %2" : "=v"(r) : "v"(lo), "v"(hi)); return r; }
template <class Epi, class Sched, bool ALIGN_EPI = false, bool SP2 = false>
__device__ __forceinline__ void gemm_phase(PG8_LAS unsigned char* lds, const Gemm g, const Sched& S, const Epi& E) {
    const int tid = opaque_tid(), wid = __builtin_amdgcn_readfirstlane(tid >> 6), lane = tid & 63, wr = wid >> 2, wc = wid & 3, fr = lane & 15, fq = lane >> 4;
    const int K = g.K, nt = K / BK;
    unsigned voffA[2], voffB[2];
#pragma unroll
    for (int i = 0; i < 2; ++i) { int R, C; stage_rc(tid * 16 + i * 8192, R, C); const int Rb = Epi::PERM ? ((R & ~31) + perm32(R & 31)) : R;
        voffA[i] = (unsigned)(R * K + C) * 2u; voffB[i] = (unsigned)(Rb * K + C) * 2u; }
    const size_t kstep = (size_t)(BK * 2);
    const size_t hstep = (size_t)HALF * K * 2;
    const size_t tstep = 2 * hstep;
    const unsigned ldsw = (unsigned)wid * 1024u;
    const int aoff = lds_byte(wr * 64 + fr, fq * 8), boff = lds_byte(wc * 32 + fr, fq * 8);
#define PG8_SA(b, h) (((b) * 2 + (h)) * HTB)
#define PG8_SB(b, h) ((4 + (b) * 2 + (h)) * HTB)
#define PG8_STAGE(bufoff, gbase, voff) do { _Pragma("unroll") for (int _i = 0; _i < 2; ++_i) \
        __builtin_amdgcn_global_load_lds((const unsigned*)((const char*)(gbase) + (voff)[_i]), (PG8_LAS unsigned*)(lds + (bufoff) + ldsw + _i * 8192), 16, 0, 0); } while (0)
#define PG8_LDA(dst, b, h) do { _Pragma("unroll") for (int m = 0; m < 4; ++m) _Pragma("unroll") for (int k = 0; k < 2; ++k) dst[m][k] = *(const PG8_LAS bf16x8*)(lds + PG8_SA(b, h) + aoff + m * 2048 + k * 1024); } while (0)
#define PG8_LDB(dst, b, h) do { _Pragma("unroll") for (int n = 0; n < 2; ++n) _Pragma("unroll") for (int k = 0; k < 2; ++k) dst[n][k] = *(const PG8_LAS bf16x8*)(lds + PG8_SB(b, h) + boff + n * 2048 + k * 1024); } while (0)
#define PG8_MMA(ai, bj, At, Bt) do { __builtin_amdgcn_s_setprio(1); _Pragma("unroll") for (int m = 0; m < 4; ++m) _Pragma("unroll") for (int n = 0; n < 2; ++n) _Pragma("unroll") for (int k = 0; k < 2; ++k) \
        acc[ai][bj][m][n] = __builtin_amdgcn_mfma_f32_16x16x32_bf16(Bt[n][k], At[m][k], acc[ai][bj][m][n], 0, 0, 0); __builtin_amdgcn_s_setprio(0); } while (0)
#define PG8_WAIT_V(n) asm volatile("s_waitcnt vmcnt(" #n ")" ::: "memory")
#define PG8_WAIT_L(n) asm volatile("s_waitcnt lgkmcnt(" #n ")" ::: "memory")
#define PG8_BAR __builtin_amdgcn_s_barrier()
#define PG8_SCHED __builtin_amdgcn_sched_barrier(0)
    Unit cur, nxt; int ui = 0;
    if (!S.next(0, cur)) return;
    f32x4 acc[2][2][4][2];
#pragma unroll
    for (int a = 0; a < 2; ++a)
#pragma unroll
        for (int b = 0; b < 2; ++b)
#pragma unroll
            for (int m = 0; m < 4; ++m)
#pragma unroll
                for (int n = 0; n < 2; ++n) acc[a][b][m][n] = (f32x4){0.f, 0.f, 0.f, 0.f};
    bf16x8 At[4][2], B0[2][2], B1[2][2];
    const char* cA = (const char*)g.A + (size_t)cur.pm * tstep; const char* cB = (const char*)g.Bt + (size_t)cur.pn * tstep;
    S.a_ready(cur);
    if constexpr (SP2) {
        PG8_STAGE(PG8_SB(0, 0), cB, voffB); PG8_STAGE(PG8_SB(0, 1), cB + hstep, voffB); PG8_STAGE(PG8_SA(0, 0), cA, voffA); PG8_STAGE(PG8_SA(0, 1), cA + hstep, voffA);
        if (wr == 1) PG8_BAR;
        PG8_WAIT_V(2); PG8_BAR;
        PG8_STAGE(PG8_SB(1, 0), cB + kstep, voffB); PG8_STAGE(PG8_SA(1, 0), cA + kstep, voffA); PG8_STAGE(PG8_SB(1, 1), cB + hstep + kstep, voffB);
        PG8_WAIT_V(6); PG8_BAR;
    } else {
        PG8_STAGE(PG8_SB(0, 0), cB, voffB); PG8_STAGE(PG8_SA(0, 0), cA, voffA); PG8_STAGE(PG8_SB(0, 1), cB + hstep, voffB); PG8_STAGE(PG8_SA(0, 1), cA + hstep, voffA);
        if (wr == 1) PG8_BAR;
        PG8_WAIT_V(4); PG8_BAR;
        PG8_STAGE(PG8_SB(1, 0), cB + kstep, voffB); PG8_STAGE(PG8_SA(1, 0), cA + kstep, voffA); PG8_STAGE(PG8_SB(1, 1), cB + hstep + kstep, voffB);
        PG8_WAIT_V(6); PG8_BAR;
    }
    for (;;) {
        const bool has_next = S.next(ui + 1, nxt);
        const char* nA = has_next ? (const char*)g.A + (size_t)nxt.pm * tstep : cA; const char* nB = has_next ? (const char*)g.Bt + (size_t)nxt.pn * tstep : cB;
        for (int t = 0; t < nt; t += 2) {
            const bool last = (t == nt - 2);
            const char* a1 = cA + (size_t)(t + 1) * kstep;
            const char* a2 = last ? nA : cA + (size_t)(t + 2) * kstep; const char* b2 = last ? nB : cB + (size_t)(t + 2) * kstep;
            const char* a3 = a2 + kstep; const char* b3 = b2 + kstep;
            if (last && has_next) S.a_ready(nxt);
            if constexpr (SP2) {
            PG8_LDB(B0, 0, 0); PG8_LDB(B1, 0, 1); PG8_SCHED; PG8_LDA(At, 0, 0); PG8_STAGE(PG8_SA(1, 1), a1 + hstep, voffA);
            PG8_WAIT_V(8); PG8_WAIT_L(0); PG8_BAR; PG8_MMA(0, 0, At, B0); PG8_MMA(0, 1, At, B1); PG8_BAR; PG8_SCHED;
            PG8_LDA(At, 0, 1); PG8_STAGE(PG8_SB(0, 0), b2, voffB); PG8_STAGE(PG8_SB(0, 1), b2 + hstep, voffB); PG8_STAGE(PG8_SA(0, 0), a2, voffA);
            PG8_WAIT_V(8); PG8_WAIT_L(0); PG8_BAR; PG8_MMA(1, 0, At, B0); PG8_MMA(1, 1, At, B1); PG8_BAR; PG8_SCHED;
            PG8_LDB(B0, 1, 0); PG8_LDB(B1, 1, 1); PG8_SCHED; PG8_LDA(At, 1, 0); PG8_STAGE(PG8_SA(0, 1), a2 + hstep, voffA);
            PG8_WAIT_V(8); PG8_WAIT_L(0); PG8_BAR; PG8_MMA(0, 0, At, B0); PG8_MMA(0, 1, At, B1); PG8_BAR; PG8_SCHED;
            PG8_LDA(At, 1, 1); PG8_STAGE(PG8_SB(1, 0), b3, voffB); PG8_STAGE(PG8_SB(1, 1), b3 + hstep, voffB); PG8_STAGE(PG8_SA(1, 0), a3, voffA);
            PG8_WAIT_V(8); PG8_WAIT_L(0); PG8_BAR; PG8_MMA(1, 0, At, B0); PG8_MMA(1, 1, At, B1); PG8_BAR; PG8_SCHED;
            } else {
            PG8_LDB(B0, 0, 0); PG8_SCHED; PG8_LDA(At, 0, 0); PG8_STAGE(PG8_SA(1, 1), a1 + hstep, voffA);
            PG8_WAIT_L(8); PG8_BAR; PG8_WAIT_L(0); PG8_MMA(0, 0, At, B0); PG8_BAR; PG8_SCHED;
            PG8_LDB(B1, 0, 1); PG8_STAGE(PG8_SB(0, 0), b2, voffB);
            PG8_BAR; PG8_WAIT_L(0); PG8_MMA(0, 1, At, B1); PG8_BAR;
            PG8_LDA(At, 0, 1); PG8_STAGE(PG8_SA(0, 0), a2, voffA);
            PG8_BAR; PG8_WAIT_L(0); PG8_MMA(1, 0, At, B0); PG8_BAR; PG8_SCHED;
            PG8_STAGE(PG8_SB(0, 1), b2 + hstep, voffB);
            PG8_WAIT_V(6); PG8_BAR; PG8_MMA(1, 1, At, B1); PG8_BAR;
            PG8_LDB(B0, 1, 0); PG8_SCHED; PG8_LDA(At, 1, 0); PG8_STAGE(PG8_SA(0, 1), a2 + hstep, voffA);
            PG8_WAIT_L(8); PG8_BAR; PG8_WAIT_L(0); PG8_MMA(0, 0, At, B0); PG8_BAR; PG8_SCHED;
            PG8_LDB(B1, 1, 1); PG8_STAGE(PG8_SB(1, 0), b3, voffB);
            PG8_BAR; PG8_WAIT_L(0); PG8_MMA(0, 1, At, B1); PG8_BAR;
            PG8_LDA(At, 1, 1); PG8_STAGE(PG8_SA(1, 0), a3, voffA);
            PG8_BAR; PG8_WAIT_L(0); PG8_MMA(1, 0, At, B0); PG8_BAR; PG8_SCHED;
            PG8_STAGE(PG8_SB(1, 1), b3 + hstep, voffB);
            PG8_WAIT_V(6); PG8_BAR; PG8_MMA(1, 1, At, B1); PG8_BAR;
            }
        }
        if constexpr (ALIGN_EPI) { if (wr == 0) PG8_BAR; }
        if constexpr (!Epi::AFTER_DRAIN) { E(acc, cur, wr, wc, fr, fq); S.done(cur); }
        if (!has_next) break;
#pragma unroll
        for (int a = 0; a < 2; ++a)
#pragma unroll
            for (int b = 0; b < 2; ++b)
#pragma unroll
                for (int m = 0; m < 4; ++m)
#pragma unroll
                    for (int n = 0; n < 2; ++n) acc[a][b][m][n] = (f32x4){0.f, 0.f, 0.f, 0.f};
        cur = nxt; cA = nA; cB = nB; ++ui;
        if constexpr (ALIGN_EPI) { if (wr == 1) PG8_BAR; }
    }
    PG8_WAIT_V(0);
    if constexpr (!ALIGN_EPI) { if (wr == 0) PG8_BAR; }
    PG8_BAR;
    if constexpr (Epi::AFTER_DRAIN) { E.fused(acc, cur, wr, wc, fr, fq, lds, wid, lane); S.done(cur); }
#undef PG8_SA
#undef PG8_SB
#undef PG8_STAGE
#undef PG8_LDA
#undef PG8_LDB
#undef PG8_MMA
#undef PG8_WAIT_V
#undef PG8_WAIT_L
#undef PG8_BAR
#undef PG8_SCHED
}
}

constexpr int NB = 8, SEQ = 2048, DM = 1024, MT = NB * SEQ, DFF = 4096, IN_DIM = 13344;
constexpr int NTHREADS = 512, NWAVES = 8, LDS_BYTES = 147456;
constexpr float EPS = 1e-6f;
typedef unsigned short bf16;
typedef unsigned v4u __attribute__((ext_vector_type(4)));
typedef unsigned v2u __attribute__((ext_vector_type(2)));
typedef float f32x4 __attribute__((ext_vector_type(4)));
typedef short bf16x8 __attribute__((ext_vector_type(8)));
enum { B_H = 0, B_DNG = 1, B_SBQ = 2, B_SSZ = 3, B_DNQ = 4, B_DNK = 5, B_DNV = 6, B_SBK = 7, B_SBV = 8, B_SSX = 9, B_SSBC = 10, NBUF = 11 };
constexpr size_t BUFE = (size_t)MT * DM;
constexpr size_t WS_W = NBUF * BUFE * 2;
constexpr size_t W_IN = 0, W_G = W_IN + (size_t)10240 * 1024, W_OUT = W_G + (size_t)6144 * 1024, W_UP = W_OUT + (size_t)1024 * 1024,
                 W_DOWN = W_UP + (size_t)4096 * 1024, W_END = W_DOWN + (size_t)4096 * 1024;
constexpr size_t WS_SMALL = WS_W + W_END * 2;
constexpr size_t WS_CTL = WS_SMALL + (size_t)MT * 64 * 4;
constexpr size_t WS_BAR = WS_CTL + 4096;
constexpr size_t CTL_BYTES = 4096 + 16384;
constexpr size_t WS_NEED = WS_CTL + CTL_BYTES;

__device__ __forceinline__ float bf2f(unsigned u) { return __builtin_bit_cast(float, u << 16); }
__device__ __forceinline__ unsigned f2bf(float f) { unsigned u = __builtin_bit_cast(unsigned, f); return (u + 0x7fffu + ((u >> 16) & 1u)) >> 16; }
typedef float f32x2 __attribute__((ext_vector_type(2)));
typedef __bf16 bf16x2_t __attribute__((ext_vector_type(2)));
__device__ __forceinline__ unsigned pk2(float lo, float hi) { f32x2 v = {lo, hi}; return __builtin_bit_cast(unsigned, __builtin_convertvector(v, bf16x2_t)); }
__device__ __forceinline__ void unpack8(v4u r, float* o) {
    o[0] = bf2f(r.x & 0xffffu); o[1] = __builtin_bit_cast(float, r.x & 0xffff0000u); o[2] = bf2f(r.y & 0xffffu); o[3] = __builtin_bit_cast(float, r.y & 0xffff0000u);
    o[4] = bf2f(r.z & 0xffffu); o[5] = __builtin_bit_cast(float, r.z & 0xffff0000u); o[6] = bf2f(r.w & 0xffffu); o[7] = __builtin_bit_cast(float, r.w & 0xffff0000u);
}
__device__ __forceinline__ v4u pack8(const float* v) { v4u w; w.x = pk2(v[0], v[1]); w.y = pk2(v[2], v[3]); w.z = pk2(v[4], v[5]); w.w = pk2(v[6], v[7]); return w; }
__device__ __forceinline__ float sigmoidf_(float x) { return __builtin_amdgcn_rcpf(1.f + __expf(-x)); }
__device__ __forceinline__ float siluf_(float x) { return x * __builtin_amdgcn_rcpf(1.f + __expf(-x)); }
__device__ __forceinline__ float softplusf_(float x) { return fmaxf(x, 0.f) + log1pf(__expf(-fabsf(x))); }
template <int CTRL> __device__ __forceinline__ float dppf(float v) { return __builtin_bit_cast(float, __builtin_amdgcn_update_dpp(0, __builtin_bit_cast(int, v), CTRL, 0xF, 0xF, true)); }
__device__ __forceinline__ float red8(float v) { v += dppf<0xB1>(v); v += dppf<0x4E>(v); v += dppf<0x141>(v); return v; }
__device__ __forceinline__ float red16(float v) { v = red8(v); v += dppf<0x140>(v); return v; }
__device__ __forceinline__ float wave_sum(float v) {
#pragma unroll
    for (int o = 1; o < 64; o <<= 1) v += __shfl_xor(v, o);
    return v;
}
#define LDS_WAIT() asm volatile("s_waitcnt lgkmcnt(0)" ::: "memory")

struct Args { const float* in[19]; float* out; unsigned char* ws; };
typedef const __attribute__((address_space(4))) Args& CArgsR;
__device__ __forceinline__ const __attribute__((address_space(4))) Args* kargs() { unsigned long long v = (unsigned long long)__builtin_amdgcn_kernarg_segment_ptr(); asm volatile("" : "+s"(v)); return (const __attribute__((address_space(4))) Args*)v; }
#ifndef PROBE_SEL
#define PROBE_SEL 0
#endif
__device__ __forceinline__ unsigned long long rt() { return __builtin_amdgcn_s_memrealtime(); }
#define PT0() unsigned long long pt_ = PROBE_SEL ? rt() : 0ull
#define PT1(k) do { if (PROBE_SEL & (1 << (k))) probe_acc += rt() - pt_; } while (0)

struct EpiRoute {
    static constexpr bool PERM = true, AFTER_DRAIN = false;
    bf16* base; int pn_off;
    __device__ __forceinline__ void operator()(const pg8::f32x4 (&acc)[2][2][4][2], const pg8::Unit& u, int wr, int wc, int fr, int fq) const {
        const int sg = (u.pn + pn_off) >> 2;
        const int bufi = sg == 0 ? B_DNG : sg == 1 ? B_DNQ : sg == 2 ? B_DNK : sg == 3 ? B_DNV : sg == 4 ? B_SBQ : sg == 5 ? B_SSZ : sg == 6 ? B_SBK : sg == 7 ? B_SBV : sg == 8 ? B_SSX : B_SSBC;
        bf16* O = base + (size_t)bufi * BUFE;
        const int col0 = (u.pn & 3) * 256 + wc * 32 + 8 * fq, row0 = u.pm * 256 + wr * 64 + fr;
#pragma unroll
        for (int ai = 0; ai < 2; ++ai)
#pragma unroll
            for (int m = 0; m < 4; ++m) { bf16* rowp = O + (size_t)(row0 + ai * 128 + m * 16) * DM + col0;
#pragma unroll
                for (int bj = 0; bj < 2; ++bj) { const pg8::f32x4 v0 = acc[ai][bj][m][0], v1 = acc[ai][bj][m][1];
                    v4u w; w.x = pk2(v0[0], v0[1]); w.y = pk2(v0[2], v0[3]); w.z = pk2(v1[0], v1[1]); w.w = pk2(v1[2], v1[3]);
                    *(v4u*)(rowp + bj * 128) = w; } }
    }
};
struct EpiRelu2 {
    static constexpr bool PERM = true, AFTER_DRAIN = false;
    bf16* O;
    __device__ __forceinline__ void operator()(const pg8::f32x4 (&acc)[2][2][4][2], const pg8::Unit& u, int wr, int wc, int fr, int fq) const {
        const int col0 = u.pn * 256 + wc * 32 + 8 * fq, row0 = u.pm * 256 + wr * 64 + fr;
#pragma unroll
        for (int ai = 0; ai < 2; ++ai)
#pragma unroll
            for (int m = 0; m < 4; ++m) { bf16* rowp = O + (size_t)(row0 + ai * 128 + m * 16) * DFF + col0;
#pragma unroll
                for (int bj = 0; bj < 2; ++bj) { float v[8];
#pragma unroll
                    for (int i = 0; i < 4; ++i) { float a = fmaxf(acc[ai][bj][m][0][i], 0.f), b = fmaxf(acc[ai][bj][m][1][i], 0.f); v[i] = a * a; v[4 + i] = b * b; }
                    *(v4u*)(rowp + bj * 128) = pack8(v); } }
    }
};
struct EpiResid {
    static constexpr bool PERM = true, AFTER_DRAIN = false;
    const float* xin; float* xout;
    __device__ __forceinline__ void operator()(const pg8::f32x4 (&acc)[2][2][4][2], const pg8::Unit& u, int wr, int wc, int fr, int fq) const {
        const int col0 = u.pn * 256 + wc * 32 + 8 * fq, row0 = u.pm * 256 + wr * 64 + fr;
#pragma unroll
        for (int ai = 0; ai < 2; ++ai)
#pragma unroll
            for (int m = 0; m < 4; ++m) { const size_t ro = (size_t)(row0 + ai * 128 + m * 16) * DM + col0;
#pragma unroll
                for (int bj = 0; bj < 2; ++bj) { const size_t o = ro + bj * 128;
                    const f32x4 a = *(const f32x4*)(xin + o), b = *(const f32x4*)(xin + o + 4);
                    f32x4 r0, r1;
#pragma unroll
                    for (int i = 0; i < 4; ++i) { r0[i] = a[i] + acc[ai][bj][m][0][i]; r1[i] = b[i] + acc[ai][bj][m][1][i]; }
                    *(f32x4*)(xout + o) = r0; *(f32x4*)(xout + o + 4) = r1; } }
    }
};
struct SchedGate {
    int G, c;
    __device__ __forceinline__ bool next(int i, pg8::Unit& u) const {
        const int tile = c + (i / 6) * G; if (tile >= 256) return false;
        const int s = i % 6, br = s >> 1, pm = tile >> 2, pn = tile & 3;
        if ((s & 1) == 0) { u.pm = pm; u.pn = br * 4 + pn; } else { u.pm = (1 + br) * 64 + pm; u.pn = (3 + br) * 4 + pn; }
        return true;
    }
    __device__ __forceinline__ void a_ready(const pg8::Unit&) const {}
    __device__ __forceinline__ void done(const pg8::Unit&) const {}
};
struct EpiGate {
    static constexpr bool PERM = true, AFTER_DRAIN = false;
    bf16* gsc; float* macc; bf16* merged;
    __device__ __forceinline__ void operator()(const pg8::f32x4 (&acc)[2][2][4][2], const pg8::Unit& u, int wr, int wc, int fr, int fq) const {
        const int j = u.pn >> 2, pn = u.pn & 3, pm = u.pm & 63;
        const int col0 = pn * 256 + wc * 32 + 8 * fq, row0 = pm * 256 + wr * 64 + fr;
#pragma unroll
        for (int ai = 0; ai < 2; ++ai)
#pragma unroll
            for (int m = 0; m < 4; ++m) { const size_t ro = (size_t)(row0 + ai * 128 + m * 16) * DM + col0;
#pragma unroll
                for (int bj = 0; bj < 2; ++bj) { const size_t o = ro + bj * 128; float v[8];
#pragma unroll
                    for (int i = 0; i < 4; ++i) { v[i] = acc[ai][bj][m][0][i]; v[4 + i] = acc[ai][bj][m][1][i]; }
                    if (j < 3) {
#pragma unroll
                        for (int i = 0; i < 8; ++i) v[i] = sigmoidf_(v[i]);
                        *(v4u*)(gsc + o) = pack8(v);
                    } else {
                        float g[8]; unpack8(*(const v4u*)(gsc + o), g);
#pragma unroll
                        for (int i = 0; i < 8; ++i) v[i] *= g[i];
                        if (j > 3) { const f32x4 a = *(const f32x4*)(macc + o), b = *(const f32x4*)(macc + o + 4);
#pragma unroll
                            for (int i = 0; i < 4; ++i) { v[i] += a[i]; v[4 + i] += b[i]; } }
                        if (j < 5) { *(f32x4*)(macc + o) = (f32x4){v[0], v[1], v[2], v[3]}; *(f32x4*)(macc + o + 4) = (f32x4){v[4], v[5], v[6], v[7]}; }
                        else *(v4u*)(merged + o) = pack8(v);
                    } } }
    }
};

__device__ __forceinline__ void transpose_item(const float* __restrict__ W, const float* __restrict__ W2, int ldw, bf16* __restrict__ WT, int K, int nblk, float* scr, int item, int lane) {
    const int kb = item / nblk, nb = item % nblk, k0 = 64 * kb, n0 = 32 * nb;
    const float* src = ((lane & 31) < 16 ? W : W2) + (size_t)(k0 + (lane >> 5)) * ldw + n0 + (lane & 31);
    float t[32];
#pragma unroll
    for (int i = 0; i < 32; ++i) t[i] = src[(size_t)(2 * i) * ldw];
#pragma unroll
    for (int i = 0; i < 32; ++i) scr[(2 * i + (lane >> 5)) * 33 + (lane & 31)] = t[i];
    LDS_WAIT();
    const int c = lane & 7;
#pragma unroll
    for (int j = 0; j < 4; ++j) { const int n = (lane >> 3) + 8 * j; const float* s = scr + (8 * c) * 33 + n;
        v4u o; o.x = pk2(s[0 * 33], s[1 * 33]); o.y = pk2(s[2 * 33], s[3 * 33]); o.z = pk2(s[4 * 33], s[5 * 33]); o.w = pk2(s[6 * 33], s[7 * 33]);
        *(v4u*)(WT + (size_t)(n0 + n) * K + k0 + 8 * c) = o; }
    LDS_WAIT();
}
__device__ __forceinline__ void rms_row_to_bf16(const float* xrow, const float* w, bf16* orow, int lane) {
    const f32x4* xr = (const f32x4*)xrow + lane; const f32x4* wr = (const f32x4*)w + lane;
    f32x4 v[4]; float s = 0.f;
#pragma unroll
    for (int j = 0; j < 4; ++j) { v[j] = xr[64 * j]; s += (v[j][0] * v[j][0] + v[j][1] * v[j][1]) + (v[j][2] * v[j][2] + v[j][3] * v[j][3]); }
    const float rstd = rsqrtf(wave_sum(s) * (1.f / DM) + EPS);
    unsigned long long* o8 = (unsigned long long*)orow + lane;
#pragma unroll
    for (int j = 0; j < 4; ++j) { const f32x4 ww = wr[64 * j];
        o8[64 * j] = (unsigned long long)pk2(v[j][0] * rstd * ww[0], v[j][1] * rstd * ww[1]) | ((unsigned long long)pk2(v[j][2] * rstd * ww[2], v[j][3] * rstd * ww[3]) << 32); }
}
__device__ __forceinline__ void phase0(unsigned char* lds, CArgsR a, int l, const float* xin) {
    constexpr int LDW = 1032;
    const int tid = opaque_tid(), lane = tid & 63, wave = __builtin_amdgcn_readfirstlane(tid >> 6), gw = blockIdx.x * NWAVES + wave, NGW = gridDim.x * NWAVES;
    bf16* Wreg = (bf16*)(a.ws + WS_W);
    const float* w_in = a.in[2] + (size_t)l * DM * IN_DIM;
    {
        float* scr = (float*)lds + wave * (64 * 33);
        const float* w_br = a.in[13] + (size_t)l * 3 * DM * DM; const float* w_out = a.in[14] + (size_t)l * DM * DM;
        const float* w_up = a.in[16] + (size_t)l * DM * DFF; const float* w_down = a.in[17] + (size_t)l * DFF * DM;
        constexpr int NSEG = 17, NIT = NSEG * 512 + 2048 + 2048;
        for (int it = gw; it < NIT; it += NGW) {
            if (it < NSEG * 512) {
                const int seg = it >> 9, r = it & 511;
                const float* W; int ldw; bf16* WT;
                if (seg < 13) {
                    const int co = seg == 0 ? 3072 : seg == 1 ? 0 : seg == 2 ? 1024 : seg == 3 ? 2048 : seg == 4 ? 4112 : seg == 5 ? 7184 : seg == 6 ? 5136 : seg == 7 ? 6160 : seg == 8 ? 8208 : seg == 9 ? 9232
                                 : 10272 + (seg - 10) * 1024;
                    W = w_in + co; ldw = IN_DIM; WT = seg < 10 ? Wreg + (size_t)seg * DM * DM : Wreg + W_G + (size_t)(seg - 10) * DM * DM;
                } else if (seg < 16) { W = w_br + (size_t)(seg - 13) * DM * DM; ldw = DM; WT = Wreg + W_G + (size_t)(3 + seg - 13) * DM * DM; }
                else { W = w_out; ldw = DM; WT = Wreg + W_OUT; }
                transpose_item(W, W, ldw, WT, DM, 32, scr, r, lane);
            } else if (it < NSEG * 512 + 2048) transpose_item(w_up, w_up, DFF, Wreg + W_UP, DM, 128, scr, it - NSEG * 512, lane);
            else transpose_item(w_down, w_down, DM, Wreg + W_DOWN, DFF, 32, scr, it - NSEG * 512 - 2048, lane);
        }
    }
    __syncthreads();
    bf16* WsT = (bf16*)lds;
    for (int idx = tid; idx < 32 * DM; idx += NTHREADS) { const int k = idx >> 5, c = idx & 31; WsT[c * LDW + k] = (bf16)f2bf(w_in[(size_t)k * IN_DIM + (c < 16 ? 4096 + c : 10256 + c - 16)]); }
    __syncthreads();
    {   const float* nw = a.in[1] + (size_t)l * DM; bf16* H = (bf16*)a.ws; float* small = (float*)(a.ws + WS_SMALL);
        const int fr = lane & 15, fq = lane >> 4;
        const float pa0 = __expf(a.in[4][l * 8 + (fr & 7)]), pb0 = a.in[5][l * 8 + (fr & 7)], pa1 = __expf(a.in[9][l * 16 + fr]), pb1 = a.in[10][l * 16 + fr];
        for (int g8 = gw; g8 < MT / 8; g8 += NGW) {
            const int r0 = g8 * 8;
#pragma unroll 1
            for (int r = 0; r < 8; ++r) rms_row_to_bf16(xin + (size_t)(r0 + r) * DM, nw, H + (size_t)(r0 + r) * DM, lane);
            asm volatile("s_waitcnt vmcnt(0)" ::: "memory");
            f32x4 c0 = {0.f, 0.f, 0.f, 0.f}, c1 = {0.f, 0.f, 0.f, 0.f};
            const bf16* ap = H + (size_t)(r0 + (fr & 7)) * DM + fq * 8;
#pragma unroll
            for (int kb = 0; kb < 4; ++kb) { bf16x8 af[8];
#pragma unroll
                for (int k = 0; k < 8; ++k) af[k] = *(const bf16x8*)(ap + (kb * 8 + k) * 32);
#pragma unroll
                for (int k = 0; k < 8; ++k) { const bf16x8 b0 = *(const bf16x8*)(WsT + fr * LDW + (kb * 8 + k) * 32 + fq * 8), b1 = *(const bf16x8*)(WsT + (16 + fr) * LDW + (kb * 8 + k) * 32 + fq * 8);
                    c0 = __builtin_amdgcn_mfma_f32_16x16x32_bf16(af[k], b0, c0, 0, 0, 0); c1 = __builtin_amdgcn_mfma_f32_16x16x32_bf16(af[k], b1, c1, 0, 0, 0); } }
            if (fq < 2) {
#pragma unroll
                for (int jj = 0; jj < 4; ++jj) { float* sp = small + (size_t)(r0 + 4 * fq + jj) * 64;
                    sp[fr] = fr < 8 ? -pa0 * softplusf_(c0[jj] + pb0) : sigmoidf_(c0[jj]);
                    const float dt = softplusf_(c1[jj] + pb1); sp[16 + fr] = dt; sp[32 + fr] = -pa1 * dt; } }
        }
    }
}

__device__ __forceinline__ void conv8(const bf16* p, int pos, const float* w, int wstride, const float* bias, float* out) {
    float acc[8];
#pragma unroll
    for (int i = 0; i < 8; ++i) acc[i] = bias ? bias[i] : 0.f;
#pragma unroll
    for (int j = 0; j < 4; ++j) { const int back = 3 - j;
        if (pos - back >= 0) { float xv[8]; unpack8(*(const v4u*)(p - (size_t)back * DM), xv);
            const f32x4 w0 = *(const f32x4*)(w + j * wstride), w1 = *(const f32x4*)(w + j * wstride + 4);
#pragma unroll
            for (int i = 0; i < 4; ++i) { acc[i] += xv[i] * w0[i]; acc[4 + i] += xv[4 + i] * w1[i]; } } }
#pragma unroll
    for (int i = 0; i < 8; ++i) out[i] = siluf_(acc[i]);
}

__device__ __forceinline__ void conv8r(const v4u (&raw)[4], const float* w, int wstride, const float* bias, float* out) {
    float acc[8];
#pragma unroll
    for (int i = 0; i < 8; ++i) acc[i] = bias ? bias[i] : 0.f;
#pragma unroll
    for (int j = 0; j < 4; ++j) { float xv[8]; unpack8(raw[j], xv);
        const f32x4 w0 = *(const f32x4*)(w + j * wstride), w1 = *(const f32x4*)(w + j * wstride + 4);
#pragma unroll
        for (int i = 0; i < 4; ++i) { acc[i] += xv[i] * w0[i]; acc[4 + i] += xv[4 + i] * w1[i]; } }
#pragma unroll
    for (int i = 0; i < 8; ++i) out[i] = siluf_(acc[i]);
}
#define LOAD4(dst, p, pos) do { _Pragma("unroll") for (int j_ = 0; j_ < 4; ++j_) { const int back_ = 3 - j_; const bool ok_ = (pos) - back_ >= 0; \
        const v4u t_ = *(const v4u*)((p) - (size_t)(ok_ ? back_ : 0) * DM); dst[j_] = ok_ ? t_ : (v4u){0u, 0u, 0u, 0u}; } } while (0)

template <int K> __device__ __forceinline__ void mma16(f32x4& acc, const bf16* Ap, int lda, const bf16* Bp, int ldb, int fr, int fq) {
    bf16x8 af[K / 32], bfv[K / 32];
#pragma unroll
    for (int k = 0; k < K / 32; ++k) { af[k] = *(const bf16x8*)(Ap + fr * lda + k * 32 + fq * 8); bfv[k] = *(const bf16x8*)(Bp + fr * ldb + k * 32 + fq * 8); }
#pragma unroll
    for (int k = 0; k < K / 32; ++k) acc = __builtin_amdgcn_mfma_f32_16x16x32_bf16(af[k], bfv[k], acc, 0, 0, 0);
}
__device__ __forceinline__ void dn_item(unsigned char* lds, CArgsR a, int l, int item, unsigned long long& probe_acc) {
    constexpr int LDK = 136, LDJ = 40, LDL = 36;
    const int b = item >> 3, h = item & 7;
    bf16* kA = (bf16*)lds;
    bf16* qA = kA + 32 * LDK;
    bf16* qgA = qA + 32 * LDK;
    bf16* wA = qgA + 32 * LDK;
    bf16* kdT = wA + 32 * LDK;
    bf16* vnT = kdT + 128 * LDJ;
    bf16* attn = vnT + 128 * LDJ;
    bf16* ST = attn + 32 * LDJ;
    float* kf = (float*)(ST + 128 * LDK);
    float* vf = kf + 32 * 128;
    float* os = kf;
    float* Lm = vf + 32 * 128;
    float* gcs = Lm + 32 * LDL;
    float* betas = gcs + 32;
    float* cwL = betas + 32;
    const int tid = opaque_tid(), w = __builtin_amdgcn_readfirstlane(tid >> 6), lane = tid & 63, fr = lane & 15, fq = lane >> 4;
    bf16* base = (bf16*)a.ws;
    const bf16* Q = base + (size_t)B_DNQ * BUFE; const bf16* K = base + (size_t)B_DNK * BUFE; const bf16* V = base + (size_t)B_DNV * BUFE; bf16* G = base + (size_t)B_DNG * BUFE;
    const float* small = (const float*)(a.ws + WS_SMALL);
    const float* cw = a.in[3] + (size_t)l * 4 * 3072;
    const size_t rowbase = (size_t)b * SEQ;
    const int tq = tid >> 4, cq = tid & 15;
    const float* nwp = a.in[6] + l * 128 + cq * 8;
    f32x4 Sacc[8];
#pragma unroll
    for (int i = 0; i < 8; ++i) Sacc[i] = (f32x4){0.f, 0.f, 0.f, 0.f};
    for (int i = tid; i < 128 * LDK / 2; i += NTHREADS) ((unsigned*)ST)[i] = 0u;
    for (int i = tid; i < 4 * 384; i += NTHREADS) { const int j = i / 384, r = i % 384; cwL[i] = cw[j * 3072 + (r >> 7) * 1024 + h * 128 + (r & 127)]; }
    __syncthreads();
    const int ta = ((tid - 256) >> 4) & 15;
    v4u rqa[4], rka[4], rva[4], rqb[4], rkb[4], rvb[4]; float rg = 0.f, rbv = 0.f;
    v4u Pv[2];
    Pv[0] = Pv[1] = (v4u){0u, 0u, 0u, 0u};
#define DN_LOADS_RAW(c_, half_) do { const int pos_ = (c_) * 32 + ta + 16 * (half_); const size_t off_ = (rowbase + pos_) * DM + h * 128 + cq * 8; LOAD4(rqa, Q + off_, pos_); LOAD4(rka, K + off_, pos_); LOAD4(rva, V + off_, pos_); } while (0)
#define DN_LOADS_RAWB(c_) do { const int pos_ = (c_) * 32 + ta + 16; const size_t off_ = (rowbase + pos_) * DM + h * 128 + cq * 8; LOAD4(rqb, Q + off_, pos_); LOAD4(rkb, K + off_, pos_); LOAD4(rvb, V + off_, pos_); } while (0)
#define DN_LOADS_SMALL(c_) do { const int t0_ = (c_) * 32; \
        { const size_t r_ = rowbase + t0_ + (lane & 31); rg = small[r_ * 64 + h]; rbv = small[r_ * 64 + 8 + h]; } } while (0)
#define DN_CONV(rq_, rk_, rv_, slot_) do { const float* cw_ = cwL + cq * 8; asm volatile("" : "+v"(cw_)); \
        { float o8_[8]; conv8r(rq_, cw_, 384, nullptr, o8_); float ss_ = 0.f; _Pragma("unroll") for (int i_ = 0; i_ < 8; ++i_) ss_ += o8_[i_] * o8_[i_]; \
          ss_ = red16(ss_); const float rn_ = rsqrtf(ss_ + EPS) * 0.08838834764831845f; _Pragma("unroll") for (int i_ = 0; i_ < 8; ++i_) o8_[i_] *= rn_; *(v4u*)(qA + (ta + 16 * (slot_)) * LDK + cq * 8) = pack8(o8_); } \
        __builtin_amdgcn_sched_barrier(0); \
        { float o8_[8]; conv8r(rk_, cw_ + 128, 384, nullptr, o8_); float ss_ = 0.f; _Pragma("unroll") for (int i_ = 0; i_ < 8; ++i_) ss_ += o8_[i_] * o8_[i_]; \
          ss_ = red16(ss_); const float rn_ = rsqrtf(ss_ + EPS); _Pragma("unroll") for (int i_ = 0; i_ < 8; ++i_) o8_[i_] *= rn_; *(v4u*)(kA + (ta + 16 * (slot_)) * LDK + cq * 8) = pack8(o8_); } \
        __builtin_amdgcn_sched_barrier(0); \
        { float o8_[8]; conv8r(rv_, cw_ + 256, 384, nullptr, o8_); Pv[slot_] = pack8(o8_); } \
        __builtin_amdgcn_sched_barrier(0); } while (0)
    if (w >= 4) { DN_LOADS_RAW(0, 0); DN_CONV(rqa, rka, rva, 0); DN_LOADS_RAW(0, 1); DN_CONV(rqa, rka, rva, 1); }
    DN_LOADS_SMALL(0);
    for (int c = 0; c < SEQ / 32; ++c) {
        const int t0 = c * 32;
        unsigned long long tp_ = PROBE_SEL ? rt() : 0ull;
#define DPT(k) do { if (PROBE_SEL) { const unsigned long long tn_ = rt(); if ((PROBE_SEL & (1 << (k))) && item == 0) probe_acc += tn_ - tp_; tp_ = tn_; } } while (0)
        float gcv = rg;
#pragma unroll
        for (int off = 1; off < 32; off <<= 1) { const float t = __shfl_up(gcv, off, 32); if ((lane & 31) >= off) gcv += t; }
        const float gc_last = __shfl(gcv, 31);
        if (w >= 4) {
#pragma unroll
            for (int s2 = 0; s2 < 2; ++s2) { const int tt = ta + 16 * s2;
                const float gc_t = __shfl(gcv, tt), beta_t = __shfl(rbv, tt);
                float q8[8], k8[8], v8[8], t8[8];
                unpack8(*(const v4u*)(qA + tt * LDK + cq * 8), q8); unpack8(*(const v4u*)(kA + tt * LDK + cq * 8), k8); unpack8(Pv[s2], v8);
                const float eg = __expf(gc_t), kb = beta_t * eg, kd = __expf(gc_last - gc_t);
#pragma unroll
                for (int i = 0; i < 8; ++i) t8[i] = q8[i] * eg;
                *(v4u*)(qgA + tt * LDK + cq * 8) = pack8(t8);
                *(f32x4*)(kf + tt * 128 + cq * 8) = (f32x4){k8[0] * kb, k8[1] * kb, k8[2] * kb, k8[3] * kb}; *(f32x4*)(kf + tt * 128 + cq * 8 + 4) = (f32x4){k8[4] * kb, k8[5] * kb, k8[6] * kb, k8[7] * kb};
                *(f32x4*)(vf + tt * 128 + cq * 8) = (f32x4){v8[0] * beta_t, v8[1] * beta_t, v8[2] * beta_t, v8[3] * beta_t}; *(f32x4*)(vf + tt * 128 + cq * 8 + 4) = (f32x4){v8[4] * beta_t, v8[5] * beta_t, v8[6] * beta_t, v8[7] * beta_t};
#pragma unroll
                for (int i = 0; i < 8; ++i) kdT[(cq * 8 + i) * LDJ + tt] = (bf16)f2bf(k8[i] * kd);
            }
        }
        if (tid < 32) { gcs[tid] = gcv; betas[tid] = rbv; }
        __syncthreads();
        DPT(12);
        if (w >= 4 && c + 1 < SEQ / 32) DN_LOADS_RAW(c + 1, 0);
        {   const int ww = w & 3, gi = ww >> 1, gj = ww & 1; f32x4 acc = {0.f, 0.f, 0.f, 0.f};
            const int jI = 16 * gj + fr, i0 = 16 * gi + 4 * fq;
            const float gj_ = gcs[jI]; const f32x4 gi4 = *(const f32x4*)(gcs + i0), bi4 = *(const f32x4*)(betas + i0);
            mma16<128>(acc, (w < 4 ? kA : qA) + gi * 16 * LDK, LDK, kA + gj * 16 * LDK, LDK, fr, fq);
            if (w < 4) {
#pragma unroll
                for (int jj = 0; jj < 4; ++jj) Lm[(i0 + jj) * LDL + jI] = jI < i0 + jj ? bi4[jj] * acc[jj] * __expf(gi4[jj] - gj_) : 0.f;
            } else {
#pragma unroll
                for (int jj = 0; jj < 4; ++jj) attn[(i0 + jj) * LDJ + jI] = (bf16)f2bf(jI <= i0 + jj ? acc[jj] * __expf(gi4[jj] - gj_) : 0.f);
            } }
        __syncthreads();
        DPT(13);
        if (w < 4) { const int cc = tid & 127; const bool is_w = w >= 2; const float* R = is_w ? kf : vf;
            float x[32];
#pragma unroll
            for (int i = 0; i < 32; ++i) x[i] = R[i * 128 + cc];
            f32x4 Lb[2][8];
            Lb[1][0] = *(const f32x4*)(Lm + 1 * LDL);
#pragma unroll
            for (int i = 1; i < 32; ++i) {
                if (i + 1 < 32) {
#pragma unroll
                    for (int j4 = 0; j4 < (i + 4) / 4; ++j4) Lb[(i + 1) & 1][j4] = *(const f32x4*)(Lm + (i + 1) * LDL + j4 * 4); }
                float a0 = x[i], a1 = 0.f, a2 = 0.f, a3 = 0.f;
#pragma unroll
                for (int j4 = 0; j4 < (i + 3) / 4; ++j4) { const f32x4 l4 = Lb[i & 1][j4];
                    if (j4 * 4 + 0 < i) a0 -= l4[0] * x[j4 * 4 + 0];
                    if (j4 * 4 + 1 < i) a1 -= l4[1] * x[j4 * 4 + 1];
                    if (j4 * 4 + 2 < i) a2 -= l4[2] * x[j4 * 4 + 2];
                    if (j4 * 4 + 3 < i) a3 -= l4[3] * x[j4 * 4 + 3]; }
                x[i] = (a0 + a1) + (a2 + a3); }
            if (is_w) {
#pragma unroll
                for (int i = 0; i < 32; ++i) wA[i * LDK + cc] = (bf16)f2bf(x[i]);
            } else {
#pragma unroll
                for (int i = 0; i < 32; ++i) vf[i * 128 + cc] = x[i];
            } }
        else if (c + 1 < SEQ / 32) { DN_LOADS_RAWB(c + 1); __builtin_amdgcn_sched_barrier(0); DN_CONV(rqa, rka, rva, 0); DN_CONV(rqb, rkb, rvb, 1); }
        __syncthreads();
        DPT(14);
        if (c + 1 < SEQ / 32) DN_LOADS_SMALL(c + 1);
        const v4u gcur = *(const v4u*)(G + (rowbase + t0 + tq) * DM + h * 128 + cq * 8);
#pragma unroll
        for (int it = 0; it < 2; ++it) { f32x4 acc = {0.f, 0.f, 0.f, 0.f};
            mma16<128>(acc, wA + it * 16 * LDK, LDK, ST + w * 16 * LDK, LDK, fr, fq);
            float vn[4];
#pragma unroll
            for (int jj = 0; jj < 4; ++jj) vn[jj] = vf[(16 * it + 4 * fq + jj) * 128 + 16 * w + fr] - acc[jj];
            v2u pk; pk.x = pk2(vn[0], vn[1]); pk.y = pk2(vn[2], vn[3]);
            *(v2u*)(vnT + (16 * w + fr) * LDJ + 16 * it + 4 * fq) = pk; }
        __syncthreads();
#pragma unroll
        for (int it = 0; it < 2; ++it) { f32x4 acc = {0.f, 0.f, 0.f, 0.f};
            mma16<128>(acc, qgA + it * 16 * LDK, LDK, ST + w * 16 * LDK, LDK, fr, fq);
            mma16<32>(acc, attn + it * 16 * LDJ, LDJ, vnT + w * 16 * LDJ, LDJ, fr, fq);
#pragma unroll
            for (int jj = 0; jj < 4; ++jj) os[(16 * it + 4 * fq + jj) * 128 + 16 * w + fr] = acc[jj]; }
        {   const float dl = __expf(gc_last);
#pragma unroll
            for (int dt = 0; dt < 8; ++dt) { Sacc[dt] = Sacc[dt] * dl; mma16<32>(Sacc[dt], kdT + dt * 16 * LDJ, LDJ, vnT + w * 16 * LDJ, LDJ, fr, fq); } }
        __syncthreads();
#pragma unroll
        for (int dt = 0; dt < 8; ++dt) { v2u pk; pk.x = pk2(Sacc[dt][0], Sacc[dt][1]); pk.y = pk2(Sacc[dt][2], Sacc[dt][3]);
            *(v2u*)(ST + (16 * w + fr) * LDK + 16 * dt + 4 * fq) = pk; }
        {   const f32x4 o0 = *(const f32x4*)(os + tq * 128 + cq * 8), o1 = *(const f32x4*)(os + tq * 128 + cq * 8 + 4);
            float ss = (o0[0] * o0[0] + o0[1] * o0[1]) + (o0[2] * o0[2] + o0[3] * o0[3]) + (o1[0] * o1[0] + o1[1] * o1[1]) + (o1[2] * o1[2] + o1[3] * o1[3]);
            ss = red16(ss);
            const float r = rsqrtf(ss * (1.f / 128.f) + EPS);
            float g8[8], o8[8], nw8[8]; unpack8(gcur, g8);
            { const f32x4 n0 = *(const f32x4*)nwp, n1 = *(const f32x4*)(nwp + 4); nw8[0] = n0[0]; nw8[1] = n0[1]; nw8[2] = n0[2]; nw8[3] = n0[3]; nw8[4] = n1[0]; nw8[5] = n1[1]; nw8[6] = n1[2]; nw8[7] = n1[3]; }
#pragma unroll
            for (int i = 0; i < 4; ++i) { o8[i] = o0[i] * r * nw8[i] * siluf_(g8[i]); o8[4 + i] = o1[i] * r * nw8[4 + i] * siluf_(g8[4 + i]); }
            *(v4u*)(G + (rowbase + t0 + tq) * DM + h * 128 + cq * 8) = pack8(o8); }
        __syncthreads();
        DPT(15);
    }
#undef DPT
#undef DN_LOADS_RAW
#undef DN_LOADS_RAWB
#undef DN_LOADS_SMALL
#undef DN_CONV
    __syncthreads();
}

__device__ __forceinline__ void ssm_item(unsigned char* lds, CArgsR a, int l, int item) {
    constexpr int LDC = 136, LDX = 40;
    const int b = item >> 4, hd = item & 15, g = hd >> 2;
    bf16* Cs = (bf16*)lds;
    bf16* Bs = Cs + 32 * LDC;
    bf16* BT = Bs + 32 * LDC;
    bf16* xdtT = BT + 128 * LDX;
    bf16* xddT = xdtT + 64 * LDX;
    bf16* Wm = xddT + 64 * LDX;
    bf16* hB = Wm + 32 * LDX;
    float* xs = (float*)(hB + 64 * LDC);
    float* acs = xs + 32 * 64;
    const int tid = opaque_tid(), w = __builtin_amdgcn_readfirstlane(tid >> 6), lane = tid & 63, fr = lane & 15, fq = lane >> 4;
    bf16* base = (bf16*)a.ws;
    const bf16* X = base + (size_t)B_SSX * BUFE; const bf16* BC = base + (size_t)B_SSBC * BUFE; bf16* Z = base + (size_t)B_SSZ * BUFE;
    const float* small = (const float*)(a.ws + WS_SMALL);
    const float* cw = a.in[7] + (size_t)l * 4 * 2048; const float* cb = a.in[8] + (size_t)l * 2048;
    const float dskip = a.in[11][l * 16 + hd];
    const size_t rowbase = (size_t)b * SEQ;
    const int tq = tid >> 4, cq = tid & 15, tv = (tid >> 3) & 31, cv = tid & 7;
    const int it = w >> 2, pt = w & 3;
    f32x4 hacc[4];
#pragma unroll
    for (int i = 0; i < 4; ++i) hacc[i] = (f32x4){0.f, 0.f, 0.f, 0.f};
    for (int i = tid; i < 64 * LDC / 2; i += NTHREADS) ((unsigned*)hB)[i] = 0u;
    v4u rB[4], rC[4], rx[4]; float ra = 0.f, rdtv = 0.f; unsigned rz[4];
#define SSM_LOADS(c_) do { const int t0_ = (c_) * 32; { const int pos_ = t0_ + tq; const size_t ro_ = (rowbase + pos_) * DM; LOAD4(rB, BC + ro_ + g * 128 + cq * 8, pos_); LOAD4(rC, BC + ro_ + 512 + g * 128 + cq * 8, pos_); } \
        if (tid < 256) { const int pos_ = t0_ + tv; LOAD4(rx, X + (rowbase + pos_) * DM + hd * 64 + cv * 8, pos_); } \
        { const size_t r_ = rowbase + t0_ + (lane & 31); rdtv = small[r_ * 64 + 16 + hd]; ra = small[r_ * 64 + 32 + hd]; } \
        _Pragma("unroll") for (int jj_ = 0; jj_ < 4; ++jj_) rz[jj_] = Z[(rowbase + t0_ + 16 * it + 4 * fq + jj_) * DM + hd * 64 + 16 * pt + fr]; } while (0)
    SSM_LOADS(0);
    for (int c = 0; c < SEQ / 32; ++c) {
        const int t0 = c * 32;
        float acum = ra;
#pragma unroll
        for (int off = 1; off < 32; off <<= 1) { const float t = __shfl_up(acum, off, 32); if ((lane & 31) >= off) acum += t; }
        const float ac_last = __shfl(acum, 31);
        {   float o8[8];
            conv8r(rB, cw + 1024 + g * 128 + cq * 8, 2048, cb + 1024 + g * 128 + cq * 8, o8);
            *(v4u*)(Bs + tq * LDC + cq * 8) = pack8(o8);
#pragma unroll
            for (int i = 0; i < 8; ++i) BT[(cq * 8 + i) * LDX + tq] = (bf16)f2bf(o8[i]);
            conv8r(rC, cw + 1536 + g * 128 + cq * 8, 2048, cb + 1536 + g * 128 + cq * 8, o8);
            *(v4u*)(Cs + tq * LDC + cq * 8) = pack8(o8);
        }
        if (w < 4) { float o8[8]; conv8r(rx, cw + hd * 64 + cv * 8, 2048, cb + hd * 64 + cv * 8, o8);
            const float dtv = __shfl(rdtv, tv), dd = dtv * __expf(ac_last - __shfl(acum, tv));
            *(f32x4*)(xs + tv * 64 + cv * 8) = (f32x4){o8[0], o8[1], o8[2], o8[3]}; *(f32x4*)(xs + tv * 64 + cv * 8 + 4) = (f32x4){o8[4], o8[5], o8[6], o8[7]};
#pragma unroll
            for (int i = 0; i < 8; ++i) { xdtT[(cv * 8 + i) * LDX + tv] = (bf16)f2bf(o8[i] * dtv); xddT[(cv * 8 + i) * LDX + tv] = (bf16)f2bf(o8[i] * dd); }
        }
        if (tid < 32) acs[tid] = acum;
        unsigned zr[4];
#pragma unroll
        for (int jj = 0; jj < 4; ++jj) zr[jj] = rz[jj];
        __syncthreads();
        if (c + 1 < SEQ / 32) SSM_LOADS(c + 1);
        if (w < 4) { const int gi = w >> 1, gj = w & 1; f32x4 acc = {0.f, 0.f, 0.f, 0.f};
            mma16<128>(acc, Cs + gi * 16 * LDC, LDC, Bs + gj * 16 * LDC, LDC, fr, fq);
            const int sI = 16 * gj + fr; const float as = acs[sI];
#pragma unroll
            for (int jj = 0; jj < 4; ++jj) { const int lI = 16 * gi + 4 * fq + jj; const float v = sI <= lI ? acc[jj] * __expf(acs[lI] - as) : 0.f; Wm[lI * LDX + sI] = (bf16)f2bf(v); } }
        __syncthreads();
        {   f32x4 a1 = {0.f, 0.f, 0.f, 0.f}, a2 = {0.f, 0.f, 0.f, 0.f};
            mma16<32>(a1, Wm + it * 16 * LDX, LDX, xdtT + pt * 16 * LDX, LDX, fr, fq);
            mma16<128>(a2, Cs + it * 16 * LDC, LDC, hB + pt * 16 * LDC, LDC, fr, fq);
            const int p = 16 * pt + fr;
#pragma unroll
            for (int jj = 0; jj < 4; ++jj) { const int lI = 16 * it + 4 * fq + jj;
                const float y = a1[jj] + __expf(acs[lI]) * a2[jj] + xs[lI * 64 + p] * dskip;
                Z[(rowbase + t0 + lI) * DM + hd * 64 + p] = (bf16)f2bf(y * siluf_(bf2f(zr[jj]))); }
            const float dl = __expf(ac_last);
#pragma unroll
            for (int p2 = 0; p2 < 4; ++p2) { hacc[p2] = hacc[p2] * dl; mma16<32>(hacc[p2], xddT + p2 * 16 * LDX, LDX, BT + w * 16 * LDX, LDX, fr, fq); }
        }
        __syncthreads();
#pragma unroll
        for (int p2 = 0; p2 < 4; ++p2)
#pragma unroll
            for (int jj = 0; jj < 4; ++jj) hB[(16 * p2 + 4 * fq + jj) * LDC + 16 * w + fr] = (bf16)f2bf(hacc[p2][jj]);
    }
#undef SSM_LOADS
    __syncthreads();
}

__device__ __forceinline__ void sb_item(unsigned char* lds, CArgsR a, int b, int hd, int qi) {
    constexpr int LD = 72;
    bf16* Ks = (bf16*)lds; bf16* Vs = Ks + 2 * 64 * LD;
    volatile unsigned* alive = (volatile unsigned*)(Vs + 2 * 64 * LD);
    const int tid = opaque_tid(), w = __builtin_amdgcn_readfirstlane(tid >> 6), lane = tid & 63, fr = lane & 15, fq = lane >> 4;
    bf16* base = (bf16*)a.ws;
    bf16* Qb = base + (size_t)B_SBQ * BUFE; const bf16* Kb = base + (size_t)B_SBK * BUFE; const bf16* Vb = base + (size_t)B_SBV * BUFE;
    const size_t rowbase = (size_t)b * SEQ;
    const int t0 = qi * 128, myq = t0 + w * 16 + fr, wmax = t0 + w * 16 + 15;
    bf16* qrow = Qb + (rowbase + myq) * DM + hd * 64;
    bf16x8 qf[2];
    qf[0] = *(const bf16x8*)(qrow + fq * 8); qf[1] = *(const bf16x8*)(qrow + 32 + fq * 8);
    f32x4 oacc[4];
#pragma unroll
    for (int i = 0; i < 4; ++i) oacc[i] = (f32x4){0.f, 0.f, 0.f, 0.f};
    float carry = 1.f;
    const int kr = tid >> 3, d8 = (tid & 7) * 8;
    v4u kreg, vreg;
    int kt = 2 * (qi + 1) - 1;
#define SB_LOAD(t) do { const size_t o_ = (rowbase + (size_t)(t) * 64 + kr) * DM + hd * 64 + d8; kreg = *(const v4u*)(Kb + o_); vreg = *(const v4u*)(Vb + o_); } while (0)
#define SB_STORE(bu) do { *(v4u*)(Ks + (bu) * 64 * LD + kr * LD + d8) = kreg; bf16* vd_ = Vs + (bu) * 64 * LD + d8 * LD + kr; \
        vd_[0] = (bf16)(vreg.x & 0xffffu); vd_[LD] = (bf16)(vreg.x >> 16); vd_[2 * LD] = (bf16)(vreg.y & 0xffffu); vd_[3 * LD] = (bf16)(vreg.y >> 16); \
        vd_[4 * LD] = (bf16)(vreg.z & 0xffffu); vd_[5 * LD] = (bf16)(vreg.z >> 16); vd_[6 * LD] = (bf16)(vreg.w & 0xffffu); vd_[7 * LD] = (bf16)(vreg.w >> 16); } while (0)
    SB_LOAD(kt); SB_STORE(0);
    __syncthreads();
    int cur = 0;
    for (; kt >= 0; --kt) {
        if (kt > 0) SB_LOAD(kt - 1);
        const int kbase = kt * 64;
        if (kbase <= wmax) {
            const bf16* Kc = Ks + cur * 64 * LD; const bf16* Vc = Vs + cur * 64 * LD;
            f32x4 z[4];
#pragma unroll
            for (int nt = 0; nt < 4; ++nt) { z[nt] = (f32x4){0.f, 0.f, 0.f, 0.f};
#pragma unroll
                for (int k2 = 0; k2 < 2; ++k2) { const bf16x8 af = *(const bf16x8*)(Kc + (nt * 16 + fr) * LD + k2 * 32 + fq * 8);
                    z[nt] = __builtin_amdgcn_mfma_f32_16x16x32_bf16(af, qf[k2], z[nt], 0, 0, 0); } }
            float kp[4][4], sg[4][4], T[4], tot[4], suf[4];
            const bool masked = kbase + 64 > t0 + w * 16;
#pragma unroll
            for (int nt = 0; nt < 4; ++nt) {
#pragma unroll
                for (int j = 0; j < 4; ++j) { const float z2 = z[nt][j] * 0.18033688011112042f;
                    const float ea = __builtin_amdgcn_exp2f(-fabsf(z2)), rc = __builtin_amdgcn_rcpf(1.f + ea); const bool pos = z2 >= 0.f;
                    sg[nt][j] = (pos ? 1.f : ea) * rc; kp[nt][j] = (pos ? ea : 1.f) * rc; }
                if (masked) {
#pragma unroll
                    for (int j = 0; j < 4; ++j) { const bool valid = kbase + nt * 16 + fq * 4 + j < myq; sg[nt][j] = valid ? sg[nt][j] : 0.f; kp[nt][j] = valid ? kp[nt][j] : 1.f; } }
                T[nt] = (kp[nt][0] * kp[nt][1]) * (kp[nt][2] * kp[nt][3]); }
#pragma unroll
            for (int nt = 0; nt < 4; ++nt) { const float p16 = __shfl_xor(T[nt], 16), s1 = T[nt] * p16, p32 = __shfl_xor(s1, 32); tot[nt] = s1 * p32;
                suf[nt] = fq == 0 ? p16 * p32 : fq == 1 ? p32 : fq == 2 ? p16 : 1.f; }
            float run = carry; float wv[4][4];
#pragma unroll
            for (int nt = 3; nt >= 0; --nt) { const float r3 = run * suf[nt], r2 = r3 * kp[nt][3], r1 = r2 * kp[nt][2], r0 = r1 * kp[nt][1];
                wv[nt][0] = sg[nt][0] * r0; wv[nt][1] = sg[nt][1] * r1; wv[nt][2] = sg[nt][2] * r2; wv[nt][3] = sg[nt][3] * r3;
                run *= tot[nt]; }
            carry = run;
#pragma unroll
            for (int kk = 0; kk < 2; ++kk) {
                v4u bw; bw.x = pk2(wv[2 * kk][0], wv[2 * kk][1]); bw.y = pk2(wv[2 * kk][2], wv[2 * kk][3]); bw.z = pk2(wv[2 * kk + 1][0], wv[2 * kk + 1][1]); bw.w = pk2(wv[2 * kk + 1][2], wv[2 * kk + 1][3]);
                const bf16x8 bfr = __builtin_bit_cast(bf16x8, bw);
#pragma unroll
                for (int mt = 0; mt < 4; ++mt) { const bf16* vp = Vc + (mt * 16 + fr) * LD + 32 * kk + 4 * fq;
                    const v2u lo = *(const v2u*)vp, hi = *(const v2u*)(vp + 16);
                    v4u av; av.x = lo.x; av.y = lo.y; av.z = hi.x; av.w = hi.y;
                    oacc[mt] = __builtin_amdgcn_mfma_f32_16x16x32_bf16(__builtin_bit_cast(bf16x8, av), bfr, oacc[mt], 0, 0, 0); }
            }
        }
        {   const bool any_alive = __ballot(carry != 0.f) != 0ull;
            if (lane == 0) alive[cur * 8 + w] = any_alive ? 1u : 0u; }
        if (kt > 0) SB_STORE(cur ^ 1);
        __syncthreads();
        unsigned al = 0u;
#pragma unroll
        for (int i = 0; i < 8; ++i) al |= alive[cur * 8 + i];
        if (al == 0u) break;
        cur ^= 1;
    }
#undef SB_LOAD
#undef SB_STORE
#pragma unroll
    for (int mt = 0; mt < 4; ++mt) { v2u wq; wq.x = pk2(oacc[mt][0], oacc[mt][1]); wq.y = pk2(oacc[mt][2], oacc[mt][3]); *(v2u*)(qrow + mt * 16 + fq * 4) = wq; }
}

__device__ __forceinline__ void phase_mixers(unsigned char* lds, CArgsR a, int l, unsigned long long& probe_acc) {
    unsigned* ctl = (unsigned*)(a.ws + WS_CTL);
    unsigned* counter = ctl + 64 * l; unsigned* gdone = ctl + 64 * l + 32;
    volatile unsigned* slot = (volatile unsigned*)(lds + LDS_BYTES - 64);
    constexpr int NDN = 64;
    const int nb = (int)gridDim.x - NDN;
    if ((int)blockIdx.x < NDN) { PT0(); dn_item(lds, a, l, (int)blockIdx.x, probe_acc); if (blockIdx.x == 0 && l == 0) PT1(9); }
    else {
        bf16* base = (bf16*)a.ws; bf16* Wreg = (bf16*)(a.ws + WS_W);
        pg8::Gemm g{base, Wreg + W_IN + (size_t)4096 * DM, MT, 6144, DM}; pg8::StaticOrder S; S.init(MT, 6144, nb, (int)blockIdx.x - NDN);
        EpiRoute E{base, 16};
        pg8::gemm_phase<EpiRoute, pg8::StaticOrder, true, true>((PG8_LAS unsigned char*)lds, g, S, E);
        __builtin_amdgcn_fence(__ATOMIC_RELEASE, "agent");
        asm volatile("s_waitcnt vmcnt(0)" ::: "memory");
        __syncthreads();
        if (threadIdx.x == 0) __hip_atomic_fetch_add(gdone, 1u, __ATOMIC_RELAXED, __HIP_MEMORY_SCOPE_AGENT);
    }
    if (threadIdx.x == 0) {
        unsigned sp = 0u;
        while (__hip_atomic_load(gdone, __ATOMIC_RELAXED, __HIP_MEMORY_SCOPE_AGENT) < (unsigned)nb && ++sp < (1u << 22)) __builtin_amdgcn_s_sleep(2);
        __builtin_amdgcn_fence(__ATOMIC_ACQUIRE, "agent");
        asm volatile("s_waitcnt vmcnt(0)" ::: "memory");
    }
    __syncthreads();
    constexpr unsigned NITEMS = 128 + 2048;
    for (;;) {
        if (threadIdx.x == 0) *slot = __hip_atomic_fetch_add(counter, 1u, __ATOMIC_RELAXED, __HIP_MEMORY_SCOPE_AGENT);
        __syncthreads();
        const unsigned item = *slot;
        __syncthreads();
        if (item >= NITEMS) break;
        PT0();
        if (item < 128) { ssm_item(lds, a, l, (int)item); if (item == 0 && l == 0) PT1(10); }
        else { const int r = (int)item - 128, qi = 15 - (r >> 7), bh = r & 127; sb_item(lds, a, bh >> 4, bh & 15, qi); if (item == 128 && l == 0) PT1(11); }
    }
}

__device__ __forceinline__ void phase_norms(CArgsR a, int l) {
    const int tid = opaque_tid(), lane = tid & 63, wave = tid >> 6, gw = blockIdx.x * NWAVES + wave, NGW = gridDim.x * NWAVES;
    bf16* base = (bf16*)a.ws;
    const bf16* Oraw = base + (size_t)B_DNV * BUFE; bf16* G = base + (size_t)B_DNG * BUFE; bf16* Y = base + (size_t)B_SSZ * BUFE;
    const float* dnw = a.in[6] + (size_t)l * 128 + (lane & 7) * 16; const float* snw = a.in[12] + (size_t)l * DM + lane * 16;
    float w1[16], w2[16];
#pragma unroll
    for (int i = 0; i < 16; ++i) { w1[i] = dnw[i]; w2[i] = snw[i]; }
    for (int m = gw; m < MT; m += NGW) {
        const size_t o = (size_t)m * DM + lane * 16;
        float v[16], s, r;
        unpack8(*(const v4u*)(Y + o), v); unpack8(*(const v4u*)(Y + o + 8), v + 8);
        s = 0.f;
#pragma unroll
        for (int i = 0; i < 16; ++i) s += v[i] * v[i];
        s = red16(s);
        r = rsqrtf(s * (1.f / 256.f) + EPS);
#pragma unroll
        for (int i = 0; i < 16; ++i) v[i] = v[i] * r * w2[i];
        *(v4u*)(Y + o) = pack8(v); *(v4u*)(Y + o + 8) = pack8(v + 8);
    }
}

#define LAS __attribute__((address_space(3)))
#define XB_TMO      128
#define XB_XCNT(j)  (256  + 64 * (j))
#define XB_XSUB(j)  (1280 + 64 * (j))
#define XB_XGEN(j)  (2304 + 64 * (j))
#define XB_TOP      3328
#define XB_TOPGEN   3392
#define XCD_BAR_WORDS 3456
#define XB_SPIN_CAP (1u << 18)

__device__ __forceinline__ unsigned xb_ld(unsigned* p)              { return __hip_atomic_load(p, __ATOMIC_RELAXED, __HIP_MEMORY_SCOPE_AGENT); }
__device__ __forceinline__ unsigned xb_add(unsigned* p, unsigned v) { return __hip_atomic_fetch_add(p, v, __ATOMIC_RELAXED, __HIP_MEMORY_SCOPE_AGENT); }
__device__ __forceinline__ unsigned xb_xcc_id() { return (unsigned)__builtin_amdgcn_s_getreg((3 << 11) | 20) & 0xFu; }
#define XB_SPIN(cond, bar) do { unsigned _sp = 0; while (cond) { __builtin_amdgcn_s_sleep(1); \
    if ((++_sp & 255u) == 0u) { if (xb_ld(&(bar)[XB_TMO])) break; if (_sp > XB_SPIN_CAP) { atomicAdd(&(bar)[XB_TMO], 1u); break; } } } } while (0)

struct XcdBarrier {
    unsigned* bar; unsigned x;
    volatile LAS unsigned* st;
};

__device__ __forceinline__ XcdBarrier xcd_barrier_post(unsigned* bar, volatile LAS unsigned* st) {
    XcdBarrier b; b.bar = bar; b.x = xb_xcc_id(); b.st = st;
    if (threadIdx.x == 0) (void)xb_add(&bar[XB_XCNT(b.x)], 1u);
    return b;
}
__device__ __forceinline__ void xcd_barrier_complete(unsigned* bar, unsigned x, unsigned& nloc, unsigned& nx) {
    const unsigned G = gridDim.x * gridDim.y * gridDim.z;
    unsigned sum, cnt, mine, sp = 0u;
    for (;;) {
        sum = 0u; cnt = 0u; mine = 0u;
#pragma unroll
        for (unsigned j = 0; j < 16; ++j) { const unsigned c = xb_ld(&bar[XB_XCNT(j)]); sum += c; cnt += (c > 0u) ? 1u : 0u; mine = (j == x) ? c : mine; }
        if (sum == G) break;
        __builtin_amdgcn_s_sleep(1);
        if ((++sp & 255u) == 0u) { if (xb_ld(&bar[XB_TMO])) break; if (sp > XB_SPIN_CAP) { atomicAdd(&bar[XB_TMO], 1u); break; } }
    }
    nloc = mine > 0u ? mine : 1u; nx = cnt > 0u ? cnt : 1u;
}

__device__ __forceinline__ void xcd_barrier(const XcdBarrier& b) {
    asm volatile("s_waitcnt vmcnt(0)" ::: "memory");
    __syncthreads();
    if (threadIdx.x == 0) {
        unsigned* bar = b.bar;
        __builtin_amdgcn_s_waitcnt(0);
        unsigned nloc = b.st[0], nx = b.st[1];
        if (nloc == 0u) { xcd_barrier_complete(bar, b.x, nloc, nx); b.st[0] = nloc; b.st[1] = nx; }
        const unsigned old = xb_add(&bar[XB_XSUB(b.x)], 1u);
        const unsigned gen = old / nloc;
        if (old + 1u == (gen + 1u) * nloc) {
            __builtin_amdgcn_fence(__ATOMIC_RELEASE, "agent");
            asm volatile("s_waitcnt vmcnt(0)" ::: "memory");
            const unsigned og = xb_add(&bar[XB_TOP], 1u);
            const unsigned tg = og / nx;
            if (og + 1u == (tg + 1u) * nx) xb_add(&bar[XB_TOPGEN], 1u);
            else XB_SPIN(xb_ld(&bar[XB_TOPGEN]) == tg, bar);
            __builtin_amdgcn_fence(__ATOMIC_ACQUIRE, "agent");
            xb_add(&bar[XB_XGEN(b.x)], 1u);
            asm volatile("s_waitcnt vmcnt(0)" ::: "memory");
        } else {
            XB_SPIN(xb_ld(&bar[XB_XGEN(b.x)]) == gen, bar);
            __builtin_amdgcn_fence(__ATOMIC_ACQUIRE, "agent");
            asm volatile("s_waitcnt vmcnt(0)" ::: "memory");
        }
    }
    __syncthreads();
}

__global__ void __launch_bounds__(NTHREADS, 2) hybrid_fwd(Args a_unused) {
    extern __shared__ __attribute__((aligned(16))) unsigned char lds[];
    cg::grid_group grid = cg::this_grid();
    PG8_LAS unsigned char* ldsl = (PG8_LAS unsigned char*)lds;
    unsigned long long probe_acc = 0ull;
#define A_ (*kargs())
    volatile LAS unsigned* bst = (volatile LAS unsigned*)((LAS unsigned char*)lds + LDS_BYTES - 32);
    if (threadIdx.x == 0) { bst[0] = 0u; bst[1] = 0u; }
    __syncthreads();
    const XcdBarrier bar = xcd_barrier_post((unsigned*)(a_unused.ws + WS_BAR), bst);
#pragma unroll 1
    for (int l = 0; l < 2; ++l) {
        asm volatile("" : "+s"(l));
        {   CArgsR a = A_; const float* xin = l == 0 ? a.in[0] : a.out;
            PT0(); phase0(lds, a, l, xin);
        if (l == 0) grid.sync(); else xcd_barrier(bar); PT1(0); }
        {   CArgsR a = A_; bf16* base = (bf16*)a.ws; bf16* Wreg = (bf16*)(a.ws + WS_W);
            pg8::Gemm g{base, Wreg + W_IN, MT, 4096, DM}; pg8::StaticOrder S; S.init(MT, 4096, (int)gridDim.x, (int)blockIdx.x);
            EpiRoute E{base, 0};
            PT0(); pg8::gemm_phase<EpiRoute, pg8::StaticOrder, true, true>(ldsl, g, S, E);
        xcd_barrier(bar); PT1(1); }
        { PT0(); phase_mixers(lds, A_, l, probe_acc);
        xcd_barrier(bar); PT1(2); }
        { PT0(); phase_norms(A_, l);
        xcd_barrier(bar); PT1(3); }
        {   CArgsR a = A_; bf16* base = (bf16*)a.ws; bf16* Wreg = (bf16*)(a.ws + WS_W);
            pg8::Gemm g{base, Wreg + W_G, 4 * MT, 6144, DM}; SchedGate S{(int)gridDim.x, (int)blockIdx.x};
            EpiGate E{base + (size_t)B_SBK * BUFE, (float*)(base + (size_t)B_DNK * BUFE), base + (size_t)B_DNQ * BUFE};
            PT0(); pg8::gemm_phase<EpiGate, SchedGate, true, true>(ldsl, g, S, E);
        xcd_barrier(bar); PT1(4); }
        {   CArgsR a = A_; bf16* base = (bf16*)a.ws; bf16* Wreg = (bf16*)(a.ws + WS_W); const float* xin = l == 0 ? a.in[0] : a.out;
            pg8::Gemm g{base + (size_t)B_DNQ * BUFE, Wreg + W_OUT, MT, DM, DM}; pg8::StaticOrder S; S.init(MT, DM, (int)gridDim.x, (int)blockIdx.x);
            EpiResid E{xin, a.out};
            PT0(); pg8::gemm_phase<EpiResid, pg8::StaticOrder, false, true>(ldsl, g, S, E);
        xcd_barrier(bar); PT1(5); }
        {   CArgsR a = A_; bf16* base = (bf16*)a.ws; const float* nw = a.in[15] + (size_t)l * DM; const float* xo = a.out;
            const int tid = opaque_tid(), lane = tid & 63, gw = blockIdx.x * NWAVES + (tid >> 6), NGW = gridDim.x * NWAVES;
            PT0(); for (int m = gw; m < MT; m += NGW) rms_row_to_bf16(xo + (size_t)m * DM, nw, base + (size_t)m * DM, lane);
        xcd_barrier(bar); PT1(6); }
        {   CArgsR a = A_; bf16* base = (bf16*)a.ws; bf16* Wreg = (bf16*)(a.ws + WS_W);
            pg8::Gemm g{base, Wreg + W_UP, MT, DFF, DM}; pg8::StaticOrder S; S.init(MT, DFF, (int)gridDim.x, (int)blockIdx.x);
            EpiRelu2 E{base + (size_t)B_DNQ * BUFE};
            PT0(); pg8::gemm_phase<EpiRelu2, pg8::StaticOrder, true, true>(ldsl, g, S, E);
        xcd_barrier(bar); PT1(7); }
        {   CArgsR a = A_; bf16* base = (bf16*)a.ws; bf16* Wreg = (bf16*)(a.ws + WS_W);
            pg8::Gemm g{base + (size_t)B_DNQ * BUFE, Wreg + W_DOWN, MT, DM, DFF}; pg8::StaticOrder S; S.init(MT, DM, (int)gridDim.x, (int)blockIdx.x);
            EpiResid E{a.out, a.out};
            PT0(); pg8::gemm_phase<EpiResid, pg8::StaticOrder, false, true>(ldsl, g, S, E);
        xcd_barrier(bar); PT1(8); }
    }
    {
        CArgsR a = A_; const float* nw = a.in[18]; float* xo = a.out;
        const int tid = opaque_tid(), lane = tid & 63, gw = blockIdx.x * NWAVES + (tid >> 6), NGW = gridDim.x * NWAVES;
        for (int m = gw; m < MT; m += NGW) {
            f32x4* xr = (f32x4*)(xo + (size_t)m * DM) + lane; const f32x4* wr = (const f32x4*)nw + lane;
            f32x4 v[4]; float s = 0.f;
#pragma unroll
            for (int j = 0; j < 4; ++j) { v[j] = xr[64 * j]; s += (v[j][0] * v[j][0] + v[j][1] * v[j][1]) + (v[j][2] * v[j][2] + v[j][3] * v[j][3]); }
            const float rstd = rsqrtf(wave_sum(s) * (1.f / DM) + EPS);
#pragma unroll
            for (int j = 0; j < 4; ++j) { const f32x4 ww = wr[64 * j]; f32x4 r;
#pragma unroll
                for (int i = 0; i < 4; ++i) r[i] = v[j][i] * rstd * ww[i];
                xr[64 * j] = r; }
        }
    }
#undef A_
    if (PROBE_SEL) { const unsigned long long t0 = rt(); while (rt() - t0 < probe_acc) __builtin_amdgcn_s_sleep(8); }
}

extern "C" void kernel_launch(void* const* d_in, const int* in_sizes, int n_in, void* d_out, int out_size, void* d_ws, size_t ws_size, hipStream_t stream) {
    static int grid = 0;
    if (grid == 0) {
        if (n_in != 19 || out_size != MT * DM || ws_size < WS_NEED) { fprintf(stderr, "kernel_launch: unexpected shapes (n_in %d out %d ws %zu need %zu)\n", n_in, out_size, ws_size, (size_t)WS_NEED); grid = -1; return; }
        int dev = 0, cus = 0, per_cu = 0;
        hipGetDevice(&dev); hipDeviceGetAttribute(&cus, hipDeviceAttributeMultiprocessorCount, dev);
        if (hipFuncSetAttribute((const void*)hybrid_fwd, hipFuncAttributeMaxDynamicSharedMemorySize, LDS_BYTES) != hipSuccess) { fprintf(stderr, "kernel_launch: hipFuncSetAttribute failed\n"); grid = -1; return; }
        if (hipOccupancyMaxActiveBlocksPerMultiprocessor(&per_cu, (const void*)hybrid_fwd, NTHREADS, LDS_BYTES) != hipSuccess || per_cu < 1) { fprintf(stderr, "kernel_launch: occupancy query gave %d\n", per_cu); per_cu = 1; }
        (void)hipGetLastError();
        grid = cus * per_cu;
    }
    if (grid < 0) return;
    if (hipMemsetAsync((char*)d_ws + WS_CTL, 0, CTL_BYTES, stream) != hipSuccess) { fprintf(stderr, "kernel_launch: memset of the control words failed\n"); return; }
    Args a{};
    for (int i = 0; i < 19; ++i) a.in[i] = (const float*)d_in[i];
    a.out = (float*)d_out; a.ws = (unsigned char*)d_ws;
    void* args[] = {&a};
    hipError_t e = hipLaunchCooperativeKernel((const void*)hybrid_fwd, dim3(grid), dim3(NTHREADS), args, LDS_BYTES, stream);
    if (e != hipSuccess) fprintf(stderr, "cooperative launch failed: %s (grid %d)\n", hipGetErrorString(e), grid);
}
```

```cpp
#include <hip/hip_runtime.h>
#include <hip/hip_cooperative_groups.h>
#include <cstdio>
#include <cstdint>
namespace cg = cooperative_groups;
__device__ __forceinline__ int opaque_tid() { int t = (int)threadIdx.x; asm volatile("" : "+v"(t)); return t; }
namespace pg8 {
#define PG8_LAS __attribute__((address_space(3)))
typedef unsigned short bf16_t;
typedef short bf16x8 __attribute__((ext_vector_type(8)));
typedef float f32x4 __attribute__((ext_vector_type(4)));
typedef unsigned u32x4 __attribute__((ext_vector_type(4)));
constexpr int BM = 256, BK = 64, HALF = 128, HTB = HALF * BK * 2  , STAGE_BYTES = 8 * HTB, NXCD = 8, WGM = 8;

__host__ __device__ __forceinline__ int lds_byte(int r, int c) { const int st = (r >> 4) * 2 + (c >> 5), rr = r & 15, cc = c & 31, ob = rr * 64 + cc * 2; return st * 1024 + (ob ^ (((ob >> 9) & 1) << 5)); }
__host__ __device__ __forceinline__ void stage_rc(int b, int& R, int& C) { const int st = b / 1024, sb = b % 1024, swz = sb ^ (((sb >> 9) & 1) << 5); R = (st >> 1) * 16 + swz / 64; C = (st & 1) * 32 + (swz % 64) / 2; }
__host__ __device__ __forceinline__ int perm32(int rho) { const int n = rho >> 4, i = rho & 15; return 8 * (i >> 2) + 4 * n + (i & 3); }

struct Unit { int pm, pn; };
struct Gemm { const bf16_t* A; const bf16_t* Bt; int M, N, K; };

struct StaticOrder {
    int nM, nN, nwg, G, c;
    __host__ __device__ void init(int M, int N, int G_, int c_) { nM = M / BM; nN = N / BM; nwg = nM * nN; G = G_; c = c_; }
    __host__ __device__ bool next(int i, Unit& u) const {
        const long L = (long)i * G + c; if (L >= nwg) return false;
        int wgid = (int)L; { const int q = nwg / NXCD, r = nwg % NXCD, xcd = wgid % NXCD, off = wgid / NXCD; wgid = (xcd < r ? xcd * (q + 1) : r * (q + 1) + (xcd - r) * q) + off; }
        const int nig = WGM * nN, gid = wgid / nig, fm = gid * WGM, gsz = (nM - fm) < WGM ? (nM - fm) : WGM;
        u.pm = fm + ((wgid % nig) % gsz); u.pn = (wgid % nig) / gsz; return true;
    }
    __device__ __forceinline__ void a_ready(const Unit&) const {}
    __device__ __forceinline__ void done(const Unit&) const {}
};
__device__ __forceinline__ unsigned cvt_pk_bf16(float lo, float hi) { unsigned r; asm volatile("v_cvt_pk_bf16_f32 %0, %1, %2" : "=v"(r) : "v"(lo), "v"(hi)); return r; }
template <class Epi, class Sched, bool ALIGN_EPI = false, bool SP2 = false>
__device__ __forceinline__ void gemm_phase(PG8_LAS unsigned char* lds, const Gemm g, const Sched& S, const Epi& E) {
    const int tid = opaque_tid(), wid = __builtin_amdgcn_readfirstlane(tid >> 6), lane = tid & 63, wr = wid >> 2, wc = wid & 3, fr = lane & 15, fq = lane >> 4;
    const int K = g.K, nt = K / BK;
    unsigned voffA[2], voffB[2];
#pragma unroll
    for (int i = 0; i < 2; ++i) { int R, C; stage_rc(tid * 16 + i * 8192, R, C); const int Rb = Epi::PERM ? ((R & ~31) + perm32(R & 31)) : R;
        voffA[i] = (unsigned)(R * K + C) * 2u; voffB[i] = (unsigned)(Rb * K + C) * 2u; }
    const size_t kstep = (size_t)(BK * 2);
    const size_t hstep = (size_t)HALF * K * 2;
    const size_t tstep = 2 * hstep;
    const unsigned ldsw = (unsigned)wid * 1024u;
    const int aoff = lds_byte(wr * 64 + fr, fq * 8), boff = lds_byte(wc * 32 + fr, fq * 8);
#define PG8_SA(b, h) (((b) * 2 + (h)) * HTB)
#define PG8_SB(b, h) ((4 + (b) * 2 + (h)) * HTB)
#define PG8_STAGE(bufoff, gbase, voff) do { _Pragma("unroll") for (int _i = 0; _i < 2; ++_i) \
        __builtin_amdgcn_global_load_lds((const unsigned*)((const char*)(gbase) + (voff)[_i]), (PG8_LAS unsigned*)(lds + (bufoff) + ldsw + _i * 8192), 16, 0, 0); } while (0)
#define PG8_LDA(dst, b, h) do { _Pragma("unroll") for (int m = 0; m < 4; ++m) _Pragma("unroll") for (int k = 0; k < 2; ++k) dst[m][k] = *(const PG8_LAS bf16x8*)(lds + PG8_SA(b, h) + aoff + m * 2048 + k * 1024); } while (0)
#define PG8_LDB(dst, b, h) do { _Pragma("unroll") for (int n = 0; n < 2; ++n) _Pragma("unroll") for (int k = 0; k < 2; ++k) dst[n][k] = *(const PG8_LAS bf16x8*)(lds + PG8_SB(b, h) + boff + n * 2048 + k * 1024); } while (0)
#define PG8_MMA(ai, bj, At, Bt) do { __builtin_amdgcn_s_setprio(1); _Pragma("unroll") for (int m = 0; m < 4; ++m) _Pragma("unroll") for (int n = 0; n < 2; ++n) _Pragma("unroll") for (int k = 0; k < 2; ++k) \
        acc[ai][bj][m][n] = __builtin_amdgcn_mfma_f32_16x16x32_bf16(Bt[n][k], At[m][k], acc[ai][bj][m][n], 0, 0, 0); __builtin_amdgcn_s_setprio(0); } while (0)
#define PG8_WAIT_V(n) asm volatile("s_waitcnt vmcnt(" #n ")" ::: "memory")
#define PG8_WAIT_L(n) asm volatile("s_waitcnt lgkmcnt(" #n ")" ::: "memory")
#define PG8_BAR __builtin_amdgcn_s_barrier()
#define PG8_SCHED __builtin_amdgcn_sched_barrier(0)
    Unit cur, nxt; int ui = 0;
    if (!S.next(0, cur)) return;
    f32x4 acc[2][2][4][2];
#pragma unroll
    for (int a = 0; a < 2; ++a)
#pragma unroll
        for (int b = 0; b < 2; ++b)
#pragma unroll
            for (int m = 0; m < 4; ++m)
#pragma unroll
                for (int n = 0; n < 2; ++n) acc[a][b][m][n] = (f32x4){0.f, 0.f, 0.f, 0.f};
    bf16x8 At[4][2], B0[2][2], B1[2][2];
    const char* cA = (const char*)g.A + (size_t)cur.pm * tstep; const char* cB = (const char*)g.Bt + (size_t)cur.pn * tstep;
    S.a_ready(cur);
    if constexpr (SP2) {
        PG8_STAGE(PG8_SB(0, 0), cB, voffB); PG8_STAGE(PG8_SB(0, 1), cB + hstep, voffB); PG8_STAGE(PG8_SA(0, 0), cA, voffA); PG8_STAGE(PG8_SA(0, 1), cA + hstep, voffA);
        if (wr == 1) PG8_BAR;
        PG8_WAIT_V(2); PG8_BAR;
        PG8_STAGE(PG8_SB(1, 0), cB + kstep, voffB); PG8_STAGE(PG8_SA(1, 0), cA + kstep, voffA); PG8_STAGE(PG8_SB(1, 1), cB + hstep + kstep, voffB);
        PG8_WAIT_V(6); PG8_BAR;
    } else {
        PG8_STAGE(PG8_SB(0, 0), cB, voffB); PG8_STAGE(PG8_SA(0, 0), cA, voffA); PG8_STAGE(PG8_SB(0, 1), cB + hstep, voffB); PG8_STAGE(PG8_SA(0, 1), cA + hstep, voffA);
        if (wr == 1) PG8_BAR;
        PG8_WAIT_V(4); PG8_BAR;
        PG8_STAGE(PG8_SB(1, 0), cB + kstep, voffB); PG8_STAGE(PG8_SA(1, 0), cA + kstep, voffA); PG8_STAGE(PG8_SB(1, 1), cB + hstep + kstep, voffB);
        PG8_WAIT_V(6); PG8_BAR;
    }
    for (;;) {
        const bool has_next = S.next(ui + 1, nxt);
        const char* nA = has_next ? (const char*)g.A + (size_t)nxt.pm * tstep : cA; const char* nB = has_next ? (const char*)g.Bt + (size_t)nxt.pn * tstep : cB;
        for (int t = 0; t < nt; t += 2) {
            const bool last = (t == nt - 2);
            const char* a1 = cA + (size_t)(t + 1) * kstep;
            const char* a2 = last ? nA : cA + (size_t)(t + 2) * kstep; const char* b2 = last ? nB : cB + (size_t)(t + 2) * kstep;
            const char* a3 = a2 + kstep; const char* b3 = b2 + kstep;
            if (last && has_next) S.a_ready(nxt);
            if constexpr (SP2) {
            PG8_LDB(B0, 0, 0); PG8_LDB(B1, 0, 1); PG8_SCHED; PG8_LDA(At, 0, 0); PG8_STAGE(PG8_SA(1, 1), a1 + hstep, voffA);
            PG8_WAIT_V(8); PG8_WAIT_L(0); PG8_BAR; PG8_MMA(0, 0, At, B0); PG8_MMA(0, 1, At, B1); PG8_BAR; PG8_SCHED;
            PG8_LDA(At, 0, 1); PG8_STAGE(PG8_SB(0, 0), b2, voffB); PG8_STAGE(PG8_SB(0, 1), b2 + hstep, voffB); PG8_STAGE(PG8_SA(0, 0), a2, voffA);
            PG8_WAIT_V(8); PG8_WAIT_L(0); PG8_BAR; PG8_MMA(1, 0, At, B0); PG8_MMA(1, 1, At, B1); PG8_BAR; PG8_SCHED;
            PG8_LDB(B0, 1, 0); PG8_LDB(B1, 1, 1); PG8_SCHED; PG8_LDA(At, 1, 0); PG8_STAGE(PG8_SA(0, 1), a2 + hstep, voffA);
            PG8_WAIT_V(8); PG8_WAIT_L(0); PG8_BAR; PG8_MMA(0, 0, At, B0); PG8_MMA(0, 1, At, B1); PG8_BAR; PG8_SCHED;
            PG8_LDA(At, 1, 1); PG8_STAGE(PG8_SB(1, 0), b3, voffB); PG8_STAGE(PG8_SB(1, 1), b3 + hstep, voffB); PG8_STAGE(PG8_SA(1, 0), a3, voffA);
            PG8_WAIT_V(8); PG8_WAIT_L(0); PG8_BAR; PG8_MMA(1, 0, At, B0); PG8_MMA(1, 1, At, B1); PG8_BAR; PG8_SCHED;
            } else {
            PG8_LDB(B0, 0, 0); PG8_SCHED; PG8_LDA(At, 0, 0); PG8_STAGE(PG8_SA(1, 1), a1 + hstep, voffA);
            PG8_WAIT_L(8); PG8_BAR; PG8_WAIT_L(0); PG8_MMA(0, 0, At, B0); PG8_BAR; PG8_SCHED;
            PG8_LDB(B1, 0, 1); PG8_STAGE(PG8_SB(0, 0), b2, voffB);
            PG8_BAR; PG8_WAIT_L(0); PG8_MMA(0, 1, At, B1); PG8_BAR;
            PG8_LDA(At, 0, 1); PG8_STAGE(PG8_SA(0, 0), a2, voffA);
            PG8_BAR; PG8_WAIT_L(0); PG8_MMA(1, 0, At, B0); PG8_BAR; PG8_SCHED;
            PG8_STAGE(PG8_SB(0, 1), b2 + hstep, voffB);
            PG8_WAIT_V(6); PG8_BAR; PG8_MMA(1, 1, At, B1); PG8_BAR;
            PG8_LDB(B0, 1, 0); PG8_SCHED; PG8_LDA(At, 1, 0); PG8_STAGE(PG8_SA(0, 1), a2 + hstep, voffA);
            PG8_WAIT_L(8); PG8_BAR; PG8_WAIT_L(0); PG8_MMA(0, 0, At, B0); PG8_BAR; PG8_SCHED;
            PG8_LDB(B1, 1, 1); PG8_STAGE(PG8_SB(1, 0), b3, voffB);
            PG8_BAR; PG8_WAIT_L(0); PG8_MMA(0, 1, At, B1); PG8_BAR;
            PG8_LDA(At, 1, 1); PG8_STAGE(PG8_SA(1, 0), a3, voffA);
            PG8_BAR; PG8_WAIT_L(0); PG8_MMA(1, 0, At, B0); PG8_BAR; PG8_SCHED;
            PG8_STAGE(PG8_SB(1, 1), b3 + hstep, voffB);
            PG8_WAIT_V(6); PG8_BAR; PG8_MMA(1, 1, At, B1); PG8_BAR;
            }
        }
        if constexpr (ALIGN_EPI) { if (wr == 0) PG8_BAR; }
        if constexpr (!Epi::AFTER_DRAIN) { E(acc, cur, wr, wc, fr, fq); S.done(cur); }
        if (!has_next) break;
#pragma unroll
        for (int a = 0; a < 2; ++a)
#pragma unroll
            for (int b = 0; b < 2; ++b)
#pragma unroll
                for (int m = 0; m < 4; ++m)
#pragma unroll
                    for (int n = 0; n < 2; ++n) acc[a][b][m][n] = (f32x4){0.f, 0.f, 0.f, 0.f};
        cur = nxt; cA = nA; cB = nB; ++ui;
        if constexpr (ALIGN_EPI) { if (wr == 1) PG8_BAR; }
    }
    PG8_WAIT_V(0);
    if constexpr (!ALIGN_EPI) { if (wr == 0) PG8_BAR; }
    PG8_BAR;
    if constexpr (Epi::AFTER_DRAIN) { E.fused(acc, cur, wr, wc, fr, fq, lds, wid, lane); S.done(cur); }
#undef PG8_SA
#undef PG8_SB
#undef PG8_STAGE
#undef PG8_LDA
#undef PG8_LDB
#undef PG8_MMA
#undef PG8_WAIT_V
#undef PG8_WAIT_L
#undef PG8_BAR
#undef PG8_SCHED
}
}

constexpr int NB = 8, SEQ = 2048, DM = 1024, MT = NB * SEQ, DFF = 4096, IN_DIM = 13344;
constexpr int NTHREADS = 512, NWAVES = 8, LDS_BYTES = 147456;
constexpr float EPS = 1e-6f;
typedef unsigned short bf16;
typedef unsigned v4u __attribute__((ext_vector_type(4)));
typedef unsigned v2u __attribute__((ext_vector_type(2)));
typedef float f32x4 __attribute__((ext_vector_type(4)));
typedef short bf16x8 __attribute__((ext_vector_type(8)));
enum { B_H = 0, B_DNG = 1, B_SBQ = 2, B_SSZ = 3, B_DNQ = 4, B_DNK = 5, B_DNV = 6, B_SBK = 7, B_SBV = 8, B_SSX = 9, B_SSBC = 10, NBUF = 11 };
constexpr size_t BUFE = (size_t)MT * DM;
constexpr size_t WS_W = NBUF * BUFE * 2;
constexpr size_t W_IN = 0, W_G = W_IN + (size_t)10240 * 1024, W_OUT = W_G + (size_t)6144 * 1024, W_UP = W_OUT + (size_t)1024 * 1024,
                 W_DOWN = W_UP + (size_t)4096 * 1024, W_END = W_DOWN + (size_t)4096 * 1024;
constexpr size_t WS_SMALL = WS_W + W_END * 2;
constexpr size_t WS_CTL = WS_SMALL + (size_t)MT * 64 * 4;
constexpr size_t WS_BAR = WS_CTL + 4096;
constexpr size_t CTL_BYTES = 4096 + 16384;
constexpr size_t WS_NEED = WS_CTL + CTL_BYTES;

__device__ __forceinline__ float bf2f(unsigned u) { return __builtin_bit_cast(float, u << 16); }
__device__ __forceinline__ unsigned f2bf(float f) { unsigned u = __builtin_bit_cast(unsigned, f); return (u + 0x7fffu + ((u >> 16) & 1u)) >> 16; }
typedef float f32x2 __attribute__((ext_vector_type(2)));
typedef __bf16 bf16x2_t __attribute__((ext_vector_type(2)));
__device__ __forceinline__ unsigned pk2(float lo, float hi) { f32x2 v = {lo, hi}; return __builtin_bit_cast(unsigned, __builtin_convertvector(v, bf16x2_t)); }
__device__ __forceinline__ void unpack8(v4u r, float* o) {
    o[0] = bf2f(r.x & 0xffffu); o[1] = __builtin_bit_cast(float, r.x & 0xffff0000u); o[2] = bf2f(r.y & 0xffffu); o[3] = __builtin_bit_cast(float, r.y & 0xffff0000u);
    o[4] = bf2f(r.z & 0xffffu); o[5] = __builtin_bit_cast(float, r.z & 0xffff0000u); o[6] = bf2f(r.w & 0xffffu); o[7] = __builtin_bit_cast(float, r.w & 0xffff0000u);
}
__device__ __forceinline__ v4u pack8(const float* v) { v4u w; w.x = pk2(v[0], v[1]); w.y = pk2(v[2], v[3]); w.z = pk2(v[4], v[5]); w.w = pk2(v[6], v[7]); return w; }
__device__ __forceinline__ float sigmoidf_(float x) { return __builtin_amdgcn_rcpf(1.f + __expf(-x)); }
__device__ __forceinline__ float siluf_(float x) { return x * __builtin_amdgcn_rcpf(1.f + __expf(-x)); }
__device__ __forceinline__ float softplusf_(float x) { return fmaxf(x, 0.f) + log1pf(__expf(-fabsf(x))); }
template <int CTRL> __device__ __forceinline__ float dppf(float v) { return __builtin_bit_cast(float, __builtin_amdgcn_update_dpp(0, __builtin_bit_cast(int, v), CTRL, 0xF, 0xF, true)); }
__device__ __forceinline__ float red8(float v) { v += dppf<0xB1>(v); v += dppf<0x4E>(v); v += dppf<0x141>(v); return v; }
__device__ __forceinline__ float red16(float v) { v = red8(v); v += dppf<0x140>(v); return v; }
__device__ __forceinline__ float wave_sum(float v) {
#pragma unroll
    for (int o = 1; o < 64; o <<= 1) v += __shfl_xor(v, o);
    return v;
}
#define LDS_WAIT() asm volatile("s_waitcnt lgkmcnt(0)" ::: "memory")

struct Args { const float* in[19]; float* out; unsigned char* ws; };
typedef const __attribute__((address_space(4))) Args& CArgsR;
__device__ __forceinline__ const __attribute__((address_space(4))) Args* kargs() { unsigned long long v = (unsigned long long)__builtin_amdgcn_kernarg_segment_ptr(); asm volatile("" : "+s"(v)); return (const __attribute__((address_space(4))) Args*)v; }
#ifndef PROBE_SEL
#define PROBE_SEL 0
#endif
__device__ __forceinline__ unsigned long long rt() { return __builtin_amdgcn_s_memrealtime(); }
#define PT0() unsigned long long pt_ = PROBE_SEL ? rt() : 0ull
#define PT1(k) do { if (PROBE_SEL & (1 << (k))) probe_acc += rt() - pt_; } while (0)

struct EpiRoute {
    static constexpr bool PERM = true, AFTER_DRAIN = false;
    bf16* base; int pn_off;
    __device__ __forceinline__ void operator()(const pg8::f32x4 (&acc)[2][2][4][2], const pg8::Unit& u, int wr, int wc, int fr, int fq) const {
        const int sg = (u.pn + pn_off) >> 2;
        const int bufi = sg == 0 ? B_DNG : sg == 1 ? B_DNQ : sg == 2 ? B_DNK : sg == 3 ? B_DNV : sg == 4 ? B_SBQ : sg == 5 ? B_SSZ : sg == 6 ? B_SBK : sg == 7 ? B_SBV : sg == 8 ? B_SSX : B_SSBC;
        bf16* O = base + (size_t)bufi * BUFE;
        const int col0 = (u.pn & 3) * 256 + wc * 32 + 8 * fq, row0 = u.pm * 256 + wr * 64 + fr;
#pragma unroll
        for (int ai = 0; ai < 2; ++ai)
#pragma unroll
            for (int m = 0; m < 4; ++m) { bf16* rowp = O + (size_t)(row0 + ai * 128 + m * 16) * DM + col0;
#pragma unroll
                for (int bj = 0; bj < 2; ++bj) { const pg8::f32x4 v0 = acc[ai][bj][m][0], v1 = acc[ai][bj][m][1];
                    v4u w; w.x = pk2(v0[0], v0[1]); w.y = pk2(v0[2], v0[3]); w.z = pk2(v1[0], v1[1]); w.w = pk2(v1[2], v1[3]);
                    *(v4u*)(rowp + bj * 128) = w; } }
    }
};
struct EpiRelu2 {
    static constexpr bool PERM = true, AFTER_DRAIN = false;
    bf16* O;
    __device__ __forceinline__ void operator()(const pg8::f32x4 (&acc)[2][2][4][2], const pg8::Unit& u, int wr, int wc, int fr, int fq) const {
        const int col0 = u.pn * 256 + wc * 32 + 8 * fq, row0 = u.pm * 256 + wr * 64 + fr;
#pragma unroll
        for (int ai = 0; ai < 2; ++ai)
#pragma unroll
            for (int m = 0; m < 4; ++m) { bf16* rowp = O + (size_t)(row0 + ai * 128 + m * 16) * DFF + col0;
#pragma unroll
                for (int bj = 0; bj < 2; ++bj) { float v[8];
#pragma unroll
                    for (int i = 0; i < 4; ++i) { float a = fmaxf(acc[ai][bj][m][0][i], 0.f), b = fmaxf(acc[ai][bj][m][1][i], 0.f); v[i] = a * a; v[4 + i] = b * b; }
                    *(v4u*)(rowp + bj * 128) = pack8(v); } }
    }
};
struct EpiResid {
    static constexpr bool PERM = true, AFTER_DRAIN = false;
    const float* xin; float* xout;
    __device__ __forceinline__ void operator()(const pg8::f32x4 (&acc)[2][2][4][2], const pg8::Unit& u, int wr, int wc, int fr, int fq) const {
        const int col0 = u.pn * 256 + wc * 32 + 8 * fq, row0 = u.pm * 256 + wr * 64 + fr;
#pragma unroll
        for (int ai = 0; ai < 2; ++ai)
#pragma unroll
            for (int m = 0; m < 4; ++m) { const size_t ro = (size_t)(row0 + ai * 128 + m * 16) * DM + col0;
#pragma unroll
                for (int bj = 0; bj < 2; ++bj) { const size_t o = ro + bj * 128;
                    const f32x4 a = *(const f32x4*)(xin + o), b = *(const f32x4*)(xin + o + 4);
                    f32x4 r0, r1;
#pragma unroll
                    for (int i = 0; i < 4; ++i) { r0[i] = a[i] + acc[ai][bj][m][0][i]; r1[i] = b[i] + acc[ai][bj][m][1][i]; }
                    *(f32x4*)(xout + o) = r0; *(f32x4*)(xout + o + 4) = r1; } }
    }
};
struct SchedGate {
    int G, c;
    __device__ __forceinline__ bool next(int i, pg8::Unit& u) const {
        const int tile = c + (i / 6) * G; if (tile >= 256) return false;
        const int s = i % 6, br = s >> 1, pm = tile >> 2, pn = tile & 3;
        if ((s & 1) == 0) { u.pm = pm; u.pn = br * 4 + pn; } else { u.pm = (1 + br) * 64 + pm; u.pn = (3 + br) * 4 + pn; }
        return true;
    }
    __device__ __forceinline__ void a_ready(const pg8::Unit&) const {}
    __device__ __forceinline__ void done(const pg8::Unit&) const {}
};
struct EpiGate {
    static constexpr bool PERM = true, AFTER_DRAIN = false;
    bf16* gsc; float* macc; bf16* merged;
    __device__ __forceinline__ void operator()(const pg8::f32x4 (&acc)[2][2][4][2], const pg8::Unit& u, int wr, int wc, int fr, int fq) const {
        const int j = u.pn >> 2, pn = u.pn & 3, pm = u.pm & 63;
        const int col0 = pn * 256 + wc * 32 + 8 * fq, row0 = pm * 256 + wr * 64 + fr;
#pragma unroll
        for (int ai = 0; ai < 2; ++ai)
#pragma unroll
            for (int m = 0; m < 4; ++m) { const size_t ro = (size_t)(row0 + ai * 128 + m * 16) * DM + col0;
#pragma unroll
                for (int bj = 0; bj < 2; ++bj) { const size_t o = ro + bj * 128; float v[8];
#pragma unroll
                    for (int i = 0; i < 4; ++i) { v[i] = acc[ai][bj][m][0][i]; v[4 + i] = acc[ai][bj][m][1][i]; }
                    if (j < 3) {
#pragma unroll
                        for (int i = 0; i < 8; ++i) v[i] = sigmoidf_(v[i]);
                        *(v4u*)(gsc + o) = pack8(v);
                    } else {
                        float g[8]; unpack8(*(const v4u*)(gsc + o), g);
#pragma unroll
                        for (int i = 0; i < 8; ++i) v[i] *= g[i];
                        if (j > 3) { const f32x4 a = *(const f32x4*)(macc + o), b = *(const f32x4*)(macc + o + 4);
#pragma unroll
                            for (int i = 0; i < 4; ++i) { v[i] += a[i]; v[4 + i] += b[i]; } }
                        if (j < 5) { *(f32x4*)(macc + o) = (f32x4){v[0], v[1], v[2], v[3]}; *(f32x4*)(macc + o + 4) = (f32x4){v[4], v[5], v[6], v[7]}; }
                        else *(v4u*)(merged + o) = pack8(v);
                    } } }
    }
};

__device__ __forceinline__ void transpose_item(const float* __restrict__ W, const float* __restrict__ W2, int ldw, bf16* __restrict__ WT, int K, int nblk, float* scr, int item, int lane) {
    const int kb = item / nblk, nb = item % nblk, k0 = 64 * kb, n0 = 32 * nb;
    const float* src = ((lane & 31) < 16 ? W : W2) + (size_t)(k0 + (lane >> 5)) * ldw + n0 + (lane & 31);
    float t[32];
#pragma unroll
    for (int i = 0; i < 32; ++i) t[i] = src[(size_t)(2 * i) * ldw];
#pragma unroll
    for (int i = 0; i < 32; ++i) scr[(2 * i + (lane >> 5)) * 33 + (lane & 31)] = t[i];
    LDS_WAIT();
    const int c = lane & 7;
#pragma unroll
    for (int j = 0; j < 4; ++j) { const int n = (lane >> 3) + 8 * j; const float* s = scr + (8 * c) * 33 + n;
        v4u o; o.x = pk2(s[0 * 33], s[1 * 33]); o.y = pk2(s[2 * 33], s[3 * 33]); o.z = pk2(s[4 * 33], s[5 * 33]); o.w = pk2(s[6 * 33], s[7 * 33]);
        *(v4u*)(WT + (size_t)(n0 + n) * K + k0 + 8 * c) = o; }
    LDS_WAIT();
}
__device__ __forceinline__ void rms_row_to_bf16(const float* xrow, const float* w, bf16* orow, int lane) {
    const f32x4* xr = (const f32x4*)xrow + lane; const f32x4* wr = (const f32x4*)w + lane;
    f32x4 v[4]; float s = 0.f;
#pragma unroll
    for (int j = 0; j < 4; ++j) { v[j] = xr[64 * j]; s += (v[j][0] * v[j][0] + v[j][1] * v[j][1]) + (v[j][2] * v[j][2] + v[j][3] * v[j][3]); }
    const float rstd = rsqrtf(wave_sum(s) * (1.f / DM) + EPS);
    unsigned long long* o8 = (unsigned long long*)orow + lane;
#pragma unroll
    for (int j = 0; j < 4; ++j) { const f32x4 ww = wr[64 * j];
        o8[64 * j] = (unsigned long long)pk2(v[j][0] * rstd * ww[0], v[j][1] * rstd * ww[1]) | ((unsigned long long)pk2(v[j][2] * rstd * ww[2], v[j][3] * rstd * ww[3]) << 32); }
}
__device__ __forceinline__ void phase0(unsigned char* lds, CArgsR a, int l, const float* xin) {
    constexpr int LDW = 1032;
    const int tid = opaque_tid(), lane = tid & 63, wave = __builtin_amdgcn_readfirstlane(tid >> 6), gw = blockIdx.x * NWAVES + wave, NGW = gridDim.x * NWAVES;
    bf16* Wreg = (bf16*)(a.ws + WS_W);
    const float* w_in = a.in[2] + (size_t)l * DM * IN_DIM;
    {
        float* scr = (float*)lds + wave * (64 * 33);
        const float* w_br = a.in[13] + (size_t)l * 3 * DM * DM; const float* w_out = a.in[14] + (size_t)l * DM * DM;
        const float* w_up = a.in[16] + (size_t)l * DM * DFF; const float* w_down = a.in[17] + (size_t)l * DFF * DM;
        constexpr int NSEG = 17, NIT = NSEG * 512 + 2048 + 2048;
        for (int it = gw; it < NIT; it += NGW) {
            if (it < NSEG * 512) {
                const int seg = it >> 9, r = it & 511;
                const float* W; int ldw; bf16* WT;
                if (seg < 13) {
                    const int co = seg == 0 ? 3072 : seg == 1 ? 0 : seg == 2 ? 1024 : seg == 3 ? 2048 : seg == 4 ? 4112 : seg == 5 ? 7184 : seg == 6 ? 5136 : seg == 7 ? 6160 : seg == 8 ? 8208 : seg == 9 ? 9232
                                 : 10272 + (seg - 10) * 1024;
                    W = w_in + co; ldw = IN_DIM; WT = seg < 10 ? Wreg + (size_t)seg * DM * DM : Wreg + W_G + (size_t)(seg - 10) * DM * DM;
                } else if (seg < 16) { W = w_br + (size_t)(seg - 13) * DM * DM; ldw = DM; WT = Wreg + W_G + (size_t)(3 + seg - 13) * DM * DM; }
                else { W = w_out; ldw = DM; WT = Wreg + W_OUT; }
                transpose_item(W, W, ldw, WT, DM, 32, scr, r, lane);
            } else if (it < NSEG * 512 + 2048) transpose_item(w_up, w_up, DFF, Wreg + W_UP, DM, 128, scr, it - NSEG * 512, lane);
            else transpose_item(w_down, w_down, DM, Wreg + W_DOWN, DFF, 32, scr, it - NSEG * 512 - 2048, lane);
        }
    }
    __syncthreads();
    bf16* WsT = (bf16*)lds;
    for (int idx = tid; idx < 32 * DM; idx += NTHREADS) { const int k = idx >> 5, c = idx & 31; WsT[c * LDW + k] = (bf16)f2bf(w_in[(size_t)k * IN_DIM + (c < 16 ? 4096 + c : 10256 + c - 16)]); }
    __syncthreads();
    {   const float* nw = a.in[1] + (size_t)l * DM; bf16* H = (bf16*)a.ws; float* small = (float*)(a.ws + WS_SMALL);
        const int fr = lane & 15, fq = lane >> 4;
        const float pa0 = __expf(a.in[4][l * 8 + (fr & 7)]), pb0 = a.in[5][l * 8 + (fr & 7)], pa1 = __expf(a.in[9][l * 16 + fr]), pb1 = a.in[10][l * 16 + fr];
        for (int g8 = gw; g8 < MT / 8; g8 += NGW) {
            const int r0 = g8 * 8;
#pragma unroll 1
            for (int r = 0; r < 8; ++r) rms_row_to_bf16(xin + (size_t)(r0 + r) * DM, nw, H + (size_t)(r0 + r) * DM, lane);
            asm volatile("s_waitcnt vmcnt(0)" ::: "memory");
            f32x4 c0 = {0.f, 0.f, 0.f, 0.f}, c1 = {0.f, 0.f, 0.f, 0.f};
            const bf16* ap = H + (size_t)(r0 + (fr & 7)) * DM + fq * 8;
#pragma unroll
            for (int kb = 0; kb < 4; ++kb) { bf16x8 af[8];
#pragma unroll
                for (int k = 0; k < 8; ++k) af[k] = *(const bf16x8*)(ap + (kb * 8 + k) * 32);
#pragma unroll
                for (int k = 0; k < 8; ++k) { const bf16x8 b0 = *(const bf16x8*)(WsT + fr * LDW + (kb * 8 + k) * 32 + fq * 8), b1 = *(const bf16x8*)(WsT + (16 + fr) * LDW + (kb * 8 + k) * 32 + fq * 8);
                    c0 = __builtin_amdgcn_mfma_f32_16x16x32_bf16(af[k], b0, c0, 0, 0, 0); c1 = __builtin_amdgcn_mfma_f32_16x16x32_bf16(af[k], b1, c1, 0, 0, 0); } }
            if (fq < 2) {
#pragma unroll
                for (int jj = 0; jj < 4; ++jj) { float* sp = small + (size_t)(r0 + 4 * fq + jj) * 64;
                    sp[fr] = fr < 8 ? -pa0 * softplusf_(c0[jj] + pb0) : sigmoidf_(c0[jj]);
                    const float dt = softplusf_(c1[jj] + pb1); sp[16 + fr] = dt; sp[32 + fr] = -pa1 * dt; } }
        }
    }
}

__device__ __forceinline__ void conv8(const bf16* p, int pos, const float* w, int wstride, const float* bias, float* out) {
    float acc[8];
#pragma unroll
    for (int i = 0; i < 8; ++i) acc[i] = bias ? bias[i] : 0.f;
#pragma unroll
    for (int j = 0; j < 4; ++j) { const int back = 3 - j;
        if (pos - back >= 0) { float xv[8]; unpack8(*(const v4u*)(p - (size_t)back * DM), xv);
            const f32x4 w0 = *(const f32x4*)(w + j * wstride), w1 = *(const f32x4*)(w + j * wstride + 4);
#pragma unroll
            for (int i = 0; i < 4; ++i) { acc[i] += xv[i] * w0[i]; acc[4 + i] += xv[4 + i] * w1[i]; } } }
#pragma unroll
    for (int i = 0; i < 8; ++i) out[i] = siluf_(acc[i]);
}

__device__ __forceinline__ void conv8r(const v4u (&raw)[4], const float* w, int wstride, const float* bias, float* out) {
    float acc[8];
#pragma unroll
    for (int i = 0; i < 8; ++i) acc[i] = bias ? bias[i] : 0.f;
#pragma unroll
    for (int j = 0; j < 4; ++j) { float xv[8]; unpack8(raw[j], xv);
        const f32x4 w0 = *(const f32x4*)(w + j * wstride), w1 = *(const f32x4*)(w + j * wstride + 4);
#pragma unroll
        for (int i = 0; i < 4; ++i) { acc[i] += xv[i] * w0[i]; acc[4 + i] += xv[4 + i] * w1[i]; } }
#pragma unroll
    for (int i = 0; i < 8; ++i) out[i] = siluf_(acc[i]);
}
#define LOAD4(dst, p, pos) do { _Pragma("unroll") for (int j_ = 0; j_ < 4; ++j_) { const int back_ = 3 - j_; const bool ok_ = (pos) - back_ >= 0; \
        const v4u t_ = *(const v4u*)((p) - (size_t)(ok_ ? back_ : 0) * DM); dst[j_] = ok_ ? t_ : (v4u){0u, 0u, 0u, 0u}; } } while (0)

template <int K> __device__ __forceinline__ void mma16(f32x4& acc, const bf16* Ap, int lda, const bf16* Bp, int ldb, int fr, int fq) {
    bf16x8 af[K / 32], bfv[K / 32];
#pragma unroll
    for (int k = 0; k < K / 32; ++k) { af[k] = *(const bf16x8*)(Ap + fr * lda + k * 32 + fq * 8); bfv[k] = *(const bf16x8*)(Bp + fr * ldb + k * 32 + fq * 8); }
#pragma unroll
    for (int k = 0; k < K / 32; ++k) acc = __builtin_amdgcn_mfma_f32_16x16x32_bf16(af[k], bfv[k], acc, 0, 0, 0);
}
template <bool SA, bool SB> __device__ __forceinline__ void mma32s(f32x4& acc, const bf16* Ap, int rA0, int lda, const bf16* Bp, int rB0, int ldb, int fr, int fq) {
    const int ra = rA0 + fr, rb = rB0 + fr;
    const bf16x8 af = *(const bf16x8*)(Ap + ra * lda + ((SA ? (fq ^ ((ra >> 3) & 3)) : fq) << 3));
    const bf16x8 bfv = *(const bf16x8*)(Bp + rb * ldb + ((SB ? (fq ^ ((rb >> 3) & 3)) : fq) << 3));
    acc = __builtin_amdgcn_mfma_f32_16x16x32_bf16(af, bfv, acc, 0, 0, 0);
}
__device__ __forceinline__ void dn_item(unsigned char* lds, CArgsR a, int l, int item, unsigned long long& probe_acc) {
    constexpr int LDK = 136, LDJ = 40, LDL = 36;
    const int b = item >> 3, h = item & 7;
    bf16* kA = (bf16*)lds;
    bf16* qA = kA + 32 * LDK;
    bf16* qgA = qA + 32 * LDK;
    bf16* wA = qgA + 32 * LDK;
    bf16* kdT = wA + 32 * LDK;
    bf16* vnT = kdT + 128 * LDJ;
    bf16* attn = vnT + 128 * LDJ;
    bf16* ST = attn + 32 * LDJ;
    float* kf = (float*)(ST + 128 * LDK);
    float* vf = kf + 32 * 128;
    float* os = kf;
    float* Lm = vf + 32 * 128;
    float* gcs = Lm + 32 * LDL;
    float* betas = gcs + 32;
    float* cwL = betas + 32;
    const int tid = opaque_tid(), w = __builtin_amdgcn_readfirstlane(tid >> 6), lane = tid & 63, fr = lane & 15, fq = lane >> 4;
    bf16* base = (bf16*)a.ws;
    const bf16* Q = base + (size_t)B_DNQ * BUFE; const bf16* K = base + (size_t)B_DNK * BUFE; const bf16* V = base + (size_t)B_DNV * BUFE; bf16* G = base + (size_t)B_DNG * BUFE;
    const float* small = (const float*)(a.ws + WS_SMALL);
    const float* cw = a.in[3] + (size_t)l * 4 * 3072;
    const size_t rowbase = (size_t)b * SEQ;
    const int tq = tid >> 4, cq = tid & 15;
    const float* nwp = a.in[6] + l * 128 + cq * 8;
    f32x4 Sacc[8];
#pragma unroll
    for (int i = 0; i < 8; ++i) Sacc[i] = (f32x4){0.f, 0.f, 0.f, 0.f};
    for (int i = tid; i < 128 * LDK / 2; i += NTHREADS) ((unsigned*)ST)[i] = 0u;
    for (int i = tid; i < 4 * 384; i += NTHREADS) { const int j = i / 384, r = i % 384; cwL[i] = cw[j * 3072 + (r >> 7) * 1024 + h * 128 + (r & 127)]; }
    __syncthreads();
    const int ta = ((tid - 256) >> 4) & 15;
    v4u rqa[4], rka[4], rva[4], rqb[4], rkb[4], rvb[4]; float rg = 0.f, rbv = 0.f;
    v4u Pv[2];
    Pv[0] = Pv[1] = (v4u){0u, 0u, 0u, 0u};
#define DN_LOADS_RAW(c_, half_) do { const int pos_ = (c_) * 32 + ta + 16 * (half_); const size_t off_ = (rowbase + pos_) * DM + h * 128 + cq * 8; LOAD4(rqa, Q + off_, pos_); LOAD4(rka, K + off_, pos_); LOAD4(rva, V + off_, pos_); } while (0)
#define DN_LOADS_RAWB(c_) do { const int pos_ = (c_) * 32 + ta + 16; const size_t off_ = (rowbase + pos_) * DM + h * 128 + cq * 8; LOAD4(rqb, Q + off_, pos_); LOAD4(rkb, K + off_, pos_); LOAD4(rvb, V + off_, pos_); } while (0)
#define DN_LOADS_SMALL(c_) do { const int t0_ = (c_) * 32; \
        { const size_t r_ = rowbase + t0_ + (lane & 31); rg = small[r_ * 64 + h]; rbv = small[r_ * 64 + 8 + h]; } } while (0)
#define DN_CONV(rq_, rk_, rv_, slot_) do { const float* cw_ = cwL + cq * 8; asm volatile("" : "+v"(cw_)); \
        { float o8_[8]; conv8r(rq_, cw_, 384, nullptr, o8_); float ss_ = 0.f; _Pragma("unroll") for (int i_ = 0; i_ < 8; ++i_) ss_ += o8_[i_] * o8_[i_]; \
          ss_ = red16(ss_); const float rn_ = rsqrtf(ss_ + EPS) * 0.08838834764831845f; _Pragma("unroll") for (int i_ = 0; i_ < 8; ++i_) o8_[i_] *= rn_; *(v4u*)(qA + (ta + 16 * (slot_)) * LDK + cq * 8) = pack8(o8_); } \
        __builtin_amdgcn_sched_barrier(0); \
        { float o8_[8]; conv8r(rk_, cw_ + 128, 384, nullptr, o8_); float ss_ = 0.f; _Pragma("unroll") for (int i_ = 0; i_ < 8; ++i_) ss_ += o8_[i_] * o8_[i_]; \
          ss_ = red16(ss_); const float rn_ = rsqrtf(ss_ + EPS); _Pragma("unroll") for (int i_ = 0; i_ < 8; ++i_) o8_[i_] *= rn_; *(v4u*)(kA + (ta + 16 * (slot_)) * LDK + cq * 8) = pack8(o8_); } \
        __builtin_amdgcn_sched_barrier(0); \
        { float o8_[8]; conv8r(rv_, cw_ + 256, 384, nullptr, o8_); Pv[slot_] = pack8(o8_); } \
        __builtin_amdgcn_sched_barrier(0); } while (0)
    if (w >= 4) { DN_LOADS_RAW(0, 0); DN_CONV(rqa, rka, rva, 0); DN_LOADS_RAW(0, 1); DN_CONV(rqa, rka, rva, 1); }
    DN_LOADS_SMALL(0);
    for (int c = 0; c < SEQ / 32; ++c) {
        const int t0 = c * 32;
        unsigned long long tp_ = PROBE_SEL ? rt() : 0ull;
#define DPT(k) do { if (PROBE_SEL) { const unsigned long long tn_ = rt(); if ((PROBE_SEL & (1 << (k))) && item == 0) probe_acc += tn_ - tp_; tp_ = tn_; } } while (0)
        float gcv = rg;
#pragma unroll
        for (int off = 1; off < 32; off <<= 1) { const float t = __shfl_up(gcv, off, 32); if ((lane & 31) >= off) gcv += t; }
        const float gc_last = __shfl(gcv, 31);
        if (w >= 4) {
#pragma unroll
            for (int s2 = 0; s2 < 2; ++s2) { const int tt = ta + 16 * s2;
                const float gc_t = __shfl(gcv, tt), beta_t = __shfl(rbv, tt);
                float q8[8], k8[8], v8[8], t8[8];
                unpack8(*(const v4u*)(qA + tt * LDK + cq * 8), q8); unpack8(*(const v4u*)(kA + tt * LDK + cq * 8), k8); unpack8(Pv[s2], v8);
                const float eg = __expf(gc_t), kb = beta_t * eg, kd = __expf(gc_last - gc_t);
#pragma unroll
                for (int i = 0; i < 8; ++i) t8[i] = q8[i] * eg;
                *(v4u*)(qgA + tt * LDK + cq * 8) = pack8(t8);
                *(f32x4*)(kf + tt * 128 + cq * 8) = (f32x4){k8[0] * kb, k8[1] * kb, k8[2] * kb, k8[3] * kb}; *(f32x4*)(kf + tt * 128 + cq * 8 + 4) = (f32x4){k8[4] * kb, k8[5] * kb, k8[6] * kb, k8[7] * kb};
                *(f32x4*)(vf + tt * 128 + cq * 8) = (f32x4){v8[0] * beta_t, v8[1] * beta_t, v8[2] * beta_t, v8[3] * beta_t}; *(f32x4*)(vf + tt * 128 + cq * 8 + 4) = (f32x4){v8[4] * beta_t, v8[5] * beta_t, v8[6] * beta_t, v8[7] * beta_t};
#pragma unroll
                for (int i = 0; i < 8; ++i) kdT[(cq * 8 + i) * LDJ + (tt ^ ((cq & 3) << 3))] = (bf16)f2bf(k8[i] * kd);
            }
        }
        if (tid < 32) { gcs[tid] = gcv; betas[tid] = rbv; }
        __syncthreads();
        DPT(12);
        if (w >= 4 && c + 1 < SEQ / 32) DN_LOADS_RAW(c + 1, 0);
        {   const int ww = w & 3, gi = ww >> 1, gj = ww & 1; f32x4 acc = {0.f, 0.f, 0.f, 0.f};
            const int jI = 16 * gj + fr, i0 = 16 * gi + 4 * fq;
            const float gj_ = gcs[jI]; const f32x4 gi4 = *(const f32x4*)(gcs + i0), bi4 = *(const f32x4*)(betas + i0);
            mma16<128>(acc, (w < 4 ? kA : qA) + gi * 16 * LDK, LDK, kA + gj * 16 * LDK, LDK, fr, fq);
            if (w < 4) {
#pragma unroll
                for (int jj = 0; jj < 4; ++jj) Lm[(i0 + jj) * LDL + jI] = jI < i0 + jj ? bi4[jj] * acc[jj] * __expf(gi4[jj] - gj_) : 0.f;
            } else {
#pragma unroll
                for (int jj = 0; jj < 4; ++jj) attn[(i0 + jj) * LDJ + jI] = (bf16)f2bf(jI <= i0 + jj ? acc[jj] * __expf(gi4[jj] - gj_) : 0.f);
            } }
        __syncthreads();
        DPT(13);
        if (w < 4) { const int cc = tid & 127; const bool is_w = w >= 2; const float* R = is_w ? kf : vf;
            float x[32];
#pragma unroll
            for (int i = 0; i < 32; ++i) x[i] = R[i * 128 + cc];
            f32x4 Lb[2][8];
            Lb[1][0] = *(const f32x4*)(Lm + 1 * LDL);
#pragma unroll
            for (int i = 1; i < 32; ++i) {
                if (i + 1 < 32) {
#pragma unroll
                    for (int j4 = 0; j4 < (i + 4) / 4; ++j4) Lb[(i + 1) & 1][j4] = *(const f32x4*)(Lm + (i + 1) * LDL + j4 * 4); }
                float a0 = x[i], a1 = 0.f, a2 = 0.f, a3 = 0.f;
#pragma unroll
                for (int j4 = 0; j4 < (i + 3) / 4; ++j4) { const f32x4 l4 = Lb[i & 1][j4];
                    if (j4 * 4 + 0 < i) a0 -= l4[0] * x[j4 * 4 + 0];
                    if (j4 * 4 + 1 < i) a1 -= l4[1] * x[j4 * 4 + 1];
                    if (j4 * 4 + 2 < i) a2 -= l4[2] * x[j4 * 4 + 2];
                    if (j4 * 4 + 3 < i) a3 -= l4[3] * x[j4 * 4 + 3]; }
                x[i] = (a0 + a1) + (a2 + a3); }
            if (is_w) {
#pragma unroll
                for (int i = 0; i < 32; ++i) wA[i * LDK + cc] = (bf16)f2bf(x[i]);
            } else {
#pragma unroll
                for (int i = 0; i < 32; ++i) vf[i * 128 + cc] = x[i];
            } }
        else if (c + 1 < SEQ / 32) { DN_LOADS_RAWB(c + 1); __builtin_amdgcn_sched_barrier(0); DN_CONV(rqa, rka, rva, 0); DN_CONV(rqb, rkb, rvb, 1); }
        __syncthreads();
        DPT(14);
        if (c + 1 < SEQ / 32) DN_LOADS_SMALL(c + 1);
        const v4u gcur = *(const v4u*)(G + (rowbase + t0 + tq) * DM + h * 128 + cq * 8);
#pragma unroll
        for (int it = 0; it < 2; ++it) { f32x4 acc = {0.f, 0.f, 0.f, 0.f};
            mma16<128>(acc, wA + it * 16 * LDK, LDK, ST + w * 16 * LDK, LDK, fr, fq);
            float vn[4];
#pragma unroll
            for (int jj = 0; jj < 4; ++jj) vn[jj] = vf[(16 * it + 4 * fq + jj) * 128 + 16 * w + fr] - acc[jj];
            v2u pk; pk.x = pk2(vn[0], vn[1]); pk.y = pk2(vn[2], vn[3]);
            *(v2u*)(vnT + (16 * w + fr) * LDJ + 16 * it + 4 * fq) = pk; }
        __syncthreads();
#pragma unroll
        for (int it = 0; it < 2; ++it) { f32x4 acc = {0.f, 0.f, 0.f, 0.f};
            mma16<128>(acc, qgA + it * 16 * LDK, LDK, ST + w * 16 * LDK, LDK, fr, fq);
            mma16<32>(acc, attn + it * 16 * LDJ, LDJ, vnT + w * 16 * LDJ, LDJ, fr, fq);
#pragma unroll
            for (int jj = 0; jj < 4; ++jj) os[(16 * it + 4 * fq + jj) * 128 + 16 * w + fr] = acc[jj]; }
        {   const float dl = __expf(gc_last);
#pragma unroll
            for (int dt = 0; dt < 8; ++dt) Sacc[dt] = Sacc[dt] * dl;
            const bf16x8 vb_ = *(const bf16x8*)(vnT + (w * 16 + fr) * LDJ + fq * 8);
            const bf16* ka_e = kdT + fr * LDJ + ((fq ^ (fr >> 3)) << 3); const bf16* ka_o = kdT + fr * LDJ + (((fq ^ (fr >> 3)) << 3) ^ 16);
#pragma unroll
            for (int dt = 0; dt < 8; ++dt) { const bf16x8 af_ = *(const bf16x8*)(((dt & 1) ? ka_o : ka_e) + dt * 16 * LDJ);
                Sacc[dt] = __builtin_amdgcn_mfma_f32_16x16x32_bf16(af_, vb_, Sacc[dt], 0, 0, 0); } }
        __syncthreads();
#pragma unroll
        for (int dt = 0; dt < 8; ++dt) { v2u pk; pk.x = pk2(Sacc[dt][0], Sacc[dt][1]); pk.y = pk2(Sacc[dt][2], Sacc[dt][3]);
            *(v2u*)(ST + (16 * w + fr) * LDK + 16 * dt + 4 * fq) = pk; }
        {   const f32x4 o0 = *(const f32x4*)(os + tq * 128 + cq * 8), o1 = *(const f32x4*)(os + tq * 128 + cq * 8 + 4);
            float ss = (o0[0] * o0[0] + o0[1] * o0[1]) + (o0[2] * o0[2] + o0[3] * o0[3]) + (o1[0] * o1[0] + o1[1] * o1[1]) + (o1[2] * o1[2] + o1[3] * o1[3]);
            ss = red16(ss);
            const float r = rsqrtf(ss * (1.f / 128.f) + EPS);
            float g8[8], o8[8], nw8[8]; unpack8(gcur, g8);
            { const f32x4 n0 = *(const f32x4*)nwp, n1 = *(const f32x4*)(nwp + 4); nw8[0] = n0[0]; nw8[1] = n0[1]; nw8[2] = n0[2]; nw8[3] = n0[3]; nw8[4] = n1[0]; nw8[5] = n1[1]; nw8[6] = n1[2]; nw8[7] = n1[3]; }
#pragma unroll
            for (int i = 0; i < 4; ++i) { o8[i] = o0[i] * r * nw8[i] * siluf_(g8[i]); o8[4 + i] = o1[i] * r * nw8[4 + i] * siluf_(g8[4 + i]); }
            *(v4u*)(G + (rowbase + t0 + tq) * DM + h * 128 + cq * 8) = pack8(o8); }
        __syncthreads();
        DPT(15);
    }
#undef DPT
#undef DN_LOADS_RAW
#undef DN_LOADS_RAWB
#undef DN_LOADS_SMALL
#undef DN_CONV
    __syncthreads();
}

__device__ __forceinline__ void ssm_item(unsigned char* lds, CArgsR a, int l, int item) {
    constexpr int LDC = 136, LDX = 40;
    const int b = item >> 4, hd = item & 15, g = hd >> 2;
    bf16* Cs = (bf16*)lds;
    bf16* Bs = Cs + 32 * LDC;
    bf16* BT = Bs + 32 * LDC;
    bf16* xdtT = BT + 128 * LDX;
    bf16* xddT = xdtT + 64 * LDX;
    bf16* Wm = xddT + 64 * LDX;
    bf16* hB = Wm + 32 * LDX;
    float* xs = (float*)(hB + 64 * LDC);
    float* acs = xs + 32 * 64;
    const int tid = opaque_tid(), w = __builtin_amdgcn_readfirstlane(tid >> 6), lane = tid & 63, fr = lane & 15, fq = lane >> 4;
    bf16* base = (bf16*)a.ws;
    const bf16* X = base + (size_t)B_SSX * BUFE; const bf16* BC = base + (size_t)B_SSBC * BUFE; bf16* Z = base + (size_t)B_SSZ * BUFE;
    const float* small = (const float*)(a.ws + WS_SMALL);
    const float* cw = a.in[7] + (size_t)l * 4 * 2048; const float* cb = a.in[8] + (size_t)l * 2048;
    const float dskip = a.in[11][l * 16 + hd];
    const size_t rowbase = (size_t)b * SEQ;
    const int tq = tid >> 4, cq = tid & 15, tv = (tid >> 3) & 31, cv = tid & 7;
    const int it = w >> 2, pt = w & 3;
    f32x4 hacc[4];
#pragma unroll
    for (int i = 0; i < 4; ++i) hacc[i] = (f32x4){0.f, 0.f, 0.f, 0.f};
    for (int i = tid; i < 64 * LDC / 2; i += NTHREADS) ((unsigned*)hB)[i] = 0u;
    v4u rB[4], rC[4], rx[4]; float ra = 0.f, rdtv = 0.f; unsigned rz[4];
#define SSM_LOADS(c_) do { const int t0_ = (c_) * 32; { const int pos_ = t0_ + tq; const size_t ro_ = (rowbase + pos_) * DM; LOAD4(rB, BC + ro_ + g * 128 + cq * 8, pos_); LOAD4(rC, BC + ro_ + 512 + g * 128 + cq * 8, pos_); } \
        if (tid < 256) { const int pos_ = t0_ + tv; LOAD4(rx, X + (rowbase + pos_) * DM + hd * 64 + cv * 8, pos_); } \
        { const size_t r_ = rowbase + t0_ + (lane & 31); rdtv = small[r_ * 64 + 16 + hd]; ra = small[r_ * 64 + 32 + hd]; } \
        _Pragma("unroll") for (int jj_ = 0; jj_ < 4; ++jj_) rz[jj_] = Z[(rowbase + t0_ + 16 * it + 4 * fq + jj_) * DM + hd * 64 + 16 * pt + fr]; } while (0)
    SSM_LOADS(0);
    for (int c = 0; c < SEQ / 32; ++c) {
        const int t0 = c * 32;
        float acum = ra;
#pragma unroll
        for (int off = 1; off < 32; off <<= 1) { const float t = __shfl_up(acum, off, 32); if ((lane & 31) >= off) acum += t; }
        const float ac_last = __shfl(acum, 31);
        {   float o8[8];
            conv8r(rB, cw + 1024 + g * 128 + cq * 8, 2048, cb + 1024 + g * 128 + cq * 8, o8);
            *(v4u*)(Bs + tq * LDC + cq * 8) = pack8(o8);
#pragma unroll
            for (int i = 0; i < 8; ++i) BT[(cq * 8 + i) * LDX + (tq ^ ((cq & 3) << 3))] = (bf16)f2bf(o8[i]);
            conv8r(rC, cw + 1536 + g * 128 + cq * 8, 2048, cb + 1536 + g * 128 + cq * 8, o8);
            *(v4u*)(Cs + tq * LDC + cq * 8) = pack8(o8);
        }
        if (w < 4) { float o8[8]; conv8r(rx, cw + hd * 64 + cv * 8, 2048, cb + hd * 64 + cv * 8, o8);
            const float dtv = __shfl(rdtv, tv), dd = dtv * __expf(ac_last - __shfl(acum, tv));
            *(f32x4*)(xs + tv * 64 + cv * 8) = (f32x4){o8[0], o8[1], o8[2], o8[3]}; *(f32x4*)(xs + tv * 64 + cv * 8 + 4) = (f32x4){o8[4], o8[5], o8[6], o8[7]};
#pragma unroll
            for (int i = 0; i < 8; ++i) { xdtT[(cv * 8 + i) * LDX + (tv ^ ((cv & 3) << 3))] = (bf16)f2bf(o8[i] * dtv); xddT[(cv * 8 + i) * LDX + (tv ^ ((cv & 3) << 3))] = (bf16)f2bf(o8[i] * dd); }
        }
        if (tid < 32) acs[tid] = acum;
        unsigned zr[4];
#pragma unroll
        for (int jj = 0; jj < 4; ++jj) zr[jj] = rz[jj];
        __syncthreads();
        if (c + 1 < SEQ / 32) SSM_LOADS(c + 1);
        if (w < 4) { const int gi = w >> 1, gj = w & 1; f32x4 acc = {0.f, 0.f, 0.f, 0.f};
            mma16<128>(acc, Cs + gi * 16 * LDC, LDC, Bs + gj * 16 * LDC, LDC, fr, fq);
            const int sI = 16 * gj + fr; const float as = acs[sI];
#pragma unroll
            for (int jj = 0; jj < 4; ++jj) { const int lI = 16 * gi + 4 * fq + jj; const float v = sI <= lI ? acc[jj] * __expf(acs[lI] - as) : 0.f; Wm[lI * LDX + sI] = (bf16)f2bf(v); } }
        __syncthreads();
        {   f32x4 a1 = {0.f, 0.f, 0.f, 0.f}, a2 = {0.f, 0.f, 0.f, 0.f};
            mma32s<false, true>(a1, Wm, it * 16, LDX, xdtT, pt * 16, LDX, fr, fq);
            mma16<128>(a2, Cs + it * 16 * LDC, LDC, hB + pt * 16 * LDC, LDC, fr, fq);
            const int p = 16 * pt + fr;
#pragma unroll
            for (int jj = 0; jj < 4; ++jj) { const int lI = 16 * it + 4 * fq + jj;
                const float y = a1[jj] + __expf(acs[lI]) * a2[jj] + xs[lI * 64 + p] * dskip;
                Z[(rowbase + t0 + lI) * DM + hd * 64 + p] = (bf16)f2bf(y * siluf_(bf2f(zr[jj]))); }
            const float dl = __expf(ac_last);
#pragma unroll
            for (int p2 = 0; p2 < 4; ++p2) { hacc[p2] = hacc[p2] * dl; mma32s<true, true>(hacc[p2], xddT, p2 * 16, LDX, BT, w * 16, LDX, fr, fq); }
        }
        __syncthreads();
#pragma unroll
        for (int p2 = 0; p2 < 4; ++p2)
#pragma unroll
            for (int jj = 0; jj < 4; ++jj) hB[(16 * p2 + 4 * fq + jj) * LDC + 16 * w + fr] = (bf16)f2bf(hacc[p2][jj]);
    }
#undef SSM_LOADS
    __syncthreads();
}

__device__ __forceinline__ void sb_item(unsigned char* lds, CArgsR a, int b, int hd, int qi) {
    constexpr int LD = 72;
    bf16* Ks = (bf16*)lds; bf16* Vs = Ks + 2 * 64 * LD;
    volatile unsigned* alive = (volatile unsigned*)(Vs + 2 * 64 * LD);
    const int tid = opaque_tid(), w = __builtin_amdgcn_readfirstlane(tid >> 6), lane = tid & 63, fr = lane & 15, fq = lane >> 4;
    bf16* base = (bf16*)a.ws;
    bf16* Qb = base + (size_t)B_SBQ * BUFE; const bf16* Kb = base + (size_t)B_SBK * BUFE; const bf16* Vb = base + (size_t)B_SBV * BUFE;
    const size_t rowbase = (size_t)b * SEQ;
    const int t0 = qi * 128, myq = t0 + w * 16 + fr, wmax = t0 + w * 16 + 15;
    bf16* qrow = Qb + (rowbase + myq) * DM + hd * 64;
    bf16x8 qf[2];
    qf[0] = *(const bf16x8*)(qrow + fq * 8); qf[1] = *(const bf16x8*)(qrow + 32 + fq * 8);
    f32x4 oacc[4];
#pragma unroll
    for (int i = 0; i < 4; ++i) oacc[i] = (f32x4){0.f, 0.f, 0.f, 0.f};
    float carry = 1.f;
    const int kr = tid >> 3, d8 = (tid & 7) * 8;
    v4u kreg, vreg;
    int kt = 2 * (qi + 1) - 1;
#define SB_LOAD(t) do { const size_t o_ = (rowbase + (size_t)(t) * 64 + kr) * DM + hd * 64 + d8; kreg = *(const v4u*)(Kb + o_); vreg = *(const v4u*)(Vb + o_); } while (0)
#define SB_STORE(bu) do { *(v4u*)(Ks + (bu) * 64 * LD + kr * LD + d8) = kreg; bf16* vd_ = Vs + (bu) * 64 * LD + d8 * LD + (kr ^ (((d8 >> 3) & 7) << 3)); \
        vd_[0] = (bf16)(vreg.x & 0xffffu); vd_[LD] = (bf16)(vreg.x >> 16); vd_[2 * LD] = (bf16)(vreg.y & 0xffffu); vd_[3 * LD] = (bf16)(vreg.y >> 16); \
        vd_[4 * LD] = (bf16)(vreg.z & 0xffffu); vd_[5 * LD] = (bf16)(vreg.z >> 16); vd_[6 * LD] = (bf16)(vreg.w & 0xffffu); vd_[7 * LD] = (bf16)(vreg.w >> 16); } while (0)
    SB_LOAD(kt); SB_STORE(0);
    __syncthreads();
    int cur = 0;
    for (; kt >= 0; --kt) {
        if (kt > 0) SB_LOAD(kt - 1);
        const int kbase = kt * 64;
        if (kbase <= wmax) {
            const bf16* Kc = Ks + cur * 64 * LD; const bf16* Vc = Vs + cur * 64 * LD;
            f32x4 z[4];
#pragma unroll
            for (int nt = 0; nt < 4; ++nt) { z[nt] = (f32x4){0.f, 0.f, 0.f, 0.f};
#pragma unroll
                for (int k2 = 0; k2 < 2; ++k2) { const bf16x8 af = *(const bf16x8*)(Kc + (nt * 16 + fr) * LD + k2 * 32 + fq * 8);
                    z[nt] = __builtin_amdgcn_mfma_f32_16x16x32_bf16(af, qf[k2], z[nt], 0, 0, 0); } }
            float kp[4][4], sg[4][4], T[4], tot[4], suf[4];
            const bool masked = kbase + 64 > t0 + w * 16;
#pragma unroll
            for (int nt = 0; nt < 4; ++nt) {
#pragma unroll
                for (int j = 0; j < 4; ++j) { const float z2 = z[nt][j] * 0.18033688011112042f;
                    const float ea = __builtin_amdgcn_exp2f(-fabsf(z2)), rc = __builtin_amdgcn_rcpf(1.f + ea); const bool pos = z2 >= 0.f;
                    sg[nt][j] = (pos ? 1.f : ea) * rc; kp[nt][j] = (pos ? ea : 1.f) * rc; }
                if (masked) {
#pragma unroll
                    for (int j = 0; j < 4; ++j) { const bool valid = kbase + nt * 16 + fq * 4 + j < myq; sg[nt][j] = valid ? sg[nt][j] : 0.f; kp[nt][j] = valid ? kp[nt][j] : 1.f; } }
                T[nt] = (kp[nt][0] * kp[nt][1]) * (kp[nt][2] * kp[nt][3]); }
#pragma unroll
            for (int nt = 0; nt < 4; ++nt) { const float p16 = __shfl_xor(T[nt], 16), s1 = T[nt] * p16, p32 = __shfl_xor(s1, 32); tot[nt] = s1 * p32;
                suf[nt] = fq == 0 ? p16 * p32 : fq == 1 ? p32 : fq == 2 ? p16 : 1.f; }
            float run = carry; float wv[4][4];
#pragma unroll
            for (int nt = 3; nt >= 0; --nt) { const float r3 = run * suf[nt], r2 = r3 * kp[nt][3], r1 = r2 * kp[nt][2], r0 = r1 * kp[nt][1];
                wv[nt][0] = sg[nt][0] * r0; wv[nt][1] = sg[nt][1] * r1; wv[nt][2] = sg[nt][2] * r2; wv[nt][3] = sg[nt][3] * r3;
                run *= tot[nt]; }
            carry = run;
#pragma unroll
            for (int kk = 0; kk < 2; ++kk) {
                v4u bw; bw.x = pk2(wv[2 * kk][0], wv[2 * kk][1]); bw.y = pk2(wv[2 * kk][2], wv[2 * kk][3]); bw.z = pk2(wv[2 * kk + 1][0], wv[2 * kk + 1][1]); bw.w = pk2(wv[2 * kk + 1][2], wv[2 * kk + 1][3]);
                const bf16x8 bfr = __builtin_bit_cast(bf16x8, bw);
#pragma unroll
                for (int mt = 0; mt < 4; ++mt) { const int vr = mt * 16 + fr, vs = ((vr >> 3) & 7) << 3; const bf16* vrow = Vc + vr * LD;
                    const v2u lo = *(const v2u*)(vrow + ((32 * kk + 4 * fq) ^ vs)), hi = *(const v2u*)(vrow + ((32 * kk + 16 + 4 * fq) ^ vs));
                    v4u av; av.x = lo.x; av.y = lo.y; av.z = hi.x; av.w = hi.y;
                    oacc[mt] = __builtin_amdgcn_mfma_f32_16x16x32_bf16(__builtin_bit_cast(bf16x8, av), bfr, oacc[mt], 0, 0, 0); }
            }
        }
        {   const bool any_alive = __ballot(carry != 0.f) != 0ull;
            if (lane == 0) alive[cur * 8 + w] = any_alive ? 1u : 0u; }
        if (kt > 0) SB_STORE(cur ^ 1);
        __syncthreads();
        unsigned al = 0u;
#pragma unroll
        for (int i = 0; i < 8; ++i) al |= alive[cur * 8 + i];
        if (al == 0u) break;
        cur ^= 1;
    }
#undef SB_LOAD
#undef SB_STORE
#pragma unroll
    for (int mt = 0; mt < 4; ++mt) { v2u wq; wq.x = pk2(oacc[mt][0], oacc[mt][1]); wq.y = pk2(oacc[mt][2], oacc[mt][3]); *(v2u*)(qrow + mt * 16 + fq * 4) = wq; }
}

__device__ __forceinline__ void phase_mixers(unsigned char* lds, CArgsR a, int l, unsigned long long& probe_acc) {
    unsigned* ctl = (unsigned*)(a.ws + WS_CTL);
    unsigned* counter = ctl + 64 * l; unsigned* gdone = ctl + 64 * l + 32;
    volatile unsigned* slot = (volatile unsigned*)(lds + LDS_BYTES - 64);
    constexpr int NDN = 64;
    const int nb = (int)gridDim.x - NDN;
    if ((int)blockIdx.x < NDN) { PT0(); dn_item(lds, a, l, (int)blockIdx.x, probe_acc); if (blockIdx.x == 0 && l == 0) PT1(9); }
    else {
        bf16* base = (bf16*)a.ws; bf16* Wreg = (bf16*)(a.ws + WS_W);
        pg8::Gemm g{base, Wreg + W_IN + (size_t)4096 * DM, MT, 6144, DM}; pg8::StaticOrder S; S.init(MT, 6144, nb, (int)blockIdx.x - NDN);
        EpiRoute E{base, 16};
        pg8::gemm_phase<EpiRoute, pg8::StaticOrder, true, true>((PG8_LAS unsigned char*)lds, g, S, E);
        __builtin_amdgcn_fence(__ATOMIC_RELEASE, "agent");
        asm volatile("s_waitcnt vmcnt(0)" ::: "memory");
        __syncthreads();
        if (threadIdx.x == 0) __hip_atomic_fetch_add(gdone, 1u, __ATOMIC_RELAXED, __HIP_MEMORY_SCOPE_AGENT);
    }
    if (threadIdx.x == 0) {
        unsigned sp = 0u;
        while (__hip_atomic_load(gdone, __ATOMIC_RELAXED, __HIP_MEMORY_SCOPE_AGENT) < (unsigned)nb && ++sp < (1u << 22)) __builtin_amdgcn_s_sleep(2);
        __builtin_amdgcn_fence(__ATOMIC_ACQUIRE, "agent");
        asm volatile("s_waitcnt vmcnt(0)" ::: "memory");
    }
    __syncthreads();
    constexpr unsigned NITEMS = 128 + 2048;
    for (;;) {
        if (threadIdx.x == 0) *slot = __hip_atomic_fetch_add(counter, 1u, __ATOMIC_RELAXED, __HIP_MEMORY_SCOPE_AGENT);
        __syncthreads();
        const unsigned item = *slot;
        __syncthreads();
        if (item >= NITEMS) break;
        PT0();
        if (item < 128) { ssm_item(lds, a, l, (int)item); if (item == 0 && l == 0) PT1(10); }
        else { const int r = (int)item - 128, qi = 15 - (r >> 7), bh = r & 127; sb_item(lds, a, bh >> 4, bh & 15, qi); if (item == 128 && l == 0) PT1(11); }
    }
}

__device__ __forceinline__ void phase_norms(CArgsR a, int l) {
    const int tid = opaque_tid(), lane = tid & 63, wave = tid >> 6, gw = blockIdx.x * NWAVES + wave, NGW = gridDim.x * NWAVES;
    bf16* base = (bf16*)a.ws;
    const bf16* Oraw = base + (size_t)B_DNV * BUFE; bf16* G = base + (size_t)B_DNG * BUFE; bf16* Y = base + (size_t)B_SSZ * BUFE;
    const float* dnw = a.in[6] + (size_t)l * 128 + (lane & 7) * 16; const float* snw = a.in[12] + (size_t)l * DM + lane * 16;
    float w1[16], w2[16];
#pragma unroll
    for (int i = 0; i < 16; ++i) { w1[i] = dnw[i]; w2[i] = snw[i]; }
    for (int m = gw; m < MT; m += NGW) {
        const size_t o = (size_t)m * DM + lane * 16;
        float v[16], s, r;
        unpack8(*(const v4u*)(Y + o), v); unpack8(*(const v4u*)(Y + o + 8), v + 8);
        s = 0.f;
#pragma unroll
        for (int i = 0; i < 16; ++i) s += v[i] * v[i];
        s = red16(s);
        r = rsqrtf(s * (1.f / 256.f) + EPS);
#pragma unroll
        for (int i = 0; i < 16; ++i) v[i] = v[i] * r * w2[i];
        *(v4u*)(Y + o) = pack8(v); *(v4u*)(Y + o + 8) = pack8(v + 8);
    }
}

#define LAS __attribute__((address_space(3)))
#define XB_TMO      128
#define XB_XCNT(j)  (256  + 64 * (j))
#define XB_XSUB(j)  (1280 + 64 * (j))
#define XB_XGEN(j)  (2304 + 64 * (j))
#define XB_TOP      3328
#define XB_TOPGEN   3392
#define XCD_BAR_WORDS 3456
#define XB_SPIN_CAP (1u << 18)

__device__ __forceinline__ unsigned xb_ld(unsigned* p)              { return __hip_atomic_load(p, __ATOMIC_RELAXED, __HIP_MEMORY_SCOPE_AGENT); }
__device__ __forceinline__ unsigned xb_add(unsigned* p, unsigned v) { return __hip_atomic_fetch_add(p, v, __ATOMIC_RELAXED, __HIP_MEMORY_SCOPE_AGENT); }
__device__ __forceinline__ unsigned xb_xcc_id() { return (unsigned)__builtin_amdgcn_s_getreg((3 << 11) | 20) & 0xFu; }
#define XB_SPIN(cond, bar) do { unsigned _sp = 0; while (cond) { __builtin_amdgcn_s_sleep(1); \
    if ((++_sp & 255u) == 0u) { if (xb_ld(&(bar)[XB_TMO])) break; if (_sp > XB_SPIN_CAP) { atomicAdd(&(bar)[XB_TMO], 1u); break; } } } } while (0)

struct XcdBarrier {
    unsigned* bar; unsigned x;
    volatile LAS unsigned* st;
};

__device__ __forceinline__ XcdBarrier xcd_barrier_post(unsigned* bar, volatile LAS unsigned* st) {
    XcdBarrier b; b.bar = bar; b.x = xb_xcc_id(); b.st = st;
    if (threadIdx.x == 0) (void)xb_add(&bar[XB_XCNT(b.x)], 1u);
    return b;
}
__device__ __forceinline__ void xcd_barrier_complete(unsigned* bar, unsigned x, unsigned& nloc, unsigned& nx) {
    const unsigned G = gridDim.x * gridDim.y * gridDim.z;
    unsigned sum, cnt, mine, sp = 0u;
    for (;;) {
        sum = 0u; cnt = 0u; mine = 0u;
#pragma unroll
        for (unsigned j = 0; j < 16; ++j) { const unsigned c = xb_ld(&bar[XB_XCNT(j)]); sum += c; cnt += (c > 0u) ? 1u : 0u; mine = (j == x) ? c : mine; }
        if (sum == G) break;
        __builtin_amdgcn_s_sleep(1);
        if ((++sp & 255u) == 0u) { if (xb_ld(&bar[XB_TMO])) break; if (sp > XB_SPIN_CAP) { atomicAdd(&bar[XB_TMO], 1u); break; } }
    }
    nloc = mine > 0u ? mine : 1u; nx = cnt > 0u ? cnt : 1u;
}

__device__ __forceinline__ void xcd_barrier(const XcdBarrier& b) {
    asm volatile("s_waitcnt vmcnt(0)" ::: "memory");
    __syncthreads();
    if (threadIdx.x == 0) {
        unsigned* bar = b.bar;
        __builtin_amdgcn_s_waitcnt(0);
        unsigned nloc = b.st[0], nx = b.st[1];
        if (nloc == 0u) { xcd_barrier_complete(bar, b.x, nloc, nx); b.st[0] = nloc; b.st[1] = nx; }
        const unsigned old = xb_add(&bar[XB_XSUB(b.x)], 1u);
        const unsigned gen = old / nloc;
        if (old + 1u == (gen + 1u) * nloc) {
            __builtin_amdgcn_fence(__ATOMIC_RELEASE, "agent");
            asm volatile("s_waitcnt vmcnt(0)" ::: "memory");
            const unsigned og = xb_add(&bar[XB_TOP], 1u);
            const unsigned tg = og / nx;
            if (og + 1u == (tg + 1u) * nx) xb_add(&bar[XB_TOPGEN], 1u);
            else XB_SPIN(xb_ld(&bar[XB_TOPGEN]) == tg, bar);
            __builtin_amdgcn_fence(__ATOMIC_ACQUIRE, "agent");
            xb_add(&bar[XB_XGEN(b.x)], 1u);
            asm volatile("s_waitcnt vmcnt(0)" ::: "memory");
        } else {
            XB_SPIN(xb_ld(&bar[XB_XGEN(b.x)]) == gen, bar);
            __builtin_amdgcn_fence(__ATOMIC_ACQUIRE, "agent");
            asm volatile("s_waitcnt vmcnt(0)" ::: "memory");
        }
    }
    __syncthreads();
}

__global__ void __launch_bounds__(NTHREADS, 2) hybrid_fwd(Args a_unused) {
    extern __shared__ __attribute__((aligned(16))) unsigned char lds[];
    cg::grid_group grid = cg::this_grid();
    PG8_LAS unsigned char* ldsl = (PG8_LAS unsigned char*)lds;
    unsigned long long probe_acc = 0ull;
#define A_ (*kargs())
    volatile LAS unsigned* bst = (volatile LAS unsigned*)((LAS unsigned char*)lds + LDS_BYTES - 32);
    if (threadIdx.x == 0) { bst[0] = 0u; bst[1] = 0u; }
    __syncthreads();
    const XcdBarrier bar = xcd_barrier_post((unsigned*)(a_unused.ws + WS_BAR), bst);
#pragma unroll 1
    for (int l = 0; l < 2; ++l) {
        asm volatile("" : "+s"(l));
        {   CArgsR a = A_; const float* xin = l == 0 ? a.in[0] : a.out;
            PT0(); phase0(lds, a, l, xin);
        if (l == 0) grid.sync(); else xcd_barrier(bar); PT1(0); }
        {   CArgsR a = A_; bf16* base = (bf16*)a.ws; bf16* Wreg = (bf16*)(a.ws + WS_W);
            pg8::Gemm g{base, Wreg + W_IN, MT, 4096, DM}; pg8::StaticOrder S; S.init(MT, 4096, (int)gridDim.x, (int)blockIdx.x);
            EpiRoute E{base, 0};
            PT0(); pg8::gemm_phase<EpiRoute, pg8::StaticOrder, true, true>(ldsl, g, S, E);
        xcd_barrier(bar); PT1(1); }
        { PT0(); phase_mixers(lds, A_, l, probe_acc);
        xcd_barrier(bar); PT1(2); }
        { PT0(); phase_norms(A_, l);
        xcd_barrier(bar); PT1(3); }
        {   CArgsR a = A_; bf16* base = (bf16*)a.ws; bf16* Wreg = (bf16*)(a.ws + WS_W);
            pg8::Gemm g{base, Wreg + W_G, 4 * MT, 6144, DM}; SchedGate S{(int)gridDim.x, (int)blockIdx.x};
            EpiGate E{base + (size_t)B_SBK * BUFE, (float*)(base + (size_t)B_DNK * BUFE), base + (size_t)B_DNQ * BUFE};
            PT0(); pg8::gemm_phase<EpiGate, SchedGate, true, true>(ldsl, g, S, E);
        xcd_barrier(bar); PT1(4); }
        {   CArgsR a = A_; bf16* base = (bf16*)a.ws; bf16* Wreg = (bf16*)(a.ws + WS_W); const float* xin = l == 0 ? a.in[0] : a.out;
            pg8::Gemm g{base + (size_t)B_DNQ * BUFE, Wreg + W_OUT, MT, DM, DM}; pg8::StaticOrder S; S.init(MT, DM, (int)gridDim.x, (int)blockIdx.x);
            EpiResid E{xin, a.out};
            PT0(); pg8::gemm_phase<EpiResid, pg8::StaticOrder, false, true>(ldsl, g, S, E);
        xcd_barrier(bar); PT1(5); }
        {   CArgsR a = A_; bf16* base = (bf16*)a.ws; const float* nw = a.in[15] + (size_t)l * DM; const float* xo = a.out;
            const int tid = opaque_tid(), lane = tid & 63, gw = blockIdx.x * NWAVES + (tid >> 6), NGW = gridDim.x * NWAVES;
            PT0(); for (int m = gw; m < MT; m += NGW) rms_row_to_bf16(xo + (size_t)m * DM, nw, base + (size_t)m * DM, lane);
        xcd_barrier(bar); PT1(6); }
        {   CArgsR a = A_; bf16* base = (bf16*)a.ws; bf16* Wreg = (bf16*)(a.ws + WS_W);
            pg8::Gemm g{base, Wreg + W_UP, MT, DFF, DM}; pg8::StaticOrder S; S.init(MT, DFF, (int)gridDim.x, (int)blockIdx.x);
            EpiRelu2 E{base + (size_t)B_DNQ * BUFE};
            PT0(); pg8::gemm_phase<EpiRelu2, pg8::StaticOrder, true, true>(ldsl, g, S, E);
        xcd_barrier(bar); PT1(7); }
        {   CArgsR a = A_; bf16* base = (bf16*)a.ws; bf16* Wreg = (bf16*)(a.ws + WS_W);
            pg8::Gemm g{base + (size_t)B_DNQ * BUFE, Wreg + W_DOWN, MT, DM, DFF}; pg8::StaticOrder S; S.init(MT, DM, (int)gridDim.x, (int)blockIdx.x);
            EpiResid E{a.out, a.out};
            PT0(); pg8::gemm_phase<EpiResid, pg8::StaticOrder, false, true>(ldsl, g, S, E);
        xcd_barrier(bar); PT1(8); }
    }
    {
        CArgsR a = A_; const float* nw = a.in[18]; float* xo = a.out;
        const int tid = opaque_tid(), lane = tid & 63, gw = blockIdx.x * NWAVES + (tid >> 6), NGW = gridDim.x * NWAVES;
        for (int m = gw; m < MT; m += NGW) {
            f32x4* xr = (f32x4*)(xo + (size_t)m * DM) + lane; const f32x4* wr = (const f32x4*)nw + lane;
            f32x4 v[4]; float s = 0.f;
#pragma unroll
            for (int j = 0; j < 4; ++j) { v[j] = xr[64 * j]; s += (v[j][0] * v[j][0] + v[j][1] * v[j][1]) + (v[j][2] * v[j][2] + v[j][3] * v[j][3]); }
            const float rstd = rsqrtf(wave_sum(s) * (1.f / DM) + EPS);
#pragma unroll
            for (int j = 0; j < 4; ++j) { const f32x4 ww = wr[64 * j]; f32x4 r;
#pragma unroll
                for (int i = 0; i < 4; ++i) r[i] = v[j][i] * rstd * ww[i];
                xr[64 * j] = r; }
        }
    }
#undef A_
    if (PROBE_SEL) { const unsigned long long t0 = rt(); while (rt() - t0 < probe_acc) __builtin_amdgcn_s_sleep(8); }
}

extern "C" void kernel_launch(void* const* d_in, const int* in_sizes, int n_in, void* d_out, int out_size, void* d_ws, size_t ws_size, hipStream_t stream) {
    static int grid = 0;
    if (grid == 0) {
        if (n_in != 19 || out_size != MT * DM || ws_size < WS_NEED) { fprintf(stderr, "kernel_launch: unexpected shapes (n_in %d out %d ws %zu need %zu)\n", n_in, out_size, ws_size, (size_t)WS_NEED); grid = -1; return; }
        int dev = 0, cus = 0, per_cu = 0;
        hipGetDevice(&dev); hipDeviceGetAttribute(&cus, hipDeviceAttributeMultiprocessorCount, dev);
        if (hipFuncSetAttribute((const void*)hybrid_fwd, hipFuncAttributeMaxDynamicSharedMemorySize, LDS_BYTES) != hipSuccess) { fprintf(stderr, "kernel_launch: hipFuncSetAttribute failed\n"); grid = -1; return; }
        if (hipOccupancyMaxActiveBlocksPerMultiprocessor(&per_cu, (const void*)hybrid_fwd, NTHREADS, LDS_BYTES) != hipSuccess || per_cu < 1) { fprintf(stderr, "kernel_launch: occupancy query gave %d\n", per_cu); per_cu = 1; }
        (void)hipGetLastError();
        grid = cus * per_cu;
    }
    if (grid < 0) return;
    if (hipMemsetAsync((char*)d_ws + WS_CTL, 0, CTL_BYTES, stream) != hipSuccess) { fprintf(stderr, "kernel_launch: memset of the control words failed\n"); return; }
    Args a{};
    for (int i = 0; i < 19; ++i) a.in[i] = (const float*)d_in[i];
    a.out = (float*)d_out; a.ws = (unsigned char*)d_ws;
    void* args[] = {&a};
    hipError_t e = hipLaunchCooperativeKernel((const void*)hybrid_fwd, dim3(grid), dim3(NTHREADS), args, LDS_BYTES, stream);
    if (e != hipSuccess) fprintf(stderr, "cooperative launch failed: %s (grid %d)\n", hipGetErrorString(e), grid);
}
```

```cpp
#include <hip/hip_runtime.h>
#include <hip/hip_cooperative_groups.h>
#include <cstdio>
#include <cstdint>
namespace cg = cooperative_groups;
__device__ __forceinline__ int opaque_tid() { int t = (int)threadIdx.x; asm volatile("" : "+v"(t)); return t; }
namespace pg8 {
#define PG8_LAS __attribute__((address_space(3)))
typedef unsigned short bf16_t;
typedef short bf16x8 __attribute__((ext_vector_type(8)));
typedef float f32x4 __attribute__((ext_vector_type(4)));
typedef unsigned u32x4 __attribute__((ext_vector_type(4)));
constexpr int BM = 256, BK = 64, HALF = 128, HTB = HALF * BK * 2  , STAGE_BYTES = 8 * HTB, NXCD = 8, WGM = 8;

__host__ __device__ __forceinline__ int lds_byte(int r, int c) { const int st = (r >> 4) * 2 + (c >> 5), rr = r & 15, cc = c & 31, ob = rr * 64 + cc * 2; return st * 1024 + (ob ^ (((ob >> 9) & 1) << 5)); }
__host__ __device__ __forceinline__ void stage_rc(int b, int& R, int& C) { const int st = b / 1024, sb = b % 1024, swz = sb ^ (((sb >> 9) & 1) << 5); R = (st >> 1) * 16 + swz / 64; C = (st & 1) * 32 + (swz % 64) / 2; }
__host__ __device__ __forceinline__ int perm32(int rho) { const int n = rho >> 4, i = rho & 15; return 8 * (i >> 2) + 4 * n + (i & 3); }

struct Unit { int pm, pn; };
struct Gemm { const bf16_t* A; const bf16_t* Bt; int M, N, K; };

struct StaticOrder {
    int nM, nN, nwg, G, c;
    __host__ __device__ void init(int M, int N, int G_, int c_) { nM = M / BM; nN = N / BM; nwg = nM * nN; G = G_; c = c_; }
    __host__ __device__ bool next(int i, Unit& u) const {
        const long L = (long)i * G + c; if (L >= nwg) return false;
        int wgid = (int)L; { const int q = nwg / NXCD, r = nwg % NXCD, xcd = wgid % NXCD, off = wgid / NXCD; wgid = (xcd < r ? xcd * (q + 1) : r * (q + 1) + (xcd - r) * q) + off; }
        const int nig = WGM * nN, gid = wgid / nig, fm = gid * WGM, gsz = (nM - fm) < WGM ? (nM - fm) : WGM;
        u.pm = fm + ((wgid % nig) % gsz); u.pn = (wgid % nig) / gsz; return true;
    }
    __device__ __forceinline__ void a_ready(const Unit&) const {}
    __device__ __forceinline__ void done(const Unit&) const {}
};
__device__ __forceinline__ unsigned cvt_pk_bf16(float lo, float hi) { unsigned r; asm volatile("v_cvt_pk_bf16_f32 %0, %1, %2" : "=v"(r) : "v"(lo), "v"(hi)); return r; }
template <class Epi, class Sched, bool ALIGN_EPI = false, bool SP2 = false>
__device__ __forceinline__ void gemm_phase(PG8_LAS unsigned char* lds, const Gemm g, const Sched& S, const Epi& E) {
    const int tid = opaque_tid(), wid = __builtin_amdgcn_readfirstlane(tid >> 6), lane = tid & 63, wr = wid >> 2, wc = wid & 3, fr = lane & 15, fq = lane >> 4;
    const int K = g.K, nt = K / BK;
    unsigned voffA[2], voffB[2];
#pragma unroll
    for (int i = 0; i < 2; ++i) { int R, C; stage_rc(tid * 16 + i * 8192, R, C); const int Rb = Epi::PERM ? ((R & ~31) + perm32(R & 31)) : R;
        voffA[i] = (unsigned)(R * K + C) * 2u; voffB[i] = (unsigned)(Rb * K + C) * 2u; }
    const size_t kstep = (size_t)(BK * 2);
    const size_t hstep = (size_t)HALF * K * 2;
    const size_t tstep = 2 * hstep;
    const unsigned ldsw = (unsigned)wid * 1024u;
    const int aoff = lds_byte(wr * 64 + fr, fq * 8), boff = lds_byte(wc * 32 + fr, fq * 8);
#define PG8_SA(b, h) (((b) * 2 + (h)) * HTB)
#define PG8_SB(b, h) ((4 + (b) * 2 + (h)) * HTB)
#define PG8_STAGE(bufoff, gbase, voff) do { _Pragma("unroll") for (int _i = 0; _i < 2; ++_i) \
        __builtin_amdgcn_global_load_lds((const unsigned*)((const char*)(gbase) + (voff)[_i]), (PG8_LAS unsigned*)(lds + (bufoff) + ldsw + _i * 8192), 16, 0, 0); } while (0)
#define PG8_LDA(dst, b, h) do { _Pragma("unroll") for (int m = 0; m < 4; ++m) _Pragma("unroll") for (int k = 0; k < 2; ++k) dst[m][k] = *(const PG8_LAS bf16x8*)(lds + PG8_SA(b, h) + aoff + m * 2048 + k * 1024); } while (0)
#define PG8_LDB(dst, b, h) do { _Pragma("unroll") for (int n = 0; n < 2; ++n) _Pragma("unroll") for (int k = 0; k < 2; ++k) dst[n][k] = *(const PG8_LAS bf16x8*)(lds + PG8_SB(b, h) + boff + n * 2048 + k * 1024); } while (0)
#define PG8_MMA(ai, bj, At, Bt) do { __builtin_amdgcn_s_setprio(1); _Pragma("unroll") for (int m = 0; m < 4; ++m) _Pragma("unroll") for (int n = 0; n < 2; ++n) _Pragma("unroll") for (int k = 0; k < 2; ++k) \
        acc[ai][bj][m][n] = __builtin_amdgcn_mfma_f32_16x16x32_bf16(Bt[n][k], At[m][k], acc[ai][bj][m][n], 0, 0, 0); __builtin_amdgcn_s_setprio(0); } while (0)
#define PG8_WAIT_V(n) asm volatile("s_waitcnt vmcnt(" #n ")" ::: "memory")
#define PG8_WAIT_L(n) asm volatile("s_waitcnt lgkmcnt(" #n ")" ::: "memory")
#define PG8_BAR __builtin_amdgcn_s_barrier()
#define PG8_SCHED __builtin_amdgcn_sched_barrier(0)
    Unit cur, nxt; int ui = 0;
    if (!S.next(0, cur)) return;
    f32x4 acc[2][2][4][2];
#pragma unroll
    for (int a = 0; a < 2; ++a)
#pragma unroll
        for (int b = 0; b < 2; ++b)
#pragma unroll
            for (int m = 0; m < 4; ++m)
#pragma unroll
                for (int n = 0; n < 2; ++n) acc[a][b][m][n] = (f32x4){0.f, 0.f, 0.f, 0.f};
    bf16x8 At[4][2], B0[2][2], B1[2][2];
    const char* cA = (const char*)g.A + (size_t)cur.pm * tstep; const char* cB = (const char*)g.Bt + (size_t)cur.pn * tstep;
    S.a_ready(cur);
    if constexpr (SP2) {
        PG8_STAGE(PG8_SB(0, 0), cB, voffB); PG8_STAGE(PG8_SB(0, 1), cB + hstep, voffB); PG8_STAGE(PG8_SA(0, 0), cA, voffA); PG8_STAGE(PG8_SA(0, 1), cA + hstep, voffA);
        if (wr == 1) PG8_BAR;
        PG8_WAIT_V(2); PG8_BAR;
        PG8_STAGE(PG8_SB(1, 0), cB + kstep, voffB); PG8_STAGE(PG8_SA(1, 0), cA + kstep, voffA); PG8_STAGE(PG8_SB(1, 1), cB + hstep + kstep, voffB);
        PG8_WAIT_V(6); PG8_BAR;
    } else {
        PG8_STAGE(PG8_SB(0, 0), cB, voffB); PG8_STAGE(PG8_SA(0, 0), cA, voffA); PG8_STAGE(PG8_SB(0, 1), cB + hstep, voffB); PG8_STAGE(PG8_SA(0, 1), cA + hstep, voffA);
        if (wr == 1) PG8_BAR;
        PG8_WAIT_V(4); PG8_BAR;
        PG8_STAGE(PG8_SB(1, 0), cB + kstep, voffB); PG8_STAGE(PG8_SA(1, 0), cA + kstep, voffA); PG8_STAGE(PG8_SB(1, 1), cB + hstep + kstep, voffB);
        PG8_WAIT_V(6); PG8_BAR;
    }
    for (;;) {
        const bool has_next = S.next(ui + 1, nxt);
        const char* nA = has_next ? (const char*)g.A + (size_t)nxt.pm * tstep : cA; const char* nB = has_next ? (const char*)g.Bt + (size_t)nxt.pn * tstep : cB;
        for (int t = 0; t < nt; t += 2) {
            const bool last = (t == nt - 2);
            const char* a1 = cA + (size_t)(t + 1) * kstep;
            const char* a2 = last ? nA : cA + (size_t)(t + 2) * kstep; const char* b2 = last ? nB : cB + (size_t)(t + 2) * kstep;
            const char* a3 = a2 + kstep; const char* b3 = b2 + kstep;
            if (last && has_next) S.a_ready(nxt);
            if constexpr (SP2) {
            PG8_LDB(B0, 0, 0); PG8_LDB(B1, 0, 1); PG8_SCHED; PG8_LDA(At, 0, 0); PG8_STAGE(PG8_SA(1, 1), a1 + hstep, voffA);
            PG8_WAIT_V(8); PG8_WAIT_L(0); PG8_BAR; PG8_MMA(0, 0, At, B0); PG8_MMA(0, 1, At, B1); PG8_BAR; PG8_SCHED;
            PG8_LDA(At, 0, 1); PG8_STAGE(PG8_SB(0, 0), b2, voffB); PG8_STAGE(PG8_SB(0, 1), b2 + hstep, voffB); PG8_STAGE(PG8_SA(0, 0), a2, voffA);
            PG8_WAIT_V(8); PG8_WAIT_L(0); PG8_BAR; PG8_MMA(1, 0, At, B0); PG8_MMA(1, 1, At, B1); PG8_BAR; PG8_SCHED;
            PG8_LDB(B0, 1, 0); PG8_LDB(B1, 1, 1); PG8_SCHED; PG8_LDA(At, 1, 0); PG8_STAGE(PG8_SA(0, 1), a2 + hstep, voffA);
            PG8_WAIT_V(8); PG8_WAIT_L(0); PG8_BAR; PG8_MMA(0, 0, At, B0); PG8_MMA(0, 1, At, B1); PG8_BAR; PG8_SCHED;
            PG8_LDA(At, 1, 1); PG8_STAGE(PG8_SB(1, 0), b3, voffB); PG8_STAGE(PG8_SB(1, 1), b3 + hstep, voffB); PG8_STAGE(PG8_SA(1, 0), a3, voffA);
            PG8_WAIT_V(8); PG8_WAIT_L(0); PG8_BAR; PG8_MMA(1, 0, At, B0); PG8_MMA(1, 1, At, B1); PG8_BAR; PG8_SCHED;
            } else {
            PG8_LDB(B0, 0, 0); PG8_SCHED; PG8_LDA(At, 0, 0); PG8_STAGE(PG8_SA(1, 1), a1 + hstep, voffA);
            PG8_WAIT_L(8); PG8_BAR; PG8_WAIT_L(0); PG8_MMA(0, 0, At, B0); PG8_BAR; PG8_SCHED;
            PG8_LDB(B1, 0, 1); PG8_STAGE(PG8_SB(0, 0), b2, voffB);
            PG8_BAR; PG8_WAIT_L(0); PG8_MMA(0, 1, At, B1); PG8_BAR;
            PG8_LDA(At, 0, 1); PG8_STAGE(PG8_SA(0, 0), a2, voffA);
            PG8_BAR; PG8_WAIT_L(0); PG8_MMA(1, 0, At, B0); PG8_BAR; PG8_SCHED;
            PG8_STAGE(PG8_SB(0, 1), b2 + hstep, voffB);
            PG8_WAIT_V(6); PG8_BAR; PG8_MMA(1, 1, At, B1); PG8_BAR;
            PG8_LDB(B0, 1, 0); PG8_SCHED; PG8_LDA(At, 1, 0); PG8_STAGE(PG8_SA(0, 1), a2 + hstep, voffA);
            PG8_WAIT_L(8); PG8_BAR; PG8_WAIT_L(0); PG8_MMA(0, 0, At, B0); PG8_BAR; PG8_SCHED;
            PG8_LDB(B1, 1, 1); PG8_STAGE(PG8_SB(1, 0), b3, voffB);
            PG8_BAR; PG8_WAIT_L(0); PG8_MMA(0, 1, At, B1); PG8_BAR;
            PG8_LDA(At, 1, 1); PG8_STAGE(PG8_SA(1, 0), a3, voffA);
            PG8_BAR; PG8_WAIT_L(0); PG8_MMA(1, 0, At, B0); PG8_BAR; PG8_SCHED;
            PG8_STAGE(PG8_SB(1, 1), b3 + hstep, voffB);
            PG8_WAIT_V(6); PG8_BAR; PG8_MMA(1, 1, At, B1); PG8_BAR;
            }
        }
        if constexpr (ALIGN_EPI) { if (wr == 0) PG8_BAR; }
        if constexpr (!Epi::AFTER_DRAIN) { E(acc, cur, wr, wc, fr, fq); S.done(cur); }
        if (!has_next) break;
#pragma unroll
        for (int a = 0; a < 2; ++a)
#pragma unroll
            for (int b = 0; b < 2; ++b)
#pragma unroll
                for (int m = 0; m < 4; ++m)
#pragma unroll
                    for (int n = 0; n < 2; ++n) acc[a][b][m][n] = (f32x4){0.f, 0.f, 0.f, 0.f};
        cur = nxt; cA = nA; cB = nB; ++ui;
        if constexpr (ALIGN_EPI) { if (wr == 1) PG8_BAR; }
    }
    PG8_WAIT_V(0);
    if constexpr (!ALIGN_EPI) { if (wr == 0) PG8_BAR; }
    PG8_BAR;
    if constexpr (Epi::AFTER_DRAIN) { E.fused(acc, cur, wr, wc, fr, fq, lds, wid, lane); S.done(cur); }
#undef PG8_SA
#undef PG8_SB
#undef PG8_STAGE
#undef PG8_LDA
#undef PG8_LDB
#undef PG8_MMA
#undef PG8_WAIT_V
#undef PG8_WAIT_L
#undef PG8_BAR
#undef PG8_SCHED
}
}

constexpr int NB = 8, SEQ = 2048, DM = 1024, MT = NB * SEQ, DFF = 4096, IN_DIM = 13344;
constexpr int NTHREADS = 512, NWAVES = 8, LDS_BYTES = 147456;
constexpr float EPS = 1e-6f;
typedef unsigned short bf16;
typedef unsigned v4u __attribute__((ext_vector_type(4)));
typedef unsigned v2u __attribute__((ext_vector_type(2)));
typedef float f32x4 __attribute__((ext_vector_type(4)));
typedef short bf16x8 __attribute__((ext_vector_type(8)));
enum { B_H = 0, B_DNG = 1, B_SBQ = 2, B_SSZ = 3, B_DNQ = 4, B_DNK = 5, B_DNV = 6, B_SBK = 7, B_SBV = 8, B_SSX = 9, B_SSBC = 10, NBUF = 11 };
constexpr size_t BUFE = (size_t)MT * DM;
constexpr size_t WS_W = NBUF * BUFE * 2;
constexpr size_t W_IN = 0, W_G = W_IN + (size_t)10240 * 1024, W_OUT = W_G + (size_t)6144 * 1024, W_UP = W_OUT + (size_t)1024 * 1024,
                 W_DOWN = W_UP + (size_t)4096 * 1024, W_END = W_DOWN + (size_t)4096 * 1024;
constexpr size_t WS_SMALL = WS_W + W_END * 2;
constexpr size_t WS_CTL = WS_SMALL + (size_t)MT * 64 * 4;
constexpr size_t WS_BAR = WS_CTL + 4096;
constexpr size_t CTL_BYTES = 4096 + 16384;
constexpr size_t WS_NEED = WS_CTL + CTL_BYTES;

__device__ __forceinline__ float bf2f(unsigned u) { return __builtin_bit_cast(float, u << 16); }
__device__ __forceinline__ unsigned f2bf(float f) { unsigned u = __builtin_bit_cast(unsigned, f); return (u + 0x7fffu + ((u >> 16) & 1u)) >> 16; }
typedef float f32x2 __attribute__((ext_vector_type(2)));
typedef __bf16 bf16x2_t __attribute__((ext_vector_type(2)));
__device__ __forceinline__ unsigned pk2(float lo, float hi) { f32x2 v = {lo, hi}; return __builtin_bit_cast(unsigned, __builtin_convertvector(v, bf16x2_t)); }
__device__ __forceinline__ void unpack8(v4u r, float* o) {
    o[0] = bf2f(r.x & 0xffffu); o[1] = __builtin_bit_cast(float, r.x & 0xffff0000u); o[2] = bf2f(r.y & 0xffffu); o[3] = __builtin_bit_cast(float, r.y & 0xffff0000u);
    o[4] = bf2f(r.z & 0xffffu); o[5] = __builtin_bit_cast(float, r.z & 0xffff0000u); o[6] = bf2f(r.w & 0xffffu); o[7] = __builtin_bit_cast(float, r.w & 0xffff0000u);
}
__device__ __forceinline__ v4u pack8(const float* v) { v4u w; w.x = pk2(v[0], v[1]); w.y = pk2(v[2], v[3]); w.z = pk2(v[4], v[5]); w.w = pk2(v[6], v[7]); return w; }
__device__ __forceinline__ float sigmoidf_(float x) { return __builtin_amdgcn_rcpf(1.f + __expf(-x)); }
__device__ __forceinline__ float siluf_(float x) { return x * __builtin_amdgcn_rcpf(1.f + __expf(-x)); }
__device__ __forceinline__ float softplusf_(float x) { return fmaxf(x, 0.f) + log1pf(__expf(-fabsf(x))); }
template <int CTRL> __device__ __forceinline__ float dppf(float v) { return __builtin_bit_cast(float, __builtin_amdgcn_update_dpp(0, __builtin_bit_cast(int, v), CTRL, 0xF, 0xF, true)); }
__device__ __forceinline__ float red8(float v) { v += dppf<0xB1>(v); v += dppf<0x4E>(v); v += dppf<0x141>(v); return v; }
__device__ __forceinline__ float red16(float v) { v = red8(v); v += dppf<0x140>(v); return v; }
__device__ __forceinline__ float wave_sum(float v) {
#pragma unroll
    for (int o = 1; o < 64; o <<= 1) v += __shfl_xor(v, o);
    return v;
}
#define LDS_WAIT() asm volatile("s_waitcnt lgkmcnt(0)" ::: "memory")

struct Args { const float* in[19]; float* out; unsigned char* ws; };
typedef const __attribute__((address_space(4))) Args& CArgsR;
__device__ __forceinline__ const __attribute__((address_space(4))) Args* kargs() { unsigned long long v = (unsigned long long)__builtin_amdgcn_kernarg_segment_ptr(); asm volatile("" : "+s"(v)); return (const __attribute__((address_space(4))) Args*)v; }
#ifndef PROBE_SEL
#define PROBE_SEL 0
#endif
__device__ __forceinline__ unsigned long long rt() { return __builtin_amdgcn_s_memrealtime(); }
#define PT0() unsigned long long pt_ = PROBE_SEL ? rt() : 0ull
#define PT1(k) do { if (PROBE_SEL & (1 << (k))) probe_acc += rt() - pt_; } while (0)

struct EpiRoute {
    static constexpr bool PERM = true, AFTER_DRAIN = false;
    bf16* base; int pn_off;
    __device__ __forceinline__ void operator()(const pg8::f32x4 (&acc)[2][2][4][2], const pg8::Unit& u, int wr, int wc, int fr, int fq) const {
        const int sg = (u.pn + pn_off) >> 2;
        const int bufi = sg == 0 ? B_DNG : sg == 1 ? B_DNQ : sg == 2 ? B_DNK : sg == 3 ? B_DNV : sg == 4 ? B_SBQ : sg == 5 ? B_SSZ : sg == 6 ? B_SBK : sg == 7 ? B_SBV : sg == 8 ? B_SSX : B_SSBC;
        bf16* O = base + (size_t)bufi * BUFE;
        const int col0 = (u.pn & 3) * 256 + wc * 32 + 8 * fq, row0 = u.pm * 256 + wr * 64 + fr;
#pragma unroll
        for (int ai = 0; ai < 2; ++ai)
#pragma unroll
            for (int m = 0; m < 4; ++m) { bf16* rowp = O + (size_t)(row0 + ai * 128 + m * 16) * DM + col0;
#pragma unroll
                for (int bj = 0; bj < 2; ++bj) { const pg8::f32x4 v0 = acc[ai][bj][m][0], v1 = acc[ai][bj][m][1];
                    v4u w; w.x = pk2(v0[0], v0[1]); w.y = pk2(v0[2], v0[3]); w.z = pk2(v1[0], v1[1]); w.w = pk2(v1[2], v1[3]);
                    *(v4u*)(rowp + bj * 128) = w; } }
    }
};
struct EpiRelu2 {
    static constexpr bool PERM = true, AFTER_DRAIN = false;
    bf16* O;
    __device__ __forceinline__ void operator()(const pg8::f32x4 (&acc)[2][2][4][2], const pg8::Unit& u, int wr, int wc, int fr, int fq) const {
        const int col0 = u.pn * 256 + wc * 32 + 8 * fq, row0 = u.pm * 256 + wr * 64 + fr;
#pragma unroll
        for (int ai = 0; ai < 2; ++ai)
#pragma unroll
            for (int m = 0; m < 4; ++m) { bf16* rowp = O + (size_t)(row0 + ai * 128 + m * 16) * DFF + col0;
#pragma unroll
                for (int bj = 0; bj < 2; ++bj) { float v[8];
#pragma unroll
                    for (int i = 0; i < 4; ++i) { float a = fmaxf(acc[ai][bj][m][0][i], 0.f), b = fmaxf(acc[ai][bj][m][1][i], 0.f); v[i] = a * a; v[4 + i] = b * b; }
                    *(v4u*)(rowp + bj * 128) = pack8(v); } }
    }
};
struct EpiResid {
    static constexpr bool PERM = true, AFTER_DRAIN = false;
    const float* xin; float* xout;
    __device__ __forceinline__ void operator()(const pg8::f32x4 (&acc)[2][2][4][2], const pg8::Unit& u, int wr, int wc, int fr, int fq) const {
        const int col0 = u.pn * 256 + wc * 32 + 8 * fq, row0 = u.pm * 256 + wr * 64 + fr;
#pragma unroll
        for (int ai = 0; ai < 2; ++ai)
#pragma unroll
            for (int m = 0; m < 4; ++m) { const size_t ro = (size_t)(row0 + ai * 128 + m * 16) * DM + col0;
#pragma unroll
                for (int bj = 0; bj < 2; ++bj) { const size_t o = ro + bj * 128;
                    const f32x4 a = *(const f32x4*)(xin + o), b = *(const f32x4*)(xin + o + 4);
                    f32x4 r0, r1;
#pragma unroll
                    for (int i = 0; i < 4; ++i) { r0[i] = a[i] + acc[ai][bj][m][0][i]; r1[i] = b[i] + acc[ai][bj][m][1][i]; }
                    *(f32x4*)(xout + o) = r0; *(f32x4*)(xout + o + 4) = r1; } }
    }
};
struct SchedGate {
    int G, c;
    __device__ __forceinline__ bool next(int i, pg8::Unit& u) const {
        const int tile = c + (i / 6) * G; if (tile >= 256) return false;
        const int s = i % 6, br = s >> 1, pm = tile >> 2, pn = tile & 3;
        if ((s & 1) == 0) { u.pm = pm; u.pn = br * 4 + pn; } else { u.pm = (1 + br) * 64 + pm; u.pn = (3 + br) * 4 + pn; }
        return true;
    }
    __device__ __forceinline__ void a_ready(const pg8::Unit&) const {}
    __device__ __forceinline__ void done(const pg8::Unit&) const {}
};
struct EpiGate {
    static constexpr bool PERM = true, AFTER_DRAIN = false;
    bf16* gsc; float* macc; bf16* merged;
    __device__ __forceinline__ void operator()(const pg8::f32x4 (&acc)[2][2][4][2], const pg8::Unit& u, int wr, int wc, int fr, int fq) const {
        const int j = u.pn >> 2, pn = u.pn & 3, pm = u.pm & 63;
        const int col0 = pn * 256 + wc * 32 + 8 * fq, row0 = pm * 256 + wr * 64 + fr;
#pragma unroll
        for (int ai = 0; ai < 2; ++ai)
#pragma unroll
            for (int m = 0; m < 4; ++m) { const size_t ro = (size_t)(row0 + ai * 128 + m * 16) * DM + col0;
#pragma unroll
                for (int bj = 0; bj < 2; ++bj) { const size_t o = ro + bj * 128; float v[8];
#pragma unroll
                    for (int i = 0; i < 4; ++i) { v[i] = acc[ai][bj][m][0][i]; v[4 + i] = acc[ai][bj][m][1][i]; }
                    if (j < 3) {
#pragma unroll
                        for (int i = 0; i < 8; ++i) v[i] = sigmoidf_(v[i]);
                        *(v4u*)(gsc + o) = pack8(v);
                    } else {
                        float g[8]; unpack8(*(const v4u*)(gsc + o), g);
#pragma unroll
                        for (int i = 0; i < 8; ++i) v[i] *= g[i];
                        if (j > 3) { const f32x4 a = *(const f32x4*)(macc + o), b = *(const f32x4*)(macc + o + 4);
#pragma unroll
                            for (int i = 0; i < 4; ++i) { v[i] += a[i]; v[4 + i] += b[i]; } }
                        if (j < 5) { *(f32x4*)(macc + o) = (f32x4){v[0], v[1], v[2], v[3]}; *(f32x4*)(macc + o + 4) = (f32x4){v[4], v[5], v[6], v[7]}; }
                        else *(v4u*)(merged + o) = pack8(v);
                    } } }
    }
};

__device__ __forceinline__ void transpose_item(const float* __restrict__ W, const float* __restrict__ W2, int ldw, bf16* __restrict__ WT, int K, int nblk, float* scr, int item, int lane) {
    const int kb = item / nblk, nb = item % nblk, k0 = 64 * kb, n0 = 32 * nb;
    const float* src = ((lane & 31) < 16 ? W : W2) + (size_t)(k0 + (lane >> 5)) * ldw + n0 + (lane & 31);
    float t[32];
#pragma unroll
    for (int i = 0; i < 32; ++i) t[i] = src[(size_t)(2 * i) * ldw];
#pragma unroll
    for (int i = 0; i < 32; ++i) scr[(2 * i + (lane >> 5)) * 33 + (lane & 31)] = t[i];
    LDS_WAIT();
    const int c = lane & 7;
#pragma unroll
    for (int j = 0; j < 4; ++j) { const int n = (lane >> 3) + 8 * j; const float* s = scr + (8 * c) * 33 + n;
        v4u o; o.x = pk2(s[0 * 33], s[1 * 33]); o.y = pk2(s[2 * 33], s[3 * 33]); o.z = pk2(s[4 * 33], s[5 * 33]); o.w = pk2(s[6 * 33], s[7 * 33]);
        *(v4u*)(WT + (size_t)(n0 + n) * K + k0 + 8 * c) = o; }
    LDS_WAIT();
}
__device__ __forceinline__ void rms_row_to_bf16(const float* xrow, const float* w, bf16* orow, int lane) {
    const f32x4* xr = (const f32x4*)xrow + lane; const f32x4* wr = (const f32x4*)w + lane;
    f32x4 v[4]; float s = 0.f;
#pragma unroll
    for (int j = 0; j < 4; ++j) { v[j] = xr[64 * j]; s += (v[j][0] * v[j][0] + v[j][1] * v[j][1]) + (v[j][2] * v[j][2] + v[j][3] * v[j][3]); }
    const float rstd = rsqrtf(wave_sum(s) * (1.f / DM) + EPS);
    unsigned long long* o8 = (unsigned long long*)orow + lane;
#pragma unroll
    for (int j = 0; j < 4; ++j) { const f32x4 ww = wr[64 * j];
        o8[64 * j] = (unsigned long long)pk2(v[j][0] * rstd * ww[0], v[j][1] * rstd * ww[1]) | ((unsigned long long)pk2(v[j][2] * rstd * ww[2], v[j][3] * rstd * ww[3]) << 32); }
}
__device__ __forceinline__ void phase0(unsigned char* lds, CArgsR a, int l, const float* xin) {
    constexpr int LDW = 1032;
    const int tid = opaque_tid(), lane = tid & 63, wave = __builtin_amdgcn_readfirstlane(tid >> 6), gw = blockIdx.x * NWAVES + wave, NGW = gridDim.x * NWAVES;
    bf16* Wreg = (bf16*)(a.ws + WS_W);
    const float* w_in = a.in[2] + (size_t)l * DM * IN_DIM;
    {
        float* scr = (float*)lds + wave * (64 * 33);
        const float* w_br = a.in[13] + (size_t)l * 3 * DM * DM; const float* w_out = a.in[14] + (size_t)l * DM * DM;
        const float* w_up = a.in[16] + (size_t)l * DM * DFF; const float* w_down = a.in[17] + (size_t)l * DFF * DM;
        constexpr int NSEG = 17, NIT = NSEG * 512 + 2048 + 2048;
        for (int it = gw; it < NIT; it += NGW) {
            if (it < NSEG * 512) {
                const int seg = it >> 9, r = it & 511;
                const float* W; int ldw; bf16* WT;
                if (seg < 13) {
                    const int co = seg == 0 ? 3072 : seg == 1 ? 0 : seg == 2 ? 1024 : seg == 3 ? 2048 : seg == 4 ? 4112 : seg == 5 ? 7184 : seg == 6 ? 5136 : seg == 7 ? 6160 : seg == 8 ? 8208 : seg == 9 ? 9232
                                 : 10272 + (seg - 10) * 1024;
                    W = w_in + co; ldw = IN_DIM; WT = seg < 10 ? Wreg + (size_t)seg * DM * DM : Wreg + W_G + (size_t)(seg - 10) * DM * DM;
                } else if (seg < 16) { W = w_br + (size_t)(seg - 13) * DM * DM; ldw = DM; WT = Wreg + W_G + (size_t)(3 + seg - 13) * DM * DM; }
                else { W = w_out; ldw = DM; WT = Wreg + W_OUT; }
                transpose_item(W, W, ldw, WT, DM, 32, scr, r, lane);
            } else if (it < NSEG * 512 + 2048) transpose_item(w_up, w_up, DFF, Wreg + W_UP, DM, 128, scr, it - NSEG * 512, lane);
            else transpose_item(w_down, w_down, DM, Wreg + W_DOWN, DFF, 32, scr, it - NSEG * 512 - 2048, lane);
        }
    }
    __syncthreads();
    bf16* WsT = (bf16*)lds;
    for (int idx = tid; idx < 32 * DM; idx += NTHREADS) { const int k = idx >> 5, c = idx & 31; WsT[c * LDW + k] = (bf16)f2bf(w_in[(size_t)k * IN_DIM + (c < 16 ? 4096 + c : 10256 + c - 16)]); }
    __syncthreads();
    {   const float* nw = a.in[1] + (size_t)l * DM; bf16* H = (bf16*)a.ws; float* small = (float*)(a.ws + WS_SMALL);
        const int fr = lane & 15, fq = lane >> 4;
        const float pa0 = __expf(a.in[4][l * 8 + (fr & 7)]), pb0 = a.in[5][l * 8 + (fr & 7)], pa1 = __expf(a.in[9][l * 16 + fr]), pb1 = a.in[10][l * 16 + fr];
        for (int g8 = gw; g8 < MT / 8; g8 += NGW) {
            const int r0 = g8 * 8;
#pragma unroll 1
            for (int r = 0; r < 8; ++r) rms_row_to_bf16(xin + (size_t)(r0 + r) * DM, nw, H + (size_t)(r0 + r) * DM, lane);
            asm volatile("s_waitcnt vmcnt(0)" ::: "memory");
            f32x4 c0 = {0.f, 0.f, 0.f, 0.f}, c1 = {0.f, 0.f, 0.f, 0.f};
            const bf16* ap = H + (size_t)(r0 + (fr & 7)) * DM + fq * 8;
#pragma unroll
            for (int kb = 0; kb < 4; ++kb) { bf16x8 af[8];
#pragma unroll
                for (int k = 0; k < 8; ++k) af[k] = *(const bf16x8*)(ap + (kb * 8 + k) * 32);
#pragma unroll
                for (int k = 0; k < 8; ++k) { const bf16x8 b0 = *(const bf16x8*)(WsT + fr * LDW + (kb * 8 + k) * 32 + fq * 8), b1 = *(const bf16x8*)(WsT + (16 + fr) * LDW + (kb * 8 + k) * 32 + fq * 8);
                    c0 = __builtin_amdgcn_mfma_f32_16x16x32_bf16(af[k], b0, c0, 0, 0, 0); c1 = __builtin_amdgcn_mfma_f32_16x16x32_bf16(af[k], b1, c1, 0, 0, 0); } }
            if (fq < 2) {
#pragma unroll
                for (int jj = 0; jj < 4; ++jj) { float* sp = small + (size_t)(r0 + 4 * fq + jj) * 64;
                    sp[fr] = fr < 8 ? -pa0 * softplusf_(c0[jj] + pb0) : sigmoidf_(c0[jj]);
                    const float dt = softplusf_(c1[jj] + pb1); sp[16 + fr] = dt; sp[32 + fr] = -pa1 * dt; } }
        }
    }
}

__device__ __forceinline__ void conv8(const bf16* p, int pos, const float* w, int wstride, const float* bias, float* out) {
    float acc[8];
#pragma unroll
    for (int i = 0; i < 8; ++i) acc[i] = bias ? bias[i] : 0.f;
#pragma unroll
    for (int j = 0; j < 4; ++j) { const int back = 3 - j;
        if (pos - back >= 0) { float xv[8]; unpack8(*(const v4u*)(p - (size_t)back * DM), xv);
            const f32x4 w0 = *(const f32x4*)(w + j * wstride), w1 = *(const f32x4*)(w + j * wstride + 4);
#pragma unroll
            for (int i = 0; i < 4; ++i) { acc[i] += xv[i] * w0[i]; acc[4 + i] += xv[4 + i] * w1[i]; } } }
#pragma unroll
    for (int i = 0; i < 8; ++i) out[i] = siluf_(acc[i]);
}

__device__ __forceinline__ void conv8r(const v4u (&raw)[4], const float* w, int wstride, const float* bias, float* out) {
    float acc[8];
#pragma unroll
    for (int i = 0; i < 8; ++i) acc[i] = bias ? bias[i] : 0.f;
#pragma unroll
    for (int j = 0; j < 4; ++j) { float xv[8]; unpack8(raw[j], xv);
        const f32x4 w0 = *(const f32x4*)(w + j * wstride), w1 = *(const f32x4*)(w + j * wstride + 4);
#pragma unroll
        for (int i = 0; i < 4; ++i) { acc[i] += xv[i] * w0[i]; acc[4 + i] += xv[4 + i] * w1[i]; } }
#pragma unroll
    for (int i = 0; i < 8; ++i) out[i] = siluf_(acc[i]);
}
#define LOAD4(dst, p, pos) do { _Pragma("unroll") for (int j_ = 0; j_ < 4; ++j_) { const int back_ = 3 - j_; const bool ok_ = (pos) - back_ >= 0; \
        const v4u t_ = *(const v4u*)((p) - (size_t)(ok_ ? back_ : 0) * DM); dst[j_] = ok_ ? t_ : (v4u){0u, 0u, 0u, 0u}; } } while (0)

template <int K> __device__ __forceinline__ void mma16(f32x4& acc, const bf16* Ap, int lda, const bf16* Bp, int ldb, int fr, int fq) {
    bf16x8 af[K / 32], bfv[K / 32];
#pragma unroll
    for (int k = 0; k < K / 32; ++k) { af[k] = *(const bf16x8*)(Ap + fr * lda + k * 32 + fq * 8); bfv[k] = *(const bf16x8*)(Bp + fr * ldb + k * 32 + fq * 8); }
#pragma unroll
    for (int k = 0; k < K / 32; ++k) acc = __builtin_amdgcn_mfma_f32_16x16x32_bf16(af[k], bfv[k], acc, 0, 0, 0);
}
template <bool SA, bool SB> __device__ __forceinline__ void mma32s(f32x4& acc, const bf16* Ap, int rA0, int lda, const bf16* Bp, int rB0, int ldb, int fr, int fq) {
    const int ra = rA0 + fr, rb = rB0 + fr;
    const bf16x8 af = *(const bf16x8*)(Ap + ra * lda + ((SA ? (fq ^ ((ra >> 3) & 3)) : fq) << 3));
    const bf16x8 bfv = *(const bf16x8*)(Bp + rb * ldb + ((SB ? (fq ^ ((rb >> 3) & 3)) : fq) << 3));
    acc = __builtin_amdgcn_mfma_f32_16x16x32_bf16(af, bfv, acc, 0, 0, 0);
}
__device__ __forceinline__ void dn_item(unsigned char* lds, CArgsR a, int l, int item, unsigned long long& probe_acc) {
    constexpr int LDK = 136, LDJ = 40, LDL = 36;
    const int b = item >> 3, h = item & 7;
    bf16* kA = (bf16*)lds;
    bf16* qA = kA + 32 * LDK;
    bf16* qgA = qA + 32 * LDK;
    bf16* wA = qgA + 32 * LDK;
    bf16* kdT = wA + 32 * LDK;
    bf16* vnT = kdT + 128 * LDJ;
    bf16* attn = vnT + 128 * LDJ;
    bf16* ST = attn + 32 * LDJ;
    float* kf = (float*)(ST + 128 * LDK);
    float* vf = kf + 32 * 128;
    float* os = kf;
    float* Lm = vf + 32 * 128;
    float* gcs = Lm + 32 * LDL;
    float* betas = gcs + 32;
    float* cwL = betas + 32;
    const int tid = opaque_tid(), w = __builtin_amdgcn_readfirstlane(tid >> 6), lane = tid & 63, fr = lane & 15, fq = lane >> 4;
    bf16* base = (bf16*)a.ws;
    const bf16* Q = base + (size_t)B_DNQ * BUFE; const bf16* K = base + (size_t)B_DNK * BUFE; const bf16* V = base + (size_t)B_DNV * BUFE; bf16* G = base + (size_t)B_DNG * BUFE;
    const float* small = (const float*)(a.ws + WS_SMALL);
    const float* cw = a.in[3] + (size_t)l * 4 * 3072;
    const size_t rowbase = (size_t)b * SEQ;
    const int tq = tid >> 4, cq = tid & 15;
    const float* nwp = a.in[6] + l * 128 + cq * 8;
    f32x4 Sacc[8];
#pragma unroll
    for (int i = 0; i < 8; ++i) Sacc[i] = (f32x4){0.f, 0.f, 0.f, 0.f};
    for (int i = tid; i < 128 * LDK / 2; i += NTHREADS) ((unsigned*)ST)[i] = 0u;
    for (int i = tid; i < 4 * 384; i += NTHREADS) { const int j = i / 384, r = i % 384; cwL[i] = cw[j * 3072 + (r >> 7) * 1024 + h * 128 + (r & 127)]; }
    __syncthreads();
    const int ta = ((tid - 256) >> 4) & 15;
    v4u rqa[4], rka[4], rva[4], rqb[4], rkb[4], rvb[4]; float rg = 0.f, rbv = 0.f;
    v4u Pv[2];
    Pv[0] = Pv[1] = (v4u){0u, 0u, 0u, 0u};
#define DN_LOADS_RAW(c_, half_) do { const int pos_ = (c_) * 32 + ta + 16 * (half_); const size_t off_ = (rowbase + pos_) * DM + h * 128 + cq * 8; LOAD4(rqa, Q + off_, pos_); LOAD4(rka, K + off_, pos_); LOAD4(rva, V + off_, pos_); } while (0)
#define DN_LOADS_RAWB(c_) do { const int pos_ = (c_) * 32 + ta + 16; const size_t off_ = (rowbase + pos_) * DM + h * 128 + cq * 8; LOAD4(rqb, Q + off_, pos_); LOAD4(rkb, K + off_, pos_); LOAD4(rvb, V + off_, pos_); } while (0)
#define DN_LOADS_SMALL(c_) do { const int t0_ = (c_) * 32; \
        { const size_t r_ = rowbase + t0_ + (lane & 31); rg = small[r_ * 64 + h]; rbv = small[r_ * 64 + 8 + h]; } } while (0)
#define DN_CONV(rq_, rk_, rv_, slot_) do { const float* cw_ = cwL + cq * 8; asm volatile("" : "+v"(cw_)); \
        { float o8_[8]; conv8r(rq_, cw_, 384, nullptr, o8_); float ss_ = 0.f; _Pragma("unroll") for (int i_ = 0; i_ < 8; ++i_) ss_ += o8_[i_] * o8_[i_]; \
          ss_ = red16(ss_); const float rn_ = rsqrtf(ss_ + EPS) * 0.08838834764831845f; _Pragma("unroll") for (int i_ = 0; i_ < 8; ++i_) o8_[i_] *= rn_; *(v4u*)(qA + (ta + 16 * (slot_)) * LDK + cq * 8) = pack8(o8_); } \
        __builtin_amdgcn_sched_barrier(0); \
        { float o8_[8]; conv8r(rk_, cw_ + 128, 384, nullptr, o8_); float ss_ = 0.f; _Pragma("unroll") for (int i_ = 0; i_ < 8; ++i_) ss_ += o8_[i_] * o8_[i_]; \
          ss_ = red16(ss_); const float rn_ = rsqrtf(ss_ + EPS); _Pragma("unroll") for (int i_ = 0; i_ < 8; ++i_) o8_[i_] *= rn_; *(v4u*)(kA + (ta + 16 * (slot_)) * LDK + cq * 8) = pack8(o8_); } \
        __builtin_amdgcn_sched_barrier(0); \
        { float o8_[8]; conv8r(rv_, cw_ + 256, 384, nullptr, o8_); Pv[slot_] = pack8(o8_); } \
        __builtin_amdgcn_sched_barrier(0); } while (0)
    if (w >= 4) { DN_LOADS_RAW(0, 0); DN_CONV(rqa, rka, rva, 0); DN_LOADS_RAW(0, 1); DN_CONV(rqa, rka, rva, 1); }
    DN_LOADS_SMALL(0);
    for (int c = 0; c < SEQ / 32; ++c) {
        const int t0 = c * 32;
        unsigned long long tp_ = PROBE_SEL ? rt() : 0ull;
#define DPT(k) do { if (PROBE_SEL) { const unsigned long long tn_ = rt(); if ((PROBE_SEL & (1 << (k))) && item == 0) probe_acc += tn_ - tp_; tp_ = tn_; } } while (0)
        float gcv = rg;
#pragma unroll
        for (int off = 1; off < 32; off <<= 1) { const float t = __shfl_up(gcv, off, 32); if ((lane & 31) >= off) gcv += t; }
        const float gc_last = __shfl(gcv, 31);
        if (w >= 4) {
#pragma unroll
            for (int s2 = 0; s2 < 2; ++s2) { const int tt = ta + 16 * s2;
                const float gc_t = __shfl(gcv, tt), beta_t = __shfl(rbv, tt);
                float q8[8], k8[8], v8[8], t8[8];
                unpack8(*(const v4u*)(qA + tt * LDK + cq * 8), q8); unpack8(*(const v4u*)(kA + tt * LDK + cq * 8), k8); unpack8(Pv[s2], v8);
                const float eg = __expf(gc_t), kb = beta_t * eg, kd = __expf(gc_last - gc_t);
#pragma unroll
                for (int i = 0; i < 8; ++i) t8[i] = q8[i] * eg;
                *(v4u*)(qgA + tt * LDK + cq * 8) = pack8(t8);
                *(f32x4*)(kf + tt * 128 + cq * 8) = (f32x4){k8[0] * kb, k8[1] * kb, k8[2] * kb, k8[3] * kb}; *(f32x4*)(kf + tt * 128 + cq * 8 + 4) = (f32x4){k8[4] * kb, k8[5] * kb, k8[6] * kb, k8[7] * kb};
                *(f32x4*)(vf + tt * 128 + cq * 8) = (f32x4){v8[0] * beta_t, v8[1] * beta_t, v8[2] * beta_t, v8[3] * beta_t}; *(f32x4*)(vf + tt * 128 + cq * 8 + 4) = (f32x4){v8[4] * beta_t, v8[5] * beta_t, v8[6] * beta_t, v8[7] * beta_t};
#pragma unroll
                for (int i = 0; i < 8; ++i) kdT[(cq * 8 + i) * LDJ + (tt ^ ((cq & 3) << 3))] = (bf16)f2bf(k8[i] * kd);
            }
        }
        if (tid < 32) { gcs[tid] = gcv; betas[tid] = rbv; }
        __syncthreads();
        DPT(12);
        if (w >= 4 && c + 1 < SEQ / 32) DN_LOADS_RAW(c + 1, 0);
        {   const int ww = w & 3, gi = ww >> 1, gj = ww & 1; f32x4 acc = {0.f, 0.f, 0.f, 0.f};
            const int jI = 16 * gj + fr, i0 = 16 * gi + 4 * fq;
            const float gj_ = gcs[jI]; const f32x4 gi4 = *(const f32x4*)(gcs + i0), bi4 = *(const f32x4*)(betas + i0);
            mma16<128>(acc, (w < 4 ? kA : qA) + gi * 16 * LDK, LDK, kA + gj * 16 * LDK, LDK, fr, fq);
            if (w < 4) {
#pragma unroll
                for (int jj = 0; jj < 4; ++jj) Lm[(i0 + jj) * LDL + jI] = jI < i0 + jj ? bi4[jj] * acc[jj] * __expf(gi4[jj] - gj_) : 0.f;
            } else {
#pragma unroll
                for (int jj = 0; jj < 4; ++jj) attn[(i0 + jj) * LDJ + jI] = (bf16)f2bf(jI <= i0 + jj ? acc[jj] * __expf(gi4[jj] - gj_) : 0.f);
            } }
        __syncthreads();
        DPT(13);
        if (w < 4) { const int cc = tid & 127; const bool is_w = w >= 2; const float* R = is_w ? kf : vf;
            float x[32];
#pragma unroll
            for (int i = 0; i < 32; ++i) x[i] = R[i * 128 + cc];
            f32x4 Lb[2][8];
            Lb[1][0] = *(const f32x4*)(Lm + 1 * LDL);
#pragma unroll
            for (int i = 1; i < 32; ++i) {
                if (i + 1 < 32) {
#pragma unroll
                    for (int j4 = 0; j4 < (i + 4) / 4; ++j4) Lb[(i + 1) & 1][j4] = *(const f32x4*)(Lm + (i + 1) * LDL + j4 * 4); }
                float a0 = x[i], a1 = 0.f, a2 = 0.f, a3 = 0.f;
#pragma unroll
                for (int j4 = 0; j4 < (i + 3) / 4; ++j4) { const f32x4 l4 = Lb[i & 1][j4];
                    if (j4 * 4 + 0 < i) a0 -= l4[0] * x[j4 * 4 + 0];
                    if (j4 * 4 + 1 < i) a1 -= l4[1] * x[j4 * 4 + 1];
                    if (j4 * 4 + 2 < i) a2 -= l4[2] * x[j4 * 4 + 2];
                    if (j4 * 4 + 3 < i) a3 -= l4[3] * x[j4 * 4 + 3]; }
                x[i] = (a0 + a1) + (a2 + a3); }
            if (is_w) {
#pragma unroll
                for (int i = 0; i < 32; ++i) wA[i * LDK + cc] = (bf16)f2bf(x[i]);
            } else {
#pragma unroll
                for (int i = 0; i < 32; ++i) vf[i * 128 + cc] = x[i];
            } }
        else if (c + 1 < SEQ / 32) { DN_LOADS_RAWB(c + 1); __builtin_amdgcn_sched_barrier(0); DN_CONV(rqa, rka, rva, 0); DN_CONV(rqb, rkb, rvb, 1); }
        __syncthreads();
        DPT(14);
        if (c + 1 < SEQ / 32) DN_LOADS_SMALL(c + 1);
        const v4u gcur = *(const v4u*)(G + (rowbase + t0 + tq) * DM + h * 128 + cq * 8);
#pragma unroll
        for (int it = 0; it < 2; ++it) { f32x4 acc = {0.f, 0.f, 0.f, 0.f};
            mma16<128>(acc, wA + it * 16 * LDK, LDK, ST + w * 16 * LDK, LDK, fr, fq);
            float vn[4];
#pragma unroll
            for (int jj = 0; jj < 4; ++jj) vn[jj] = vf[(16 * it + 4 * fq + jj) * 128 + 16 * w + fr] - acc[jj];
            v2u pk; pk.x = pk2(vn[0], vn[1]); pk.y = pk2(vn[2], vn[3]);
            *(v2u*)(vnT + (16 * w + fr) * LDJ + 16 * it + 4 * fq) = pk; }
        __syncthreads();
#pragma unroll
        for (int it = 0; it < 2; ++it) { f32x4 acc = {0.f, 0.f, 0.f, 0.f};
            mma16<128>(acc, qgA + it * 16 * LDK, LDK, ST + w * 16 * LDK, LDK, fr, fq);
            mma16<32>(acc, attn + it * 16 * LDJ, LDJ, vnT + w * 16 * LDJ, LDJ, fr, fq);
#pragma unroll
            for (int jj = 0; jj < 4; ++jj) os[(16 * it + 4 * fq + jj) * 128 + 16 * w + fr] = acc[jj]; }
        {   const float dl = __expf(gc_last);
#pragma unroll
            for (int dt = 0; dt < 8; ++dt) Sacc[dt] = Sacc[dt] * dl;
            const bf16x8 vb_ = *(const bf16x8*)(vnT + (w * 16 + fr) * LDJ + fq * 8);
            const bf16* ka_e = kdT + fr * LDJ + ((fq ^ (fr >> 3)) << 3); const bf16* ka_o = kdT + fr * LDJ + (((fq ^ (fr >> 3)) << 3) ^ 16);
#pragma unroll
            for (int dt = 0; dt < 8; ++dt) { const bf16x8 af_ = *(const bf16x8*)(((dt & 1) ? ka_o : ka_e) + dt * 16 * LDJ);
                Sacc[dt] = __builtin_amdgcn_mfma_f32_16x16x32_bf16(af_, vb_, Sacc[dt], 0, 0, 0); } }
        __syncthreads();
#pragma unroll
        for (int dt = 0; dt < 8; ++dt) { v2u pk; pk.x = pk2(Sacc[dt][0], Sacc[dt][1]); pk.y = pk2(Sacc[dt][2], Sacc[dt][3]);
            *(v2u*)(ST + (16 * w + fr) * LDK + 16 * dt + 4 * fq) = pk; }
        {   const f32x4 o0 = *(const f32x4*)(os + tq * 128 + cq * 8), o1 = *(const f32x4*)(os + tq * 128 + cq * 8 + 4);
            float ss = (o0[0] * o0[0] + o0[1] * o0[1]) + (o0[2] * o0[2] + o0[3] * o0[3]) + (o1[0] * o1[0] + o1[1] * o1[1]) + (o1[2] * o1[2] + o1[3] * o1[3]);
            ss = red16(ss);
            const float r = rsqrtf(ss * (1.f / 128.f) + EPS);
            float g8[8], o8[8], nw8[8]; unpack8(gcur, g8);
            { const f32x4 n0 = *(const f32x4*)nwp, n1 = *(const f32x4*)(nwp + 4); nw8[0] = n0[0]; nw8[1] = n0[1]; nw8[2] = n0[2]; nw8[3] = n0[3]; nw8[4] = n1[0]; nw8[5] = n1[1]; nw8[6] = n1[2]; nw8[7] = n1[3]; }
#pragma unroll
            for (int i = 0; i < 4; ++i) { o8[i] = o0[i] * r * nw8[i] * siluf_(g8[i]); o8[4 + i] = o1[i] * r * nw8[4 + i] * siluf_(g8[4 + i]); }
            *(v4u*)(G + (rowbase + t0 + tq) * DM + h * 128 + cq * 8) = pack8(o8); }
        __syncthreads();
        DPT(15);
    }
#undef DPT
#undef DN_LOADS_RAW
#undef DN_LOADS_RAWB
#undef DN_LOADS_SMALL
#undef DN_CONV
    __syncthreads();
}

__device__ __forceinline__ void ssm_item(unsigned char* lds, CArgsR a, int l, int item) {
    constexpr int LDC = 136, LDX = 40;
    const int b = item >> 4, hd = item & 15, g = hd >> 2;
    bf16* Cs = (bf16*)lds;
    bf16* Bs = Cs + 32 * LDC;
    bf16* BT = Bs + 32 * LDC;
    bf16* xdtT = BT + 128 * LDX;
    bf16* xddT = xdtT + 64 * LDX;
    bf16* Wm = xddT + 64 * LDX;
    bf16* hB = Wm + 32 * LDX;
    float* xs = (float*)(hB + 64 * LDC);
    float* acs = xs + 32 * 64;
    const int tid = opaque_tid(), w = __builtin_amdgcn_readfirstlane(tid >> 6), lane = tid & 63, fr = lane & 15, fq = lane >> 4;
    bf16* base = (bf16*)a.ws;
    const bf16* X = base + (size_t)B_SSX * BUFE; const bf16* BC = base + (size_t)B_SSBC * BUFE; bf16* Z = base + (size_t)B_SSZ * BUFE;
    const float* small = (const float*)(a.ws + WS_SMALL);
    const float* cw = a.in[7] + (size_t)l * 4 * 2048; const float* cb = a.in[8] + (size_t)l * 2048;
    const float dskip = a.in[11][l * 16 + hd];
    const size_t rowbase = (size_t)b * SEQ;
    const int tq = tid >> 4, cq = tid & 15, tv = (tid >> 3) & 31, cv = tid & 7;
    const int it = w >> 2, pt = w & 3;
    f32x4 hacc[4];
#pragma unroll
    for (int i = 0; i < 4; ++i) hacc[i] = (f32x4){0.f, 0.f, 0.f, 0.f};
    for (int i = tid; i < 64 * LDC / 2; i += NTHREADS) ((unsigned*)hB)[i] = 0u;
    v4u rB[4], rC[4], rx[4]; float ra = 0.f, rdtv = 0.f; unsigned rz[4];
#define SSM_LOADS(c_) do { const int t0_ = (c_) * 32; { const int pos_ = t0_ + tq; const size_t ro_ = (rowbase + pos_) * DM; LOAD4(rB, BC + ro_ + g * 128 + cq * 8, pos_); LOAD4(rC, BC + ro_ + 512 + g * 128 + cq * 8, pos_); } \
        if (tid >= 256) { const int pos_ = t0_ + tv; LOAD4(rx, X + (rowbase + pos_) * DM + hd * 64 + cv * 8, pos_); } \
        { const size_t r_ = rowbase + t0_ + (lane & 31); rdtv = small[r_ * 64 + 16 + hd]; ra = small[r_ * 64 + 32 + hd]; } \
        _Pragma("unroll") for (int jj_ = 0; jj_ < 4; ++jj_) rz[jj_] = Z[(rowbase + t0_ + 16 * it + 4 * fq + jj_) * DM + hd * 64 + 16 * pt + fr]; } while (0)
    SSM_LOADS(0);
    for (int c = 0; c < SEQ / 32; ++c) {
        const int t0 = c * 32;
        float acum = ra;
#pragma unroll
        for (int off = 1; off < 32; off <<= 1) { const float t = __shfl_up(acum, off, 32); if ((lane & 31) >= off) acum += t; }
        const float ac_last = __shfl(acum, 31);
        {   float o8[8];
            conv8r(rB, cw + 1024 + g * 128 + cq * 8, 2048, cb + 1024 + g * 128 + cq * 8, o8);
            *(v4u*)(Bs + tq * LDC + cq * 8) = pack8(o8);
#pragma unroll
            for (int i = 0; i < 8; ++i) BT[(cq * 8 + i) * LDX + (tq ^ ((cq & 3) << 3))] = (bf16)f2bf(o8[i]);
            conv8r(rC, cw + 1536 + g * 128 + cq * 8, 2048, cb + 1536 + g * 128 + cq * 8, o8);
            *(v4u*)(Cs + tq * LDC + cq * 8) = pack8(o8);
        }
        if (tid < 32) acs[tid] = acum;
        unsigned zr[4];
#pragma unroll
        for (int jj = 0; jj < 4; ++jj) zr[jj] = rz[jj];
        __syncthreads();
        if (w >= 4) { float o8[8]; conv8r(rx, cw + hd * 64 + cv * 8, 2048, cb + hd * 64 + cv * 8, o8);
            const float dtv = __shfl(rdtv, tv), dd = dtv * __expf(ac_last - __shfl(acum, tv));
            *(f32x4*)(xs + tv * 64 + cv * 8) = (f32x4){o8[0], o8[1], o8[2], o8[3]}; *(f32x4*)(xs + tv * 64 + cv * 8 + 4) = (f32x4){o8[4], o8[5], o8[6], o8[7]};
#pragma unroll
            for (int i = 0; i < 8; ++i) { xdtT[(cv * 8 + i) * LDX + (tv ^ ((cv & 3) << 3))] = (bf16)f2bf(o8[i] * dtv); xddT[(cv * 8 + i) * LDX + (tv ^ ((cv & 3) << 3))] = (bf16)f2bf(o8[i] * dd); }
        }
        else { const int gi = w >> 1, gj = w & 1; f32x4 acc = {0.f, 0.f, 0.f, 0.f};
            mma16<128>(acc, Cs + gi * 16 * LDC, LDC, Bs + gj * 16 * LDC, LDC, fr, fq);
            const int sI = 16 * gj + fr; const float as = acs[sI];
#pragma unroll
            for (int jj = 0; jj < 4; ++jj) { const int lI = 16 * gi + 4 * fq + jj; const float v = sI <= lI ? acc[jj] * __expf(acs[lI] - as) : 0.f; Wm[lI * LDX + sI] = (bf16)f2bf(v); } }
        if (c + 1 < SEQ / 32) SSM_LOADS(c + 1);
        __syncthreads();
        {   f32x4 a1 = {0.f, 0.f, 0.f, 0.f}, a2 = {0.f, 0.f, 0.f, 0.f};
            mma32s<false, true>(a1, Wm, it * 16, LDX, xdtT, pt * 16, LDX, fr, fq);
            mma16<128>(a2, Cs + it * 16 * LDC, LDC, hB + pt * 16 * LDC, LDC, fr, fq);
            const int p = 16 * pt + fr;
#pragma unroll
            for (int jj = 0; jj < 4; ++jj) { const int lI = 16 * it + 4 * fq + jj;
                const float y = a1[jj] + __expf(acs[lI]) * a2[jj] + xs[lI * 64 + p] * dskip;
                Z[(rowbase + t0 + lI) * DM + hd * 64 + p] = (bf16)f2bf(y * siluf_(bf2f(zr[jj]))); }
            const float dl = __expf(ac_last);
#pragma unroll
            for (int p2 = 0; p2 < 4; ++p2) { hacc[p2] = hacc[p2] * dl; mma32s<true, true>(hacc[p2], xddT, p2 * 16, LDX, BT, w * 16, LDX, fr, fq); }
        }
        __syncthreads();
#pragma unroll
        for (int p2 = 0; p2 < 4; ++p2)
#pragma unroll
            for (int jj = 0; jj < 4; ++jj) hB[(16 * p2 + 4 * fq + jj) * LDC + 16 * w + fr] = (bf16)f2bf(hacc[p2][jj]);
    }
#undef SSM_LOADS
    __syncthreads();
}

__device__ __forceinline__ void sb_item(unsigned char* lds, CArgsR a, int b, int hd, int qi) {
    constexpr int LD = 72;
    bf16* Ks = (bf16*)lds; bf16* Vs = Ks + 2 * 64 * LD;
    volatile unsigned* alive = (volatile unsigned*)(Vs + 2 * 64 * LD);
    const int tid = opaque_tid(), w = __builtin_amdgcn_readfirstlane(tid >> 6), lane = tid & 63, fr = lane & 15, fq = lane >> 4;
    bf16* base = (bf16*)a.ws;
    bf16* Qb = base + (size_t)B_SBQ * BUFE; const bf16* Kb = base + (size_t)B_SBK * BUFE; const bf16* Vb = base + (size_t)B_SBV * BUFE;
    const size_t rowbase = (size_t)b * SEQ;
    const int t0 = qi * 128, myq = t0 + w * 16 + fr, wmax = t0 + w * 16 + 15;
    bf16* qrow = Qb + (rowbase + myq) * DM + hd * 64;
    bf16x8 qf[2];
    qf[0] = *(const bf16x8*)(qrow + fq * 8); qf[1] = *(const bf16x8*)(qrow + 32 + fq * 8);
    f32x4 oacc[4];
#pragma unroll
    for (int i = 0; i < 4; ++i) oacc[i] = (f32x4){0.f, 0.f, 0.f, 0.f};
    float carry = 1.f;
    const int kr = tid >> 3, d8 = (tid & 7) * 8;
    v4u kreg, vreg;
    int kt = 2 * (qi + 1) - 1;
#define SB_LOAD(t) do { const size_t o_ = (rowbase + (size_t)(t) * 64 + kr) * DM + hd * 64 + d8; kreg = *(const v4u*)(Kb + o_); vreg = *(const v4u*)(Vb + o_); } while (0)
#define SB_STORE(bu) do { *(v4u*)(Ks + (bu) * 64 * LD + kr * LD + d8) = kreg; bf16* vd_ = Vs + (bu) * 64 * LD + d8 * LD + (kr ^ (((d8 >> 3) & 7) << 3)); \
        vd_[0] = (bf16)(vreg.x & 0xffffu); vd_[LD] = (bf16)(vreg.x >> 16); vd_[2 * LD] = (bf16)(vreg.y & 0xffffu); vd_[3 * LD] = (bf16)(vreg.y >> 16); \
        vd_[4 * LD] = (bf16)(vreg.z & 0xffffu); vd_[5 * LD] = (bf16)(vreg.z >> 16); vd_[6 * LD] = (bf16)(vreg.w & 0xffffu); vd_[7 * LD] = (bf16)(vreg.w >> 16); } while (0)
    SB_LOAD(kt); SB_STORE(0);
    __syncthreads();
    int cur = 0;
    for (; kt >= 0; --kt) {
        if (kt > 0) SB_LOAD(kt - 1);
        const int kbase = kt * 64;
        if (kbase <= wmax) {
            const bf16* Kc = Ks + cur * 64 * LD; const bf16* Vc = Vs + cur * 64 * LD;
            f32x4 z[4];
#pragma unroll
            for (int nt = 0; nt < 4; ++nt) { z[nt] = (f32x4){0.f, 0.f, 0.f, 0.f};
#pragma unroll
                for (int k2 = 0; k2 < 2; ++k2) { const bf16x8 af = *(const bf16x8*)(Kc + (nt * 16 + fr) * LD + k2 * 32 + fq * 8);
                    z[nt] = __builtin_amdgcn_mfma_f32_16x16x32_bf16(af, qf[k2], z[nt], 0, 0, 0); } }
            float kp[4][4], sg[4][4], T[4], tot[4], suf[4];
            const bool masked = kbase + 64 > t0 + w * 16;
#pragma unroll
            for (int nt = 0; nt < 4; ++nt) {
#pragma unroll
                for (int j = 0; j < 4; ++j) { const float z2 = z[nt][j] * 0.18033688011112042f;
                    const float ea = __builtin_amdgcn_exp2f(-fabsf(z2)), rc = __builtin_amdgcn_rcpf(1.f + ea); const bool pos = z2 >= 0.f;
                    sg[nt][j] = (pos ? 1.f : ea) * rc; kp[nt][j] = (pos ? ea : 1.f) * rc; }
                if (masked) {
#pragma unroll
                    for (int j = 0; j < 4; ++j) { const bool valid = kbase + nt * 16 + fq * 4 + j < myq; sg[nt][j] = valid ? sg[nt][j] : 0.f; kp[nt][j] = valid ? kp[nt][j] : 1.f; } }
                T[nt] = (kp[nt][0] * kp[nt][1]) * (kp[nt][2] * kp[nt][3]); }
#pragma unroll
            for (int nt = 0; nt < 4; ++nt) { const float p16 = __shfl_xor(T[nt], 16), s1 = T[nt] * p16, p32 = __shfl_xor(s1, 32); tot[nt] = s1 * p32;
                suf[nt] = fq == 0 ? p16 * p32 : fq == 1 ? p32 : fq == 2 ? p16 : 1.f; }
            float run = carry; float wv[4][4];
#pragma unroll
            for (int nt = 3; nt >= 0; --nt) { const float r3 = run * suf[nt], r2 = r3 * kp[nt][3], r1 = r2 * kp[nt][2], r0 = r1 * kp[nt][1];
                wv[nt][0] = sg[nt][0] * r0; wv[nt][1] = sg[nt][1] * r1; wv[nt][2] = sg[nt][2] * r2; wv[nt][3] = sg[nt][3] * r3;
                run *= tot[nt]; }
            carry = run;
#pragma unroll
            for (int kk = 0; kk < 2; ++kk) {
                v4u bw; bw.x = pk2(wv[2 * kk][0], wv[2 * kk][1]); bw.y = pk2(wv[2 * kk][2], wv[2 * kk][3]); bw.z = pk2(wv[2 * kk + 1][0], wv[2 * kk + 1][1]); bw.w = pk2(wv[2 * kk + 1][2], wv[2 * kk + 1][3]);
                const bf16x8 bfr = __builtin_bit_cast(bf16x8, bw);
#pragma unroll
                for (int mt = 0; mt < 4; ++mt) { const int vr = mt * 16 + fr, vs = ((vr >> 3) & 7) << 3; const bf16* vrow = Vc + vr * LD;
                    const v2u lo = *(const v2u*)(vrow + ((32 * kk + 4 * fq) ^ vs)), hi = *(const v2u*)(vrow + ((32 * kk + 16 + 4 * fq) ^ vs));
                    v4u av; av.x = lo.x; av.y = lo.y; av.z = hi.x; av.w = hi.y;
                    oacc[mt] = __builtin_amdgcn_mfma_f32_16x16x32_bf16(__builtin_bit_cast(bf16x8, av), bfr, oacc[mt], 0, 0, 0); }
            }
        }
        {   const bool any_alive = __ballot(carry != 0.f) != 0ull;
            if (lane == 0) alive[cur * 8 + w] = any_alive ? 1u : 0u; }
        if (kt > 0) SB_STORE(cur ^ 1);
        __syncthreads();
        unsigned al = 0u;
#pragma unroll
        for (int i = 0; i < 8; ++i) al |= alive[cur * 8 + i];
        if (al == 0u) break;
        cur ^= 1;
    }
#undef SB_LOAD
#undef SB_STORE
#pragma unroll
    for (int mt = 0; mt < 4; ++mt) { v2u wq; wq.x = pk2(oacc[mt][0], oacc[mt][1]); wq.y = pk2(oacc[mt][2], oacc[mt][3]); *(v2u*)(qrow + mt * 16 + fq * 4) = wq; }
}

__device__ __forceinline__ void phase_mixers(unsigned char* lds, CArgsR a, int l, unsigned long long& probe_acc) {
    unsigned* ctl = (unsigned*)(a.ws + WS_CTL);
    unsigned* counter = ctl + 64 * l; unsigned* gdone = ctl + 64 * l + 32;
    volatile unsigned* slot = (volatile unsigned*)(lds + LDS_BYTES - 64);
    constexpr int NDN = 64;
    const int nb = (int)gridDim.x - NDN;
    if ((int)blockIdx.x < NDN) { PT0(); dn_item(lds, a, l, (int)blockIdx.x, probe_acc); if (blockIdx.x == 0 && l == 0) PT1(9); }
    else {
        bf16* base = (bf16*)a.ws; bf16* Wreg = (bf16*)(a.ws + WS_W);
        pg8::Gemm g{base, Wreg + W_IN + (size_t)4096 * DM, MT, 6144, DM}; pg8::StaticOrder S; S.init(MT, 6144, nb, (int)blockIdx.x - NDN);
        EpiRoute E{base, 16};
        pg8::gemm_phase<EpiRoute, pg8::StaticOrder, true, true>((PG8_LAS unsigned char*)lds, g, S, E);
        __builtin_amdgcn_fence(__ATOMIC_RELEASE, "agent");
        asm volatile("s_waitcnt vmcnt(0)" ::: "memory");
        __syncthreads();
        if (threadIdx.x == 0) __hip_atomic_fetch_add(gdone, 1u, __ATOMIC_RELAXED, __HIP_MEMORY_SCOPE_AGENT);
    }
    if (threadIdx.x == 0) {
        unsigned sp = 0u;
        while (__hip_atomic_load(gdone, __ATOMIC_RELAXED, __HIP_MEMORY_SCOPE_AGENT) < (unsigned)nb && ++sp < (1u << 22)) __builtin_amdgcn_s_sleep(2);
        __builtin_amdgcn_fence(__ATOMIC_ACQUIRE, "agent");
        asm volatile("s_waitcnt vmcnt(0)" ::: "memory");
    }
    __syncthreads();
    constexpr unsigned NITEMS = 128 + 2048;
    for (;;) {
        if (threadIdx.x == 0) *slot = __hip_atomic_fetch_add(counter, 1u, __ATOMIC_RELAXED, __HIP_MEMORY_SCOPE_AGENT);
        __syncthreads();
        const unsigned item = *slot;
        __syncthreads();
        if (item >= NITEMS) break;
        PT0();
        if (item < 128) { ssm_item(lds, a, l, (int)item); if (item == 0 && l == 0) PT1(10); }
        else { const int r = (int)item - 128, qi = 15 - (r >> 7), bh = r & 127; sb_item(lds, a, bh >> 4, bh & 15, qi); if (item == 128 && l == 0) PT1(11); }
    }
}

__device__ __forceinline__ void phase_norms(CArgsR a, int l) {
    const int tid = opaque_tid(), lane = tid & 63, wave = tid >> 6, gw = blockIdx.x * NWAVES + wave, NGW = gridDim.x * NWAVES;
    bf16* base = (bf16*)a.ws;
    const bf16* Oraw = base + (size_t)B_DNV * BUFE; bf16* G = base + (size_t)B_DNG * BUFE; bf16* Y = base + (size_t)B_SSZ * BUFE;
    const float* dnw = a.in[6] + (size_t)l * 128 + (lane & 7) * 16; const float* snw = a.in[12] + (size_t)l * DM + lane * 16;
    float w1[16], w2[16];
#pragma unroll
    for (int i = 0; i < 16; ++i) { w1[i] = dnw[i]; w2[i] = snw[i]; }
    for (int m = gw; m < MT; m += NGW) {
        const size_t o = (size_t)m * DM + lane * 16;
        float v[16], s, r;
        unpack8(*(const v4u*)(Y + o), v); unpack8(*(const v4u*)(Y + o + 8), v + 8);
        s = 0.f;
#pragma unroll
        for (int i = 0; i < 16; ++i) s += v[i] * v[i];
        s = red16(s);
        r = rsqrtf(s * (1.f / 256.f) + EPS);
#pragma unroll
        for (int i = 0; i < 16; ++i) v[i] = v[i] * r * w2[i];
        *(v4u*)(Y + o) = pack8(v); *(v4u*)(Y + o + 8) = pack8(v + 8);
    }
}

#define LAS __attribute__((address_space(3)))
#define XB_TMO      128
#define XB_XCNT(j)  (256  + 64 * (j))
#define XB_XSUB(j)  (1280 + 64 * (j))
#define XB_XGEN(j)  (2304 + 64 * (j))
#define XB_TOP      3328
#define XB_TOPGEN   3392
#define XCD_BAR_WORDS 3456
#define XB_SPIN_CAP (1u << 18)

__device__ __forceinline__ unsigned xb_ld(unsigned* p)              { return __hip_atomic_load(p, __ATOMIC_RELAXED, __HIP_MEMORY_SCOPE_AGENT); }
__device__ __forceinline__ unsigned xb_add(unsigned* p, unsigned v) { return __hip_atomic_fetch_add(p, v, __ATOMIC_RELAXED, __HIP_MEMORY_SCOPE_AGENT); }
__device__ __forceinline__ unsigned xb_xcc_id() { return (unsigned)__builtin_amdgcn_s_getreg((3 << 11) | 20) & 0xFu; }
#define XB_SPIN(cond, bar) do { unsigned _sp = 0; while (cond) { __builtin_amdgcn_s_sleep(1); \
    if ((++_sp & 255u) == 0u) { if (xb_ld(&(bar)[XB_TMO])) break; if (_sp > XB_SPIN_CAP) { atomicAdd(&(bar)[XB_TMO], 1u); break; } } } } while (0)

struct XcdBarrier {
    unsigned* bar; unsigned x;
    volatile LAS unsigned* st;
};

__device__ __forceinline__ XcdBarrier xcd_barrier_post(unsigned* bar, volatile LAS unsigned* st) {
    XcdBarrier b; b.bar = bar; b.x = xb_xcc_id(); b.st = st;
    if (threadIdx.x == 0) (void)xb_add(&bar[XB_XCNT(b.x)], 1u);
    return b;
}
__device__ __forceinline__ void xcd_barrier_complete(unsigned* bar, unsigned x, unsigned& nloc, unsigned& nx) {
    const unsigned G = gridDim.x * gridDim.y * gridDim.z;
    unsigned sum, cnt, mine, sp = 0u;
    for (;;) {
        sum = 0u; cnt = 0u; mine = 0u;
#pragma unroll
        for (unsigned j = 0; j < 16; ++j) { const unsigned c = xb_ld(&bar[XB_XCNT(j)]); sum += c; cnt += (c > 0u) ? 1u : 0u; mine = (j == x) ? c : mine; }
        if (sum == G) break;
        __builtin_amdgcn_s_sleep(1);
        if ((++sp & 255u) == 0u) { if (xb_ld(&bar[XB_TMO])) break; if (sp > XB_SPIN_CAP) { atomicAdd(&bar[XB_TMO], 1u); break; } }
    }
    nloc = mine > 0u ? mine : 1u; nx = cnt > 0u ? cnt : 1u;
}

__device__ __forceinline__ void xcd_barrier(const XcdBarrier& b) {
    asm volatile("s_waitcnt vmcnt(0)" ::: "memory");
    __syncthreads();
    if (threadIdx.x == 0) {
        unsigned* bar = b.bar;
        __builtin_amdgcn_s_waitcnt(0);
        unsigned nloc = b.st[0], nx = b.st[1];
        if (nloc == 0u) { xcd_barrier_complete(bar, b.x, nloc, nx); b.st[0] = nloc; b.st[1] = nx; }
        const unsigned old = xb_add(&bar[XB_XSUB(b.x)], 1u);
        const unsigned gen = old / nloc;
        if (old + 1u == (gen + 1u) * nloc) {
            __builtin_amdgcn_fence(__ATOMIC_RELEASE, "agent");
            asm volatile("s_waitcnt vmcnt(0)" ::: "memory");
            const unsigned og = xb_add(&bar[XB_TOP], 1u);
            const unsigned tg = og / nx;
            if (og + 1u == (tg + 1u) * nx) xb_add(&bar[XB_TOPGEN], 1u);
            else XB_SPIN(xb_ld(&bar[XB_TOPGEN]) == tg, bar);
            __builtin_amdgcn_fence(__ATOMIC_ACQUIRE, "agent");
            xb_add(&bar[XB_XGEN(b.x)], 1u);
            asm volatile("s_waitcnt vmcnt(0)" ::: "memory");
        } else {
            XB_SPIN(xb_ld(&bar[XB_XGEN(b.x)]) == gen, bar);
            __builtin_amdgcn_fence(__ATOMIC_ACQUIRE, "agent");
            asm volatile("s_waitcnt vmcnt(0)" ::: "memory");
        }
    }
    __syncthreads();
}

__global__ void __launch_bounds__(NTHREADS, 2) hybrid_fwd(Args a_unused) {
    extern __shared__ __attribute__((aligned(16))) unsigned char lds[];
    cg::grid_group grid = cg::this_grid();
    PG8_LAS unsigned char* ldsl = (PG8_LAS unsigned char*)lds;
    unsigned long long probe_acc = 0ull;
#define A_ (*kargs())
    volatile LAS unsigned* bst = (volatile LAS unsigned*)((LAS unsigned char*)lds + LDS_BYTES - 32);
    if (threadIdx.x == 0) { bst[0] = 0u; bst[1] = 0u; }
    __syncthreads();
    const XcdBarrier bar = xcd_barrier_post((unsigned*)(a_unused.ws + WS_BAR), bst);
#pragma unroll 1
    for (int l = 0; l < 2; ++l) {
        asm volatile("" : "+s"(l));
        {   CArgsR a = A_; const float* xin = l == 0 ? a.in[0] : a.out;
            PT0(); phase0(lds, a, l, xin);
        if (l == 0) grid.sync(); else xcd_barrier(bar); PT1(0); }
        {   CArgsR a = A_; bf16* base = (bf16*)a.ws; bf16* Wreg = (bf16*)(a.ws + WS_W);
            pg8::Gemm g{base, Wreg + W_IN, MT, 4096, DM}; pg8::StaticOrder S; S.init(MT, 4096, (int)gridDim.x, (int)blockIdx.x);
            EpiRoute E{base, 0};
            PT0(); pg8::gemm_phase<EpiRoute, pg8::StaticOrder, true, true>(ldsl, g, S, E);
        xcd_barrier(bar); PT1(1); }
        { PT0(); phase_mixers(lds, A_, l, probe_acc);
        xcd_barrier(bar); PT1(2); }
        { PT0(); phase_norms(A_, l);
        xcd_barrier(bar); PT1(3); }
        {   CArgsR a = A_; bf16* base = (bf16*)a.ws; bf16* Wreg = (bf16*)(a.ws + WS_W);
            pg8::Gemm g{base, Wreg + W_G, 4 * MT, 6144, DM}; SchedGate S{(int)gridDim.x, (int)blockIdx.x};
            EpiGate E{base + (size_t)B_SBK * BUFE, (float*)(base + (size_t)B_DNK * BUFE), base + (size_t)B_DNQ * BUFE};
            PT0(); pg8::gemm_phase<EpiGate, SchedGate, true, true>(ldsl, g, S, E);
        xcd_barrier(bar); PT1(4); }
        {   CArgsR a = A_; bf16* base = (bf16*)a.ws; bf16* Wreg = (bf16*)(a.ws + WS_W); const float* xin = l == 0 ? a.in[0] : a.out;
            pg8::Gemm g{base + (size_t)B_DNQ * BUFE, Wreg + W_OUT, MT, DM, DM}; pg8::StaticOrder S; S.init(MT, DM, (int)gridDim.x, (int)blockIdx.x);
            EpiResid E{xin, a.out};
            PT0(); pg8::gemm_phase<EpiResid, pg8::StaticOrder, false, true>(ldsl, g, S, E);
        xcd_barrier(bar); PT1(5); }
        {   CArgsR a = A_; bf16* base = (bf16*)a.ws; const float* nw = a.in[15] + (size_t)l * DM; const float* xo = a.out;
            const int tid = opaque_tid(), lane = tid & 63, gw = blockIdx.x * NWAVES + (tid >> 6), NGW = gridDim.x * NWAVES;
            PT0(); for (int m = gw; m < MT; m += NGW) rms_row_to_bf16(xo + (size_t)m * DM, nw, base + (size_t)m * DM, lane);
        xcd_barrier(bar); PT1(6); }
        {   CArgsR a = A_; bf16* base = (bf16*)a.ws; bf16* Wreg = (bf16*)(a.ws + WS_W);
            pg8::Gemm g{base, Wreg + W_UP, MT, DFF, DM}; pg8::StaticOrder S; S.init(MT, DFF, (int)gridDim.x, (int)blockIdx.x);
            EpiRelu2 E{base + (size_t)B_DNQ * BUFE};
            PT0(); pg8::gemm_phase<EpiRelu2, pg8::StaticOrder, true, true>(ldsl, g, S, E);
        xcd_barrier(bar); PT1(7); }
        {   CArgsR a = A_; bf16* base = (bf16*)a.ws; bf16* Wreg = (bf16*)(a.ws + WS_W);
            pg8::Gemm g{base + (size_t)B_DNQ * BUFE, Wreg + W_DOWN, MT, DM, DFF}; pg8::StaticOrder S; S.init(MT, DM, (int)gridDim.x, (int)blockIdx.x);
            EpiResid E{a.out, a.out};
            PT0(); pg8::gemm_phase<EpiResid, pg8::StaticOrder, false, true>(ldsl, g, S, E);
        xcd_barrier(bar); PT1(8); }
    }
    {
        CArgsR a = A_; const float* nw = a.in[18]; float* xo = a.out;
        const int tid = opaque_tid(), lane = tid & 63, gw = blockIdx.x * NWAVES + (tid >> 6), NGW = gridDim.x * NWAVES;
        for (int m = gw; m < MT; m += NGW) {
            f32x4* xr = (f32x4*)(xo + (size_t)m * DM) + lane; const f32x4* wr = (const f32x4*)nw + lane;
            f32x4 v[4]; float s = 0.f;
#pragma unroll
            for (int j = 0; j < 4; ++j) { v[j] = xr[64 * j]; s += (v[j][0] * v[j][0] + v[j][1] * v[j][1]) + (v[j][2] * v[j][2] + v[j][3] * v[j][3]); }
            const float rstd = rsqrtf(wave_sum(s) * (1.f / DM) + EPS);
#pragma unroll
            for (int j = 0; j < 4; ++j) { const f32x4 ww = wr[64 * j]; f32x4 r;
#pragma unroll
                for (int i = 0; i < 4; ++i) r[i] = v[j][i] * rstd * ww[i];
                xr[64 * j] = r; }
        }
    }
#undef A_
    if (PROBE_SEL) { const unsigned long long t0 = rt(); while (rt() - t0 < probe_acc) __builtin_amdgcn_s_sleep(8); }
}

extern "C" void kernel_launch(void* const* d_in, const int* in_sizes, int n_in, void* d_out, int out_size, void* d_ws, size_t ws_size, hipStream_t stream) {
    static int grid = 0;
    if (grid == 0) {
        if (n_in != 19 || out_size != MT * DM || ws_size < WS_NEED) { fprintf(stderr, "kernel_launch: unexpected shapes (n_in %d out %d ws %zu need %zu)\n", n_in, out_size, ws_size, (size_t)WS_NEED); grid = -1; return; }
        int dev = 0, cus = 0, per_cu = 0;
        hipGetDevice(&dev); hipDeviceGetAttribute(&cus, hipDeviceAttributeMultiprocessorCount, dev);
        if (hipFuncSetAttribute((const void*)hybrid_fwd, hipFuncAttributeMaxDynamicSharedMemorySize, LDS_BYTES) != hipSuccess) { fprintf(stderr, "kernel_launch: hipFuncSetAttribute failed\n"); grid = -1; return; }
        if (hipOccupancyMaxActiveBlocksPerMultiprocessor(&per_cu, (const void*)hybrid_fwd, NTHREADS, LDS_BYTES) != hipSuccess || per_cu < 1) { fprintf(stderr, "kernel_launch: occupancy query gave %d\n", per_cu); per_cu = 1; }
        (void)hipGetLastError();
        grid = cus * per_cu;
    }
    if (grid < 0) return;
    if (hipMemsetAsync((char*)d_ws + WS_CTL, 0, CTL_BYTES, stream) != hipSuccess) { fprintf(stderr, "kernel_launch: memset of the control words failed\n"); return; }
    Args a{};
    for (int i = 0; i < 19; ++i) a.in[i] = (const float*)d_in[i];
    a.out = (float*)d_out; a.ws = (unsigned char*)d_ws;
    void* args[] = {&a};
    hipError_t e = hipLaunchCooperativeKernel((const void*)hybrid_fwd, dim3(grid), dim3(NTHREADS), args, LDS_BYTES, stream);
    if (e != hipSuccess) fprintf(stderr, "cooperative launch failed: %s (grid %d)\n", hipGetErrorString(e), grid);
}
```

```cpp
#include <hip/hip_runtime.h>
#include <hip/hip_cooperative_groups.h>
#include <cstdio>
#include <cstdint>
namespace cg = cooperative_groups;
__device__ __forceinline__ int opaque_tid() { int t = (int)threadIdx.x; asm volatile("" : "+v"(t)); return t; }
namespace pg8 {
#define PG8_LAS __attribute__((address_space(3)))
typedef unsigned short bf16_t;
typedef short bf16x8 __attribute__((ext_vector_type(8)));
typedef float f32x4 __attribute__((ext_vector_type(4)));
typedef unsigned u32x4 __attribute__((ext_vector_type(4)));
constexpr int BM = 256, BK = 64, HALF = 128, HTB = HALF * BK * 2  , STAGE_BYTES = 8 * HTB, NXCD = 8, WGM = 8;

__host__ __device__ __forceinline__ int lds_byte(int r, int c) { const int st = (r >> 4) * 2 + (c >> 5), rr = r & 15, cc = c & 31, ob = rr * 64 + cc * 2; return st * 1024 + (ob ^ (((ob >> 9) & 1) << 5)); }
__host__ __device__ __forceinline__ void stage_rc(int b, int& R, int& C) { const int st = b / 1024, sb = b % 1024, swz = sb ^ (((sb >> 9) & 1) << 5); R = (st >> 1) * 16 + swz / 64; C = (st & 1) * 32 + (swz % 64) / 2; }
__host__ __device__ __forceinline__ int perm32(int rho) { const int n = rho >> 4, i = rho & 15; return 8 * (i >> 2) + 4 * n + (i & 3); }

struct Unit { int pm, pn; };
struct Gemm { const bf16_t* A; const bf16_t* Bt; int M, N, K; };

struct StaticOrder {
    int nM, nN, nwg, G, c;
    __host__ __device__ void init(int M, int N, int G_, int c_) { nM = M / BM; nN = N / BM; nwg = nM * nN; G = G_; c = c_; }
    __host__ __device__ bool next(int i, Unit& u) const {
        const long L = (long)i * G + c; if (L >= nwg) return false;
        int wgid = (int)L; { const int q = nwg / NXCD, r = nwg % NXCD, xcd = wgid % NXCD, off = wgid / NXCD; wgid = (xcd < r ? xcd * (q + 1) : r * (q + 1) + (xcd - r) * q) + off; }
        const int nig = WGM * nN, gid = wgid / nig, fm = gid * WGM, gsz = (nM - fm) < WGM ? (nM - fm) : WGM;
        u.pm = fm + ((wgid % nig) % gsz); u.pn = (wgid % nig) / gsz; return true;
    }
    __device__ __forceinline__ void a_ready(const Unit&) const {}
    __device__ __forceinline__ void done(const Unit&) const {}
};
__device__ __forceinline__ unsigned cvt_pk_bf16(float lo, float hi) { unsigned r; asm volatile("v_cvt_pk_bf16_f32 %0, %1, %2" : "=v"(r) : "v"(lo), "v"(hi)); return r; }
template <class Epi, class Sched, bool ALIGN_EPI = false, bool SP2 = false>
__device__ __forceinline__ void gemm_phase(PG8_LAS unsigned char* lds, const Gemm g, const Sched& S, const Epi& E) {
    const int tid = opaque_tid(), wid = __builtin_amdgcn_readfirstlane(tid >> 6), lane = tid & 63, wr = wid >> 2, wc = wid & 3, fr = lane & 15, fq = lane >> 4;
    const int K = g.K, nt = K / BK;
    unsigned voffA[2], voffB[2];
#pragma unroll
    for (int i = 0; i < 2; ++i) { int R, C; stage_rc(tid * 16 + i * 8192, R, C); const int Rb = Epi::PERM ? ((R & ~31) + perm32(R & 31)) : R;
        voffA[i] = (unsigned)(R * K + C) * 2u; voffB[i] = (unsigned)(Rb * K + C) * 2u; }
    const size_t kstep = (size_t)(BK * 2);
    const size_t hstep = (size_t)HALF * K * 2;
    const size_t tstep = 2 * hstep;
    const unsigned ldsw = (unsigned)wid * 1024u;
    const int aoff = lds_byte(wr * 64 + fr, fq * 8), boff = lds_byte(wc * 32 + fr, fq * 8);
#define PG8_SA(b, h) (((b) * 2 + (h)) * HTB)
#define PG8_SB(b, h) ((4 + (b) * 2 + (h)) * HTB)
#define PG8_STAGE(bufoff, gbase, voff) do { _Pragma("unroll") for (int _i = 0; _i < 2; ++_i) \
        __builtin_amdgcn_global_load_lds((const unsigned*)((const char*)(gbase) + (voff)[_i]), (PG8_LAS unsigned*)(lds + (bufoff) + ldsw + _i * 8192), 16, 0, 0); } while (0)
#define PG8_LDA(dst, b, h) do { _Pragma("unroll") for (int m = 0; m < 4; ++m) _Pragma("unroll") for (int k = 0; k < 2; ++k) dst[m][k] = *(const PG8_LAS bf16x8*)(lds + PG8_SA(b, h) + aoff + m * 2048 + k * 1024); } while (0)
#define PG8_LDB(dst, b, h) do { _Pragma("unroll") for (int n = 0; n < 2; ++n) _Pragma("unroll") for (int k = 0; k < 2; ++k) dst[n][k] = *(const PG8_LAS bf16x8*)(lds + PG8_SB(b, h) + boff + n * 2048 + k * 1024); } while (0)
#define PG8_MMA(ai, bj, At, Bt) do { __builtin_amdgcn_s_setprio(1); _Pragma("unroll") for (int m = 0; m < 4; ++m) _Pragma("unroll") for (int n = 0; n < 2; ++n) _Pragma("unroll") for (int k = 0; k < 2; ++k) \
        acc[ai][bj][m][n] = __builtin_amdgcn_mfma_f32_16x16x32_bf16(Bt[n][k], At[m][k], acc[ai][bj][m][n], 0, 0, 0); __builtin_amdgcn_s_setprio(0); } while (0)
#define PG8_WAIT_V(n) asm volatile("s_waitcnt vmcnt(" #n ")" ::: "memory")
#define PG8_WAIT_L(n) asm volatile("s_waitcnt lgkmcnt(" #n ")" ::: "memory")
#define PG8_BAR __builtin_amdgcn_s_barrier()
#define PG8_SCHED __builtin_amdgcn_sched_barrier(0)
    Unit cur, nxt; int ui = 0;
    if (!S.next(0, cur)) return;
    f32x4 acc[2][2][4][2];
#pragma unroll
    for (int a = 0; a < 2; ++a)
#pragma unroll
        for (int b = 0; b < 2; ++b)
#pragma unroll
            for (int m = 0; m < 4; ++m)
#pragma unroll
                for (int n = 0; n < 2; ++n) acc[a][b][m][n] = (f32x4){0.f, 0.f, 0.f, 0.f};
    bf16x8 At[4][2], B0[2][2], B1[2][2];
    const char* cA = (const char*)g.A + (size_t)cur.pm * tstep; const char* cB = (const char*)g.Bt + (size_t)cur.pn * tstep;
    S.a_ready(cur);
    if constexpr (SP2) {
        PG8_STAGE(PG8_SB(0, 0), cB, voffB); PG8_STAGE(PG8_SB(0, 1), cB + hstep, voffB); PG8_STAGE(PG8_SA(0, 0), cA, voffA); PG8_STAGE(PG8_SA(0, 1), cA + hstep, voffA);
        if (wr == 1) PG8_BAR;
        PG8_WAIT_V(2); PG8_BAR;
        PG8_STAGE(PG8_SB(1, 0), cB + kstep, voffB); PG8_STAGE(PG8_SA(1, 0), cA + kstep, voffA); PG8_STAGE(PG8_SB(1, 1), cB + hstep + kstep, voffB);
        PG8_WAIT_V(6); PG8_BAR;
    } else {
        PG8_STAGE(PG8_SB(0, 0), cB, voffB); PG8_STAGE(PG8_SA(0, 0), cA, voffA); PG8_STAGE(PG8_SB(0, 1), cB + hstep, voffB); PG8_STAGE(PG8_SA(0, 1), cA + hstep, voffA);
        if (wr == 1) PG8_BAR;
        PG8_WAIT_V(4); PG8_BAR;
        PG8_STAGE(PG8_SB(1, 0), cB + kstep, voffB); PG8_STAGE(PG8_SA(1, 0), cA + kstep, voffA); PG8_STAGE(PG8_SB(1, 1), cB + hstep + kstep, voffB);
        PG8_WAIT_V(6); PG8_BAR;
    }
    for (;;) {
        const bool has_next = S.next(ui + 1, nxt);
        const char* nA = has_next ? (const char*)g.A + (size_t)nxt.pm * tstep : cA; const char* nB = has_next ? (const char*)g.Bt + (size_t)nxt.pn * tstep : cB;
        for (int t = 0; t < nt; t += 2) {
            const bool last = (t == nt - 2);
            const char* a1 = cA + (size_t)(t + 1) * kstep;
            const char* a2 = last ? nA : cA + (size_t)(t + 2) * kstep; const char* b2 = last ? nB : cB + (size_t)(t + 2) * kstep;
            const char* a3 = a2 + kstep; const char* b3 = b2 + kstep;
            if (last && has_next) S.a_ready(nxt);
            if constexpr (SP2) {
            PG8_LDB(B0, 0, 0); PG8_LDB(B1, 0, 1); PG8_SCHED; PG8_LDA(At, 0, 0); PG8_STAGE(PG8_SA(1, 1), a1 + hstep, voffA);
            PG8_WAIT_V(8); PG8_WAIT_L(0); PG8_BAR; PG8_MMA(0, 0, At, B0); PG8_MMA(0, 1, At, B1); PG8_BAR; PG8_SCHED;
            PG8_LDA(At, 0, 1); PG8_STAGE(PG8_SB(0, 0), b2, voffB); PG8_STAGE(PG8_SB(0, 1), b2 + hstep, voffB); PG8_STAGE(PG8_SA(0, 0), a2, voffA);
            PG8_WAIT_V(8); PG8_WAIT_L(0); PG8_BAR; PG8_MMA(1, 0, At, B0); PG8_MMA(1, 1, At, B1); PG8_BAR; PG8_SCHED;
            PG8_LDB(B0, 1, 0); PG8_LDB(B1, 1, 1); PG8_SCHED; PG8_LDA(At, 1, 0); PG8_STAGE(PG8_SA(0, 1), a2 + hstep, voffA);
            PG8_WAIT_V(8); PG8_WAIT_L(0); PG8_BAR; PG8_MMA(0, 0, At, B0); PG8_MMA(0, 1, At, B1); PG8_BAR; PG8_SCHED;
            PG8_LDA(At, 1, 1); PG8_STAGE(PG8_SB(1, 0), b3, voffB); PG8_STAGE(PG8_SB(1, 1), b3 + hstep, voffB); PG8_STAGE(PG8_SA(1, 0), a3, voffA);
            PG8_WAIT_V(8); PG8_WAIT_L(0); PG8_BAR; PG8_MMA(1, 0, At, B0); PG8_MMA(1, 1, At, B1); PG8_BAR; PG8_SCHED;
            } else {
            PG8_LDB(B0, 0, 0); PG8_SCHED; PG8_LDA(At, 0, 0); PG8_STAGE(PG8_SA(1, 1), a1 + hstep, voffA);
            PG8_WAIT_L(8); PG8_BAR; PG8_WAIT_L(0); PG8_MMA(0, 0, At, B0); PG8_BAR; PG8_SCHED;
            PG8_LDB(B1, 0, 1); PG8_STAGE(PG8_SB(0, 0), b2, voffB);
            PG8_BAR; PG8_WAIT_L(0); PG8_MMA(0, 1, At, B1); PG8_BAR;
            PG8_LDA(At, 0, 1); PG8_STAGE(PG8_SA(0, 0), a2, voffA);
            PG8_BAR; PG8_WAIT_L(0); PG8_MMA(1, 0, At, B0); PG8_BAR; PG8_SCHED;
            PG8_STAGE(PG8_SB(0, 1), b2 + hstep, voffB);
            PG8_WAIT_V(6); PG8_BAR; PG8_MMA(1, 1, At, B1); PG8_BAR;
            PG8_LDB(B0, 1, 0); PG8_SCHED; PG8_LDA(At, 1, 0); PG8_STAGE(PG8_SA(0, 1), a2 + hstep, voffA);
            PG8_WAIT_L(8); PG8_BAR; PG8_WAIT_L(0); PG8_MMA(0, 0, At, B0); PG8_BAR; PG8_SCHED;
            PG8_LDB(B1, 1, 1); PG8_STAGE(PG8_SB(1, 0), b3, voffB);
            PG8_BAR; PG8_WAIT_L(0); PG8_MMA(0, 1, At, B1); PG8_BAR;
            PG8_LDA(At, 1, 1); PG8_STAGE(PG8_SA(1, 0), a3, voffA);
            PG8_BAR; PG8_WAIT_L(0); PG8_MMA(1, 0, At, B0); PG8_BAR; PG8_SCHED;
            PG8_STAGE(PG8_SB(1, 1), b3 + hstep, voffB);
            PG8_WAIT_V(6); PG8_BAR; PG8_MMA(1, 1, At, B1); PG8_BAR;
            }
        }
        if constexpr (ALIGN_EPI) { if (wr == 0) PG8_BAR; }
        if constexpr (!Epi::AFTER_DRAIN) { E(acc, cur, wr, wc, fr, fq); S.done(cur); }
        if (!has_next) break;
#pragma unroll
        for (int a = 0; a < 2; ++a)
#pragma unroll
            for (int b = 0; b < 2; ++b)
#pragma unroll
                for (int m = 0; m < 4; ++m)
#pragma unroll
                    for (int n = 0; n < 2; ++n) acc[a][b][m][n] = (f32x4){0.f, 0.f, 0.f, 0.f};
        cur = nxt; cA = nA; cB = nB; ++ui;
        if constexpr (ALIGN_EPI) { if (wr == 1) PG8_BAR; }
    }
    PG8_WAIT_V(0);
    if constexpr (!ALIGN_EPI) { if (wr == 0) PG8_BAR; }
    PG8_BAR;
    if constexpr (Epi::AFTER_DRAIN) { E.fused(acc, cur, wr, wc, fr, fq, lds, wid, lane); S.done(cur); }
#undef PG8_SA
#undef PG8_SB
#undef PG8_STAGE
#undef PG8_LDA
#undef PG8_LDB
#undef PG8_MMA
#undef PG8_WAIT_V
#undef PG8_WAIT_L
#undef PG8_BAR
#undef PG8_SCHED
}
}

constexpr int NB = 8, SEQ = 2048, DM = 1024, MT = NB * SEQ, DFF = 4096, IN_DIM = 13344;
constexpr int NTHREADS = 512, NWAVES = 8, LDS_BYTES = 147456;
constexpr float EPS = 1e-6f;
typedef unsigned short bf16;
typedef unsigned v4u __attribute__((ext_vector_type(4)));
typedef unsigned v2u __attribute__((ext_vector_type(2)));
typedef float f32x4 __attribute__((ext_vector_type(4)));
typedef short bf16x8 __attribute__((ext_vector_type(8)));
enum { B_H = 0, B_DNG = 1, B_SBQ = 2, B_SSZ = 3, B_DNQ = 4, B_DNK = 5, B_DNV = 6, B_SBK = 7, B_SBV = 8, B_SSX = 9, B_SSBC = 10, NBUF = 11 };
constexpr size_t BUFE = (size_t)MT * DM;
constexpr size_t WS_W = NBUF * BUFE * 2;
constexpr size_t W_IN = 0, W_G = W_IN + (size_t)10240 * 1024, W_OUT = W_G + (size_t)6144 * 1024, W_UP = W_OUT + (size_t)1024 * 1024,
                 W_DOWN = W_UP + (size_t)4096 * 1024, W_END = W_DOWN + (size_t)4096 * 1024;
constexpr size_t WS_SMALL = WS_W + W_END * 2;
constexpr size_t WS_CTL = WS_SMALL + (size_t)MT * 64 * 4;
constexpr size_t WS_BAR = WS_CTL + 4096;
constexpr size_t CTL_BYTES = 4096 + 16384;
constexpr size_t WS_NEED = WS_CTL + CTL_BYTES;

__device__ __forceinline__ float bf2f(unsigned u) { return __builtin_bit_cast(float, u << 16); }
__device__ __forceinline__ unsigned f2bf(float f) { unsigned u = __builtin_bit_cast(unsigned, f); return (u + 0x7fffu + ((u >> 16) & 1u)) >> 16; }
typedef float f32x2 __attribute__((ext_vector_type(2)));
typedef __bf16 bf16x2_t __attribute__((ext_vector_type(2)));
__device__ __forceinline__ unsigned pk2(float lo, float hi) { f32x2 v = {lo, hi}; return __builtin_bit_cast(unsigned, __builtin_convertvector(v, bf16x2_t)); }
__device__ __forceinline__ void unpack8(v4u r, float* o) {
    o[0] = bf2f(r.x & 0xffffu); o[1] = __builtin_bit_cast(float, r.x & 0xffff0000u); o[2] = bf2f(r.y & 0xffffu); o[3] = __builtin_bit_cast(float, r.y & 0xffff0000u);
    o[4] = bf2f(r.z & 0xffffu); o[5] = __builtin_bit_cast(float, r.z & 0xffff0000u); o[6] = bf2f(r.w & 0xffffu); o[7] = __builtin_bit_cast(float, r.w & 0xffff0000u);
}
__device__ __forceinline__ v4u pack8(const float* v) { v4u w; w.x = pk2(v[0], v[1]); w.y = pk2(v[2], v[3]); w.z = pk2(v[4], v[5]); w.w = pk2(v[6], v[7]); return w; }
__device__ __forceinline__ float sigmoidf_(float x) { return __builtin_amdgcn_rcpf(1.f + __expf(-x)); }
__device__ __forceinline__ float siluf_(float x) { return x * __builtin_amdgcn_rcpf(1.f + __expf(-x)); }
__device__ __forceinline__ float softplusf_(float x) { return fmaxf(x, 0.f) + log1pf(__expf(-fabsf(x))); }
template <int CTRL> __device__ __forceinline__ float dppf(float v) { return __builtin_bit_cast(float, __builtin_amdgcn_update_dpp(0, __builtin_bit_cast(int, v), CTRL, 0xF, 0xF, true)); }
__device__ __forceinline__ float red8(float v) { v += dppf<0xB1>(v); v += dppf<0x4E>(v); v += dppf<0x141>(v); return v; }
__device__ __forceinline__ float red16(float v) { v = red8(v); v += dppf<0x140>(v); return v; }
__device__ __forceinline__ float wave_sum(float v) {
#pragma unroll
    for (int o = 1; o < 64; o <<= 1) v += __shfl_xor(v, o);
    return v;
}
#define LDS_WAIT() asm volatile("s_waitcnt lgkmcnt(0)" ::: "memory")

struct Args { const float* in[19]; float* out; unsigned char* ws; };
typedef const __attribute__((address_space(4))) Args& CArgsR;
__device__ __forceinline__ const __attribute__((address_space(4))) Args* kargs() { unsigned long long v = (unsigned long long)__builtin_amdgcn_kernarg_segment_ptr(); asm volatile("" : "+s"(v)); return (const __attribute__((address_space(4))) Args*)v; }
#ifndef PROBE_SEL
#define PROBE_SEL 0
#endif
__device__ __forceinline__ unsigned long long rt() { return __builtin_amdgcn_s_memrealtime(); }
#define PT0() unsigned long long pt_ = PROBE_SEL ? rt() : 0ull
#define PT1(k) do { if (PROBE_SEL & (1 << (k))) probe_acc += rt() - pt_; } while (0)

struct EpiRoute {
    static constexpr bool PERM = true, AFTER_DRAIN = false;
    bf16* base; int pn_off;
    __device__ __forceinline__ void operator()(const pg8::f32x4 (&acc)[2][2][4][2], const pg8::Unit& u, int wr, int wc, int fr, int fq) const {
        const int sg = (u.pn + pn_off) >> 2;
        const int bufi = sg == 0 ? B_DNG : sg == 1 ? B_DNQ : sg == 2 ? B_DNK : sg == 3 ? B_DNV : sg == 4 ? B_SBQ : sg == 5 ? B_SSZ : sg == 6 ? B_SBK : sg == 7 ? B_SBV : sg == 8 ? B_SSX : B_SSBC;
        bf16* O = base + (size_t)bufi * BUFE;
        const int col0 = (u.pn & 3) * 256 + wc * 32 + 8 * fq, row0 = u.pm * 256 + wr * 64 + fr;
#pragma unroll
        for (int ai = 0; ai < 2; ++ai)
#pragma unroll
            for (int m = 0; m < 4; ++m) { bf16* rowp = O + (size_t)(row0 + ai * 128 + m * 16) * DM + col0;
#pragma unroll
                for (int bj = 0; bj < 2; ++bj) { const pg8::f32x4 v0 = acc[ai][bj][m][0], v1 = acc[ai][bj][m][1];
                    v4u w; w.x = pk2(v0[0], v0[1]); w.y = pk2(v0[2], v0[3]); w.z = pk2(v1[0], v1[1]); w.w = pk2(v1[2], v1[3]);
                    *(v4u*)(rowp + bj * 128) = w; } }
    }
};
struct EpiRelu2 {
    static constexpr bool PERM = true, AFTER_DRAIN = false;
    bf16* O;
    __device__ __forceinline__ void operator()(const pg8::f32x4 (&acc)[2][2][4][2], const pg8::Unit& u, int wr, int wc, int fr, int fq) const {
        const int col0 = u.pn * 256 + wc * 32 + 8 * fq, row0 = u.pm * 256 + wr * 64 + fr;
#pragma unroll
        for (int ai = 0; ai < 2; ++ai)
#pragma unroll
            for (int m = 0; m < 4; ++m) { bf16* rowp = O + (size_t)(row0 + ai * 128 + m * 16) * DFF + col0;
#pragma unroll
                for (int bj = 0; bj < 2; ++bj) { float v[8];
#pragma unroll
                    for (int i = 0; i < 4; ++i) { float a = fmaxf(acc[ai][bj][m][0][i], 0.f), b = fmaxf(acc[ai][bj][m][1][i], 0.f); v[i] = a * a; v[4 + i] = b * b; }
                    *(v4u*)(rowp + bj * 128) = pack8(v); } }
    }
};
struct EpiResid {
    static constexpr bool PERM = true, AFTER_DRAIN = false;
    const float* xin; float* xout;
    __device__ __forceinline__ void operator()(const pg8::f32x4 (&acc)[2][2][4][2], const pg8::Unit& u, int wr, int wc, int fr, int fq) const {
        const int col0 = u.pn * 256 + wc * 32 + 8 * fq, row0 = u.pm * 256 + wr * 64 + fr;
#pragma unroll
        for (int ai = 0; ai < 2; ++ai)
#pragma unroll
            for (int m = 0; m < 4; ++m) { const size_t ro = (size_t)(row0 + ai * 128 + m * 16) * DM + col0;
#pragma unroll
                for (int bj = 0; bj < 2; ++bj) { const size_t o = ro + bj * 128;
                    const f32x4 a = *(const f32x4*)(xin + o), b = *(const f32x4*)(xin + o + 4);
                    f32x4 r0, r1;
#pragma unroll
                    for (int i = 0; i < 4; ++i) { r0[i] = a[i] + acc[ai][bj][m][0][i]; r1[i] = b[i] + acc[ai][bj][m][1][i]; }
                    *(f32x4*)(xout + o) = r0; *(f32x4*)(xout + o + 4) = r1; } }
    }
};
struct SchedGate {
    int G, c;
    __device__ __forceinline__ bool next(int i, pg8::Unit& u) const {
        const int tile = c + (i / 6) * G; if (tile >= 256) return false;
        const int s = i % 6, br = s >> 1, xj = tile >> 3, pm = (tile & 7) * 8 + (xj >> 2), pn = xj & 3;
        if ((s & 1) == 0) { u.pm = pm; u.pn = br * 4 + pn; } else { u.pm = (1 + br) * 64 + pm; u.pn = (3 + br) * 4 + pn; }
        return true;
    }
    __device__ __forceinline__ void a_ready(const pg8::Unit&) const {}
    __device__ __forceinline__ void done(const pg8::Unit&) const {}
};
struct EpiGate {
    static constexpr bool PERM = true, AFTER_DRAIN = false;
    bf16* gsc; float* macc; bf16* merged;
    __device__ __forceinline__ void operator()(const pg8::f32x4 (&acc)[2][2][4][2], const pg8::Unit& u, int wr, int wc, int fr, int fq) const {
        const int j = u.pn >> 2, pn = u.pn & 3, pm = u.pm & 63;
        const int col0 = pn * 256 + wc * 32 + 8 * fq, row0 = pm * 256 + wr * 64 + fr;
#pragma unroll
        for (int ai = 0; ai < 2; ++ai)
#pragma unroll
            for (int m = 0; m < 4; ++m) { const size_t ro = (size_t)(row0 + ai * 128 + m * 16) * DM + col0;
#pragma unroll
                for (int bj = 0; bj < 2; ++bj) { const size_t o = ro + bj * 128; float v[8];
#pragma unroll
                    for (int i = 0; i < 4; ++i) { v[i] = acc[ai][bj][m][0][i]; v[4 + i] = acc[ai][bj][m][1][i]; }
                    if (j < 3) {
#pragma unroll
                        for (int i = 0; i < 8; ++i) v[i] = sigmoidf_(v[i]);
                        *(v4u*)(gsc + o) = pack8(v);
                    } else {
                        float g[8]; unpack8(*(const v4u*)(gsc + o), g);
#pragma unroll
                        for (int i = 0; i < 8; ++i) v[i] *= g[i];
                        if (j > 3) { const f32x4 a = *(const f32x4*)(macc + o), b = *(const f32x4*)(macc + o + 4);
#pragma unroll
                            for (int i = 0; i < 4; ++i) { v[i] += a[i]; v[4 + i] += b[i]; } }
                        if (j < 5) { *(f32x4*)(macc + o) = (f32x4){v[0], v[1], v[2], v[3]}; *(f32x4*)(macc + o + 4) = (f32x4){v[4], v[5], v[6], v[7]}; }
                        else *(v4u*)(merged + o) = pack8(v);
                    } } }
    }
};

__device__ __forceinline__ void transpose_item(const float* __restrict__ W, const float* __restrict__ W2, int ldw, bf16* __restrict__ WT, int K, int nblk, float* scr, int item, int lane) {
    const int kb = item / nblk, nb = item % nblk, k0 = 64 * kb, n0 = 32 * nb;
    const float* src = ((lane & 31) < 16 ? W : W2) + (size_t)(k0 + (lane >> 5)) * ldw + n0 + (lane & 31);
    float t[32];
#pragma unroll
    for (int i = 0; i < 32; ++i) t[i] = src[(size_t)(2 * i) * ldw];
#pragma unroll
    for (int i = 0; i < 32; ++i) scr[(2 * i + (lane >> 5)) * 33 + (lane & 31)] = t[i];
    LDS_WAIT();
    const int c = lane & 7;
#pragma unroll
    for (int j = 0; j < 4; ++j) { const int n = (lane >> 3) + 8 * j; const float* s = scr + (8 * c) * 33 + n;
        v4u o; o.x = pk2(s[0 * 33], s[1 * 33]); o.y = pk2(s[2 * 33], s[3 * 33]); o.z = pk2(s[4 * 33], s[5 * 33]); o.w = pk2(s[6 * 33], s[7 * 33]);
        *(v4u*)(WT + (size_t)(n0 + n) * K + k0 + 8 * c) = o; }
    LDS_WAIT();
}
__device__ __forceinline__ void rms_row_to_bf16(const float* xrow, const float* w, bf16* orow, int lane) {
    const f32x4* xr = (const f32x4*)xrow + lane; const f32x4* wr = (const f32x4*)w + lane;
    f32x4 v[4]; float s = 0.f;
#pragma unroll
    for (int j = 0; j < 4; ++j) { v[j] = xr[64 * j]; s += (v[j][0] * v[j][0] + v[j][1] * v[j][1]) + (v[j][2] * v[j][2] + v[j][3] * v[j][3]); }
    const float rstd = rsqrtf(wave_sum(s) * (1.f / DM) + EPS);
    unsigned long long* o8 = (unsigned long long*)orow + lane;
#pragma unroll
    for (int j = 0; j < 4; ++j) { const f32x4 ww = wr[64 * j];
        o8[64 * j] = (unsigned long long)pk2(v[j][0] * rstd * ww[0], v[j][1] * rstd * ww[1]) | ((unsigned long long)pk2(v[j][2] * rstd * ww[2], v[j][3] * rstd * ww[3]) << 32); }
}
__device__ __forceinline__ void phase0(unsigned char* lds, CArgsR a, int l, const float* xin) {
    constexpr int LDW = 1032;
    const int tid = opaque_tid(), lane = tid & 63, wave = __builtin_amdgcn_readfirstlane(tid >> 6), gw = blockIdx.x * NWAVES + wave, NGW = gridDim.x * NWAVES;
    bf16* Wreg = (bf16*)(a.ws + WS_W);
    const float* w_in = a.in[2] + (size_t)l * DM * IN_DIM;
    {
        float* scr = (float*)lds + wave * (64 * 33);
        const float* w_br = a.in[13] + (size_t)l * 3 * DM * DM; const float* w_out = a.in[14] + (size_t)l * DM * DM;
        const float* w_up = a.in[16] + (size_t)l * DM * DFF; const float* w_down = a.in[17] + (size_t)l * DFF * DM;
        constexpr int NSEG = 17, NIT = NSEG * 512 + 2048 + 2048;
        for (int it = gw; it < NIT; it += NGW) {
            if (it < NSEG * 512) {
                const int seg = it >> 9, r = it & 511;
                const float* W; int ldw; bf16* WT;
                if (seg < 13) {
                    const int co = seg == 0 ? 3072 : seg == 1 ? 0 : seg == 2 ? 1024 : seg == 3 ? 2048 : seg == 4 ? 4112 : seg == 5 ? 7184 : seg == 6 ? 5136 : seg == 7 ? 6160 : seg == 8 ? 8208 : seg == 9 ? 9232
                                 : 10272 + (seg - 10) * 1024;
                    W = w_in + co; ldw = IN_DIM; WT = seg < 10 ? Wreg + (size_t)seg * DM * DM : Wreg + W_G + (size_t)(seg - 10) * DM * DM;
                } else if (seg < 16) { W = w_br + (size_t)(seg - 13) * DM * DM; ldw = DM; WT = Wreg + W_G + (size_t)(3 + seg - 13) * DM * DM; }
                else { W = w_out; ldw = DM; WT = Wreg + W_OUT; }
                transpose_item(W, W, ldw, WT, DM, 32, scr, r, lane);
            } else if (it < NSEG * 512 + 2048) transpose_item(w_up, w_up, DFF, Wreg + W_UP, DM, 128, scr, it - NSEG * 512, lane);
            else transpose_item(w_down, w_down, DM, Wreg + W_DOWN, DFF, 32, scr, it - NSEG * 512 - 2048, lane);
        }
    }
    __syncthreads();
    bf16* WsT = (bf16*)lds;
    for (int idx = tid; idx < 32 * DM; idx += NTHREADS) { const int k = idx >> 5, c = idx & 31; WsT[c * LDW + k] = (bf16)f2bf(w_in[(size_t)k * IN_DIM + (c < 16 ? 4096 + c : 10256 + c - 16)]); }
    __syncthreads();
    {   const float* nw = a.in[1] + (size_t)l * DM; bf16* H = (bf16*)a.ws; float* small = (float*)(a.ws + WS_SMALL);
        const int fr = lane & 15, fq = lane >> 4;
        const float pa0 = __expf(a.in[4][l * 8 + (fr & 7)]), pb0 = a.in[5][l * 8 + (fr & 7)], pa1 = __expf(a.in[9][l * 16 + fr]), pb1 = a.in[10][l * 16 + fr];
        for (int g8 = gw; g8 < MT / 8; g8 += NGW) {
            const int r0 = g8 * 8;
#pragma unroll 1
            for (int r = 0; r < 8; ++r) rms_row_to_bf16(xin + (size_t)(r0 + r) * DM, nw, H + (size_t)(r0 + r) * DM, lane);
            asm volatile("s_waitcnt vmcnt(0)" ::: "memory");
            f32x4 c0 = {0.f, 0.f, 0.f, 0.f}, c1 = {0.f, 0.f, 0.f, 0.f};
            const bf16* ap = H + (size_t)(r0 + (fr & 7)) * DM + fq * 8;
#pragma unroll
            for (int kb = 0; kb < 4; ++kb) { bf16x8 af[8];
#pragma unroll
                for (int k = 0; k < 8; ++k) af[k] = *(const bf16x8*)(ap + (kb * 8 + k) * 32);
#pragma unroll
                for (int k = 0; k < 8; ++k) { const bf16x8 b0 = *(const bf16x8*)(WsT + fr * LDW + (kb * 8 + k) * 32 + fq * 8), b1 = *(const bf16x8*)(WsT + (16 + fr) * LDW + (kb * 8 + k) * 32 + fq * 8);
                    c0 = __builtin_amdgcn_mfma_f32_16x16x32_bf16(af[k], b0, c0, 0, 0, 0); c1 = __builtin_amdgcn_mfma_f32_16x16x32_bf16(af[k], b1, c1, 0, 0, 0); } }
            if (fq < 2) {
#pragma unroll
                for (int jj = 0; jj < 4; ++jj) { float* sp = small + (size_t)(r0 + 4 * fq + jj) * 64;
                    sp[fr] = fr < 8 ? -pa0 * softplusf_(c0[jj] + pb0) : sigmoidf_(c0[jj]);
                    const float dt = softplusf_(c1[jj] + pb1); sp[16 + fr] = dt; sp[32 + fr] = -pa1 * dt; } }
        }
    }
}

__device__ __forceinline__ void conv8(const bf16* p, int pos, const float* w, int wstride, const float* bias, float* out) {
    float acc[8];
#pragma unroll
    for (int i = 0; i < 8; ++i) acc[i] = bias ? bias[i] : 0.f;
#pragma unroll
    for (int j = 0; j < 4; ++j) { const int back = 3 - j;
        if (pos - back >= 0) { float xv[8]; unpack8(*(const v4u*)(p - (size_t)back * DM), xv);
            const f32x4 w0 = *(const f32x4*)(w + j * wstride), w1 = *(const f32x4*)(w + j * wstride + 4);
#pragma unroll
            for (int i = 0; i < 4; ++i) { acc[i] += xv[i] * w0[i]; acc[4 + i] += xv[4 + i] * w1[i]; } } }
#pragma unroll
    for (int i = 0; i < 8; ++i) out[i] = siluf_(acc[i]);
}

__device__ __forceinline__ void conv8r(const v4u (&raw)[4], const float* w, int wstride, const float* bias, float* out) {
    float acc[8];
#pragma unroll
    for (int i = 0; i < 8; ++i) acc[i] = bias ? bias[i] : 0.f;
#pragma unroll
    for (int j = 0; j < 4; ++j) { float xv[8]; unpack8(raw[j], xv);
        const f32x4 w0 = *(const f32x4*)(w + j * wstride), w1 = *(const f32x4*)(w + j * wstride + 4);
#pragma unroll
        for (int i = 0; i < 4; ++i) { acc[i] += xv[i] * w0[i]; acc[4 + i] += xv[4 + i] * w1[i]; } }
#pragma unroll
    for (int i = 0; i < 8; ++i) out[i] = siluf_(acc[i]);
}
#define LOAD4(dst, p, pos) do { _Pragma("unroll") for (int j_ = 0; j_ < 4; ++j_) { const int back_ = 3 - j_; const bool ok_ = (pos) - back_ >= 0; \
        const v4u t_ = *(const v4u*)((p) - (size_t)(ok_ ? back_ : 0) * DM); dst[j_] = ok_ ? t_ : (v4u){0u, 0u, 0u, 0u}; } } while (0)

template <int K> __device__ __forceinline__ void mma16(f32x4& acc, const bf16* Ap, int lda, const bf16* Bp, int ldb, int fr, int fq) {
    bf16x8 af[K / 32], bfv[K / 32];
#pragma unroll
    for (int k = 0; k < K / 32; ++k) { af[k] = *(const bf16x8*)(Ap + fr * lda + k * 32 + fq * 8); bfv[k] = *(const bf16x8*)(Bp + fr * ldb + k * 32 + fq * 8); }
#pragma unroll
    for (int k = 0; k < K / 32; ++k) acc = __builtin_amdgcn_mfma_f32_16x16x32_bf16(af[k], bfv[k], acc, 0, 0, 0);
}
template <bool SA, bool SB> __device__ __forceinline__ void mma32s(f32x4& acc, const bf16* Ap, int rA0, int lda, const bf16* Bp, int rB0, int ldb, int fr, int fq) {
    const int ra = rA0 + fr, rb = rB0 + fr;
    const bf16x8 af = *(const bf16x8*)(Ap + ra * lda + ((SA ? (fq ^ ((ra >> 3) & 3)) : fq) << 3));
    const bf16x8 bfv = *(const bf16x8*)(Bp + rb * ldb + ((SB ? (fq ^ ((rb >> 3) & 3)) : fq) << 3));
    acc = __builtin_amdgcn_mfma_f32_16x16x32_bf16(af, bfv, acc, 0, 0, 0);
}
__device__ __forceinline__ void dn_item(unsigned char* lds, CArgsR a, int l, int item, unsigned long long& probe_acc) {
    constexpr int LDK = 136, LDJ = 40, LDL = 36;
    const int b = item >> 3, h = item & 7;
    bf16* kA = (bf16*)lds;
    bf16* qA = kA + 32 * LDK;
    bf16* qgA = qA + 32 * LDK;
    bf16* wA = qgA + 32 * LDK;
    bf16* kdT = wA + 32 * LDK;
    bf16* vnT = kdT + 128 * LDJ;
    bf16* attn = vnT + 128 * LDJ;
    bf16* ST = attn + 32 * LDJ;
    float* kf = (float*)(ST + 128 * LDK);
    float* vf = kf + 32 * 128;
    float* os = kf;
    float* Lm = vf + 32 * 128;
    float* gcs = Lm + 32 * LDL;
    float* betas = gcs + 32;
    float* cwL = betas + 32;
    const int tid = opaque_tid(), w = __builtin_amdgcn_readfirstlane(tid >> 6), lane = tid & 63, fr = lane & 15, fq = lane >> 4;
    bf16* base = (bf16*)a.ws;
    const bf16* Q = base + (size_t)B_DNQ * BUFE; const bf16* K = base + (size_t)B_DNK * BUFE; const bf16* V = base + (size_t)B_DNV * BUFE; bf16* G = base + (size_t)B_DNG * BUFE;
    const float* small = (const float*)(a.ws + WS_SMALL);
    const float* cw = a.in[3] + (size_t)l * 4 * 3072;
    const size_t rowbase = (size_t)b * SEQ;
    const int tq = tid >> 4, cq = tid & 15;
    const float* nwp = a.in[6] + l * 128 + cq * 8;
    f32x4 Sacc[8];
#pragma unroll
    for (int i = 0; i < 8; ++i) Sacc[i] = (f32x4){0.f, 0.f, 0.f, 0.f};
    for (int i = tid; i < 128 * LDK / 2; i += NTHREADS) ((unsigned*)ST)[i] = 0u;
    for (int i = tid; i < 4 * 384; i += NTHREADS) { const int j = i / 384, r = i % 384; cwL[i] = cw[j * 3072 + (r >> 7) * 1024 + h * 128 + (r & 127)]; }
    __syncthreads();
    const int ta = ((tid - 256) >> 4) & 15;
    v4u rqa[4], rka[4], rva[4], rqb[4], rkb[4], rvb[4]; float rg = 0.f, rbv = 0.f;
    v4u Pv[2];
    Pv[0] = Pv[1] = (v4u){0u, 0u, 0u, 0u};
#define DN_LOADS_RAW(c_, half_) do { const int pos_ = (c_) * 32 + ta + 16 * (half_); const size_t off_ = (rowbase + pos_) * DM + h * 128 + cq * 8; LOAD4(rqa, Q + off_, pos_); LOAD4(rka, K + off_, pos_); LOAD4(rva, V + off_, pos_); } while (0)
#define DN_LOADS_RAWB(c_) do { const int pos_ = (c_) * 32 + ta + 16; const size_t off_ = (rowbase + pos_) * DM + h * 128 + cq * 8; LOAD4(rqb, Q + off_, pos_); LOAD4(rkb, K + off_, pos_); LOAD4(rvb, V + off_, pos_); } while (0)
#define DN_LOADS_SMALL(c_) do { const int t0_ = (c_) * 32; \
        { const size_t r_ = rowbase + t0_ + (lane & 31); rg = small[r_ * 64 + h]; rbv = small[r_ * 64 + 8 + h]; } } while (0)
#define DN_CONV(rq_, rk_, rv_, slot_) do { const float* cw_ = cwL + cq * 8; asm volatile("" : "+v"(cw_)); \
        { float o8_[8]; conv8r(rq_, cw_, 384, nullptr, o8_); float ss_ = 0.f; _Pragma("unroll") for (int i_ = 0; i_ < 8; ++i_) ss_ += o8_[i_] * o8_[i_]; \
          ss_ = red16(ss_); const float rn_ = rsqrtf(ss_ + EPS) * 0.08838834764831845f; _Pragma("unroll") for (int i_ = 0; i_ < 8; ++i_) o8_[i_] *= rn_; *(v4u*)(qA + (ta + 16 * (slot_)) * LDK + cq * 8) = pack8(o8_); } \
        __builtin_amdgcn_sched_barrier(0); \
        { float o8_[8]; conv8r(rk_, cw_ + 128, 384, nullptr, o8_); float ss_ = 0.f; _Pragma("unroll") for (int i_ = 0; i_ < 8; ++i_) ss_ += o8_[i_] * o8_[i_]; \
          ss_ = red16(ss_); const float rn_ = rsqrtf(ss_ + EPS); _Pragma("unroll") for (int i_ = 0; i_ < 8; ++i_) o8_[i_] *= rn_; *(v4u*)(kA + (ta + 16 * (slot_)) * LDK + cq * 8) = pack8(o8_); } \
        __builtin_amdgcn_sched_barrier(0); \
        { float o8_[8]; conv8r(rv_, cw_ + 256, 384, nullptr, o8_); Pv[slot_] = pack8(o8_); } \
        __builtin_amdgcn_sched_barrier(0); } while (0)
    if (w >= 4) { DN_LOADS_RAW(0, 0); DN_CONV(rqa, rka, rva, 0); DN_LOADS_RAW(0, 1); DN_CONV(rqa, rka, rva, 1); }
    DN_LOADS_SMALL(0);
    for (int c = 0; c < SEQ / 32; ++c) {
        const int t0 = c * 32;
        unsigned long long tp_ = PROBE_SEL ? rt() : 0ull;
#define DPT(k) do { if (PROBE_SEL) { const unsigned long long tn_ = rt(); if ((PROBE_SEL & (1 << (k))) && item == 0) probe_acc += tn_ - tp_; tp_ = tn_; } } while (0)
        float gcv = rg;
#pragma unroll
        for (int off = 1; off < 32; off <<= 1) { const float t = __shfl_up(gcv, off, 32); if ((lane & 31) >= off) gcv += t; }
        const float gc_last = __shfl(gcv, 31);
        if (w >= 4) {
#pragma unroll
            for (int s2 = 0; s2 < 2; ++s2) { const int tt = ta + 16 * s2;
                const float gc_t = __shfl(gcv, tt), beta_t = __shfl(rbv, tt);
                float q8[8], k8[8], v8[8], t8[8];
                unpack8(*(const v4u*)(qA + tt * LDK + cq * 8), q8); unpack8(*(const v4u*)(kA + tt * LDK + cq * 8), k8); unpack8(Pv[s2], v8);
                const float eg = __expf(gc_t), kb = beta_t * eg, kd = __expf(gc_last - gc_t);
#pragma unroll
                for (int i = 0; i < 8; ++i) t8[i] = q8[i] * eg;
                *(v4u*)(qgA + tt * LDK + cq * 8) = pack8(t8);
                *(f32x4*)(kf + tt * 128 + cq * 8) = (f32x4){k8[0] * kb, k8[1] * kb, k8[2] * kb, k8[3] * kb}; *(f32x4*)(kf + tt * 128 + cq * 8 + 4) = (f32x4){k8[4] * kb, k8[5] * kb, k8[6] * kb, k8[7] * kb};
                *(f32x4*)(vf + tt * 128 + cq * 8) = (f32x4){v8[0] * beta_t, v8[1] * beta_t, v8[2] * beta_t, v8[3] * beta_t}; *(f32x4*)(vf + tt * 128 + cq * 8 + 4) = (f32x4){v8[4] * beta_t, v8[5] * beta_t, v8[6] * beta_t, v8[7] * beta_t};
#pragma unroll
                for (int i = 0; i < 8; ++i) kdT[(cq * 8 + i) * LDJ + (tt ^ ((cq & 3) << 3))] = (bf16)f2bf(k8[i] * kd);
            }
        }
        if (tid < 32) { gcs[tid] = gcv; betas[tid] = rbv; }
        __syncthreads();
        DPT(12);
        if (w >= 4 && c + 1 < SEQ / 32) DN_LOADS_RAW(c + 1, 0);
        {   const int ww = w & 3, gi = ww >> 1, gj = ww & 1; f32x4 acc = {0.f, 0.f, 0.f, 0.f};
            const int jI = 16 * gj + fr, i0 = 16 * gi + 4 * fq;
            const float gj_ = gcs[jI]; const f32x4 gi4 = *(const f32x4*)(gcs + i0), bi4 = *(const f32x4*)(betas + i0);
            mma16<128>(acc, (w < 4 ? kA : qA) + gi * 16 * LDK, LDK, kA + gj * 16 * LDK, LDK, fr, fq);
            if (w < 4) {
#pragma unroll
                for (int jj = 0; jj < 4; ++jj) Lm[(i0 + jj) * LDL + jI] = jI < i0 + jj ? bi4[jj] * acc[jj] * __expf(gi4[jj] - gj_) : 0.f;
            } else {
#pragma unroll
                for (int jj = 0; jj < 4; ++jj) attn[(i0 + jj) * LDJ + jI] = (bf16)f2bf(jI <= i0 + jj ? acc[jj] * __expf(gi4[jj] - gj_) : 0.f);
            } }
        __syncthreads();
        DPT(13);
        if (w < 4) { const int cc = tid & 127; const bool is_w = w >= 2; const float* R = is_w ? kf : vf;
            float x[32];
#pragma unroll
            for (int i = 0; i < 32; ++i) x[i] = R[i * 128 + cc];
            f32x4 Lb[2][8];
            Lb[1][0] = *(const f32x4*)(Lm + 1 * LDL);
#pragma unroll
            for (int i = 1; i < 32; ++i) {
                if (i + 1 < 32) {
#pragma unroll
                    for (int j4 = 0; j4 < (i + 4) / 4; ++j4) Lb[(i + 1) & 1][j4] = *(const f32x4*)(Lm + (i + 1) * LDL + j4 * 4); }
                float a0 = x[i], a1 = 0.f, a2 = 0.f, a3 = 0.f;
#pragma unroll
                for (int j4 = 0; j4 < (i + 3) / 4; ++j4) { const f32x4 l4 = Lb[i & 1][j4];
                    if (j4 * 4 + 0 < i) a0 -= l4[0] * x[j4 * 4 + 0];
                    if (j4 * 4 + 1 < i) a1 -= l4[1] * x[j4 * 4 + 1];
                    if (j4 * 4 + 2 < i) a2 -= l4[2] * x[j4 * 4 + 2];
                    if (j4 * 4 + 3 < i) a3 -= l4[3] * x[j4 * 4 + 3]; }
                x[i] = (a0 + a1) + (a2 + a3); }
            if (is_w) {
#pragma unroll
                for (int i = 0; i < 32; ++i) wA[i * LDK + cc] = (bf16)f2bf(x[i]);
            } else {
#pragma unroll
                for (int i = 0; i < 32; ++i) vf[i * 128 + cc] = x[i];
            } }
        else if (c + 1 < SEQ / 32) { DN_LOADS_RAWB(c + 1); __builtin_amdgcn_sched_barrier(0); DN_CONV(rqa, rka, rva, 0); DN_CONV(rqb, rkb, rvb, 1); }
        __syncthreads();
        DPT(14);
        if (c + 1 < SEQ / 32) DN_LOADS_SMALL(c + 1);
        const v4u gcur = *(const v4u*)(G + (rowbase + t0 + tq) * DM + h * 128 + cq * 8);
#pragma unroll
        for (int it = 0; it < 2; ++it) { f32x4 acc = {0.f, 0.f, 0.f, 0.f};
            mma16<128>(acc, wA + it * 16 * LDK, LDK, ST + w * 16 * LDK, LDK, fr, fq);
            float vn[4];
#pragma unroll
            for (int jj = 0; jj < 4; ++jj) vn[jj] = vf[(16 * it + 4 * fq + jj) * 128 + 16 * w + fr] - acc[jj];
            v2u pk; pk.x = pk2(vn[0], vn[1]); pk.y = pk2(vn[2], vn[3]);
            *(v2u*)(vnT + (16 * w + fr) * LDJ + 16 * it + 4 * fq) = pk; }
        __syncthreads();
#pragma unroll
        for (int it = 0; it < 2; ++it) { f32x4 acc = {0.f, 0.f, 0.f, 0.f};
            mma16<128>(acc, qgA + it * 16 * LDK, LDK, ST + w * 16 * LDK, LDK, fr, fq);
            mma16<32>(acc, attn + it * 16 * LDJ, LDJ, vnT + w * 16 * LDJ, LDJ, fr, fq);
#pragma unroll
            for (int jj = 0; jj < 4; ++jj) os[(16 * it + 4 * fq + jj) * 128 + 16 * w + fr] = acc[jj]; }
        {   const float dl = __expf(gc_last);
#pragma unroll
            for (int dt = 0; dt < 8; ++dt) Sacc[dt] = Sacc[dt] * dl;
            const bf16x8 vb_ = *(const bf16x8*)(vnT + (w * 16 + fr) * LDJ + fq * 8);
            const bf16* ka_e = kdT + fr * LDJ + ((fq ^ (fr >> 3)) << 3); const bf16* ka_o = kdT + fr * LDJ + (((fq ^ (fr >> 3)) << 3) ^ 16);
#pragma unroll
            for (int dt = 0; dt < 8; ++dt) { const bf16x8 af_ = *(const bf16x8*)(((dt & 1) ? ka_o : ka_e) + dt * 16 * LDJ);
                Sacc[dt] = __builtin_amdgcn_mfma_f32_16x16x32_bf16(af_, vb_, Sacc[dt], 0, 0, 0); } }
        __syncthreads();
#pragma unroll
        for (int dt = 0; dt < 8; ++dt) { v2u pk; pk.x = pk2(Sacc[dt][0], Sacc[dt][1]); pk.y = pk2(Sacc[dt][2], Sacc[dt][3]);
            *(v2u*)(ST + (16 * w + fr) * LDK + 16 * dt + 4 * fq) = pk; }
        {   const f32x4 o0 = *(const f32x4*)(os + tq * 128 + cq * 8), o1 = *(const f32x4*)(os + tq * 128 + cq * 8 + 4);
            float ss = (o0[0] * o0[0] + o0[1] * o0[1]) + (o0[2] * o0[2] + o0[3] * o0[3]) + (o1[0] * o1[0] + o1[1] * o1[1]) + (o1[2] * o1[2] + o1[3] * o1[3]);
            ss = red16(ss);
            const float r = rsqrtf(ss * (1.f / 128.f) + EPS);
            float g8[8], o8[8], nw8[8]; unpack8(gcur, g8);
            { const f32x4 n0 = *(const f32x4*)nwp, n1 = *(const f32x4*)(nwp + 4); nw8[0] = n0[0]; nw8[1] = n0[1]; nw8[2] = n0[2]; nw8[3] = n0[3]; nw8[4] = n1[0]; nw8[5] = n1[1]; nw8[6] = n1[2]; nw8[7] = n1[3]; }
#pragma unroll
            for (int i = 0; i < 4; ++i) { o8[i] = o0[i] * r * nw8[i] * siluf_(g8[i]); o8[4 + i] = o1[i] * r * nw8[4 + i] * siluf_(g8[4 + i]); }
            *(v4u*)(G + (rowbase + t0 + tq) * DM + h * 128 + cq * 8) = pack8(o8); }
        __syncthreads();
        DPT(15);
    }
#undef DPT
#undef DN_LOADS_RAW
#undef DN_LOADS_RAWB
#undef DN_LOADS_SMALL
#undef DN_CONV
    __syncthreads();
}

__device__ __forceinline__ void ssm_item(unsigned char* lds, CArgsR a, int l, int item) {
    constexpr int LDC = 136, LDX = 40;
    const int b = item >> 4, hd = item & 15, g = hd >> 2;
    bf16* Cs = (bf16*)lds;
    bf16* Bs = Cs + 32 * LDC;
    bf16* BT = Bs + 32 * LDC;
    bf16* xdtT = BT + 128 * LDX;
    bf16* xddT = xdtT + 64 * LDX;
    bf16* Wm = xddT + 64 * LDX;
    bf16* hB = Wm + 32 * LDX;
    float* xs = (float*)(hB + 64 * LDC);
    float* acs = xs + 32 * 64;
    const int tid = opaque_tid(), w = __builtin_amdgcn_readfirstlane(tid >> 6), lane = tid & 63, fr = lane & 15, fq = lane >> 4;
    bf16* base = (bf16*)a.ws;
    const bf16* X = base + (size_t)B_SSX * BUFE; const bf16* BC = base + (size_t)B_SSBC * BUFE; bf16* Z = base + (size_t)B_SSZ * BUFE;
    const float* small = (const float*)(a.ws + WS_SMALL);
    const float* cw = a.in[7] + (size_t)l * 4 * 2048; const float* cb = a.in[8] + (size_t)l * 2048;
    const float dskip = a.in[11][l * 16 + hd];
    const size_t rowbase = (size_t)b * SEQ;
    const int tq = tid >> 4, cq = tid & 15, tv = (tid >> 3) & 31, cv = tid & 7;
    const int it = w >> 2, pt = w & 3;
    f32x4 hacc[4];
#pragma unroll
    for (int i = 0; i < 4; ++i) hacc[i] = (f32x4){0.f, 0.f, 0.f, 0.f};
    for (int i = tid; i < 64 * LDC / 2; i += NTHREADS) ((unsigned*)hB)[i] = 0u;
    v4u rB[4], rC[4], rx[4]; float ra = 0.f, rdtv = 0.f; unsigned rz[4];
#define SSM_LOADS(c_) do { const int t0_ = (c_) * 32; { const int pos_ = t0_ + tq; const size_t ro_ = (rowbase + pos_) * DM; LOAD4(rB, BC + ro_ + g * 128 + cq * 8, pos_); LOAD4(rC, BC + ro_ + 512 + g * 128 + cq * 8, pos_); } \
        if (tid >= 256) { const int pos_ = t0_ + tv; LOAD4(rx, X + (rowbase + pos_) * DM + hd * 64 + cv * 8, pos_); } \
        { const size_t r_ = rowbase + t0_ + (lane & 31); rdtv = small[r_ * 64 + 16 + hd]; ra = small[r_ * 64 + 32 + hd]; } \
        _Pragma("unroll") for (int jj_ = 0; jj_ < 4; ++jj_) rz[jj_] = Z[(rowbase + t0_ + 16 * it + 4 * fq + jj_) * DM + hd * 64 + 16 * pt + fr]; } while (0)
    SSM_LOADS(0);
    for (int c = 0; c < SEQ / 32; ++c) {
        const int t0 = c * 32;
        float acum = ra;
#pragma unroll
        for (int off = 1; off < 32; off <<= 1) { const float t = __shfl_up(acum, off, 32); if ((lane & 31) >= off) acum += t; }
        const float ac_last = __shfl(acum, 31);
        {   float o8[8];
            conv8r(rB, cw + 1024 + g * 128 + cq * 8, 2048, cb + 1024 + g * 128 + cq * 8, o8);
            *(v4u*)(Bs + tq * LDC + cq * 8) = pack8(o8);
#pragma unroll
            for (int i = 0; i < 8; ++i) BT[(cq * 8 + i) * LDX + (tq ^ ((cq & 3) << 3))] = (bf16)f2bf(o8[i]);
            conv8r(rC, cw + 1536 + g * 128 + cq * 8, 2048, cb + 1536 + g * 128 + cq * 8, o8);
            *(v4u*)(Cs + tq * LDC + cq * 8) = pack8(o8);
        }
        if (tid < 32) acs[tid] = acum;
        unsigned zr[4];
#pragma unroll
        for (int jj = 0; jj < 4; ++jj) zr[jj] = rz[jj];
        __syncthreads();
        if (w >= 4) { float o8[8]; conv8r(rx, cw + hd * 64 + cv * 8, 2048, cb + hd * 64 + cv * 8, o8);
            const float dtv = __shfl(rdtv, tv), dd = dtv * __expf(ac_last - __shfl(acum, tv));
            *(f32x4*)(xs + tv * 64 + cv * 8) = (f32x4){o8[0], o8[1], o8[2], o8[3]}; *(f32x4*)(xs + tv * 64 + cv * 8 + 4) = (f32x4){o8[4], o8[5], o8[6], o8[7]};
#pragma unroll
            for (int i = 0; i < 8; ++i) { xdtT[(cv * 8 + i) * LDX + (tv ^ ((cv & 3) << 3))] = (bf16)f2bf(o8[i] * dtv); xddT[(cv * 8 + i) * LDX + (tv ^ ((cv & 3) << 3))] = (bf16)f2bf(o8[i] * dd); }
        }
        else { const int gi = w >> 1, gj = w & 1; f32x4 acc = {0.f, 0.f, 0.f, 0.f};
            mma16<128>(acc, Cs + gi * 16 * LDC, LDC, Bs + gj * 16 * LDC, LDC, fr, fq);
            const int sI = 16 * gj + fr; const float as = acs[sI];
#pragma unroll
            for (int jj = 0; jj < 4; ++jj) { const int lI = 16 * gi + 4 * fq + jj; const float v = sI <= lI ? acc[jj] * __expf(acs[lI] - as) : 0.f; Wm[lI * LDX + sI] = (bf16)f2bf(v); } }
        if (c + 1 < SEQ / 32) SSM_LOADS(c + 1);
        __syncthreads();
        {   f32x4 a1 = {0.f, 0.f, 0.f, 0.f}, a2 = {0.f, 0.f, 0.f, 0.f};
            mma32s<false, true>(a1, Wm, it * 16, LDX, xdtT, pt * 16, LDX, fr, fq);
            mma16<128>(a2, Cs + it * 16 * LDC, LDC, hB + pt * 16 * LDC, LDC, fr, fq);
            const int p = 16 * pt + fr;
#pragma unroll
            for (int jj = 0; jj < 4; ++jj) { const int lI = 16 * it + 4 * fq + jj;
                const float y = a1[jj] + __expf(acs[lI]) * a2[jj] + xs[lI * 64 + p] * dskip;
                Z[(rowbase + t0 + lI) * DM + hd * 64 + p] = (bf16)f2bf(y * siluf_(bf2f(zr[jj]))); }
            const float dl = __expf(ac_last);
#pragma unroll
            for (int p2 = 0; p2 < 4; ++p2) { hacc[p2] = hacc[p2] * dl; mma32s<true, true>(hacc[p2], xddT, p2 * 16, LDX, BT, w * 16, LDX, fr, fq); }
        }
        __syncthreads();
#pragma unroll
        for (int p2 = 0; p2 < 4; ++p2)
#pragma unroll
            for (int jj = 0; jj < 4; ++jj) hB[(16 * p2 + 4 * fq + jj) * LDC + 16 * w + fr] = (bf16)f2bf(hacc[p2][jj]);
    }
#undef SSM_LOADS
    __syncthreads();
}

__device__ __forceinline__ void sb_item(unsigned char* lds, CArgsR a, int b, int hd, int qi) {
    constexpr int LD = 72;
    bf16* Ks = (bf16*)lds; bf16* Vs = Ks + 2 * 64 * LD;
    volatile unsigned* alive = (volatile unsigned*)(Vs + 2 * 64 * LD);
    const int tid = opaque_tid(), w = __builtin_amdgcn_readfirstlane(tid >> 6), lane = tid & 63, fr = lane & 15, fq = lane >> 4;
    bf16* base = (bf16*)a.ws;
    bf16* Qb = base + (size_t)B_SBQ * BUFE; const bf16* Kb = base + (size_t)B_SBK * BUFE; const bf16* Vb = base + (size_t)B_SBV * BUFE;
    const size_t rowbase = (size_t)b * SEQ;
    const int t0 = qi * 128, myq = t0 + w * 16 + fr, wmax = t0 + w * 16 + 15;
    bf16* qrow = Qb + (rowbase + myq) * DM + hd * 64;
    bf16x8 qf[2];
    qf[0] = *(const bf16x8*)(qrow + fq * 8); qf[1] = *(const bf16x8*)(qrow + 32 + fq * 8);
    f32x4 oacc[4];
#pragma unroll
    for (int i = 0; i < 4; ++i) oacc[i] = (f32x4){0.f, 0.f, 0.f, 0.f};
    float carry = 1.f;
    const int kr = tid >> 3, d8 = (tid & 7) * 8;
    v4u kreg, vreg;
    int kt = 2 * (qi + 1) - 1;
#define SB_LOAD(t) do { const size_t o_ = (rowbase + (size_t)(t) * 64 + kr) * DM + hd * 64 + d8; kreg = *(const v4u*)(Kb + o_); vreg = *(const v4u*)(Vb + o_); } while (0)
#define SB_STORE(bu) do { *(v4u*)(Ks + (bu) * 64 * LD + kr * LD + d8) = kreg; bf16* vd_ = Vs + (bu) * 64 * LD + d8 * LD + (kr ^ (((d8 >> 3) & 7) << 3)); \
        vd_[0] = (bf16)(vreg.x & 0xffffu); vd_[LD] = (bf16)(vreg.x >> 16); vd_[2 * LD] = (bf16)(vreg.y & 0xffffu); vd_[3 * LD] = (bf16)(vreg.y >> 16); \
        vd_[4 * LD] = (bf16)(vreg.z & 0xffffu); vd_[5 * LD] = (bf16)(vreg.z >> 16); vd_[6 * LD] = (bf16)(vreg.w & 0xffffu); vd_[7 * LD] = (bf16)(vreg.w >> 16); } while (0)
    SB_LOAD(kt); SB_STORE(0);
    __syncthreads();
    int cur = 0;
    for (; kt >= 0; --kt) {
        if (kt > 0) SB_LOAD(kt - 1);
        const int kbase = kt * 64;
        if (kbase <= wmax) {
            const bf16* Kc = Ks + cur * 64 * LD; const bf16* Vc = Vs + cur * 64 * LD;
            f32x4 z[4];
#pragma unroll
            for (int nt = 0; nt < 4; ++nt) { z[nt] = (f32x4){0.f, 0.f, 0.f, 0.f};
#pragma unroll
                for (int k2 = 0; k2 < 2; ++k2) { const bf16x8 af = *(const bf16x8*)(Kc + (nt * 16 + fr) * LD + k2 * 32 + fq * 8);
                    z[nt] = __builtin_amdgcn_mfma_f32_16x16x32_bf16(af, qf[k2], z[nt], 0, 0, 0); } }
            float kp[4][4], sg[4][4], T[4], tot[4], suf[4];
            const bool masked = kbase + 64 > t0 + w * 16;
#pragma unroll
            for (int nt = 0; nt < 4; ++nt) {
#pragma unroll
                for (int j = 0; j < 4; ++j) { const float z2 = z[nt][j] * 0.18033688011112042f;
                    const float ea = __builtin_amdgcn_exp2f(-fabsf(z2)), rc = __builtin_amdgcn_rcpf(1.f + ea); const bool pos = z2 >= 0.f;
                    sg[nt][j] = (pos ? 1.f : ea) * rc; kp[nt][j] = (pos ? ea : 1.f) * rc; }
                if (masked) {
#pragma unroll
                    for (int j = 0; j < 4; ++j) { const bool valid = kbase + nt * 16 + fq * 4 + j < myq; sg[nt][j] = valid ? sg[nt][j] : 0.f; kp[nt][j] = valid ? kp[nt][j] : 1.f; } }
                T[nt] = (kp[nt][0] * kp[nt][1]) * (kp[nt][2] * kp[nt][3]); }
#pragma unroll
            for (int nt = 0; nt < 4; ++nt) { const float p16 = __shfl_xor(T[nt], 16), s1 = T[nt] * p16, p32 = __shfl_xor(s1, 32); tot[nt] = s1 * p32;
                suf[nt] = fq == 0 ? p16 * p32 : fq == 1 ? p32 : fq == 2 ? p16 : 1.f; }
            float run = carry; float wv[4][4];
#pragma unroll
            for (int nt = 3; nt >= 0; --nt) { const float r3 = run * suf[nt], r2 = r3 * kp[nt][3], r1 = r2 * kp[nt][2], r0 = r1 * kp[nt][1];
                wv[nt][0] = sg[nt][0] * r0; wv[nt][1] = sg[nt][1] * r1; wv[nt][2] = sg[nt][2] * r2; wv[nt][3] = sg[nt][3] * r3;
                run *= tot[nt]; }
            carry = run;
#pragma unroll
            for (int kk = 0; kk < 2; ++kk) {
                v4u bw; bw.x = pk2(wv[2 * kk][0], wv[2 * kk][1]); bw.y = pk2(wv[2 * kk][2], wv[2 * kk][3]); bw.z = pk2(wv[2 * kk + 1][0], wv[2 * kk + 1][1]); bw.w = pk2(wv[2 * kk + 1][2], wv[2 * kk + 1][3]);
                const bf16x8 bfr = __builtin_bit_cast(bf16x8, bw);
#pragma unroll
                for (int mt = 0; mt < 4; ++mt) { const int vr = mt * 16 + fr, vs = ((vr >> 3) & 7) << 3; const bf16* vrow = Vc + vr * LD;
                    const v2u lo = *(const v2u*)(vrow + ((32 * kk + 4 * fq) ^ vs)), hi = *(const v2u*)(vrow + ((32 * kk + 16 + 4 * fq) ^ vs));
                    v4u av; av.x = lo.x; av.y = lo.y; av.z = hi.x; av.w = hi.y;
                    oacc[mt] = __builtin_amdgcn_mfma_f32_16x16x32_bf16(__builtin_bit_cast(bf16x8, av), bfr, oacc[mt], 0, 0, 0); }
            }
        }
        {   const bool any_alive = __ballot(carry != 0.f) != 0ull;
            if (lane == 0) alive[cur * 8 + w] = any_alive ? 1u : 0u; }
        if (kt > 0) SB_STORE(cur ^ 1);
        __syncthreads();
        unsigned al = 0u;
#pragma unroll
        for (int i = 0; i < 8; ++i) al |= alive[cur * 8 + i];
        if (al == 0u) break;
        cur ^= 1;
    }
#undef SB_LOAD
#undef SB_STORE
#pragma unroll
    for (int mt = 0; mt < 4; ++mt) { v2u wq; wq.x = pk2(oacc[mt][0], oacc[mt][1]); wq.y = pk2(oacc[mt][2], oacc[mt][3]); *(v2u*)(qrow + mt * 16 + fq * 4) = wq; }
}

__device__ __forceinline__ void phase_mixers(unsigned char* lds, CArgsR a, int l, unsigned long long& probe_acc) {
    unsigned* ctl = (unsigned*)(a.ws + WS_CTL);
    unsigned* counter = ctl + 64 * l; unsigned* gdone = ctl + 64 * l + 32;
    volatile unsigned* slot = (volatile unsigned*)(lds + LDS_BYTES - 64);
    constexpr int NDN = 64;
    const int nb = (int)gridDim.x - NDN;
    if ((int)blockIdx.x < NDN) { PT0(); dn_item(lds, a, l, (int)blockIdx.x, probe_acc); if (blockIdx.x == 0 && l == 0) PT1(9); }
    else {
        bf16* base = (bf16*)a.ws; bf16* Wreg = (bf16*)(a.ws + WS_W);
        pg8::Gemm g{base, Wreg + W_IN + (size_t)4096 * DM, MT, 6144, DM}; pg8::StaticOrder S; S.init(MT, 6144, nb, (int)blockIdx.x - NDN);
        EpiRoute E{base, 16};
        pg8::gemm_phase<EpiRoute, pg8::StaticOrder, true, true>((PG8_LAS unsigned char*)lds, g, S, E);
        __builtin_amdgcn_fence(__ATOMIC_RELEASE, "agent");
        asm volatile("s_waitcnt vmcnt(0)" ::: "memory");
        __syncthreads();
        if (threadIdx.x == 0) __hip_atomic_fetch_add(gdone, 1u, __ATOMIC_RELAXED, __HIP_MEMORY_SCOPE_AGENT);
    }
    if (threadIdx.x == 0) {
        unsigned sp = 0u;
        while (__hip_atomic_load(gdone, __ATOMIC_RELAXED, __HIP_MEMORY_SCOPE_AGENT) < (unsigned)nb && ++sp < (1u << 22)) __builtin_amdgcn_s_sleep(2);
        __builtin_amdgcn_fence(__ATOMIC_ACQUIRE, "agent");
        asm volatile("s_waitcnt vmcnt(0)" ::: "memory");
    }
    __syncthreads();
    constexpr unsigned NITEMS = 128 + 2048;
    for (;;) {
        if (threadIdx.x == 0) *slot = __hip_atomic_fetch_add(counter, 1u, __ATOMIC_RELAXED, __HIP_MEMORY_SCOPE_AGENT);
        __syncthreads();
        const unsigned item = *slot;
        __syncthreads();
        if (item >= NITEMS) break;
        PT0();
        if (item < 128) { ssm_item(lds, a, l, (int)item); if (item == 0 && l == 0) PT1(10); }
        else { const int r = (int)item - 128, qi = 15 - (r >> 7), bh = r & 127; sb_item(lds, a, bh >> 4, bh & 15, qi); if (item == 128 && l == 0) PT1(11); }
    }
}

__device__ __forceinline__ void phase_norms(CArgsR a, int l) {
    const int tid = opaque_tid(), lane = tid & 63, wave = tid >> 6, gw = blockIdx.x * NWAVES + wave, NGW = gridDim.x * NWAVES;
    bf16* base = (bf16*)a.ws;
    const bf16* Oraw = base + (size_t)B_DNV * BUFE; bf16* G = base + (size_t)B_DNG * BUFE; bf16* Y = base + (size_t)B_SSZ * BUFE;
    const float* dnw = a.in[6] + (size_t)l * 128 + (lane & 7) * 16; const float* snw = a.in[12] + (size_t)l * DM + lane * 16;
    float w1[16], w2[16];
#pragma unroll
    for (int i = 0; i < 16; ++i) { w1[i] = dnw[i]; w2[i] = snw[i]; }
    for (int m = gw; m < MT; m += NGW) {
        const size_t o = (size_t)m * DM + lane * 16;
        float v[16], s, r;
        unpack8(*(const v4u*)(Y + o), v); unpack8(*(const v4u*)(Y + o + 8), v + 8);
        s = 0.f;
#pragma unroll
        for (int i = 0; i < 16; ++i) s += v[i] * v[i];
        s = red16(s);
        r = rsqrtf(s * (1.f / 256.f) + EPS);
#pragma unroll
        for (int i = 0; i < 16; ++i) v[i] = v[i] * r * w2[i];
        *(v4u*)(Y + o) = pack8(v); *(v4u*)(Y + o + 8) = pack8(v + 8);
    }
}

#define LAS __attribute__((address_space(3)))
#define XB_TMO      128
#define XB_XCNT(j)  (256  + 64 * (j))
#define XB_XSUB(j)  (1280 + 64 * (j))
#define XB_XGEN(j)  (2304 + 64 * (j))
#define XB_TOP      3328
#define XB_TOPGEN   3392
#define XCD_BAR_WORDS 3456
#define XB_SPIN_CAP (1u << 18)

__device__ __forceinline__ unsigned xb_ld(unsigned* p)              { return __hip_atomic_load(p, __ATOMIC_RELAXED, __HIP_MEMORY_SCOPE_AGENT); }
__device__ __forceinline__ unsigned xb_add(unsigned* p, unsigned v) { return __hip_atomic_fetch_add(p, v, __ATOMIC_RELAXED, __HIP_MEMORY_SCOPE_AGENT); }
__device__ __forceinline__ unsigned xb_xcc_id() { return (unsigned)__builtin_amdgcn_s_getreg((3 << 11) | 20) & 0xFu; }
#define XB_SPIN(cond, bar) do { unsigned _sp = 0; while (cond) { __builtin_amdgcn_s_sleep(1); \
    if ((++_sp & 255u) == 0u) { if (xb_ld(&(bar)[XB_TMO])) break; if (_sp > XB_SPIN_CAP) { atomicAdd(&(bar)[XB_TMO], 1u); break; } } } } while (0)

struct XcdBarrier {
    unsigned* bar; unsigned x;
    volatile LAS unsigned* st;
};

__device__ __forceinline__ XcdBarrier xcd_barrier_post(unsigned* bar, volatile LAS unsigned* st) {
    XcdBarrier b; b.bar = bar; b.x = xb_xcc_id(); b.st = st;
    if (threadIdx.x == 0) (void)xb_add(&bar[XB_XCNT(b.x)], 1u);
    return b;
}
__device__ __forceinline__ void xcd_barrier_complete(unsigned* bar, unsigned x, unsigned& nloc, unsigned& nx) {
    const unsigned G = gridDim.x * gridDim.y * gridDim.z;
    unsigned sum, cnt, mine, sp = 0u;
    for (;;) {
        sum = 0u; cnt = 0u; mine = 0u;
#pragma unroll
        for (unsigned j = 0; j < 16; ++j) { const unsigned c = xb_ld(&bar[XB_XCNT(j)]); sum += c; cnt += (c > 0u) ? 1u : 0u; mine = (j == x) ? c : mine; }
        if (sum == G) break;
        __builtin_amdgcn_s_sleep(1);
        if ((++sp & 255u) == 0u) { if (xb_ld(&bar[XB_TMO])) break; if (sp > XB_SPIN_CAP) { atomicAdd(&bar[XB_TMO], 1u); break; } }
    }
    nloc = mine > 0u ? mine : 1u; nx = cnt > 0u ? cnt : 1u;
}

__device__ __forceinline__ void xcd_barrier(const XcdBarrier& b) {
    asm volatile("s_waitcnt vmcnt(0)" ::: "memory");
    __syncthreads();
    if (threadIdx.x == 0) {
        unsigned* bar = b.bar;
        __builtin_amdgcn_s_waitcnt(0);
        unsigned nloc = b.st[0], nx = b.st[1];
        if (nloc == 0u) { xcd_barrier_complete(bar, b.x, nloc, nx); b.st[0] = nloc; b.st[1] = nx; }
        const unsigned old = xb_add(&bar[XB_XSUB(b.x)], 1u);
        const unsigned gen = old / nloc;
        if (old + 1u == (gen + 1u) * nloc) {
            __builtin_amdgcn_fence(__ATOMIC_RELEASE, "agent");
            asm volatile("s_waitcnt vmcnt(0)" ::: "memory");
            const unsigned og = xb_add(&bar[XB_TOP], 1u);
            const unsigned tg = og / nx;
            if (og + 1u == (tg + 1u) * nx) xb_add(&bar[XB_TOPGEN], 1u);
            else XB_SPIN(xb_ld(&bar[XB_TOPGEN]) == tg, bar);
            __builtin_amdgcn_fence(__ATOMIC_ACQUIRE, "agent");
            xb_add(&bar[XB_XGEN(b.x)], 1u);
            asm volatile("s_waitcnt vmcnt(0)" ::: "memory");
        } else {
            XB_SPIN(xb_ld(&bar[XB_XGEN(b.x)]) == gen, bar);
            __builtin_amdgcn_fence(__ATOMIC_ACQUIRE, "agent");
            asm volatile("s_waitcnt vmcnt(0)" ::: "memory");
        }
    }
    __syncthreads();
}

__global__ void __launch_bounds__(NTHREADS, 2) hybrid_fwd(Args a_unused) {
    extern __shared__ __attribute__((aligned(16))) unsigned char lds[];
    cg::grid_group grid = cg::this_grid();
    PG8_LAS unsigned char* ldsl = (PG8_LAS unsigned char*)lds;
    unsigned long long probe_acc = 0ull;
#define A_ (*kargs())
    volatile LAS unsigned* bst = (volatile LAS unsigned*)((LAS unsigned char*)lds + LDS_BYTES - 32);
    if (threadIdx.x == 0) { bst[0] = 0u; bst[1] = 0u; }
    __syncthreads();
    const XcdBarrier bar = xcd_barrier_post((unsigned*)(a_unused.ws + WS_BAR), bst);
#pragma unroll 1
    for (int l = 0; l < 2; ++l) {
        asm volatile("" : "+s"(l));
        {   CArgsR a = A_; const float* xin = l == 0 ? a.in[0] : a.out;
            PT0(); phase0(lds, a, l, xin);
        if (l == 0) grid.sync(); else xcd_barrier(bar); PT1(0); }
        {   CArgsR a = A_; bf16* base = (bf16*)a.ws; bf16* Wreg = (bf16*)(a.ws + WS_W);
            pg8::Gemm g{base, Wreg + W_IN, MT, 4096, DM}; pg8::StaticOrder S; S.init(MT, 4096, (int)gridDim.x, (int)blockIdx.x);
            EpiRoute E{base, 0};
            PT0(); pg8::gemm_phase<EpiRoute, pg8::StaticOrder, true, true>(ldsl, g, S, E);
        xcd_barrier(bar); PT1(1); }
        { PT0(); phase_mixers(lds, A_, l, probe_acc);
        xcd_barrier(bar); PT1(2); }
        { PT0(); phase_norms(A_, l);
        xcd_barrier(bar); PT1(3); }
        {   CArgsR a = A_; bf16* base = (bf16*)a.ws; bf16* Wreg = (bf16*)(a.ws + WS_W);
            pg8::Gemm g{base, Wreg + W_G, 4 * MT, 6144, DM}; SchedGate S{(int)gridDim.x, (int)blockIdx.x};
            EpiGate E{base + (size_t)B_SBK * BUFE, (float*)(base + (size_t)B_DNK * BUFE), base + (size_t)B_DNQ * BUFE};
            PT0(); pg8::gemm_phase<EpiGate, SchedGate, true, true>(ldsl, g, S, E);
        xcd_barrier(bar); PT1(4); }
        {   CArgsR a = A_; bf16* base = (bf16*)a.ws; bf16* Wreg = (bf16*)(a.ws + WS_W); const float* xin = l == 0 ? a.in[0] : a.out;
            pg8::Gemm g{base + (size_t)B_DNQ * BUFE, Wreg + W_OUT, MT, DM, DM}; pg8::StaticOrder S; S.init(MT, DM, (int)gridDim.x, (int)blockIdx.x);
            EpiResid E{xin, a.out};
            PT0(); pg8::gemm_phase<EpiResid, pg8::StaticOrder, false, false>(ldsl, g, S, E);
        xcd_barrier(bar); PT1(5); }
        {   CArgsR a = A_; bf16* base = (bf16*)a.ws; const float* nw = a.in[15] + (size_t)l * DM; const float* xo = a.out;
            const int tid = opaque_tid(), lane = tid & 63, gw = blockIdx.x * NWAVES + (tid >> 6), NGW = gridDim.x * NWAVES;
            PT0(); for (int m = gw; m < MT; m += NGW) rms_row_to_bf16(xo + (size_t)m * DM, nw, base + (size_t)m * DM, lane);
        xcd_barrier(bar); PT1(6); }
        {   CArgsR a = A_; bf16* base = (bf16*)a.ws; bf16* Wreg = (bf16*)(a.ws + WS_W);
            pg8::Gemm g{base, Wreg + W_UP, MT, DFF, DM}; pg8::StaticOrder S; S.init(MT, DFF, (int)gridDim.x, (int)blockIdx.x);
            EpiRelu2 E{base + (size_t)B_DNQ * BUFE};
            PT0(); pg8::gemm_phase<EpiRelu2, pg8::StaticOrder, true, true>(ldsl, g, S, E);
        xcd_barrier(bar); PT1(7); }
        {   CArgsR a = A_; bf16* base = (bf16*)a.ws; bf16* Wreg = (bf16*)(a.ws + WS_W);
            pg8::Gemm g{base + (size_t)B_DNQ * BUFE, Wreg + W_DOWN, MT, DM, DFF}; pg8::StaticOrder S; S.init(MT, DM, (int)gridDim.x, (int)blockIdx.x);
            EpiResid E{a.out, a.out};
            PT0(); pg8::gemm_phase<EpiResid, pg8::StaticOrder, false, false>(ldsl, g, S, E);
        xcd_barrier(bar); PT1(8); }
    }
    {
        CArgsR a = A_; const float* nw = a.in[18]; float* xo = a.out;
        const int tid = opaque_tid(), lane = tid & 63, gw = blockIdx.x * NWAVES + (tid >> 6), NGW = gridDim.x * NWAVES;
        for (int m = gw; m < MT; m += NGW) {
            f32x4* xr = (f32x4*)(xo + (size_t)m * DM) + lane; const f32x4* wr = (const f32x4*)nw + lane;
            f32x4 v[4]; float s = 0.f;
#pragma unroll
            for (int j = 0; j < 4; ++j) { v[j] = xr[64 * j]; s += (v[j][0] * v[j][0] + v[j][1] * v[j][1]) + (v[j][2] * v[j][2] + v[j][3] * v[j][3]); }
            const float rstd = rsqrtf(wave_sum(s) * (1.f / DM) + EPS);
#pragma unroll
            for (int j = 0; j < 4; ++j) { const f32x4 ww = wr[64 * j]; f32x4 r;
#pragma unroll
                for (int i = 0; i < 4; ++i) r[i] = v[j][i] * rstd * ww[i];
                xr[64 * j] = r; }
        }
    }
#undef A_
    if (PROBE_SEL) { const unsigned long long t0 = rt(); while (rt() - t0 < probe_acc) __builtin_amdgcn_s_sleep(8); }
}

extern "C" void kernel_launch(void* const* d_in, const int* in_sizes, int n_in, void* d_out, int out_size, void* d_ws, size_t ws_size, hipStream_t stream) {
    static int grid = 0;
    if (grid == 0) {
        if (n_in != 19 || out_size != MT * DM || ws_size < WS_NEED) { fprintf(stderr, "kernel_launch: unexpected shapes (n_in %d out %d ws %zu need %zu)\n", n_in, out_size, ws_size, (size_t)WS_NEED); grid = -1; return; }
        int dev = 0, cus = 0, per_cu = 0;
        hipGetDevice(&dev); hipDeviceGetAttribute(&cus, hipDeviceAttributeMultiprocessorCount, dev);
        if (hipFuncSetAttribute((const void*)hybrid_fwd, hipFuncAttributeMaxDynamicSharedMemorySize, LDS_BYTES) != hipSuccess) { fprintf(stderr, "kernel_launch: hipFuncSetAttribute failed\n"); grid = -1; return; }
        if (hipOccupancyMaxActiveBlocksPerMultiprocessor(&per_cu, (const void*)hybrid_fwd, NTHREADS, LDS_BYTES) != hipSuccess || per_cu < 1) { fprintf(stderr, "kernel_launch: occupancy query gave %d\n", per_cu); per_cu = 1; }
        (void)hipGetLastError();
        grid = cus * per_cu;
    }
    if (grid < 0) return;
    if (hipMemsetAsync((char*)d_ws + WS_CTL, 0, CTL_BYTES, stream) != hipSuccess) { fprintf(stderr, "kernel_launch: memset of the control words failed\n"); return; }
    Args a{};
    for (int i = 0; i < 19; ++i) a.in[i] = (const float*)d_in[i];
    a.out = (float*)d_out; a.ws = (unsigned char*)d_ws;
    void* args[] = {&a};
    hipError_t e = hipLaunchCooperativeKernel((const void*)hybrid_fwd, dim3(grid), dim3(NTHREADS), args, LDS_BYTES, stream);
    if (e != hipSuccess) fprintf(stderr, "cooperative launch failed: %s (grid %d)\n", hipGetErrorString(e), grid);
}
```

```cpp
#include <hip/hip_runtime.h>
#include <hip/hip_cooperative_groups.h>
#include <cstdio>
#include <cstdint>
namespace cg = cooperative_groups;
__device__ __forceinline__ int opaque_tid() { int t = (int)threadIdx.x; asm volatile("" : "+v"(t)); return t; }
namespace pg8 {
#define PG8_LAS __attribute__((address_space(3)))
typedef unsigned short bf16_t;
typedef short bf16x8 __attribute__((ext_vector_type(8)));
typedef float f32x4 __attribute__((ext_vector_type(4)));
typedef unsigned u32x4 __attribute__((ext_vector_type(4)));
constexpr int BM = 256, BK = 64, HALF = 128, HTB = HALF * BK * 2  , STAGE_BYTES = 8 * HTB, NXCD = 8, WGM = 8;

__host__ __device__ __forceinline__ int lds_byte(int r, int c) { const int st = (r >> 4) * 2 + (c >> 5), rr = r & 15, cc = c & 31, ob = rr * 64 + cc * 2; return st * 1024 + (ob ^ (((ob >> 9) & 1) << 5)); }
__host__ __device__ __forceinline__ void stage_rc(int b, int& R, int& C) { const int st = b / 1024, sb = b % 1024, swz = sb ^ (((sb >> 9) & 1) << 5); R = (st >> 1) * 16 + swz / 64; C = (st & 1) * 32 + (swz % 64) / 2; }
__host__ __device__ __forceinline__ int perm32(int rho) { const int n = rho >> 4, i = rho & 15; return 8 * (i >> 2) + 4 * n + (i & 3); }

struct Unit { int pm, pn; };
struct Gemm { const bf16_t* A; const bf16_t* Bt; int M, N, K; };

struct StaticOrder {
    int nM, nN, nwg, G, c;
    __host__ __device__ void init(int M, int N, int G_, int c_) { nM = M / BM; nN = N / BM; nwg = nM * nN; G = G_; c = c_; }
    __host__ __device__ bool next(int i, Unit& u) const {
        const long L = (long)i * G + c; if (L >= nwg) return false;
        int wgid = (int)L; { const int q = nwg / NXCD, r = nwg % NXCD, xcd = wgid % NXCD, off = wgid / NXCD; wgid = (xcd < r ? xcd * (q + 1) : r * (q + 1) + (xcd - r) * q) + off; }
        const int nig = WGM * nN, gid = wgid / nig, fm = gid * WGM, gsz = (nM - fm) < WGM ? (nM - fm) : WGM;
        u.pm = fm + ((wgid % nig) % gsz); u.pn = (wgid % nig) / gsz; return true;
    }
    __device__ __forceinline__ void a_ready(const Unit&) const {}
    __device__ __forceinline__ void done(const Unit&) const {}
};
__device__ __forceinline__ unsigned cvt_pk_bf16(float lo, float hi) { unsigned r; asm volatile("v_cvt_pk_bf16_f32 %0, %1, %2" : "=v"(r) : "v"(lo), "v"(hi)); return r; }
template <class Epi, class Sched, bool ALIGN_EPI = false, bool SP2 = false>
__device__ __forceinline__ void gemm_phase(PG8_LAS unsigned char* lds, const Gemm g, const Sched& S, const Epi& E) {
    const int tid = opaque_tid(), wid = __builtin_amdgcn_readfirstlane(tid >> 6), lane = tid & 63, wr = wid >> 2, wc = wid & 3, fr = lane & 15, fq = lane >> 4;
    const int K = g.K, nt = K / BK;
    unsigned voffA[2], voffB[2];
#pragma unroll
    for (int i = 0; i < 2; ++i) { int R, C; stage_rc(tid * 16 + i * 8192, R, C); const int Rb = Epi::PERM ? ((R & ~31) + perm32(R & 31)) : R;
        voffA[i] = (unsigned)(R * K + C) * 2u; voffB[i] = (unsigned)(Rb * K + C) * 2u; }
    const size_t kstep = (size_t)(BK * 2);
    const size_t hstep = (size_t)HALF * K * 2;
    const size_t tstep = 2 * hstep;
    const unsigned ldsw = (unsigned)wid * 1024u;
    const int aoff = lds_byte(wr * 64 + fr, fq * 8), boff = lds_byte(wc * 32 + fr, fq * 8);
#define PG8_SA(b, h) (((b) * 2 + (h)) * HTB)
#define PG8_SB(b, h) ((4 + (b) * 2 + (h)) * HTB)
#define PG8_STAGE(bufoff, gbase, voff) do { _Pragma("unroll") for (int _i = 0; _i < 2; ++_i) \
        __builtin_amdgcn_global_load_lds((const unsigned*)((const char*)(gbase) + (voff)[_i]), (PG8_LAS unsigned*)(lds + (bufoff) + ldsw + _i * 8192), 16, 0, 0); } while (0)
#define PG8_LDA(dst, b, h) do { _Pragma("unroll") for (int m = 0; m < 4; ++m) _Pragma("unroll") for (int k = 0; k < 2; ++k) dst[m][k] = *(const PG8_LAS bf16x8*)(lds + PG8_SA(b, h) + aoff + m * 2048 + k * 1024); } while (0)
#define PG8_LDB(dst, b, h) do { _Pragma("unroll") for (int n = 0; n < 2; ++n) _Pragma("unroll") for (int k = 0; k < 2; ++k) dst[n][k] = *(const PG8_LAS bf16x8*)(lds + PG8_SB(b, h) + boff + n * 2048 + k * 1024); } while (0)
#define PG8_MMA(ai, bj, At, Bt) do { __builtin_amdgcn_s_setprio(1); _Pragma("unroll") for (int m = 0; m < 4; ++m) _Pragma("unroll") for (int n = 0; n < 2; ++n) _Pragma("unroll") for (int k = 0; k < 2; ++k) \
        acc[ai][bj][m][n] = __builtin_amdgcn_mfma_f32_16x16x32_bf16(Bt[n][k], At[m][k], acc[ai][bj][m][n], 0, 0, 0); __builtin_amdgcn_s_setprio(0); } while (0)
#define PG8_WAIT_V(n) asm volatile("s_waitcnt vmcnt(" #n ")" ::: "memory")
#define PG8_WAIT_L(n) asm volatile("s_waitcnt lgkmcnt(" #n ")" ::: "memory")
#define PG8_BAR __builtin_amdgcn_s_barrier()
#define PG8_SCHED __builtin_amdgcn_sched_barrier(0)
    Unit cur, nxt; int ui = 0;
    if (!S.next(0, cur)) return;
    f32x4 acc[2][2][4][2];
#pragma unroll
    for (int a = 0; a < 2; ++a)
#pragma unroll
        for (int b = 0; b < 2; ++b)
#pragma unroll
            for (int m = 0; m < 4; ++m)
#pragma unroll
                for (int n = 0; n < 2; ++n) acc[a][b][m][n] = (f32x4){0.f, 0.f, 0.f, 0.f};
    bf16x8 At[4][2], B0[2][2], B1[2][2];
    const char* cA = (const char*)g.A + (size_t)cur.pm * tstep; const char* cB = (const char*)g.Bt + (size_t)cur.pn * tstep;
    S.a_ready(cur);
    if constexpr (SP2) {
        PG8_STAGE(PG8_SB(0, 0), cB, voffB); PG8_STAGE(PG8_SB(0, 1), cB + hstep, voffB); PG8_STAGE(PG8_SA(0, 0), cA, voffA); PG8_STAGE(PG8_SA(0, 1), cA + hstep, voffA);
        if (wr == 1) PG8_BAR;
        PG8_WAIT_V(2); PG8_BAR;
        PG8_STAGE(PG8_SB(1, 0), cB + kstep, voffB); PG8_STAGE(PG8_SA(1, 0), cA + kstep, voffA); PG8_STAGE(PG8_SB(1, 1), cB + hstep + kstep, voffB);
        PG8_WAIT_V(6); PG8_BAR;
    } else {
        PG8_STAGE(PG8_SB(0, 0), cB, voffB); PG8_STAGE(PG8_SA(0, 0), cA, voffA); PG8_STAGE(PG8_SB(0, 1), cB + hstep, voffB); PG8_STAGE(PG8_SA(0, 1), cA + hstep, voffA);
        if (wr == 1) PG8_BAR;
        PG8_WAIT_V(4); PG8_BAR;
        PG8_STAGE(PG8_SB(1, 0), cB + kstep, voffB); PG8_STAGE(PG8_SA(1, 0), cA + kstep, voffA); PG8_STAGE(PG8_SB(1, 1), cB + hstep + kstep, voffB);
        PG8_WAIT_V(6); PG8_BAR;
    }
    for (;;) {
        const bool has_next = S.next(ui + 1, nxt);
        const char* nA = has_next ? (const char*)g.A + (size_t)nxt.pm * tstep : cA; const char* nB = has_next ? (const char*)g.Bt + (size_t)nxt.pn * tstep : cB;
        for (int t = 0; t < nt; t += 2) {
            const bool last = (t == nt - 2);
            const char* a1 = cA + (size_t)(t + 1) * kstep;
            const char* a2 = last ? nA : cA + (size_t)(t + 2) * kstep; const char* b2 = last ? nB : cB + (size_t)(t + 2) * kstep;
            const char* a3 = a2 + kstep; const char* b3 = b2 + kstep;
            if (last && has_next) S.a_ready(nxt);
            if constexpr (SP2) {
            PG8_LDB(B0, 0, 0); PG8_LDB(B1, 0, 1); PG8_SCHED; PG8_LDA(At, 0, 0); PG8_STAGE(PG8_SA(1, 1), a1 + hstep, voffA);
            PG8_WAIT_V(8); PG8_WAIT_L(0); PG8_BAR; PG8_MMA(0, 0, At, B0); PG8_MMA(0, 1, At, B1); PG8_BAR; PG8_SCHED;
            PG8_LDA(At, 0, 1); PG8_STAGE(PG8_SB(0, 0), b2, voffB); PG8_STAGE(PG8_SB(0, 1), b2 + hstep, voffB); PG8_STAGE(PG8_SA(0, 0), a2, voffA);
            PG8_WAIT_V(8); PG8_WAIT_L(0); PG8_BAR; PG8_MMA(1, 0, At, B0); PG8_MMA(1, 1, At, B1); PG8_BAR; PG8_SCHED;
            PG8_LDB(B0, 1, 0); PG8_LDB(B1, 1, 1); PG8_SCHED; PG8_LDA(At, 1, 0); PG8_STAGE(PG8_SA(0, 1), a2 + hstep, voffA);
            PG8_WAIT_V(8); PG8_WAIT_L(0); PG8_BAR; PG8_MMA(0, 0, At, B0); PG8_MMA(0, 1, At, B1); PG8_BAR; PG8_SCHED;
            PG8_LDA(At, 1, 1); PG8_STAGE(PG8_SB(1, 0), b3, voffB); PG8_STAGE(PG8_SB(1, 1), b3 + hstep, voffB); PG8_STAGE(PG8_SA(1, 0), a3, voffA);
            PG8_WAIT_V(8); PG8_WAIT_L(0); PG8_BAR; PG8_MMA(1, 0, At, B0); PG8_MMA(1, 1, At, B1); PG8_BAR; PG8_SCHED;
            } else {
            PG8_LDB(B0, 0, 0); PG8_SCHED; PG8_LDA(At, 0, 0); PG8_STAGE(PG8_SA(1, 1), a1 + hstep, voffA);
            PG8_WAIT_L(8); PG8_BAR; PG8_WAIT_L(0); PG8_MMA(0, 0, At, B0); PG8_BAR; PG8_SCHED;
            PG8_LDB(B1, 0, 1); PG8_STAGE(PG8_SB(0, 0), b2, voffB);
            PG8_BAR; PG8_WAIT_L(0); PG8_MMA(0, 1, At, B1); PG8_BAR;
            PG8_LDA(At, 0, 1); PG8_STAGE(PG8_SA(0, 0), a2, voffA);
            PG8_BAR; PG8_WAIT_L(0); PG8_MMA(1, 0, At, B0); PG8_BAR; PG8_SCHED;
            PG8_STAGE(PG8_SB(0, 1), b2 + hstep, voffB);
            PG8_WAIT_V(6); PG8_BAR; PG8_MMA(1, 1, At, B1); PG8_BAR;
            PG8_LDB(B0, 1, 0); PG8_SCHED; PG8_LDA(At, 1, 0); PG8_STAGE(PG8_SA(0, 1), a2 + hstep, voffA);
            PG8_WAIT_L(8); PG8_BAR; PG8_WAIT_L(0); PG8_MMA(0, 0, At, B0); PG8_BAR; PG8_SCHED;
            PG8_LDB(B1, 1, 1); PG8_STAGE(PG8_SB(1, 0), b3, voffB);
            PG8_BAR; PG8_WAIT_L(0); PG8_MMA(0, 1, At, B1); PG8_BAR;
            PG8_LDA(At, 1, 1); PG8_STAGE(PG8_SA(1, 0), a3, voffA);
            PG8_BAR; PG8_WAIT_L(0); PG8_MMA(1, 0, At, B0); PG8_BAR; PG8_SCHED;
            PG8_STAGE(PG8_SB(1, 1), b3 + hstep, voffB);
            PG8_WAIT_V(6); PG8_BAR; PG8_MMA(1, 1, At, B1); PG8_BAR;
            }
        }
        if constexpr (ALIGN_EPI) { if (wr == 0) PG8_BAR; }
        if constexpr (!Epi::AFTER_DRAIN) { E(acc, cur, wr, wc, fr, fq); S.done(cur); }
        if (!has_next) break;
#pragma unroll
        for (int a = 0; a < 2; ++a)
#pragma unroll
            for (int b = 0; b < 2; ++b)
#pragma unroll
                for (int m = 0; m < 4; ++m)
#pragma unroll
                    for (int n = 0; n < 2; ++n) acc[a][b][m][n] = (f32x4){0.f, 0.f, 0.f, 0.f};
        cur = nxt; cA = nA; cB = nB; ++ui;
        if constexpr (ALIGN_EPI) { if (wr == 1) PG8_BAR; }
    }
    PG8_WAIT_V(0);
    if constexpr (!ALIGN_EPI) { if (wr == 0) PG8_BAR; }
    PG8_BAR;
    if constexpr (Epi::AFTER_DRAIN) { E.fused(acc, cur, wr, wc, fr, fq, lds, wid, lane); S.done(cur); }
#undef PG8_SA
#undef PG8_SB
#undef PG8_STAGE
#undef PG8_LDA
#undef PG8_LDB
#undef PG8_MMA
#undef PG8_WAIT_V
#undef PG8_WAIT_L
#undef PG8_BAR
#undef PG8_SCHED
}
}

constexpr int NB = 8, SEQ = 2048, DM = 1024, MT = NB * SEQ, DFF = 4096, IN_DIM = 13344;
constexpr int NTHREADS = 512, NWAVES = 8, LDS_BYTES = 147456;
constexpr float EPS = 1e-6f;
typedef unsigned short bf16;
typedef unsigned v4u __attribute__((ext_vector_type(4)));
typedef unsigned v2u __attribute__((ext_vector_type(2)));
typedef float f32x4 __attribute__((ext_vector_type(4)));
typedef short bf16x8 __attribute__((ext_vector_type(8)));
enum { B_H = 0, B_DNG = 1, B_SBQ = 2, B_SSZ = 3, B_DNQ = 4, B_DNK = 5, B_DNV = 6, B_SBK = 7, B_SBV = 8, B_SSX = 9, B_SSBC = 10, NBUF = 11 };
constexpr size_t BUFE = (size_t)MT * DM;
constexpr size_t WS_W = NBUF * BUFE * 2;
constexpr size_t W_IN = 0, W_G = W_IN + (size_t)10240 * 1024, W_OUT = W_G + (size_t)6144 * 1024, W_UP = W_OUT + (size_t)1024 * 1024,
                 W_DOWN = W_UP + (size_t)4096 * 1024, W_END = W_DOWN + (size_t)4096 * 1024;
constexpr size_t WS_SMALL = WS_W + W_END * 2;
constexpr size_t WS_CTL = WS_SMALL + (size_t)MT * 64 * 4;
constexpr size_t WS_BAR = WS_CTL + 4096;
constexpr size_t CTL_BYTES = 4096 + 16384;
constexpr size_t WS_NEED = WS_CTL + CTL_BYTES;

__device__ __forceinline__ float bf2f(unsigned u) { return __builtin_bit_cast(float, u << 16); }
__device__ __forceinline__ unsigned f2bf(float f) { unsigned u = __builtin_bit_cast(unsigned, f); return (u + 0x7fffu + ((u >> 16) & 1u)) >> 16; }
typedef float f32x2 __attribute__((ext_vector_type(2)));
typedef __bf16 bf16x2_t __attribute__((ext_vector_type(2)));
__device__ __forceinline__ unsigned pk2(float lo, float hi) { f32x2 v = {lo, hi}; return __builtin_bit_cast(unsigned, __builtin_convertvector(v, bf16x2_t)); }
__device__ __forceinline__ void unpack8(v4u r, float* o) {
    o[0] = bf2f(r.x & 0xffffu); o[1] = __builtin_bit_cast(float, r.x & 0xffff0000u); o[2] = bf2f(r.y & 0xffffu); o[3] = __builtin_bit_cast(float, r.y & 0xffff0000u);
    o[4] = bf2f(r.z & 0xffffu); o[5] = __builtin_bit_cast(float, r.z & 0xffff0000u); o[6] = bf2f(r.w & 0xffffu); o[7] = __builtin_bit_cast(float, r.w & 0xffff0000u);
}
__device__ __forceinline__ v4u pack8(const float* v) { v4u w; w.x = pk2(v[0], v[1]); w.y = pk2(v[2], v[3]); w.z = pk2(v[4], v[5]); w.w = pk2(v[6], v[7]); return w; }
__device__ __forceinline__ float sigmoidf_(float x) { return __builtin_amdgcn_rcpf(1.f + __expf(-x)); }
__device__ __forceinline__ float siluf_(float x) { return x * __builtin_amdgcn_rcpf(1.f + __expf(-x)); }
__device__ __forceinline__ float softplusf_(float x) { return fmaxf(x, 0.f) + log1pf(__expf(-fabsf(x))); }
template <int CTRL> __device__ __forceinline__ float dppf(float v) { return __builtin_bit_cast(float, __builtin_amdgcn_update_dpp(0, __builtin_bit_cast(int, v), CTRL, 0xF, 0xF, true)); }
__device__ __forceinline__ float red8(float v) { v += dppf<0xB1>(v); v += dppf<0x4E>(v); v += dppf<0x141>(v); return v; }
__device__ __forceinline__ float red16(float v) { v = red8(v); v += dppf<0x140>(v); return v; }
__device__ __forceinline__ float wave_sum(float v) {
#pragma unroll
    for (int o = 1; o < 64; o <<= 1) v += __shfl_xor(v, o);
    return v;
}
#define LDS_WAIT() asm volatile("s_waitcnt lgkmcnt(0)" ::: "memory")

struct Args { const float* in[19]; float* out; unsigned char* ws; };
typedef const __attribute__((address_space(4))) Args& CArgsR;
__device__ __forceinline__ const __attribute__((address_space(4))) Args* kargs() { unsigned long long v = (unsigned long long)__builtin_amdgcn_kernarg_segment_ptr(); asm volatile("" : "+s"(v)); return (const __attribute__((address_space(4))) Args*)v; }
#ifndef PROBE_SEL
#define PROBE_SEL 0
#endif
__device__ __forceinline__ unsigned long long rt() { return __builtin_amdgcn_s_memrealtime(); }
#define PT0() unsigned long long pt_ = PROBE_SEL ? rt() : 0ull
#define PT1(k) do { if (PROBE_SEL & (1 << (k))) probe_acc += rt() - pt_; } while (0)

struct EpiRoute {
    static constexpr bool PERM = true, AFTER_DRAIN = false;
    bf16* base; int pn_off;
    __device__ __forceinline__ void operator()(const pg8::f32x4 (&acc)[2][2][4][2], const pg8::Unit& u, int wr, int wc, int fr, int fq) const {
        const int sg = (u.pn + pn_off) >> 2;
        const int bufi = sg == 0 ? B_DNG : sg == 1 ? B_DNQ : sg == 2 ? B_DNK : sg == 3 ? B_DNV : sg == 4 ? B_SBQ : sg == 5 ? B_SSZ : sg == 6 ? B_SBK : sg == 7 ? B_SBV : sg == 8 ? B_SSX : B_SSBC;
        bf16* O = base + (size_t)bufi * BUFE;
        const int col0 = (u.pn & 3) * 256 + wc * 32 + 8 * fq, row0 = u.pm * 256 + wr * 64 + fr;
#pragma unroll
        for (int ai = 0; ai < 2; ++ai)
#pragma unroll
            for (int m = 0; m < 4; ++m) { bf16* rowp = O + (size_t)(row0 + ai * 128 + m * 16) * DM + col0;
#pragma unroll
                for (int bj = 0; bj < 2; ++bj) { const pg8::f32x4 v0 = acc[ai][bj][m][0], v1 = acc[ai][bj][m][1];
                    v4u w; w.x = pk2(v0[0], v0[1]); w.y = pk2(v0[2], v0[3]); w.z = pk2(v1[0], v1[1]); w.w = pk2(v1[2], v1[3]);
                    *(v4u*)(rowp + bj * 128) = w; } }
    }
};
struct EpiRelu2 {
    static constexpr bool PERM = true, AFTER_DRAIN = false;
    bf16* O;
    __device__ __forceinline__ void operator()(const pg8::f32x4 (&acc)[2][2][4][2], const pg8::Unit& u, int wr, int wc, int fr, int fq) const {
        const int col0 = u.pn * 256 + wc * 32 + 8 * fq, row0 = u.pm * 256 + wr * 64 + fr;
#pragma unroll
        for (int ai = 0; ai < 2; ++ai)
#pragma unroll
            for (int m = 0; m < 4; ++m) { bf16* rowp = O + (size_t)(row0 + ai * 128 + m * 16) * DFF + col0;
#pragma unroll
                for (int bj = 0; bj < 2; ++bj) { float v[8];
#pragma unroll
                    for (int i = 0; i < 4; ++i) { float a = fmaxf(acc[ai][bj][m][0][i], 0.f), b = fmaxf(acc[ai][bj][m][1][i], 0.f); v[i] = a * a; v[4 + i] = b * b; }
                    *(v4u*)(rowp + bj * 128) = pack8(v); } }
    }
};
struct EpiResid {
    static constexpr bool PERM = true, AFTER_DRAIN = false;
    const float* xin; float* xout;
    __device__ __forceinline__ void operator()(const pg8::f32x4 (&acc)[2][2][4][2], const pg8::Unit& u, int wr, int wc, int fr, int fq) const {
        const int col0 = u.pn * 256 + wc * 32 + 8 * fq, row0 = u.pm * 256 + wr * 64 + fr;
#pragma unroll
        for (int ai = 0; ai < 2; ++ai)
#pragma unroll
            for (int m = 0; m < 4; ++m) { const size_t ro = (size_t)(row0 + ai * 128 + m * 16) * DM + col0;
#pragma unroll
                for (int bj = 0; bj < 2; ++bj) { const size_t o = ro + bj * 128;
                    const f32x4 a = *(const f32x4*)(xin + o), b = *(const f32x4*)(xin + o + 4);
                    f32x4 r0, r1;
#pragma unroll
                    for (int i = 0; i < 4; ++i) { r0[i] = a[i] + acc[ai][bj][m][0][i]; r1[i] = b[i] + acc[ai][bj][m][1][i]; }
                    *(f32x4*)(xout + o) = r0; *(f32x4*)(xout + o + 4) = r1; } }
    }
};
struct SchedGate {
    int G, c;
    __device__ __forceinline__ bool next(int i, pg8::Unit& u) const {
        const int tile = c + (i / 6) * G; if (tile >= 256) return false;
        const int s = i % 6, br = s >> 1, xj = tile >> 3, pm = (tile & 7) * 8 + (xj >> 2), pn = xj & 3;
        if ((s & 1) == 0) { u.pm = pm; u.pn = br * 4 + pn; } else { u.pm = (1 + br) * 64 + pm; u.pn = (3 + br) * 4 + pn; }
        return true;
    }
    __device__ __forceinline__ void a_ready(const pg8::Unit&) const {}
    __device__ __forceinline__ void done(const pg8::Unit&) const {}
};
struct EpiGate {
    static constexpr bool PERM = true, AFTER_DRAIN = false;
    bf16* gsc; float* macc; bf16* merged;
    __device__ __forceinline__ void operator()(const pg8::f32x4 (&acc)[2][2][4][2], const pg8::Unit& u, int wr, int wc, int fr, int fq) const {
        const int j = u.pn >> 2, pn = u.pn & 3, pm = u.pm & 63;
        const int col0 = pn * 256 + wc * 32 + 8 * fq, row0 = pm * 256 + wr * 64 + fr;
#pragma unroll
        for (int ai = 0; ai < 2; ++ai)
#pragma unroll
            for (int m = 0; m < 4; ++m) { const size_t ro = (size_t)(row0 + ai * 128 + m * 16) * DM + col0;
#pragma unroll
                for (int bj = 0; bj < 2; ++bj) { const size_t o = ro + bj * 128; float v[8];
#pragma unroll
                    for (int i = 0; i < 4; ++i) { v[i] = acc[ai][bj][m][0][i]; v[4 + i] = acc[ai][bj][m][1][i]; }
                    if (j < 3) {
#pragma unroll
                        for (int i = 0; i < 8; ++i) v[i] = sigmoidf_(v[i]);
                        *(v4u*)(gsc + o) = pack8(v);
                    } else {
                        float g[8]; unpack8(*(const v4u*)(gsc + o), g);
#pragma unroll
                        for (int i = 0; i < 8; ++i) v[i] *= g[i];
                        if (j > 3) { const f32x4 a = *(const f32x4*)(macc + o), b = *(const f32x4*)(macc + o + 4);
#pragma unroll
                            for (int i = 0; i < 4; ++i) { v[i] += a[i]; v[4 + i] += b[i]; } }
                        if (j < 5) { *(f32x4*)(macc + o) = (f32x4){v[0], v[1], v[2], v[3]}; *(f32x4*)(macc + o + 4) = (f32x4){v[4], v[5], v[6], v[7]}; }
                        else *(v4u*)(merged + o) = pack8(v);
                    } } }
    }
};

__device__ __forceinline__ void transpose_item(const float* __restrict__ W, const float* __restrict__ W2, int ldw, bf16* __restrict__ WT, int K, int nblk, float* scr, int item, int lane) {
    const int kb = item / nblk, nb = item % nblk, k0 = 64 * kb, n0 = 32 * nb;
    const float* src = ((lane & 31) < 16 ? W : W2) + (size_t)(k0 + (lane >> 5)) * ldw + n0 + (lane & 31);
    float t[32];
#pragma unroll
    for (int i = 0; i < 32; ++i) t[i] = src[(size_t)(2 * i) * ldw];
#pragma unroll
    for (int i = 0; i < 32; ++i) scr[(2 * i + (lane >> 5)) * 33 + (lane & 31)] = t[i];
    LDS_WAIT();
    const int c = lane & 7;
#pragma unroll
    for (int j = 0; j < 4; ++j) { const int n = (lane >> 3) + 8 * j; const float* s = scr + (8 * c) * 33 + n;
        v4u o; o.x = pk2(s[0 * 33], s[1 * 33]); o.y = pk2(s[2 * 33], s[3 * 33]); o.z = pk2(s[4 * 33], s[5 * 33]); o.w = pk2(s[6 * 33], s[7 * 33]);
        *(v4u*)(WT + (size_t)(n0 + n) * K + k0 + 8 * c) = o; }
    LDS_WAIT();
}
__device__ __forceinline__ void rms_row_to_bf16(const float* xrow, const float* w, bf16* orow, int lane) {
    const f32x4* xr = (const f32x4*)xrow + lane; const f32x4* wr = (const f32x4*)w + lane;
    f32x4 v[4]; float s = 0.f;
#pragma unroll
    for (int j = 0; j < 4; ++j) { v[j] = xr[64 * j]; s += (v[j][0] * v[j][0] + v[j][1] * v[j][1]) + (v[j][2] * v[j][2] + v[j][3] * v[j][3]); }
    const float rstd = rsqrtf(wave_sum(s) * (1.f / DM) + EPS);
    unsigned long long* o8 = (unsigned long long*)orow + lane;
#pragma unroll
    for (int j = 0; j < 4; ++j) { const f32x4 ww = wr[64 * j];
        o8[64 * j] = (unsigned long long)pk2(v[j][0] * rstd * ww[0], v[j][1] * rstd * ww[1]) | ((unsigned long long)pk2(v[j][2] * rstd * ww[2], v[j][3] * rstd * ww[3]) << 32); }
}
__device__ __forceinline__ void rms_row2_to_bf16(const float* xa, const float* xb, const float* w, bf16* oa, bf16* ob, int lane) {
    const f32x4* xra = (const f32x4*)xa + lane; const f32x4* xrb = (const f32x4*)xb + lane; const f32x4* wr = (const f32x4*)w + lane;
    f32x4 va[4], vb[4]; float sa = 0.f, sb = 0.f;
#pragma unroll
    for (int j = 0; j < 4; ++j) { va[j] = xra[64 * j]; vb[j] = xrb[64 * j]; }
#pragma unroll
    for (int j = 0; j < 4; ++j) { sa += (va[j][0] * va[j][0] + va[j][1] * va[j][1]) + (va[j][2] * va[j][2] + va[j][3] * va[j][3]); sb += (vb[j][0] * vb[j][0] + vb[j][1] * vb[j][1]) + (vb[j][2] * vb[j][2] + vb[j][3] * vb[j][3]); }
    const float ra = rsqrtf(wave_sum(sa) * (1.f / DM) + EPS), rb = rsqrtf(wave_sum(sb) * (1.f / DM) + EPS);
    unsigned long long* pa = (unsigned long long*)oa + lane; unsigned long long* pb = (unsigned long long*)ob + lane;
#pragma unroll
    for (int j = 0; j < 4; ++j) { const f32x4 ww = wr[64 * j];
        pa[64 * j] = (unsigned long long)pk2(va[j][0] * ra * ww[0], va[j][1] * ra * ww[1]) | ((unsigned long long)pk2(va[j][2] * ra * ww[2], va[j][3] * ra * ww[3]) << 32);
        pb[64 * j] = (unsigned long long)pk2(vb[j][0] * rb * ww[0], vb[j][1] * rb * ww[1]) | ((unsigned long long)pk2(vb[j][2] * rb * ww[2], vb[j][3] * rb * ww[3]) << 32); }
}
__device__ __forceinline__ void phase0(unsigned char* lds, CArgsR a, int l, const float* xin) {
    constexpr int LDW = 1032;
    const int tid = opaque_tid(), lane = tid & 63, wave = __builtin_amdgcn_readfirstlane(tid >> 6), gw = blockIdx.x * NWAVES + wave, NGW = gridDim.x * NWAVES;
    bf16* Wreg = (bf16*)(a.ws + WS_W);
    const float* w_in = a.in[2] + (size_t)l * DM * IN_DIM;
    {
        float* scr = (float*)lds + wave * (64 * 33);
        const float* w_br = a.in[13] + (size_t)l * 3 * DM * DM; const float* w_out = a.in[14] + (size_t)l * DM * DM;
        const float* w_up = a.in[16] + (size_t)l * DM * DFF; const float* w_down = a.in[17] + (size_t)l * DFF * DM;
        constexpr int NSEG = 17, NIT = NSEG * 512 + 2048 + 2048;
        for (int it = gw; it < NIT; it += NGW) {
            if (it < NSEG * 512) {
                const int seg = it >> 9, r = it & 511;
                const float* W; int ldw; bf16* WT;
                if (seg < 13) {
                    const int co = seg == 0 ? 3072 : seg == 1 ? 0 : seg == 2 ? 1024 : seg == 3 ? 2048 : seg == 4 ? 4112 : seg == 5 ? 7184 : seg == 6 ? 5136 : seg == 7 ? 6160 : seg == 8 ? 8208 : seg == 9 ? 9232
                                 : 10272 + (seg - 10) * 1024;
                    W = w_in + co; ldw = IN_DIM; WT = seg < 10 ? Wreg + (size_t)seg * DM * DM : Wreg + W_G + (size_t)(seg - 10) * DM * DM;
                } else if (seg < 16) { W = w_br + (size_t)(seg - 13) * DM * DM; ldw = DM; WT = Wreg + W_G + (size_t)(3 + seg - 13) * DM * DM; }
                else { W = w_out; ldw = DM; WT = Wreg + W_OUT; }
                transpose_item(W, W, ldw, WT, DM, 32, scr, r, lane);
            } else if (it < NSEG * 512 + 2048) transpose_item(w_up, w_up, DFF, Wreg + W_UP, DM, 128, scr, it - NSEG * 512, lane);
            else transpose_item(w_down, w_down, DM, Wreg + W_DOWN, DFF, 32, scr, it - NSEG * 512 - 2048, lane);
        }
    }
    __syncthreads();
    bf16* WsT = (bf16*)lds;
    for (int idx = tid; idx < 32 * DM; idx += NTHREADS) { const int k = idx >> 5, c = idx & 31; WsT[c * LDW + k] = (bf16)f2bf(w_in[(size_t)k * IN_DIM + (c < 16 ? 4096 + c : 10256 + c - 16)]); }
    __syncthreads();
    {   const float* nw = a.in[1] + (size_t)l * DM; bf16* H = (bf16*)a.ws; float* small = (float*)(a.ws + WS_SMALL);
        const int fr = lane & 15, fq = lane >> 4;
        const float pa0 = __expf(a.in[4][l * 8 + (fr & 7)]), pb0 = a.in[5][l * 8 + (fr & 7)], pa1 = __expf(a.in[9][l * 16 + fr]), pb1 = a.in[10][l * 16 + fr];
        for (int g8 = gw; g8 < MT / 8; g8 += NGW) {
            const int r0 = g8 * 8;
#pragma unroll 1
            for (int r = 0; r < 8; ++r) rms_row_to_bf16(xin + (size_t)(r0 + r) * DM, nw, H + (size_t)(r0 + r) * DM, lane);
            asm volatile("s_waitcnt vmcnt(0)" ::: "memory");
            f32x4 c0 = {0.f, 0.f, 0.f, 0.f}, c1 = {0.f, 0.f, 0.f, 0.f};
            const bf16* ap = H + (size_t)(r0 + (fr & 7)) * DM + fq * 8;
#pragma unroll
            for (int kb = 0; kb < 4; ++kb) { bf16x8 af[8];
#pragma unroll
                for (int k = 0; k < 8; ++k) af[k] = *(const bf16x8*)(ap + (kb * 8 + k) * 32);
#pragma unroll
                for (int k = 0; k < 8; ++k) { const bf16x8 b0 = *(const bf16x8*)(WsT + fr * LDW + (kb * 8 + k) * 32 + fq * 8), b1 = *(const bf16x8*)(WsT + (16 + fr) * LDW + (kb * 8 + k) * 32 + fq * 8);
                    c0 = __builtin_amdgcn_mfma_f32_16x16x32_bf16(af[k], b0, c0, 0, 0, 0); c1 = __builtin_amdgcn_mfma_f32_16x16x32_bf16(af[k], b1, c1, 0, 0, 0); } }
            if (fq < 2) {
#pragma unroll
                for (int jj = 0; jj < 4; ++jj) { float* sp = small + (size_t)(r0 + 4 * fq + jj) * 64;
                    sp[fr] = fr < 8 ? -pa0 * softplusf_(c0[jj] + pb0) : sigmoidf_(c0[jj]);
                    const float dt = softplusf_(c1[jj] + pb1); sp[16 + fr] = dt; sp[32 + fr] = -pa1 * dt; } }
        }
    }
}

__device__ __forceinline__ void conv8(const bf16* p, int pos, const float* w, int wstride, const float* bias, float* out) {
    float acc[8];
#pragma unroll
    for (int i = 0; i < 8; ++i) acc[i] = bias ? bias[i] : 0.f;
#pragma unroll
    for (int j = 0; j < 4; ++j) { const int back = 3 - j;
        if (pos - back >= 0) { float xv[8]; unpack8(*(const v4u*)(p - (size_t)back * DM), xv);
            const f32x4 w0 = *(const f32x4*)(w + j * wstride), w1 = *(const f32x4*)(w + j * wstride + 4);
#pragma unroll
            for (int i = 0; i < 4; ++i) { acc[i] += xv[i] * w0[i]; acc[4 + i] += xv[4 + i] * w1[i]; } } }
#pragma unroll
    for (int i = 0; i < 8; ++i) out[i] = siluf_(acc[i]);
}

__device__ __forceinline__ void conv8r(const v4u (&raw)[4], const float* w, int wstride, const float* bias, float* out) {
    float acc[8];
#pragma unroll
    for (int i = 0; i < 8; ++i) acc[i] = bias ? bias[i] : 0.f;
#pragma unroll
    for (int j = 0; j < 4; ++j) { float xv[8]; unpack8(raw[j], xv);
        const f32x4 w0 = *(const f32x4*)(w + j * wstride), w1 = *(const f32x4*)(w + j * wstride + 4);
#pragma unroll
        for (int i = 0; i < 4; ++i) { acc[i] += xv[i] * w0[i]; acc[4 + i] += xv[4 + i] * w1[i]; } }
#pragma unroll
    for (int i = 0; i < 8; ++i) out[i] = siluf_(acc[i]);
}
#define LOAD4(dst, p, pos) do { _Pragma("unroll") for (int j_ = 0; j_ < 4; ++j_) { const int back_ = 3 - j_; const bool ok_ = (pos) - back_ >= 0; \
        const v4u t_ = *(const v4u*)((p) - (size_t)(ok_ ? back_ : 0) * DM); dst[j_] = ok_ ? t_ : (v4u){0u, 0u, 0u, 0u}; } } while (0)

template <int K> __device__ __forceinline__ void mma16(f32x4& acc, const bf16* Ap, int lda, const bf16* Bp, int ldb, int fr, int fq) {
    bf16x8 af[K / 32], bfv[K / 32];
#pragma unroll
    for (int k = 0; k < K / 32; ++k) { af[k] = *(const bf16x8*)(Ap + fr * lda + k * 32 + fq * 8); bfv[k] = *(const bf16x8*)(Bp + fr * ldb + k * 32 + fq * 8); }
#pragma unroll
    for (int k = 0; k < K / 32; ++k) acc = __builtin_amdgcn_mfma_f32_16x16x32_bf16(af[k], bfv[k], acc, 0, 0, 0);
}
template <bool SA, bool SB> __device__ __forceinline__ void mma32s(f32x4& acc, const bf16* Ap, int rA0, int lda, const bf16* Bp, int rB0, int ldb, int fr, int fq) {
    const int ra = rA0 + fr, rb = rB0 + fr;
    const bf16x8 af = *(const bf16x8*)(Ap + ra * lda + ((SA ? (fq ^ ((ra >> 3) & 3)) : fq) << 3));
    const bf16x8 bfv = *(const bf16x8*)(Bp + rb * ldb + ((SB ? (fq ^ ((rb >> 3) & 3)) : fq) << 3));
    acc = __builtin_amdgcn_mfma_f32_16x16x32_bf16(af, bfv, acc, 0, 0, 0);
}
__device__ __forceinline__ void dn_item(unsigned char* lds, CArgsR a, int l, int item, unsigned long long& probe_acc) {
    constexpr int LDK = 136, LDJ = 40, LDL = 36;
    const int b = item >> 3, h = item & 7;
    bf16* kA = (bf16*)lds;
    bf16* qA = kA + 32 * LDK;
    bf16* qgA = qA + 32 * LDK;
    bf16* wA = qgA + 32 * LDK;
    bf16* kdT = wA + 32 * LDK;
    bf16* vnT = kdT + 128 * LDJ;
    bf16* attn = vnT + 128 * LDJ;
    bf16* ST = attn + 32 * LDJ;
    float* kf = (float*)(ST + 128 * LDK);
    float* vf = kf + 32 * 128;
    float* os = kf;
    float* Lm = vf + 32 * 128;
    float* gcs = Lm + 32 * LDL;
    float* betas = gcs + 32;
    float* cwL = betas + 32;
    const int tid = opaque_tid(), w = __builtin_amdgcn_readfirstlane(tid >> 6), lane = tid & 63, fr = lane & 15, fq = lane >> 4;
    bf16* base = (bf16*)a.ws;
    const bf16* Q = base + (size_t)B_DNQ * BUFE; const bf16* K = base + (size_t)B_DNK * BUFE; const bf16* V = base + (size_t)B_DNV * BUFE; bf16* G = base + (size_t)B_DNG * BUFE;
    const float* small = (const float*)(a.ws + WS_SMALL);
    const float* cw = a.in[3] + (size_t)l * 4 * 3072;
    const size_t rowbase = (size_t)b * SEQ;
    const int tq = tid >> 4, cq = tid & 15;
    const float* nwp = a.in[6] + l * 128 + cq * 8;
    f32x4 Sacc[8];
#pragma unroll
    for (int i = 0; i < 8; ++i) Sacc[i] = (f32x4){0.f, 0.f, 0.f, 0.f};
    for (int i = tid; i < 128 * LDK / 2; i += NTHREADS) ((unsigned*)ST)[i] = 0u;
    for (int i = tid; i < 4 * 384; i += NTHREADS) { const int j = i / 384, r = i % 384; cwL[i] = cw[j * 3072 + (r >> 7) * 1024 + h * 128 + (r & 127)]; }
    __syncthreads();
    const int ta = ((tid - 256) >> 4) & 15;
    v4u rqa[4], rka[4], rva[4], rqb[4], rkb[4], rvb[4]; float rg = 0.f, rbv = 0.f;
    v4u Pv[2];
    Pv[0] = Pv[1] = (v4u){0u, 0u, 0u, 0u};
#define DN_LOADS_RAW(c_, half_) do { const int pos_ = (c_) * 32 + ta + 16 * (half_); const size_t off_ = (rowbase + pos_) * DM + h * 128 + cq * 8; LOAD4(rqa, Q + off_, pos_); LOAD4(rka, K + off_, pos_); LOAD4(rva, V + off_, pos_); } while (0)
#define DN_LOADS_RAWB(c_) do { const int pos_ = (c_) * 32 + ta + 16; const size_t off_ = (rowbase + pos_) * DM + h * 128 + cq * 8; LOAD4(rqb, Q + off_, pos_); LOAD4(rkb, K + off_, pos_); LOAD4(rvb, V + off_, pos_); } while (0)
#define DN_LOADS_SMALL(c_) do { const int t0_ = (c_) * 32; \
        { const size_t r_ = rowbase + t0_ + (lane & 31); rg = small[r_ * 64 + h]; rbv = small[r_ * 64 + 8 + h]; } } while (0)
#define DN_CONV(rq_, rk_, rv_, slot_) do { const float* cw_ = cwL + cq * 8; asm volatile("" : "+v"(cw_)); \
        { float o8_[8]; conv8r(rq_, cw_, 384, nullptr, o8_); float ss_ = 0.f; _Pragma("unroll") for (int i_ = 0; i_ < 8; ++i_) ss_ += o8_[i_] * o8_[i_]; \
          ss_ = red16(ss_); const float rn_ = rsqrtf(ss_ + EPS) * 0.08838834764831845f; _Pragma("unroll") for (int i_ = 0; i_ < 8; ++i_) o8_[i_] *= rn_; *(v4u*)(qA + (ta + 16 * (slot_)) * LDK + cq * 8) = pack8(o8_); } \
        __builtin_amdgcn_sched_barrier(0); \
        { float o8_[8]; conv8r(rk_, cw_ + 128, 384, nullptr, o8_); float ss_ = 0.f; _Pragma("unroll") for (int i_ = 0; i_ < 8; ++i_) ss_ += o8_[i_] * o8_[i_]; \
          ss_ = red16(ss_); const float rn_ = rsqrtf(ss_ + EPS); _Pragma("unroll") for (int i_ = 0; i_ < 8; ++i_) o8_[i_] *= rn_; *(v4u*)(kA + (ta + 16 * (slot_)) * LDK + cq * 8) = pack8(o8_); } \
        __builtin_amdgcn_sched_barrier(0); \
        { float o8_[8]; conv8r(rv_, cw_ + 256, 384, nullptr, o8_); Pv[slot_] = pack8(o8_); } \
        __builtin_amdgcn_sched_barrier(0); } while (0)
    if (w >= 4) { DN_LOADS_RAW(0, 0); DN_CONV(rqa, rka, rva, 0); DN_LOADS_RAW(0, 1); DN_CONV(rqa, rka, rva, 1); }
    DN_LOADS_SMALL(0);
    for (int c = 0; c < SEQ / 32; ++c) {
        const int t0 = c * 32;
        unsigned long long tp_ = PROBE_SEL ? rt() : 0ull;
#define DPT(k) do { if (PROBE_SEL) { const unsigned long long tn_ = rt(); if ((PROBE_SEL & (1 << (k))) && item == 0) probe_acc += tn_ - tp_; tp_ = tn_; } } while (0)
        float gcv = rg;
#pragma unroll
        for (int off = 1; off < 32; off <<= 1) { const float t = __shfl_up(gcv, off, 32); if ((lane & 31) >= off) gcv += t; }
        const float gc_last = __shfl(gcv, 31);
        if (w >= 4) {
#pragma unroll
            for (int s2 = 0; s2 < 2; ++s2) { const int tt = ta + 16 * s2;
                const float gc_t = __shfl(gcv, tt), beta_t = __shfl(rbv, tt);
                float q8[8], k8[8], v8[8], t8[8];
                unpack8(*(const v4u*)(qA + tt * LDK + cq * 8), q8); unpack8(*(const v4u*)(kA + tt * LDK + cq * 8), k8); unpack8(Pv[s2], v8);
                const float eg = __expf(gc_t), kb = beta_t * eg, kd = __expf(gc_last - gc_t);
#pragma unroll
                for (int i = 0; i < 8; ++i) t8[i] = q8[i] * eg;
                *(v4u*)(qgA + tt * LDK + cq * 8) = pack8(t8);
                *(f32x4*)(kf + tt * 128 + cq * 8) = (f32x4){k8[0] * kb, k8[1] * kb, k8[2] * kb, k8[3] * kb}; *(f32x4*)(kf + tt * 128 + cq * 8 + 4) = (f32x4){k8[4] * kb, k8[5] * kb, k8[6] * kb, k8[7] * kb};
                *(f32x4*)(vf + tt * 128 + cq * 8) = (f32x4){v8[0] * beta_t, v8[1] * beta_t, v8[2] * beta_t, v8[3] * beta_t}; *(f32x4*)(vf + tt * 128 + cq * 8 + 4) = (f32x4){v8[4] * beta_t, v8[5] * beta_t, v8[6] * beta_t, v8[7] * beta_t};
#pragma unroll
                for (int i = 0; i < 8; ++i) kdT[(cq * 8 + i) * LDJ + (tt ^ ((cq & 3) << 3))] = (bf16)f2bf(k8[i] * kd);
            }
        }
        if (tid < 32) { gcs[tid] = gcv; betas[tid] = rbv; }
        __syncthreads();
        DPT(12);
        if (w >= 4 && c + 1 < SEQ / 32) DN_LOADS_RAW(c + 1, 0);
        {   const int ww = w & 3, gi = ww >> 1, gj = ww & 1; f32x4 acc = {0.f, 0.f, 0.f, 0.f};
            const int jI = 16 * gj + fr, i0 = 16 * gi + 4 * fq;
            const float gj_ = gcs[jI]; const f32x4 gi4 = *(const f32x4*)(gcs + i0), bi4 = *(const f32x4*)(betas + i0);
            mma16<128>(acc, (w < 4 ? kA : qA) + gi * 16 * LDK, LDK, kA + gj * 16 * LDK, LDK, fr, fq);
            if (w < 4) {
#pragma unroll
                for (int jj = 0; jj < 4; ++jj) Lm[(i0 + jj) * LDL + jI] = jI < i0 + jj ? bi4[jj] * acc[jj] * __expf(gi4[jj] - gj_) : 0.f;
            } else {
#pragma unroll
                for (int jj = 0; jj < 4; ++jj) attn[(i0 + jj) * LDJ + jI] = (bf16)f2bf(jI <= i0 + jj ? acc[jj] * __expf(gi4[jj] - gj_) : 0.f);
            } }
        __syncthreads();
        DPT(13);
        if (w < 4) { const int cc = tid & 127; const bool is_w = w >= 2; const float* R = is_w ? kf : vf;
            float x[32];
#pragma unroll
            for (int i = 0; i < 32; ++i) x[i] = R[i * 128 + cc];
            f32x4 Lb[2][8];
            Lb[1][0] = *(const f32x4*)(Lm + 1 * LDL);
#pragma unroll
            for (int i = 1; i < 32; ++i) {
                if (i + 1 < 32) {
#pragma unroll
                    for (int j4 = 0; j4 < (i + 4) / 4; ++j4) Lb[(i + 1) & 1][j4] = *(const f32x4*)(Lm + (i + 1) * LDL + j4 * 4); }
                float a0 = x[i], a1 = 0.f, a2 = 0.f, a3 = 0.f;
#pragma unroll
                for (int j4 = 0; j4 < (i + 3) / 4; ++j4) { const f32x4 l4 = Lb[i & 1][j4];
                    if (j4 * 4 + 0 < i) a0 -= l4[0] * x[j4 * 4 + 0];
                    if (j4 * 4 + 1 < i) a1 -= l4[1] * x[j4 * 4 + 1];
                    if (j4 * 4 + 2 < i) a2 -= l4[2] * x[j4 * 4 + 2];
                    if (j4 * 4 + 3 < i) a3 -= l4[3] * x[j4 * 4 + 3]; }
                x[i] = (a0 + a1) + (a2 + a3); }
            if (is_w) {
#pragma unroll
                for (int i = 0; i < 32; ++i) wA[i * LDK + cc] = (bf16)f2bf(x[i]);
            } else {
#pragma unroll
                for (int i = 0; i < 32; ++i) vf[i * 128 + cc] = x[i];
            } }
        else if (c + 1 < SEQ / 32) { DN_LOADS_RAWB(c + 1); __builtin_amdgcn_sched_barrier(0); DN_CONV(rqa, rka, rva, 0); DN_CONV(rqb, rkb, rvb, 1); }
        __syncthreads();
        DPT(14);
        if (c + 1 < SEQ / 32) DN_LOADS_SMALL(c + 1);
        const v4u gcur = *(const v4u*)(G + (rowbase + t0 + tq) * DM + h * 128 + cq * 8);
#pragma unroll
        for (int it = 0; it < 2; ++it) { f32x4 acc = {0.f, 0.f, 0.f, 0.f};
            mma16<128>(acc, wA + it * 16 * LDK, LDK, ST + w * 16 * LDK, LDK, fr, fq);
            float vn[4];
#pragma unroll
            for (int jj = 0; jj < 4; ++jj) vn[jj] = vf[(16 * it + 4 * fq + jj) * 128 + 16 * w + fr] - acc[jj];
            v2u pk; pk.x = pk2(vn[0], vn[1]); pk.y = pk2(vn[2], vn[3]);
            *(v2u*)(vnT + (16 * w + fr) * LDJ + 16 * it + 4 * fq) = pk; }
        __syncthreads();
#pragma unroll
        for (int it = 0; it < 2; ++it) { f32x4 acc = {0.f, 0.f, 0.f, 0.f};
            mma16<128>(acc, qgA + it * 16 * LDK, LDK, ST + w * 16 * LDK, LDK, fr, fq);
            mma16<32>(acc, attn + it * 16 * LDJ, LDJ, vnT + w * 16 * LDJ, LDJ, fr, fq);
#pragma unroll
            for (int jj = 0; jj < 4; ++jj) os[(16 * it + 4 * fq + jj) * 128 + 16 * w + fr] = acc[jj]; }
        {   const float dl = __expf(gc_last);
#pragma unroll
            for (int dt = 0; dt < 8; ++dt) Sacc[dt] = Sacc[dt] * dl;
            const bf16x8 vb_ = *(const bf16x8*)(vnT + (w * 16 + fr) * LDJ + fq * 8);
            const bf16* ka_e = kdT + fr * LDJ + ((fq ^ (fr >> 3)) << 3); const bf16* ka_o = kdT + fr * LDJ + (((fq ^ (fr >> 3)) << 3) ^ 16);
#pragma unroll
            for (int dt = 0; dt < 8; ++dt) { const bf16x8 af_ = *(const bf16x8*)(((dt & 1) ? ka_o : ka_e) + dt * 16 * LDJ);
                Sacc[dt] = __builtin_amdgcn_mfma_f32_16x16x32_bf16(af_, vb_, Sacc[dt], 0, 0, 0); } }
        __syncthreads();
#pragma unroll
        for (int dt = 0; dt < 8; ++dt) { v2u pk; pk.x = pk2(Sacc[dt][0], Sacc[dt][1]); pk.y = pk2(Sacc[dt][2], Sacc[dt][3]);
            *(v2u*)(ST + (16 * w + fr) * LDK + 16 * dt + 4 * fq) = pk; }
        {   const f32x4 o0 = *(const f32x4*)(os + tq * 128 + cq * 8), o1 = *(const f32x4*)(os + tq * 128 + cq * 8 + 4);
            float ss = (o0[0] * o0[0] + o0[1] * o0[1]) + (o0[2] * o0[2] + o0[3] * o0[3]) + (o1[0] * o1[0] + o1[1] * o1[1]) + (o1[2] * o1[2] + o1[3] * o1[3]);
            ss = red16(ss);
            const float r = rsqrtf(ss * (1.f / 128.f) + EPS);
            float g8[8], o8[8], nw8[8]; unpack8(gcur, g8);
            { const f32x4 n0 = *(const f32x4*)nwp, n1 = *(const f32x4*)(nwp + 4); nw8[0] = n0[0]; nw8[1] = n0[1]; nw8[2] = n0[2]; nw8[3] = n0[3]; nw8[4] = n1[0]; nw8[5] = n1[1]; nw8[6] = n1[2]; nw8[7] = n1[3]; }
#pragma unroll
            for (int i = 0; i < 4; ++i) { o8[i] = o0[i] * r * nw8[i] * siluf_(g8[i]); o8[4 + i] = o1[i] * r * nw8[4 + i] * siluf_(g8[4 + i]); }
            *(v4u*)(G + (rowbase + t0 + tq) * DM + h * 128 + cq * 8) = pack8(o8); }
        __syncthreads();
        DPT(15);
    }
#undef DPT
#undef DN_LOADS_RAW
#undef DN_LOADS_RAWB
#undef DN_LOADS_SMALL
#undef DN_CONV
    __syncthreads();
}

__device__ __forceinline__ void ssm_item(unsigned char* lds, CArgsR a, int l, int item) {
    constexpr int LDC = 136, LDX = 40;
    const int b = item >> 4, hd = item & 15, g = hd >> 2;
    bf16* Cs = (bf16*)lds;
    bf16* Bs = Cs + 32 * LDC;
    bf16* BT = Bs + 32 * LDC;
    bf16* xdtT = BT + 128 * LDX;
    bf16* xddT = xdtT + 64 * LDX;
    bf16* Wm = xddT + 64 * LDX;
    bf16* hB = Wm + 32 * LDX;
    float* xs = (float*)(hB + 64 * LDC);
    float* acs = xs + 32 * 64;
    const int tid = opaque_tid(), w = __builtin_amdgcn_readfirstlane(tid >> 6), lane = tid & 63, fr = lane & 15, fq = lane >> 4;
    bf16* base = (bf16*)a.ws;
    const bf16* X = base + (size_t)B_SSX * BUFE; const bf16* BC = base + (size_t)B_SSBC * BUFE; bf16* Z = base + (size_t)B_SSZ * BUFE;
    const float* small = (const float*)(a.ws + WS_SMALL);
    const float* cw = a.in[7] + (size_t)l * 4 * 2048; const float* cb = a.in[8] + (size_t)l * 2048;
    const float dskip = a.in[11][l * 16 + hd];
    const size_t rowbase = (size_t)b * SEQ;
    const int tq = tid >> 4, cq = tid & 15, tv = (tid >> 3) & 31, cv = tid & 7;
    const int it = w >> 2, pt = w & 3;
    f32x4 hacc[4];
#pragma unroll
    for (int i = 0; i < 4; ++i) hacc[i] = (f32x4){0.f, 0.f, 0.f, 0.f};
    for (int i = tid; i < 64 * LDC / 2; i += NTHREADS) ((unsigned*)hB)[i] = 0u;
    v4u rB[4], rC[4], rx[4]; float ra = 0.f, rdtv = 0.f; unsigned rz[4];
#define SSM_LOADS(c_) do { const int t0_ = (c_) * 32; { const int pos_ = t0_ + tq; const size_t ro_ = (rowbase + pos_) * DM; LOAD4(rB, BC + ro_ + g * 128 + cq * 8, pos_); LOAD4(rC, BC + ro_ + 512 + g * 128 + cq * 8, pos_); } \
        if (tid >= 256) { const int pos_ = t0_ + tv; LOAD4(rx, X + (rowbase + pos_) * DM + hd * 64 + cv * 8, pos_); } \
        { const size_t r_ = rowbase + t0_ + (lane & 31); rdtv = small[r_ * 64 + 16 + hd]; ra = small[r_ * 64 + 32 + hd]; } \
        _Pragma("unroll") for (int jj_ = 0; jj_ < 4; ++jj_) rz[jj_] = Z[(rowbase + t0_ + 16 * it + 4 * fq + jj_) * DM + hd * 64 + 16 * pt + fr]; } while (0)
    SSM_LOADS(0);
    for (int c = 0; c < SEQ / 32; ++c) {
        const int t0 = c * 32;
        float acum = ra;
#pragma unroll
        for (int off = 1; off < 32; off <<= 1) { const float t = __shfl_up(acum, off, 32); if ((lane & 31) >= off) acum += t; }
        const float ac_last = __shfl(acum, 31);
        {   float o8[8];
            conv8r(rB, cw + 1024 + g * 128 + cq * 8, 2048, cb + 1024 + g * 128 + cq * 8, o8);
            *(v4u*)(Bs + tq * LDC + cq * 8) = pack8(o8);
#pragma unroll
            for (int i = 0; i < 8; ++i) BT[(cq * 8 + i) * LDX + (tq ^ ((cq & 3) << 3))] = (bf16)f2bf(o8[i]);
            conv8r(rC, cw + 1536 + g * 128 + cq * 8, 2048, cb + 1536 + g * 128 + cq * 8, o8);
            *(v4u*)(Cs + tq * LDC + cq * 8) = pack8(o8);
        }
        if (tid < 32) acs[tid] = acum;
        unsigned zr[4];
#pragma unroll
        for (int jj = 0; jj < 4; ++jj) zr[jj] = rz[jj];
        __syncthreads();
        if (w >= 4) { float o8[8]; conv8r(rx, cw + hd * 64 + cv * 8, 2048, cb + hd * 64 + cv * 8, o8);
            const float dtv = __shfl(rdtv, tv), dd = dtv * __expf(ac_last - __shfl(acum, tv));
            *(f32x4*)(xs + tv * 64 + cv * 8) = (f32x4){o8[0], o8[1], o8[2], o8[3]}; *(f32x4*)(xs + tv * 64 + cv * 8 + 4) = (f32x4){o8[4], o8[5], o8[6], o8[7]};
#pragma unroll
            for (int i = 0; i < 8; ++i) { xdtT[(cv * 8 + i) * LDX + (tv ^ ((cv & 3) << 3))] = (bf16)f2bf(o8[i] * dtv); xddT[(cv * 8 + i) * LDX + (tv ^ ((cv & 3) << 3))] = (bf16)f2bf(o8[i] * dd); }
        }
        else { const int gi = w >> 1, gj = w & 1; f32x4 acc = {0.f, 0.f, 0.f, 0.f};
            mma16<128>(acc, Cs + gi * 16 * LDC, LDC, Bs + gj * 16 * LDC, LDC, fr, fq);
            const int sI = 16 * gj + fr; const float as = acs[sI];
#pragma unroll
            for (int jj = 0; jj < 4; ++jj) { const int lI = 16 * gi + 4 * fq + jj; const float v = sI <= lI ? acc[jj] * __expf(acs[lI] - as) : 0.f; Wm[lI * LDX + sI] = (bf16)f2bf(v); } }
        if (c + 1 < SEQ / 32) SSM_LOADS(c + 1);
        __syncthreads();
        {   f32x4 a1 = {0.f, 0.f, 0.f, 0.f}, a2 = {0.f, 0.f, 0.f, 0.f};
            mma32s<false, true>(a1, Wm, it * 16, LDX, xdtT, pt * 16, LDX, fr, fq);
            mma16<128>(a2, Cs + it * 16 * LDC, LDC, hB + pt * 16 * LDC, LDC, fr, fq);
            const int p = 16 * pt + fr;
#pragma unroll
            for (int jj = 0; jj < 4; ++jj) { const int lI = 16 * it + 4 * fq + jj;
                const float y = a1[jj] + __expf(acs[lI]) * a2[jj] + xs[lI * 64 + p] * dskip;
                Z[(rowbase + t0 + lI) * DM + hd * 64 + p] = (bf16)f2bf(y * siluf_(bf2f(zr[jj]))); }
            const float dl = __expf(ac_last);
#pragma unroll
            for (int p2 = 0; p2 < 4; ++p2) { hacc[p2] = hacc[p2] * dl; mma32s<true, true>(hacc[p2], xddT, p2 * 16, LDX, BT, w * 16, LDX, fr, fq); }
        }
        __syncthreads();
#pragma unroll
        for (int p2 = 0; p2 < 4; ++p2)
#pragma unroll
            for (int jj = 0; jj < 4; ++jj) hB[(16 * p2 + 4 * fq + jj) * LDC + 16 * w + fr] = (bf16)f2bf(hacc[p2][jj]);
    }
#undef SSM_LOADS
    __syncthreads();
}

__device__ __forceinline__ void sb_item(unsigned char* lds, CArgsR a, int b, int hd, int qi) {
    constexpr int LD = 72;
    bf16* Ks = (bf16*)lds; bf16* Vs = Ks + 2 * 64 * LD;
    volatile unsigned* alive = (volatile unsigned*)(Vs + 2 * 64 * LD);
    const int tid = opaque_tid(), w = __builtin_amdgcn_readfirstlane(tid >> 6), lane = tid & 63, fr = lane & 15, fq = lane >> 4;
    bf16* base = (bf16*)a.ws;
    bf16* Qb = base + (size_t)B_SBQ * BUFE; const bf16* Kb = base + (size_t)B_SBK * BUFE; const bf16* Vb = base + (size_t)B_SBV * BUFE;
    const size_t rowbase = (size_t)b * SEQ;
    const int t0 = qi * 128, myq = t0 + w * 16 + fr, wmax = t0 + w * 16 + 15;
    bf16* qrow = Qb + (rowbase + myq) * DM + hd * 64;
    bf16x8 qf[2];
    qf[0] = *(const bf16x8*)(qrow + fq * 8); qf[1] = *(const bf16x8*)(qrow + 32 + fq * 8);
    f32x4 oacc[4];
#pragma unroll
    for (int i = 0; i < 4; ++i) oacc[i] = (f32x4){0.f, 0.f, 0.f, 0.f};
    float carry = 1.f;
    const int kr = tid >> 3, d8 = (tid & 7) * 8;
    v4u kreg, vreg;
    int kt = 2 * (qi + 1) - 1;
#define SB_LOAD(t) do { const size_t o_ = (rowbase + (size_t)(t) * 64 + kr) * DM + hd * 64 + d8; kreg = *(const v4u*)(Kb + o_); vreg = *(const v4u*)(Vb + o_); } while (0)
#define SB_STORE(bu) do { *(v4u*)(Ks + (bu) * 64 * LD + kr * LD + d8) = kreg; bf16* vd_ = Vs + (bu) * 64 * LD + d8 * LD + (kr ^ (((d8 >> 3) & 7) << 3)); \
        vd_[0] = (bf16)(vreg.x & 0xffffu); vd_[LD] = (bf16)(vreg.x >> 16); vd_[2 * LD] = (bf16)(vreg.y & 0xffffu); vd_[3 * LD] = (bf16)(vreg.y >> 16); \
        vd_[4 * LD] = (bf16)(vreg.z & 0xffffu); vd_[5 * LD] = (bf16)(vreg.z >> 16); vd_[6 * LD] = (bf16)(vreg.w & 0xffffu); vd_[7 * LD] = (bf16)(vreg.w >> 16); } while (0)
    SB_LOAD(kt); SB_STORE(0);
    __syncthreads();
    int cur = 0;
    for (; kt >= 0; --kt) {
        if (kt > 0) SB_LOAD(kt - 1);
        const int kbase = kt * 64;
        if (kbase <= wmax) {
            const bf16* Kc = Ks + cur * 64 * LD; const bf16* Vc = Vs + cur * 64 * LD;
            f32x4 z[4];
#pragma unroll
            for (int nt = 0; nt < 4; ++nt) { z[nt] = (f32x4){0.f, 0.f, 0.f, 0.f};
#pragma unroll
                for (int k2 = 0; k2 < 2; ++k2) { const bf16x8 af = *(const bf16x8*)(Kc + (nt * 16 + fr) * LD + k2 * 32 + fq * 8);
                    z[nt] = __builtin_amdgcn_mfma_f32_16x16x32_bf16(af, qf[k2], z[nt], 0, 0, 0); } }
            float kp[4][4], sg[4][4], T[4], tot[4], suf[4];
            const bool masked = kbase + 64 > t0 + w * 16;
#pragma unroll
            for (int nt = 0; nt < 4; ++nt) {
#pragma unroll
                for (int j = 0; j < 4; ++j) { const float z2 = z[nt][j] * 0.18033688011112042f;
                    const float ea = __builtin_amdgcn_exp2f(-fabsf(z2)), rc = __builtin_amdgcn_rcpf(1.f + ea); const bool pos = z2 >= 0.f;
                    sg[nt][j] = (pos ? 1.f : ea) * rc; kp[nt][j] = (pos ? ea : 1.f) * rc; }
                if (masked) {
#pragma unroll
                    for (int j = 0; j < 4; ++j) { const bool valid = kbase + nt * 16 + fq * 4 + j < myq; sg[nt][j] = valid ? sg[nt][j] : 0.f; kp[nt][j] = valid ? kp[nt][j] : 1.f; } }
                T[nt] = (kp[nt][0] * kp[nt][1]) * (kp[nt][2] * kp[nt][3]); }
#pragma unroll
            for (int nt = 0; nt < 4; ++nt) { const float p16 = __shfl_xor(T[nt], 16), s1 = T[nt] * p16, p32 = __shfl_xor(s1, 32); tot[nt] = s1 * p32;
                suf[nt] = fq == 0 ? p16 * p32 : fq == 1 ? p32 : fq == 2 ? p16 : 1.f; }
            float run = carry; float wv[4][4];
#pragma unroll
            for (int nt = 3; nt >= 0; --nt) { const float r3 = run * suf[nt], r2 = r3 * kp[nt][3], r1 = r2 * kp[nt][2], r0 = r1 * kp[nt][1];
                wv[nt][0] = sg[nt][0] * r0; wv[nt][1] = sg[nt][1] * r1; wv[nt][2] = sg[nt][2] * r2; wv[nt][3] = sg[nt][3] * r3;
                run *= tot[nt]; }
            carry = run;
#pragma unroll
            for (int kk = 0; kk < 2; ++kk) {
                v4u bw; bw.x = pk2(wv[2 * kk][0], wv[2 * kk][1]); bw.y = pk2(wv[2 * kk][2], wv[2 * kk][3]); bw.z = pk2(wv[2 * kk + 1][0], wv[2 * kk + 1][1]); bw.w = pk2(wv[2 * kk + 1][2], wv[2 * kk + 1][3]);
                const bf16x8 bfr = __builtin_bit_cast(bf16x8, bw);
#pragma unroll
                for (int mt = 0; mt < 4; ++mt) { const int vr = mt * 16 + fr, vs = ((vr >> 3) & 7) << 3; const bf16* vrow = Vc + vr * LD;
                    const v2u lo = *(const v2u*)(vrow + ((32 * kk + 4 * fq) ^ vs)), hi = *(const v2u*)(vrow + ((32 * kk + 16 + 4 * fq) ^ vs));
                    v4u av; av.x = lo.x; av.y = lo.y; av.z = hi.x; av.w = hi.y;
                    oacc[mt] = __builtin_amdgcn_mfma_f32_16x16x32_bf16(__builtin_bit_cast(bf16x8, av), bfr, oacc[mt], 0, 0, 0); }
            }
        }
        {   const bool any_alive = __ballot(carry != 0.f) != 0ull;
            if (lane == 0) alive[cur * 8 + w] = any_alive ? 1u : 0u; }
        if (kt > 0) SB_STORE(cur ^ 1);
        __syncthreads();
        unsigned al = 0u;
#pragma unroll
        for (int i = 0; i < 8; ++i) al |= alive[cur * 8 + i];
        if (al == 0u) break;
        cur ^= 1;
    }
#undef SB_LOAD
#undef SB_STORE
#pragma unroll
    for (int mt = 0; mt < 4; ++mt) { v2u wq; wq.x = pk2(oacc[mt][0], oacc[mt][1]); wq.y = pk2(oacc[mt][2], oacc[mt][3]); *(v2u*)(qrow + mt * 16 + fq * 4) = wq; }
}

__device__ __forceinline__ void phase_mixers(unsigned char* lds, CArgsR a, int l, unsigned long long& probe_acc) {
    unsigned* ctl = (unsigned*)(a.ws + WS_CTL);
    unsigned* counter = ctl + 64 * l; unsigned* gdone = ctl + 64 * l + 32;
    volatile unsigned* slot = (volatile unsigned*)(lds + LDS_BYTES - 64);
    constexpr int NDN = 64;
    const int nb = (int)gridDim.x - NDN;
    if ((int)blockIdx.x < NDN) { PT0(); dn_item(lds, a, l, (int)blockIdx.x, probe_acc); if (blockIdx.x == 0 && l == 0) PT1(9); }
    else {
        bf16* base = (bf16*)a.ws; bf16* Wreg = (bf16*)(a.ws + WS_W);
        pg8::Gemm g{base, Wreg + W_IN + (size_t)4096 * DM, MT, 6144, DM}; pg8::StaticOrder S; S.init(MT, 6144, nb, (int)blockIdx.x - NDN);
        EpiRoute E{base, 16};
        pg8::gemm_phase<EpiRoute, pg8::StaticOrder, true, true>((PG8_LAS unsigned char*)lds, g, S, E);
        __builtin_amdgcn_fence(__ATOMIC_RELEASE, "agent");
        asm volatile("s_waitcnt vmcnt(0)" ::: "memory");
        __syncthreads();
        if (threadIdx.x == 0) __hip_atomic_fetch_add(gdone, 1u, __ATOMIC_RELAXED, __HIP_MEMORY_SCOPE_AGENT);
    }
    if (threadIdx.x == 0) {
        unsigned sp = 0u;
        while (__hip_atomic_load(gdone, __ATOMIC_RELAXED, __HIP_MEMORY_SCOPE_AGENT) < (unsigned)nb && ++sp < (1u << 22)) __builtin_amdgcn_s_sleep(2);
        __builtin_amdgcn_fence(__ATOMIC_ACQUIRE, "agent");
        asm volatile("s_waitcnt vmcnt(0)" ::: "memory");
    }
    __syncthreads();
    constexpr unsigned NITEMS = 128 + 2048;
    for (;;) {
        if (threadIdx.x == 0) *slot = __hip_atomic_fetch_add(counter, 1u, __ATOMIC_RELAXED, __HIP_MEMORY_SCOPE_AGENT);
        __syncthreads();
        const unsigned item = *slot;
        __syncthreads();
        if (item >= NITEMS) break;
        PT0();
        if (item < 128) { ssm_item(lds, a, l, (int)item); if (item == 0 && l == 0) PT1(10); }
        else { const int r = (int)item - 128, qi = 15 - (r >> 7), bh = r & 127; sb_item(lds, a, bh >> 4, bh & 15, qi); if (item == 128 && l == 0) PT1(11); }
    }
}

__device__ __forceinline__ void phase_norms(CArgsR a, int l) {
    const int tid = opaque_tid(), lane = tid & 63, wave = tid >> 6, gw = blockIdx.x * NWAVES + wave, NGW = gridDim.x * NWAVES;
    bf16* base = (bf16*)a.ws;
    const bf16* Oraw = base + (size_t)B_DNV * BUFE; bf16* G = base + (size_t)B_DNG * BUFE; bf16* Y = base + (size_t)B_SSZ * BUFE;
    const float* dnw = a.in[6] + (size_t)l * 128 + (lane & 7) * 16; const float* snw = a.in[12] + (size_t)l * DM + lane * 16;
    float w1[16], w2[16];
#pragma unroll
    for (int i = 0; i < 16; ++i) { w1[i] = dnw[i]; w2[i] = snw[i]; }
    for (int m = gw; m < MT; m += NGW) {
        const size_t o = (size_t)m * DM + lane * 16;
        float v[16], s, r;
        unpack8(*(const v4u*)(Y + o), v); unpack8(*(const v4u*)(Y + o + 8), v + 8);
        s = 0.f;
#pragma unroll
        for (int i = 0; i < 16; ++i) s += v[i] * v[i];
        s = red16(s);
        r = rsqrtf(s * (1.f / 256.f) + EPS);
#pragma unroll
        for (int i = 0; i < 16; ++i) v[i] = v[i] * r * w2[i];
        *(v4u*)(Y + o) = pack8(v); *(v4u*)(Y + o + 8) = pack8(v + 8);
    }
}

#define LAS __attribute__((address_space(3)))
#define XB_TMO      128
#define XB_XCNT(j)  (256  + 64 * (j))
#define XB_XSUB(j)  (1280 + 64 * (j))
#define XB_XGEN(j)  (2304 + 64 * (j))
#define XB_TOP      3328
#define XB_TOPGEN   3392
#define XCD_BAR_WORDS 3456
#define XB_SPIN_CAP (1u << 18)

__device__ __forceinline__ unsigned xb_ld(unsigned* p)              { return __hip_atomic_load(p, __ATOMIC_RELAXED, __HIP_MEMORY_SCOPE_AGENT); }
__device__ __forceinline__ unsigned xb_add(unsigned* p, unsigned v) { return __hip_atomic_fetch_add(p, v, __ATOMIC_RELAXED, __HIP_MEMORY_SCOPE_AGENT); }
__device__ __forceinline__ unsigned xb_xcc_id() { return (unsigned)__builtin_amdgcn_s_getreg((3 << 11) | 20) & 0xFu; }
#define XB_SPIN(cond, bar) do { unsigned _sp = 0; while (cond) { __builtin_amdgcn_s_sleep(1); \
    if ((++_sp & 255u) == 0u) { if (xb_ld(&(bar)[XB_TMO])) break; if (_sp > XB_SPIN_CAP) { atomicAdd(&(bar)[XB_TMO], 1u); break; } } } } while (0)

struct XcdBarrier {
    unsigned* bar; unsigned x;
    volatile LAS unsigned* st;
};

__device__ __forceinline__ XcdBarrier xcd_barrier_post(unsigned* bar, volatile LAS unsigned* st) {
    XcdBarrier b; b.bar = bar; b.x = xb_xcc_id(); b.st = st;
    if (threadIdx.x == 0) (void)xb_add(&bar[XB_XCNT(b.x)], 1u);
    return b;
}
__device__ __forceinline__ void xcd_barrier_complete(unsigned* bar, unsigned x, unsigned& nloc, unsigned& nx) {
    const unsigned G = gridDim.x * gridDim.y * gridDim.z;
    unsigned sum, cnt, mine, sp = 0u;
    for (;;) {
        sum = 0u; cnt = 0u; mine = 0u;
#pragma unroll
        for (unsigned j = 0; j < 16; ++j) { const unsigned c = xb_ld(&bar[XB_XCNT(j)]); sum += c; cnt += (c > 0u) ? 1u : 0u; mine = (j == x) ? c : mine; }
        if (sum == G) break;
        __builtin_amdgcn_s_sleep(1);
        if ((++sp & 255u) == 0u) { if (xb_ld(&bar[XB_TMO])) break; if (sp > XB_SPIN_CAP) { atomicAdd(&bar[XB_TMO], 1u); break; } }
    }
    nloc = mine > 0u ? mine : 1u; nx = cnt > 0u ? cnt : 1u;
}

__device__ __forceinline__ void xcd_barrier(const XcdBarrier& b) {
    asm volatile("s_waitcnt vmcnt(0)" ::: "memory");
    __syncthreads();
    if (threadIdx.x == 0) {
        unsigned* bar = b.bar;
        __builtin_amdgcn_s_waitcnt(0);
        unsigned nloc = b.st[0], nx = b.st[1];
        if (nloc == 0u) { xcd_barrier_complete(bar, b.x, nloc, nx); b.st[0] = nloc; b.st[1] = nx; }
        const unsigned old = xb_add(&bar[XB_XSUB(b.x)], 1u);
        const unsigned gen = old / nloc;
        if (old + 1u == (gen + 1u) * nloc) {
            __builtin_amdgcn_fence(__ATOMIC_RELEASE, "agent");
            asm volatile("s_waitcnt vmcnt(0)" ::: "memory");
            const unsigned og = xb_add(&bar[XB_TOP], 1u);
            const unsigned tg = og / nx;
            if (og + 1u == (tg + 1u) * nx) xb_add(&bar[XB_TOPGEN], 1u);
            else XB_SPIN(xb_ld(&bar[XB_TOPGEN]) == tg, bar);
            __builtin_amdgcn_fence(__ATOMIC_ACQUIRE, "agent");
            xb_add(&bar[XB_XGEN(b.x)], 1u);
            asm volatile("s_waitcnt vmcnt(0)" ::: "memory");
        } else {
            XB_SPIN(xb_ld(&bar[XB_XGEN(b.x)]) == gen, bar);
            __builtin_amdgcn_fence(__ATOMIC_ACQUIRE, "agent");
            asm volatile("s_waitcnt vmcnt(0)" ::: "memory");
        }
    }
    __syncthreads();
}

__global__ void __launch_bounds__(NTHREADS, 2) hybrid_fwd(Args a_unused) {
    extern __shared__ __attribute__((aligned(16))) unsigned char lds[];
    cg::grid_group grid = cg::this_grid();
    PG8_LAS unsigned char* ldsl = (PG8_LAS unsigned char*)lds;
    unsigned long long probe_acc = 0ull;
#define A_ (*kargs())
    volatile LAS unsigned* bst = (volatile LAS unsigned*)((LAS unsigned char*)lds + LDS_BYTES - 32);
    if (threadIdx.x == 0) { bst[0] = 0u; bst[1] = 0u; }
    __syncthreads();
    const XcdBarrier bar = xcd_barrier_post((unsigned*)(a_unused.ws + WS_BAR), bst);
#pragma unroll 1
    for (int l = 0; l < 2; ++l) {
        asm volatile("" : "+s"(l));
        {   CArgsR a = A_; const float* xin = l == 0 ? a.in[0] : a.out;
            PT0(); phase0(lds, a, l, xin);
        if (l == 0) grid.sync(); else xcd_barrier(bar); PT1(0); }
        {   CArgsR a = A_; bf16* base = (bf16*)a.ws; bf16* Wreg = (bf16*)(a.ws + WS_W);
            pg8::Gemm g{base, Wreg + W_IN, MT, 4096, DM}; pg8::StaticOrder S; S.init(MT, 4096, (int)gridDim.x, (int)blockIdx.x);
            EpiRoute E{base, 0};
            PT0(); pg8::gemm_phase<EpiRoute, pg8::StaticOrder, true, true>(ldsl, g, S, E);
        xcd_barrier(bar); PT1(1); }
        { PT0(); phase_mixers(lds, A_, l, probe_acc);
        xcd_barrier(bar); PT1(2); }
        { PT0(); phase_norms(A_, l);
        xcd_barrier(bar); PT1(3); }
        {   CArgsR a = A_; bf16* base = (bf16*)a.ws; bf16* Wreg = (bf16*)(a.ws + WS_W);
            pg8::Gemm g{base, Wreg + W_G, 4 * MT, 6144, DM}; SchedGate S{(int)gridDim.x, (int)blockIdx.x};
            EpiGate E{base + (size_t)B_SBK * BUFE, (float*)(base + (size_t)B_DNK * BUFE), base + (size_t)B_DNQ * BUFE};
            PT0(); pg8::gemm_phase<EpiGate, SchedGate, true, true>(ldsl, g, S, E);
        xcd_barrier(bar); PT1(4); }
        {   CArgsR a = A_; bf16* base = (bf16*)a.ws; bf16* Wreg = (bf16*)(a.ws + WS_W); const float* xin = l == 0 ? a.in[0] : a.out;
            pg8::Gemm g{base + (size_t)B_DNQ * BUFE, Wreg + W_OUT, MT, DM, DM}; pg8::StaticOrder S; S.init(MT, DM, (int)gridDim.x, (int)blockIdx.x);
            EpiResid E{xin, a.out};
            PT0(); pg8::gemm_phase<EpiResid, pg8::StaticOrder, false, true>(ldsl, g, S, E);
        xcd_barrier(bar); PT1(5); }
        {   CArgsR a = A_; bf16* base = (bf16*)a.ws; const float* nw = a.in[15] + (size_t)l * DM; const float* xo = a.out;
            const int tid = opaque_tid(), lane = tid & 63, gw = blockIdx.x * NWAVES + (tid >> 6), NGW = gridDim.x * NWAVES;
            PT0(); for (int m = gw; m < MT; m += 2 * NGW) rms_row2_to_bf16(xo + (size_t)m * DM, xo + (size_t)(m + NGW) * DM, nw, base + (size_t)m * DM, base + (size_t)(m + NGW) * DM, lane);
        xcd_barrier(bar); PT1(6); }
        {   CArgsR a = A_; bf16* base = (bf16*)a.ws; bf16* Wreg = (bf16*)(a.ws + WS_W);
            pg8::Gemm g{base, Wreg + W_UP, MT, DFF, DM}; pg8::StaticOrder S; S.init(MT, DFF, (int)gridDim.x, (int)blockIdx.x);
            EpiRelu2 E{base + (size_t)B_DNQ * BUFE};
            PT0(); pg8::gemm_phase<EpiRelu2, pg8::StaticOrder, true, true>(ldsl, g, S, E);
        xcd_barrier(bar); PT1(7); }
        {   CArgsR a = A_; bf16* base = (bf16*)a.ws; bf16* Wreg = (bf16*)(a.ws + WS_W);
            pg8::Gemm g{base + (size_t)B_DNQ * BUFE, Wreg + W_DOWN, MT, DM, DFF}; pg8::StaticOrder S; S.init(MT, DM, (int)gridDim.x, (int)blockIdx.x);
            EpiResid E{a.out, a.out};
            PT0(); pg8::gemm_phase<EpiResid, pg8::StaticOrder, false, true>(ldsl, g, S, E);
        xcd_barrier(bar); PT1(8); }
    }
    {
        CArgsR a = A_; const float* nw = a.in[18]; float* xo = a.out;
        const int tid = opaque_tid(), lane = tid & 63, gw = blockIdx.x * NWAVES + (tid >> 6), NGW = gridDim.x * NWAVES;
        for (int m = gw; m < MT; m += 2 * NGW) {
            f32x4* xr = (f32x4*)(xo + (size_t)m * DM) + lane; f32x4* xr2 = (f32x4*)(xo + (size_t)(m + NGW) * DM) + lane; const f32x4* wr = (const f32x4*)nw + lane;
            f32x4 v[4], u[4]; float s = 0.f, s2 = 0.f;
#pragma unroll
            for (int j = 0; j < 4; ++j) { v[j] = xr[64 * j]; u[j] = xr2[64 * j]; }
#pragma unroll
            for (int j = 0; j < 4; ++j) { s += (v[j][0] * v[j][0] + v[j][1] * v[j][1]) + (v[j][2] * v[j][2] + v[j][3] * v[j][3]); s2 += (u[j][0] * u[j][0] + u[j][1] * u[j][1]) + (u[j][2] * u[j][2] + u[j][3] * u[j][3]); }
            const float rstd = rsqrtf(wave_sum(s) * (1.f / DM) + EPS), rstd2 = rsqrtf(wave_sum(s2) * (1.f / DM) + EPS);
#pragma unroll
            for (int j = 0; j < 4; ++j) { const f32x4 ww = wr[64 * j]; f32x4 r, r2;
#pragma unroll
                for (int i = 0; i < 4; ++i) { r[i] = v[j][i] * rstd * ww[i]; r2[i] = u[j][i] * rstd2 * ww[i]; }
                xr[64 * j] = r; xr2[64 * j] = r2; }
        }
    }
#undef A_
    if (PROBE_SEL) { const unsigned long long t0 = rt(); while (rt() - t0 < probe_acc) __builtin_amdgcn_s_sleep(8); }
}

extern "C" void kernel_launch(void* const* d_in, const int* in_sizes, int n_in, void* d_out, int out_size, void* d_ws, size_t ws_size, hipStream_t stream) {
    static int grid = 0;
    if (grid == 0) {
        if (n_in != 19 || out_size != MT * DM || ws_size < WS_NEED) { fprintf(stderr, "kernel_launch: unexpected shapes (n_in %d out %d ws %zu need %zu)\n", n_in, out_size, ws_size, (size_t)WS_NEED); grid = -1; return; }
        int dev = 0, cus = 0, per_cu = 0;
        hipGetDevice(&dev); hipDeviceGetAttribute(&cus, hipDeviceAttributeMultiprocessorCount, dev);
        if (hipFuncSetAttribute((const void*)hybrid_fwd, hipFuncAttributeMaxDynamicSharedMemorySize, LDS_BYTES) != hipSuccess) { fprintf(stderr, "kernel_launch: hipFuncSetAttribute failed\n"); grid = -1; return; }
        if (hipOccupancyMaxActiveBlocksPerMultiprocessor(&per_cu, (const void*)hybrid_fwd, NTHREADS, LDS_BYTES) != hipSuccess || per_cu < 1) { fprintf(stderr, "kernel_launch: occupancy query gave %d\n", per_cu); per_cu = 1; }
        (void)hipGetLastError();
        grid = cus * per_cu;
    }
    if (grid < 0) return;
    if (hipMemsetAsync((char*)d_ws + WS_CTL, 0, CTL_BYTES, stream) != hipSuccess) { fprintf(stderr, "kernel_launch: memset of the control words failed\n"); return; }
    Args a{};
    for (int i = 0; i < 19; ++i) a.in[i] = (const float*)d_in[i];
    a.out = (float*)d_out; a.ws = (unsigned char*)d_ws;
    void* args[] = {&a};
    hipError_t e = hipLaunchCooperativeKernel((const void*)hybrid_fwd, dim3(grid), dim3(NTHREADS), args, LDS_BYTES, stream);
    if (e != hipSuccess) fprintf(stderr, "cooperative launch failed: %s (grid %d)\n", hipGetErrorString(e), grid);
}
```

```cpp
#include <hip/hip_runtime.h>
#include <hip/hip_cooperative_groups.h>
#include <cstdio>
#include <cstdint>
namespace cg = cooperative_groups;
__device__ __forceinline__ int opaque_tid() { int t = (int)threadIdx.x; asm volatile("" : "+v"(t)); return t; }
namespace pg8 {
#define PG8_LAS __attribute__((address_space(3)))
typedef unsigned short bf16_t;
typedef short bf16x8 __attribute__((ext_vector_type(8)));
typedef float f32x4 __attribute__((ext_vector_type(4)));
typedef unsigned u32x4 __attribute__((ext_vector_type(4)));
constexpr int BM = 256, BK = 64, HALF = 128, HTB = HALF * BK * 2  , STAGE_BYTES = 8 * HTB, NXCD = 8, WGM = 8;

__host__ __device__ __forceinline__ int lds_byte(int r, int c) { const int st = (r >> 4) * 2 + (c >> 5), rr = r & 15, cc = c & 31, ob = rr * 64 + cc * 2; return st * 1024 + (ob ^ (((ob >> 9) & 1) << 5)); }
__host__ __device__ __forceinline__ void stage_rc(int b, int& R, int& C) { const int st = b / 1024, sb = b % 1024, swz = sb ^ (((sb >> 9) & 1) << 5); R = (st >> 1) * 16 + swz / 64; C = (st & 1) * 32 + (swz % 64) / 2; }
__host__ __device__ __forceinline__ int perm32(int rho) { const int n = rho >> 4, i = rho & 15; return 8 * (i >> 2) + 4 * n + (i & 3); }

struct Unit { int pm, pn; };
struct Gemm { const bf16_t* A; const bf16_t* Bt; int M, N, K; };

struct StaticOrder {
    int nM, nN, nwg, G, c;
    __host__ __device__ void init(int M, int N, int G_, int c_) { nM = M / BM; nN = N / BM; nwg = nM * nN; G = G_; c = c_; }
    __host__ __device__ bool next(int i, Unit& u) const {
        const long L = (long)i * G + c; if (L >= nwg) return false;
        int wgid = (int)L; { const int q = nwg / NXCD, r = nwg % NXCD, xcd = wgid % NXCD, off = wgid / NXCD; wgid = (xcd < r ? xcd * (q + 1) : r * (q + 1) + (xcd - r) * q) + off; }
        const int nig = WGM * nN, gid = wgid / nig, fm = gid * WGM, gsz = (nM - fm) < WGM ? (nM - fm) : WGM;
        u.pm = fm + ((wgid % nig) % gsz); u.pn = (wgid % nig) / gsz; return true;
    }
    __device__ __forceinline__ void a_ready(const Unit&) const {}
    __device__ __forceinline__ void done(const Unit&) const {}
};
__device__ __forceinline__ unsigned cvt_pk_bf16(float lo, float hi) { unsigned r; asm volatile("v_cvt_pk_bf16_f32 %0, %1, %2" : "=v"(r) : "v"(lo), "v"(hi)); return r; }
template <class Epi, class Sched, bool ALIGN_EPI = false, bool SP2 = false>
__device__ __forceinline__ void gemm_phase(PG8_LAS unsigned char* lds, const Gemm g, const Sched& S, const Epi& E) {
    const int tid = opaque_tid(), wid = __builtin_amdgcn_readfirstlane(tid >> 6), lane = tid & 63, wr = wid >> 2, wc = wid & 3, fr = lane & 15, fq = lane >> 4;
    const int K = g.K, nt = K / BK;
    unsigned voffA[2], voffB[2];
#pragma unroll
    for (int i = 0; i < 2; ++i) { int R, C; stage_rc(tid * 16 + i * 8192, R, C); const int Rb = Epi::PERM ? ((R & ~31) + perm32(R & 31)) : R;
        voffA[i] = (unsigned)(R * K + C) * 2u; voffB[i] = (unsigned)(Rb * K + C) * 2u; }
    const size_t kstep = (size_t)(BK * 2);
    const size_t hstep = (size_t)HALF * K * 2;
    const size_t tstep = 2 * hstep;
    const unsigned ldsw = (unsigned)wid * 1024u;
    const int aoff = lds_byte(wr * 64 + fr, fq * 8), boff = lds_byte(wc * 32 + fr, fq * 8);
#define PG8_SA(b, h) (((b) * 2 + (h)) * HTB)
#define PG8_SB(b, h) ((4 + (b) * 2 + (h)) * HTB)
#define PG8_STAGE(bufoff, gbase, voff) do { _Pragma("unroll") for (int _i = 0; _i < 2; ++_i) \
        __builtin_amdgcn_global_load_lds((const unsigned*)((const char*)(gbase) + (voff)[_i]), (PG8_LAS unsigned*)(lds + (bufoff) + ldsw + _i * 8192), 16, 0, 0); } while (0)
#define PG8_LDA(dst, b, h) do { _Pragma("unroll") for (int m = 0; m < 4; ++m) _Pragma("unroll") for (int k = 0; k < 2; ++k) dst[m][k] = *(const PG8_LAS bf16x8*)(lds + PG8_SA(b, h) + aoff + m * 2048 + k * 1024); } while (0)
#define PG8_LDB(dst, b, h) do { _Pragma("unroll") for (int n = 0; n < 2; ++n) _Pragma("unroll") for (int k = 0; k < 2; ++k) dst[n][k] = *(const PG8_LAS bf16x8*)(lds + PG8_SB(b, h) + boff + n * 2048 + k * 1024); } while (0)
#define PG8_MMA(ai, bj, At, Bt) do { __builtin_amdgcn_s_setprio(1); _Pragma("unroll") for (int m = 0; m < 4; ++m) _Pragma("unroll") for (int n = 0; n < 2; ++n) _Pragma("unroll") for (int k = 0; k < 2; ++k) \
        acc[ai][bj][m][n] = __builtin_amdgcn_mfma_f32_16x16x32_bf16(Bt[n][k], At[m][k], acc[ai][bj][m][n], 0, 0, 0); __builtin_amdgcn_s_setprio(0); } while (0)
#define PG8_WAIT_V(n) asm volatile("s_waitcnt vmcnt(" #n ")" ::: "memory")
#define PG8_WAIT_L(n) asm volatile("s_waitcnt lgkmcnt(" #n ")" ::: "memory")
#define PG8_BAR __builtin_amdgcn_s_barrier()
#define PG8_SCHED __builtin_amdgcn_sched_barrier(0)
    Unit cur, nxt; int ui = 0;
    if (!S.next(0, cur)) return;
    f32x4 acc[2][2][4][2];
#pragma unroll
    for (int a = 0; a < 2; ++a)
#pragma unroll
        for (int b = 0; b < 2; ++b)
#pragma unroll
            for (int m = 0; m < 4; ++m)
#pragma unroll
                for (int n = 0; n < 2; ++n) acc[a][b][m][n] = (f32x4){0.f, 0.f, 0.f, 0.f};
    bf16x8 At[4][2], B0[2][2], B1[2][2];
    const char* cA = (const char*)g.A + (size_t)cur.pm * tstep; const char* cB = (const char*)g.Bt + (size_t)cur.pn * tstep;
    S.a_ready(cur);
    if constexpr (SP2) {
        PG8_STAGE(PG8_SB(0, 0), cB, voffB); PG8_STAGE(PG8_SB(0, 1), cB + hstep, voffB); PG8_STAGE(PG8_SA(0, 0), cA, voffA); PG8_STAGE(PG8_SA(0, 1), cA + hstep, voffA);
        if (wr == 1) PG8_BAR;
        PG8_WAIT_V(2); PG8_BAR;
        PG8_STAGE(PG8_SB(1, 0), cB + kstep, voffB); PG8_STAGE(PG8_SA(1, 0), cA + kstep, voffA); PG8_STAGE(PG8_SB(1, 1), cB + hstep + kstep, voffB);
        PG8_WAIT_V(6); PG8_BAR;
    } else {
        PG8_STAGE(PG8_SB(0, 0), cB, voffB); PG8_STAGE(PG8_SA(0, 0), cA, voffA); PG8_STAGE(PG8_SB(0, 1), cB + hstep, voffB); PG8_STAGE(PG8_SA(0, 1), cA + hstep, voffA);
        if (wr == 1) PG8_BAR;
        PG8_WAIT_V(4); PG8_BAR;
        PG8_STAGE(PG8_SB(1, 0), cB + kstep, voffB); PG8_STAGE(PG8_SA(1, 0), cA + kstep, voffA); PG8_STAGE(PG8_SB(1, 1), cB + hstep + kstep, voffB);
        PG8_WAIT_V(6); PG8_BAR;
    }
    for (;;) {
        const bool has_next = S.next(ui + 1, nxt);
        const char* nA = has_next ? (const char*)g.A + (size_t)nxt.pm * tstep : cA; const char* nB = has_next ? (const char*)g.Bt + (size_t)nxt.pn * tstep : cB;
        for (int t = 0; t < nt; t += 2) {
            const bool last = (t == nt - 2);
            const char* a1 = cA + (size_t)(t + 1) * kstep;
            const char* a2 = last ? nA : cA + (size_t)(t + 2) * kstep; const char* b2 = last ? nB : cB + (size_t)(t + 2) * kstep;
            const char* a3 = a2 + kstep; const char* b3 = b2 + kstep;
            if (last && has_next) S.a_ready(nxt);
            if constexpr (SP2) {
            PG8_LDB(B0, 0, 0); PG8_LDB(B1, 0, 1); PG8_SCHED; PG8_LDA(At, 0, 0); PG8_STAGE(PG8_SA(1, 1), a1 + hstep, voffA);
            PG8_WAIT_V(8); PG8_WAIT_L(0); PG8_BAR; PG8_MMA(0, 0, At, B0); PG8_MMA(0, 1, At, B1); PG8_BAR; PG8_SCHED;
            PG8_LDA(At, 0, 1); PG8_STAGE(PG8_SB(0, 0), b2, voffB); PG8_STAGE(PG8_SB(0, 1), b2 + hstep, voffB); PG8_STAGE(PG8_SA(0, 0), a2, voffA);
            PG8_WAIT_V(8); PG8_WAIT_L(0); PG8_BAR; PG8_MMA(1, 0, At, B0); PG8_MMA(1, 1, At, B1); PG8_BAR; PG8_SCHED;
            PG8_LDB(B0, 1, 0); PG8_LDB(B1, 1, 1); PG8_SCHED; PG8_LDA(At, 1, 0); PG8_STAGE(PG8_SA(0, 1), a2 + hstep, voffA);
            PG8_WAIT_V(8); PG8_WAIT_L(0); PG8_BAR; PG8_MMA(0, 0, At, B0); PG8_MMA(0, 1, At, B1); PG8_BAR; PG8_SCHED;
            PG8_LDA(At, 1, 1); PG8_STAGE(PG8_SB(1, 0), b3, voffB); PG8_STAGE(PG8_SB(1, 1), b3 + hstep, voffB); PG8_STAGE(PG8_SA(1, 0), a3, voffA);
            PG8_WAIT_V(8); PG8_WAIT_L(0); PG8_BAR; PG8_MMA(1, 0, At, B0); PG8_MMA(1, 1, At, B1); PG8_BAR; PG8_SCHED;
            } else {
            PG8_LDB(B0, 0, 0); PG8_SCHED; PG8_LDA(At, 0, 0); PG8_STAGE(PG8_SA(1, 1), a1 + hstep, voffA);
            PG8_WAIT_L(8); PG8_BAR; PG8_WAIT_L(0); PG8_MMA(0, 0, At, B0); PG8_BAR; PG8_SCHED;
            PG8_LDB(B1, 0, 1); PG8_STAGE(PG8_SB(0, 0), b2, voffB);
            PG8_BAR; PG8_WAIT_L(0); PG8_MMA(0, 1, At, B1); PG8_BAR;
            PG8_LDA(At, 0, 1); PG8_STAGE(PG8_SA(0, 0), a2, voffA);
            PG8_BAR; PG8_WAIT_L(0); PG8_MMA(1, 0, At, B0); PG8_BAR; PG8_SCHED;
            PG8_STAGE(PG8_SB(0, 1), b2 + hstep, voffB);
            PG8_WAIT_V(6); PG8_BAR; PG8_MMA(1, 1, At, B1); PG8_BAR;
            PG8_LDB(B0, 1, 0); PG8_SCHED; PG8_LDA(At, 1, 0); PG8_STAGE(PG8_SA(0, 1), a2 + hstep, voffA);
            PG8_WAIT_L(8); PG8_BAR; PG8_WAIT_L(0); PG8_MMA(0, 0, At, B0); PG8_BAR; PG8_SCHED;
            PG8_LDB(B1, 1, 1); PG8_STAGE(PG8_SB(1, 0), b3, voffB);
            PG8_BAR; PG8_WAIT_L(0); PG8_MMA(0, 1, At, B1); PG8_BAR;
            PG8_LDA(At, 1, 1); PG8_STAGE(PG8_SA(1, 0), a3, voffA);
            PG8_BAR; PG8_WAIT_L(0); PG8_MMA(1, 0, At, B0); PG8_BAR; PG8_SCHED;
            PG8_STAGE(PG8_SB(1, 1), b3 + hstep, voffB);
            PG8_WAIT_V(6); PG8_BAR; PG8_MMA(1, 1, At, B1); PG8_BAR;
            }
        }
        if constexpr (ALIGN_EPI) { if (wr == 0) PG8_BAR; }
        if constexpr (!Epi::AFTER_DRAIN) { E(acc, cur, wr, wc, fr, fq); S.done(cur); }
        if (!has_next) break;
#pragma unroll
        for (int a = 0; a < 2; ++a)
#pragma unroll
            for (int b = 0; b < 2; ++b)
#pragma unroll
                for (int m = 0; m < 4; ++m)
#pragma unroll
                    for (int n = 0; n < 2; ++n) acc[a][b][m][n] = (f32x4){0.f, 0.f, 0.f, 0.f};
        cur = nxt; cA = nA; cB = nB; ++ui;
        if constexpr (ALIGN_EPI) { if (wr == 1) PG8_BAR; }
    }
    PG8_WAIT_V(0);
    if constexpr (!ALIGN_EPI) { if (wr == 0) PG8_BAR; }
    PG8_BAR;
    if constexpr (Epi::AFTER_DRAIN) { E.fused(acc, cur, wr, wc, fr, fq, lds, wid, lane); S.done(cur); }
#undef PG8_SA
#undef PG8_SB
#undef PG8_STAGE
#undef PG8_LDA
#undef PG8_LDB
#undef PG8_MMA
#undef PG8_WAIT_V
#undef PG8_WAIT_L
#undef PG8_BAR
#undef PG8_SCHED
}
}

constexpr int NB = 8, SEQ = 2048, DM = 1024, MT = NB * SEQ, DFF = 4096, IN_DIM = 13344;
constexpr int NTHREADS = 512, NWAVES = 8, LDS_BYTES = 147456;
constexpr float EPS = 1e-6f;
typedef unsigned short bf16;
typedef unsigned v4u __attribute__((ext_vector_type(4)));
typedef unsigned v2u __attribute__((ext_vector_type(2)));
typedef float f32x4 __attribute__((ext_vector_type(4)));
typedef short bf16x8 __attribute__((ext_vector_type(8)));
enum { B_H = 0, B_DNG = 1, B_SBQ = 2, B_SSZ = 3, B_DNQ = 4, B_DNK = 5, B_DNV = 6, B_SBK = 7, B_SBV = 8, B_SSX = 9, B_SSBC = 10, NBUF = 11 };
constexpr size_t BUFE = (size_t)MT * DM;
constexpr size_t WS_W = NBUF * BUFE * 2;
constexpr size_t W_IN = 0, W_G = W_IN + (size_t)10240 * 1024, W_OUT = W_G + (size_t)6144 * 1024, W_UP = W_OUT + (size_t)1024 * 1024,
                 W_DOWN = W_UP + (size_t)4096 * 1024, W_END = W_DOWN + (size_t)4096 * 1024;
constexpr size_t WS_SMALL = WS_W + W_END * 2;
constexpr size_t WS_CTL = WS_SMALL + (size_t)MT * 64 * 4;
constexpr size_t WS_BAR = WS_CTL + 4096;
constexpr size_t CTL_BYTES = 4096 + 16384;
constexpr size_t WS_NEED = WS_CTL + CTL_BYTES;

__device__ __forceinline__ float bf2f(unsigned u) { return __builtin_bit_cast(float, u << 16); }
__device__ __forceinline__ unsigned f2bf(float f) { unsigned u = __builtin_bit_cast(unsigned, f); return (u + 0x7fffu + ((u >> 16) & 1u)) >> 16; }
typedef float f32x2 __attribute__((ext_vector_type(2)));
typedef __bf16 bf16x2_t __attribute__((ext_vector_type(2)));
__device__ __forceinline__ unsigned pk2(float lo, float hi) { f32x2 v = {lo, hi}; return __builtin_bit_cast(unsigned, __builtin_convertvector(v, bf16x2_t)); }
__device__ __forceinline__ void unpack8(v4u r, float* o) {
    o[0] = bf2f(r.x & 0xffffu); o[1] = __builtin_bit_cast(float, r.x & 0xffff0000u); o[2] = bf2f(r.y & 0xffffu); o[3] = __builtin_bit_cast(float, r.y & 0xffff0000u);
    o[4] = bf2f(r.z & 0xffffu); o[5] = __builtin_bit_cast(float, r.z & 0xffff0000u); o[6] = bf2f(r.w & 0xffffu); o[7] = __builtin_bit_cast(float, r.w & 0xffff0000u);
}
__device__ __forceinline__ v4u pack8(const float* v) { v4u w; w.x = pk2(v[0], v[1]); w.y = pk2(v[2], v[3]); w.z = pk2(v[4], v[5]); w.w = pk2(v[6], v[7]); return w; }
__device__ __forceinline__ float sigmoidf_(float x) { return __builtin_amdgcn_rcpf(1.f + __expf(-x)); }
__device__ __forceinline__ float siluf_(float x) { return x * __builtin_amdgcn_rcpf(1.f + __expf(-x)); }
__device__ __forceinline__ float softplusf_(float x) { return fmaxf(x, 0.f) + log1pf(__expf(-fabsf(x))); }
template <int CTRL> __device__ __forceinline__ float dppf(float v) { return __builtin_bit_cast(float, __builtin_amdgcn_update_dpp(0, __builtin_bit_cast(int, v), CTRL, 0xF, 0xF, true)); }
__device__ __forceinline__ float red8(float v) { v += dppf<0xB1>(v); v += dppf<0x4E>(v); v += dppf<0x141>(v); return v; }
__device__ __forceinline__ float red16(float v) { v = red8(v); v += dppf<0x140>(v); return v; }
__device__ __forceinline__ float wave_sum(float v) {
#pragma unroll
    for (int o = 1; o < 64; o <<= 1) v += __shfl_xor(v, o);
    return v;
}
#define LDS_WAIT() asm volatile("s_waitcnt lgkmcnt(0)" ::: "memory")

struct Args { const float* in[19]; float* out; unsigned char* ws; };
typedef const __attribute__((address_space(4))) Args& CArgsR;
__device__ __forceinline__ const __attribute__((address_space(4))) Args* kargs() { unsigned long long v = (unsigned long long)__builtin_amdgcn_kernarg_segment_ptr(); asm volatile("" : "+s"(v)); return (const __attribute__((address_space(4))) Args*)v; }
#ifndef PROBE_SEL
#define PROBE_SEL 0
#endif
__device__ __forceinline__ unsigned long long rt() { return __builtin_amdgcn_s_memrealtime(); }
#define PT0() unsigned long long pt_ = PROBE_SEL ? rt() : 0ull
#define PT1(k) do { if (PROBE_SEL & (1 << (k))) probe_acc += rt() - pt_; } while (0)

struct EpiRoute {
    static constexpr bool PERM = true, AFTER_DRAIN = false;
    bf16* base; int pn_off;
    __device__ __forceinline__ void operator()(const pg8::f32x4 (&acc)[2][2][4][2], const pg8::Unit& u, int wr, int wc, int fr, int fq) const {
        const int sg = (u.pn + pn_off) >> 2;
        const int bufi = sg == 0 ? B_DNG : sg == 1 ? B_DNQ : sg == 2 ? B_DNK : sg == 3 ? B_DNV : sg == 4 ? B_SBQ : sg == 5 ? B_SSZ : sg == 6 ? B_SBK : sg == 7 ? B_SBV : sg == 8 ? B_SSX : B_SSBC;
        bf16* O = base + (size_t)bufi * BUFE;
        const int col0 = (u.pn & 3) * 256 + wc * 32 + 8 * fq, row0 = u.pm * 256 + wr * 64 + fr;
#pragma unroll
        for (int ai = 0; ai < 2; ++ai)
#pragma unroll
            for (int m = 0; m < 4; ++m) { bf16* rowp = O + (size_t)(row0 + ai * 128 + m * 16) * DM + col0;
#pragma unroll
                for (int bj = 0; bj < 2; ++bj) { const pg8::f32x4 v0 = acc[ai][bj][m][0], v1 = acc[ai][bj][m][1];
                    v4u w; w.x = pk2(v0[0], v0[1]); w.y = pk2(v0[2], v0[3]); w.z = pk2(v1[0], v1[1]); w.w = pk2(v1[2], v1[3]);
                    *(v4u*)(rowp + bj * 128) = w; } }
    }
};
struct EpiRelu2 {
    static constexpr bool PERM = true, AFTER_DRAIN = false;
    bf16* O;
    __device__ __forceinline__ void operator()(const pg8::f32x4 (&acc)[2][2][4][2], const pg8::Unit& u, int wr, int wc, int fr, int fq) const {
        const int col0 = u.pn * 256 + wc * 32 + 8 * fq, row0 = u.pm * 256 + wr * 64 + fr;
#pragma unroll
        for (int ai = 0; ai < 2; ++ai)
#pragma unroll
            for (int m = 0; m < 4; ++m) { bf16* rowp = O + (size_t)(row0 + ai * 128 + m * 16) * DFF + col0;
#pragma unroll
                for (int bj = 0; bj < 2; ++bj) { float v[8];
#pragma unroll
                    for (int i = 0; i < 4; ++i) { float a = fmaxf(acc[ai][bj][m][0][i], 0.f), b = fmaxf(acc[ai][bj][m][1][i], 0.f); v[i] = a * a; v[4 + i] = b * b; }
                    *(v4u*)(rowp + bj * 128) = pack8(v); } }
    }
};
struct EpiResid {
    static constexpr bool PERM = true, AFTER_DRAIN = false;
    const float* xin; float* xout;
    __device__ __forceinline__ void operator()(const pg8::f32x4 (&acc)[2][2][4][2], const pg8::Unit& u, int wr, int wc, int fr, int fq) const {
        const int col0 = u.pn * 256 + wc * 32 + 8 * fq, row0 = u.pm * 256 + wr * 64 + fr;
#pragma unroll
        for (int ai = 0; ai < 2; ++ai)
#pragma unroll
            for (int m = 0; m < 4; ++m) { const size_t ro = (size_t)(row0 + ai * 128 + m * 16) * DM + col0;
#pragma unroll
                for (int bj = 0; bj < 2; ++bj) { const size_t o = ro + bj * 128;
                    const f32x4 a = *(const f32x4*)(xin + o), b = *(const f32x4*)(xin + o + 4);
                    f32x4 r0, r1;
#pragma unroll
                    for (int i = 0; i < 4; ++i) { r0[i] = a[i] + acc[ai][bj][m][0][i]; r1[i] = b[i] + acc[ai][bj][m][1][i]; }
                    *(f32x4*)(xout + o) = r0; *(f32x4*)(xout + o + 4) = r1; } }
    }
};
struct SchedGate {
    int G, c;
    __device__ __forceinline__ bool next(int i, pg8::Unit& u) const {
        const int tile = c + (i / 6) * G; if (tile >= 256) return false;
        const int s = i % 6, br = s >> 1, xj = tile >> 3, pm = (tile & 7) * 8 + (xj >> 2), pn = xj & 3;
        if ((s & 1) == 0) { u.pm = pm; u.pn = br * 4 + pn; } else { u.pm = (1 + br) * 64 + pm; u.pn = (3 + br) * 4 + pn; }
        return true;
    }
    __device__ __forceinline__ void a_ready(const pg8::Unit&) const {}
    __device__ __forceinline__ void done(const pg8::Unit&) const {}
};
struct EpiGate {
    static constexpr bool PERM = true, AFTER_DRAIN = false;
    bf16* gsc; float* macc; bf16* merged;
    __device__ __forceinline__ void operator()(const pg8::f32x4 (&acc)[2][2][4][2], const pg8::Unit& u, int wr, int wc, int fr, int fq) const {
        const int j = u.pn >> 2, pn = u.pn & 3, pm = u.pm & 63;
        const int col0 = pn * 256 + wc * 32 + 8 * fq, row0 = pm * 256 + wr * 64 + fr;
#pragma unroll
        for (int ai = 0; ai < 2; ++ai)
#pragma unroll
            for (int m = 0; m < 4; ++m) { const size_t ro = (size_t)(row0 + ai * 128 + m * 16) * DM + col0;
#pragma unroll
                for (int bj = 0; bj < 2; ++bj) { const size_t o = ro + bj * 128; float v[8];
#pragma unroll
                    for (int i = 0; i < 4; ++i) { v[i] = acc[ai][bj][m][0][i]; v[4 + i] = acc[ai][bj][m][1][i]; }
                    if (j < 3) {
#pragma unroll
                        for (int i = 0; i < 8; ++i) v[i] = sigmoidf_(v[i]);
                        *(v4u*)(gsc + o) = pack8(v);
                    } else {
                        float g[8]; unpack8(*(const v4u*)(gsc + o), g);
#pragma unroll
                        for (int i = 0; i < 8; ++i) v[i] *= g[i];
                        if (j > 3) { const f32x4 a = *(const f32x4*)(macc + o), b = *(const f32x4*)(macc + o + 4);
#pragma unroll
                            for (int i = 0; i < 4; ++i) { v[i] += a[i]; v[4 + i] += b[i]; } }
                        if (j < 5) { *(f32x4*)(macc + o) = (f32x4){v[0], v[1], v[2], v[3]}; *(f32x4*)(macc + o + 4) = (f32x4){v[4], v[5], v[6], v[7]}; }
                        else *(v4u*)(merged + o) = pack8(v);
                    } } }
    }
};

__device__ __forceinline__ void transpose_item(const float* __restrict__ W, const float* __restrict__ W2, int ldw, bf16* __restrict__ WT, int K, int nblk, float* scr, int item, int lane) {
    const int kb = item / nblk, nb = item % nblk, k0 = 64 * kb, n0 = 32 * nb;
    const float* src = ((lane & 31) < 16 ? W : W2) + (size_t)(k0 + (lane >> 5)) * ldw + n0 + (lane & 31);
    float t[32];
#pragma unroll
    for (int i = 0; i < 32; ++i) t[i] = src[(size_t)(2 * i) * ldw];
#pragma unroll
    for (int i = 0; i < 32; ++i) scr[(2 * i + (lane >> 5)) * 33 + (lane & 31)] = t[i];
    LDS_WAIT();
    const int c = lane & 7;
#pragma unroll
    for (int j = 0; j < 4; ++j) { const int n = (lane >> 3) + 8 * j; const float* s = scr + (8 * c) * 33 + n;
        v4u o; o.x = pk2(s[0 * 33], s[1 * 33]); o.y = pk2(s[2 * 33], s[3 * 33]); o.z = pk2(s[4 * 33], s[5 * 33]); o.w = pk2(s[6 * 33], s[7 * 33]);
        *(v4u*)(WT + (size_t)(n0 + n) * K + k0 + 8 * c) = o; }
    LDS_WAIT();
}
__device__ __forceinline__ void rms_row_to_bf16(const float* xrow, const float* w, bf16* orow, int lane) {
    const f32x4* xr = (const f32x4*)xrow + lane; const f32x4* wr = (const f32x4*)w + lane;
    f32x4 v[4]; float s = 0.f;
#pragma unroll
    for (int j = 0; j < 4; ++j) { v[j] = xr[64 * j]; s += (v[j][0] * v[j][0] + v[j][1] * v[j][1]) + (v[j][2] * v[j][2] + v[j][3] * v[j][3]); }
    const float rstd = rsqrtf(wave_sum(s) * (1.f / DM) + EPS);
    unsigned long long* o8 = (unsigned long long*)orow + lane;
#pragma unroll
    for (int j = 0; j < 4; ++j) { const f32x4 ww = wr[64 * j];
        o8[64 * j] = (unsigned long long)pk2(v[j][0] * rstd * ww[0], v[j][1] * rstd * ww[1]) | ((unsigned long long)pk2(v[j][2] * rstd * ww[2], v[j][3] * rstd * ww[3]) << 32); }
}
template <int NR> __device__ __forceinline__ void rms_rows_to_bf16(const float* x, size_t rstride, const float* w, bf16* o, int lane) {
    const f32x4* wr = (const f32x4*)w + lane;
    f32x4 v[NR][4]; float ss[NR];
#pragma unroll
    for (int r = 0; r < NR; ++r)
#pragma unroll
        for (int j = 0; j < 4; ++j) v[r][j] = ((const f32x4*)(x + r * rstride) + lane)[64 * j];
#pragma unroll
    for (int r = 0; r < NR; ++r) { float s = 0.f;
#pragma unroll
        for (int j = 0; j < 4; ++j) s += (v[r][j][0] * v[r][j][0] + v[r][j][1] * v[r][j][1]) + (v[r][j][2] * v[r][j][2] + v[r][j][3] * v[r][j][3]);
        ss[r] = s; }
#pragma unroll
    for (int r = 0; r < NR; ++r) ss[r] = rsqrtf(wave_sum(ss[r]) * (1.f / DM) + EPS);
#pragma unroll
    for (int j = 0; j < 4; ++j) { const f32x4 ww = wr[64 * j];
#pragma unroll
        for (int r = 0; r < NR; ++r) { unsigned long long* p = (unsigned long long*)(o + r * rstride) + lane;
            p[64 * j] = (unsigned long long)pk2(v[r][j][0] * ss[r] * ww[0], v[r][j][1] * ss[r] * ww[1]) | ((unsigned long long)pk2(v[r][j][2] * ss[r] * ww[2], v[r][j][3] * ss[r] * ww[3]) << 32); } }
}
__device__ __forceinline__ void rms_row2_to_bf16(const float* xa, const float* xb, const float* w, bf16* oa, bf16* ob, int lane) {
    const f32x4* xra = (const f32x4*)xa + lane; const f32x4* xrb = (const f32x4*)xb + lane; const f32x4* wr = (const f32x4*)w + lane;
    f32x4 va[4], vb[4]; float sa = 0.f, sb = 0.f;
#pragma unroll
    for (int j = 0; j < 4; ++j) { va[j] = xra[64 * j]; vb[j] = xrb[64 * j]; }
#pragma unroll
    for (int j = 0; j < 4; ++j) { sa += (va[j][0] * va[j][0] + va[j][1] * va[j][1]) + (va[j][2] * va[j][2] + va[j][3] * va[j][3]); sb += (vb[j][0] * vb[j][0] + vb[j][1] * vb[j][1]) + (vb[j][2] * vb[j][2] + vb[j][3] * vb[j][3]); }
    const float ra = rsqrtf(wave_sum(sa) * (1.f / DM) + EPS), rb = rsqrtf(wave_sum(sb) * (1.f / DM) + EPS);
    unsigned long long* pa = (unsigned long long*)oa + lane; unsigned long long* pb = (unsigned long long*)ob + lane;
#pragma unroll
    for (int j = 0; j < 4; ++j) { const f32x4 ww = wr[64 * j];
        pa[64 * j] = (unsigned long long)pk2(va[j][0] * ra * ww[0], va[j][1] * ra * ww[1]) | ((unsigned long long)pk2(va[j][2] * ra * ww[2], va[j][3] * ra * ww[3]) << 32);
        pb[64 * j] = (unsigned long long)pk2(vb[j][0] * rb * ww[0], vb[j][1] * rb * ww[1]) | ((unsigned long long)pk2(vb[j][2] * rb * ww[2], vb[j][3] * rb * ww[3]) << 32); }
}
__device__ __forceinline__ void phase0(unsigned char* lds, CArgsR a, int l, const float* xin) {
    constexpr int LDW = 1032;
    const int tid = opaque_tid(), lane = tid & 63, wave = __builtin_amdgcn_readfirstlane(tid >> 6), gw = blockIdx.x * NWAVES + wave, NGW = gridDim.x * NWAVES;
    bf16* Wreg = (bf16*)(a.ws + WS_W);
    const float* w_in = a.in[2] + (size_t)l * DM * IN_DIM;
    {
        float* scr = (float*)lds + wave * (64 * 33);
        const float* w_br = a.in[13] + (size_t)l * 3 * DM * DM; const float* w_out = a.in[14] + (size_t)l * DM * DM;
        const float* w_up = a.in[16] + (size_t)l * DM * DFF; const float* w_down = a.in[17] + (size_t)l * DFF * DM;
        constexpr int NSEG = 17, NIT = NSEG * 512 + 2048 + 2048;
        for (int it = gw; it < NIT; it += NGW) {
            if (it < NSEG * 512) {
                const int seg = it >> 9, r = it & 511;
                const float* W; int ldw; bf16* WT;
                if (seg < 13) {
                    const int co = seg == 0 ? 3072 : seg == 1 ? 0 : seg == 2 ? 1024 : seg == 3 ? 2048 : seg == 4 ? 4112 : seg == 5 ? 7184 : seg == 6 ? 5136 : seg == 7 ? 6160 : seg == 8 ? 8208 : seg == 9 ? 9232
                                 : 10272 + (seg - 10) * 1024;
                    W = w_in + co; ldw = IN_DIM; WT = seg < 10 ? Wreg + (size_t)seg * DM * DM : Wreg + W_G + (size_t)(seg - 10) * DM * DM;
                } else if (seg < 16) { W = w_br + (size_t)(seg - 13) * DM * DM; ldw = DM; WT = Wreg + W_G + (size_t)(3 + seg - 13) * DM * DM; }
                else { W = w_out; ldw = DM; WT = Wreg + W_OUT; }
                transpose_item(W, W, ldw, WT, DM, 32, scr, r, lane);
            } else if (it < NSEG * 512 + 2048) transpose_item(w_up, w_up, DFF, Wreg + W_UP, DM, 128, scr, it - NSEG * 512, lane);
            else transpose_item(w_down, w_down, DM, Wreg + W_DOWN, DFF, 32, scr, it - NSEG * 512 - 2048, lane);
        }
    }
    __syncthreads();
    bf16* WsT = (bf16*)lds;
    for (int idx = tid; idx < 32 * DM; idx += NTHREADS) { const int k = idx >> 5, c = idx & 31; WsT[c * LDW + k] = (bf16)f2bf(w_in[(size_t)k * IN_DIM + (c < 16 ? 4096 + c : 10256 + c - 16)]); }
    __syncthreads();
    {   const float* nw = a.in[1] + (size_t)l * DM; bf16* H = (bf16*)a.ws; float* small = (float*)(a.ws + WS_SMALL);
        const int fr = lane & 15, fq = lane >> 4;
        const float pa0 = __expf(a.in[4][l * 8 + (fr & 7)]), pb0 = a.in[5][l * 8 + (fr & 7)], pa1 = __expf(a.in[9][l * 16 + fr]), pb1 = a.in[10][l * 16 + fr];
        for (int g8 = gw; g8 < MT / 8; g8 += NGW) {
            const int r0 = g8 * 8;
#pragma unroll 1
            for (int r = 0; r < 8; ++r) rms_row_to_bf16(xin + (size_t)(r0 + r) * DM, nw, H + (size_t)(r0 + r) * DM, lane);
            asm volatile("s_waitcnt vmcnt(0)" ::: "memory");
            f32x4 c0 = {0.f, 0.f, 0.f, 0.f}, c1 = {0.f, 0.f, 0.f, 0.f};
            const bf16* ap = H + (size_t)(r0 + (fr & 7)) * DM + fq * 8;
#pragma unroll
            for (int kb = 0; kb < 4; ++kb) { bf16x8 af[8];
#pragma unroll
                for (int k = 0; k < 8; ++k) af[k] = *(const bf16x8*)(ap + (kb * 8 + k) * 32);
#pragma unroll
                for (int k = 0; k < 8; ++k) { const bf16x8 b0 = *(const bf16x8*)(WsT + fr * LDW + (kb * 8 + k) * 32 + fq * 8), b1 = *(const bf16x8*)(WsT + (16 + fr) * LDW + (kb * 8 + k) * 32 + fq * 8);
                    c0 = __builtin_amdgcn_mfma_f32_16x16x32_bf16(af[k], b0, c0, 0, 0, 0); c1 = __builtin_amdgcn_mfma_f32_16x16x32_bf16(af[k], b1, c1, 0, 0, 0); } }
            if (fq < 2) {
#pragma unroll
                for (int jj = 0; jj < 4; ++jj) { float* sp = small + (size_t)(r0 + 4 * fq + jj) * 64;
                    sp[fr] = fr < 8 ? -pa0 * softplusf_(c0[jj] + pb0) : sigmoidf_(c0[jj]);
                    const float dt = softplusf_(c1[jj] + pb1); sp[16 + fr] = dt; sp[32 + fr] = -pa1 * dt; } }
        }
    }
}

__device__ __forceinline__ void conv8(const bf16* p, int pos, const float* w, int wstride, const float* bias, float* out) {
    float acc[8];
#pragma unroll
    for (int i = 0; i < 8; ++i) acc[i] = bias ? bias[i] : 0.f;
#pragma unroll
    for (int j = 0; j < 4; ++j) { const int back = 3 - j;
        if (pos - back >= 0) { float xv[8]; unpack8(*(const v4u*)(p - (size_t)back * DM), xv);
            const f32x4 w0 = *(const f32x4*)(w + j * wstride), w1 = *(const f32x4*)(w + j * wstride + 4);
#pragma unroll
            for (int i = 0; i < 4; ++i) { acc[i] += xv[i] * w0[i]; acc[4 + i] += xv[4 + i] * w1[i]; } } }
#pragma unroll
    for (int i = 0; i < 8; ++i) out[i] = siluf_(acc[i]);
}

__device__ __forceinline__ void conv8r(const v4u (&raw)[4], const float* w, int wstride, const float* bias, float* out) {
    float acc[8];
#pragma unroll
    for (int i = 0; i < 8; ++i) acc[i] = bias ? bias[i] : 0.f;
#pragma unroll
    for (int j = 0; j < 4; ++j) { float xv[8]; unpack8(raw[j], xv);
        const f32x4 w0 = *(const f32x4*)(w + j * wstride), w1 = *(const f32x4*)(w + j * wstride + 4);
#pragma unroll
        for (int i = 0; i < 4; ++i) { acc[i] += xv[i] * w0[i]; acc[4 + i] += xv[4 + i] * w1[i]; } }
#pragma unroll
    for (int i = 0; i < 8; ++i) out[i] = siluf_(acc[i]);
}
#define LOAD4(dst, p, pos) do { _Pragma("unroll") for (int j_ = 0; j_ < 4; ++j_) { const int back_ = 3 - j_; const bool ok_ = (pos) - back_ >= 0; \
        const v4u t_ = *(const v4u*)((p) - (size_t)(ok_ ? back_ : 0) * DM); dst[j_] = ok_ ? t_ : (v4u){0u, 0u, 0u, 0u}; } } while (0)

template <int K> __device__ __forceinline__ void mma16(f32x4& acc, const bf16* Ap, int lda, const bf16* Bp, int ldb, int fr, int fq) {
    bf16x8 af[K / 32], bfv[K / 32];
#pragma unroll
    for (int k = 0; k < K / 32; ++k) { af[k] = *(const bf16x8*)(Ap + fr * lda + k * 32 + fq * 8); bfv[k] = *(const bf16x8*)(Bp + fr * ldb + k * 32 + fq * 8); }
#pragma unroll
    for (int k = 0; k < K / 32; ++k) acc = __builtin_amdgcn_mfma_f32_16x16x32_bf16(af[k], bfv[k], acc, 0, 0, 0);
}
template <bool SA, bool SB> __device__ __forceinline__ void mma32s(f32x4& acc, const bf16* Ap, int rA0, int lda, const bf16* Bp, int rB0, int ldb, int fr, int fq) {
    const int ra = rA0 + fr, rb = rB0 + fr;
    const bf16x8 af = *(const bf16x8*)(Ap + ra * lda + ((SA ? (fq ^ ((ra >> 3) & 3)) : fq) << 3));
    const bf16x8 bfv = *(const bf16x8*)(Bp + rb * ldb + ((SB ? (fq ^ ((rb >> 3) & 3)) : fq) << 3));
    acc = __builtin_amdgcn_mfma_f32_16x16x32_bf16(af, bfv, acc, 0, 0, 0);
}
__device__ __forceinline__ void dn_item(unsigned char* lds, CArgsR a, int l, int item, unsigned long long& probe_acc) {
    constexpr int LDK = 136, LDJ = 40, LDL = 36;
    const int b = item >> 3, h = item & 7;
    bf16* kA = (bf16*)lds;
    bf16* qA = kA + 32 * LDK;
    bf16* qgA = qA + 32 * LDK;
    bf16* wA = qgA + 32 * LDK;
    bf16* kdT = wA + 32 * LDK;
    bf16* vnT = kdT + 128 * LDJ;
    bf16* attn = vnT + 128 * LDJ;
    bf16* ST = attn + 32 * LDJ;
    float* kf = (float*)(ST + 128 * LDK);
    float* vf = kf + 32 * 128;
    float* os = kf;
    float* Lm = vf + 32 * 128;
    float* gcs = Lm + 32 * LDL;
    float* betas = gcs + 32;
    float* cwL = betas + 32;
    const int tid = opaque_tid(), w = __builtin_amdgcn_readfirstlane(tid >> 6), lane = tid & 63, fr = lane & 15, fq = lane >> 4;
    bf16* base = (bf16*)a.ws;
    const bf16* Q = base + (size_t)B_DNQ * BUFE; const bf16* K = base + (size_t)B_DNK * BUFE; const bf16* V = base + (size_t)B_DNV * BUFE; bf16* G = base + (size_t)B_DNG * BUFE;
    const float* small = (const float*)(a.ws + WS_SMALL);
    const float* cw = a.in[3] + (size_t)l * 4 * 3072;
    const size_t rowbase = (size_t)b * SEQ;
    const int tq = tid >> 4, cq = tid & 15;
    const float* nwp = a.in[6] + l * 128 + cq * 8;
    f32x4 Sacc[8];
#pragma unroll
    for (int i = 0; i < 8; ++i) Sacc[i] = (f32x4){0.f, 0.f, 0.f, 0.f};
    for (int i = tid; i < 128 * LDK / 2; i += NTHREADS) ((unsigned*)ST)[i] = 0u;
    for (int i = tid; i < 4 * 384; i += NTHREADS) { const int j = i / 384, r = i % 384; cwL[i] = cw[j * 3072 + (r >> 7) * 1024 + h * 128 + (r & 127)]; }
    __syncthreads();
    const int ta = ((tid - 256) >> 4) & 15;
    v4u rqa[4], rka[4], rva[4], rqb[4], rkb[4], rvb[4]; float rg = 0.f, rbv = 0.f;
    v4u Pv[2];
    Pv[0] = Pv[1] = (v4u){0u, 0u, 0u, 0u};
#define DN_LOADS_RAW(c_, half_) do { const int pos_ = (c_) * 32 + ta + 16 * (half_); const size_t off_ = (rowbase + pos_) * DM + h * 128 + cq * 8; LOAD4(rqa, Q + off_, pos_); LOAD4(rka, K + off_, pos_); LOAD4(rva, V + off_, pos_); } while (0)
#define DN_LOADS_RAWB(c_) do { const int pos_ = (c_) * 32 + ta + 16; const size_t off_ = (rowbase + pos_) * DM + h * 128 + cq * 8; LOAD4(rqb, Q + off_, pos_); LOAD4(rkb, K + off_, pos_); LOAD4(rvb, V + off_, pos_); } while (0)
#define DN_LOADS_SMALL(c_) do { const int t0_ = (c_) * 32; \
        { const size_t r_ = rowbase + t0_ + (lane & 31); rg = small[r_ * 64 + h]; rbv = small[r_ * 64 + 8 + h]; } } while (0)
#define DN_CONV(rq_, rk_, rv_, slot_) do { const float* cw_ = cwL + cq * 8; asm volatile("" : "+v"(cw_)); \
        { float o8_[8]; conv8r(rq_, cw_, 384, nullptr, o8_); float ss_ = 0.f; _Pragma("unroll") for (int i_ = 0; i_ < 8; ++i_) ss_ += o8_[i_] * o8_[i_]; \
          ss_ = red16(ss_); const float rn_ = rsqrtf(ss_ + EPS) * 0.08838834764831845f; _Pragma("unroll") for (int i_ = 0; i_ < 8; ++i_) o8_[i_] *= rn_; *(v4u*)(qA + (ta + 16 * (slot_)) * LDK + cq * 8) = pack8(o8_); } \
        __builtin_amdgcn_sched_barrier(0); \
        { float o8_[8]; conv8r(rk_, cw_ + 128, 384, nullptr, o8_); float ss_ = 0.f; _Pragma("unroll") for (int i_ = 0; i_ < 8; ++i_) ss_ += o8_[i_] * o8_[i_]; \
          ss_ = red16(ss_); const float rn_ = rsqrtf(ss_ + EPS); _Pragma("unroll") for (int i_ = 0; i_ < 8; ++i_) o8_[i_] *= rn_; *(v4u*)(kA + (ta + 16 * (slot_)) * LDK + cq * 8) = pack8(o8_); } \
        __builtin_amdgcn_sched_barrier(0); \
        { float o8_[8]; conv8r(rv_, cw_ + 256, 384, nullptr, o8_); Pv[slot_] = pack8(o8_); } \
        __builtin_amdgcn_sched_barrier(0); } while (0)
    if (w >= 4) { DN_LOADS_RAW(0, 0); DN_CONV(rqa, rka, rva, 0); DN_LOADS_RAW(0, 1); DN_CONV(rqa, rka, rva, 1); }
    DN_LOADS_SMALL(0);
    for (int c = 0; c < SEQ / 32; ++c) {
        const int t0 = c * 32;
        unsigned long long tp_ = PROBE_SEL ? rt() : 0ull;
#define DPT(k) do { if (PROBE_SEL) { const unsigned long long tn_ = rt(); if ((PROBE_SEL & (1 << (k))) && item == 0) probe_acc += tn_ - tp_; tp_ = tn_; } } while (0)
        float gcv = rg;
#pragma unroll
        for (int off = 1; off < 32; off <<= 1) { const float t = __shfl_up(gcv, off, 32); if ((lane & 31) >= off) gcv += t; }
        const float gc_last = __shfl(gcv, 31);
        if (w >= 4) {
#pragma unroll
            for (int s2 = 0; s2 < 2; ++s2) { const int tt = ta + 16 * s2;
                const float gc_t = __shfl(gcv, tt), beta_t = __shfl(rbv, tt);
                float q8[8], k8[8], v8[8], t8[8];
                unpack8(*(const v4u*)(qA + tt * LDK + cq * 8), q8); unpack8(*(const v4u*)(kA + tt * LDK + cq * 8), k8); unpack8(Pv[s2], v8);
                const float eg = __expf(gc_t), kb = beta_t * eg, kd = __expf(gc_last - gc_t);
#pragma unroll
                for (int i = 0; i < 8; ++i) t8[i] = q8[i] * eg;
                *(v4u*)(qgA + tt * LDK + cq * 8) = pack8(t8);
                *(f32x4*)(kf + tt * 128 + cq * 8) = (f32x4){k8[0] * kb, k8[1] * kb, k8[2] * kb, k8[3] * kb}; *(f32x4*)(kf + tt * 128 + cq * 8 + 4) = (f32x4){k8[4] * kb, k8[5] * kb, k8[6] * kb, k8[7] * kb};
                *(f32x4*)(vf + tt * 128 + cq * 8) = (f32x4){v8[0] * beta_t, v8[1] * beta_t, v8[2] * beta_t, v8[3] * beta_t}; *(f32x4*)(vf + tt * 128 + cq * 8 + 4) = (f32x4){v8[4] * beta_t, v8[5] * beta_t, v8[6] * beta_t, v8[7] * beta_t};
#pragma unroll
                for (int i = 0; i < 8; ++i) kdT[(cq * 8 + i) * LDJ + (tt ^ ((cq & 3) << 3))] = (bf16)f2bf(k8[i] * kd);
            }
        }
        if (tid < 32) { gcs[tid] = gcv; betas[tid] = rbv; }
        __syncthreads();
        DPT(12);
        if (w >= 4 && c + 1 < SEQ / 32) DN_LOADS_RAW(c + 1, 0);
        {   const int ww = w & 3, gi = ww >> 1, gj = ww & 1; f32x4 acc = {0.f, 0.f, 0.f, 0.f};
            const int jI = 16 * gj + fr, i0 = 16 * gi + 4 * fq;
            const float gj_ = gcs[jI]; const f32x4 gi4 = *(const f32x4*)(gcs + i0), bi4 = *(const f32x4*)(betas + i0);
            mma16<128>(acc, (w < 4 ? kA : qA) + gi * 16 * LDK, LDK, kA + gj * 16 * LDK, LDK, fr, fq);
            if (w < 4) {
#pragma unroll
                for (int jj = 0; jj < 4; ++jj) Lm[(i0 + jj) * LDL + jI] = jI < i0 + jj ? bi4[jj] * acc[jj] * __expf(gi4[jj] - gj_) : 0.f;
            } else {
#pragma unroll
                for (int jj = 0; jj < 4; ++jj) attn[(i0 + jj) * LDJ + jI] = (bf16)f2bf(jI <= i0 + jj ? acc[jj] * __expf(gi4[jj] - gj_) : 0.f);
            } }
        __syncthreads();
        DPT(13);
        if (w < 4) { const int cc = tid & 127; const bool is_w = w >= 2; const float* R = is_w ? kf : vf;
            float x[32];
#pragma unroll
            for (int i = 0; i < 32; ++i) x[i] = R[i * 128 + cc];
            f32x4 Lb[2][8];
            Lb[1][0] = *(const f32x4*)(Lm + 1 * LDL);
#pragma unroll
            for (int i = 1; i < 32; ++i) {
                if (i + 1 < 32) {
#pragma unroll
                    for (int j4 = 0; j4 < (i + 4) / 4; ++j4) Lb[(i + 1) & 1][j4] = *(const f32x4*)(Lm + (i + 1) * LDL + j4 * 4); }
                float a0 = x[i], a1 = 0.f, a2 = 0.f, a3 = 0.f;
#pragma unroll
                for (int j4 = 0; j4 < (i + 3) / 4; ++j4) { const f32x4 l4 = Lb[i & 1][j4];
                    if (j4 * 4 + 0 < i) a0 -= l4[0] * x[j4 * 4 + 0];
                    if (j4 * 4 + 1 < i) a1 -= l4[1] * x[j4 * 4 + 1];
                    if (j4 * 4 + 2 < i) a2 -= l4[2] * x[j4 * 4 + 2];
                    if (j4 * 4 + 3 < i) a3 -= l4[3] * x[j4 * 4 + 3]; }
                x[i] = (a0 + a1) + (a2 + a3); }
            if (is_w) {
#pragma unroll
                for (int i = 0; i < 32; ++i) wA[i * LDK + cc] = (bf16)f2bf(x[i]);
            } else {
#pragma unroll
                for (int i = 0; i < 32; ++i) vf[i * 128 + cc] = x[i];
            } }
        else if (c + 1 < SEQ / 32) { DN_LOADS_RAWB(c + 1); __builtin_amdgcn_sched_barrier(0); DN_CONV(rqa, rka, rva, 0); DN_CONV(rqb, rkb, rvb, 1); }
        __syncthreads();
        DPT(14);
        if (c + 1 < SEQ / 32) DN_LOADS_SMALL(c + 1);
        const v4u gcur = *(const v4u*)(G + (rowbase + t0 + tq) * DM + h * 128 + cq * 8);
#pragma unroll
        for (int it = 0; it < 2; ++it) { f32x4 acc = {0.f, 0.f, 0.f, 0.f};
            mma16<128>(acc, wA + it * 16 * LDK, LDK, ST + w * 16 * LDK, LDK, fr, fq);
            float vn[4];
#pragma unroll
            for (int jj = 0; jj < 4; ++jj) vn[jj] = vf[(16 * it + 4 * fq + jj) * 128 + 16 * w + fr] - acc[jj];
            v2u pk; pk.x = pk2(vn[0], vn[1]); pk.y = pk2(vn[2], vn[3]);
            *(v2u*)(vnT + (16 * w + fr) * LDJ + 16 * it + 4 * fq) = pk; }
        __syncthreads();
#pragma unroll
        for (int it = 0; it < 2; ++it) { f32x4 acc = {0.f, 0.f, 0.f, 0.f};
            mma16<128>(acc, qgA + it * 16 * LDK, LDK, ST + w * 16 * LDK, LDK, fr, fq);
            mma16<32>(acc, attn + it * 16 * LDJ, LDJ, vnT + w * 16 * LDJ, LDJ, fr, fq);
#pragma unroll
            for (int jj = 0; jj < 4; ++jj) os[(16 * it + 4 * fq + jj) * 128 + 16 * w + fr] = acc[jj]; }
        {   const float dl = __expf(gc_last);
#pragma unroll
            for (int dt = 0; dt < 8; ++dt) Sacc[dt] = Sacc[dt] * dl;
            const bf16x8 vb_ = *(const bf16x8*)(vnT + (w * 16 + fr) * LDJ + fq * 8);
            const bf16* ka_e = kdT + fr * LDJ + ((fq ^ (fr >> 3)) << 3); const bf16* ka_o = kdT + fr * LDJ + (((fq ^ (fr >> 3)) << 3) ^ 16);
#pragma unroll
            for (int dt = 0; dt < 8; ++dt) { const bf16x8 af_ = *(const bf16x8*)(((dt & 1) ? ka_o : ka_e) + dt * 16 * LDJ);
                Sacc[dt] = __builtin_amdgcn_mfma_f32_16x16x32_bf16(af_, vb_, Sacc[dt], 0, 0, 0); } }
        __syncthreads();
#pragma unroll
        for (int dt = 0; dt < 8; ++dt) { v2u pk; pk.x = pk2(Sacc[dt][0], Sacc[dt][1]); pk.y = pk2(Sacc[dt][2], Sacc[dt][3]);
            *(v2u*)(ST + (16 * w + fr) * LDK + 16 * dt + 4 * fq) = pk; }
        {   const f32x4 o0 = *(const f32x4*)(os + tq * 128 + cq * 8), o1 = *(const f32x4*)(os + tq * 128 + cq * 8 + 4);
            float ss = (o0[0] * o0[0] + o0[1] * o0[1]) + (o0[2] * o0[2] + o0[3] * o0[3]) + (o1[0] * o1[0] + o1[1] * o1[1]) + (o1[2] * o1[2] + o1[3] * o1[3]);
            ss = red16(ss);
            const float r = rsqrtf(ss * (1.f / 128.f) + EPS);
            float g8[8], o8[8], nw8[8]; unpack8(gcur, g8);
            { const f32x4 n0 = *(const f32x4*)nwp, n1 = *(const f32x4*)(nwp + 4); nw8[0] = n0[0]; nw8[1] = n0[1]; nw8[2] = n0[2]; nw8[3] = n0[3]; nw8[4] = n1[0]; nw8[5] = n1[1]; nw8[6] = n1[2]; nw8[7] = n1[3]; }
#pragma unroll
            for (int i = 0; i < 4; ++i) { o8[i] = o0[i] * r * nw8[i] * siluf_(g8[i]); o8[4 + i] = o1[i] * r * nw8[4 + i] * siluf_(g8[4 + i]); }
            *(v4u*)(G + (rowbase + t0 + tq) * DM + h * 128 + cq * 8) = pack8(o8); }
        __syncthreads();
        DPT(15);
    }
#undef DPT
#undef DN_LOADS_RAW
#undef DN_LOADS_RAWB
#undef DN_LOADS_SMALL
#undef DN_CONV
    __syncthreads();
}

__device__ __forceinline__ void ssm_item(unsigned char* lds, CArgsR a, int l, int item) {
    constexpr int LDC = 136, LDX = 40;
    const int b = item >> 4, hd = item & 15, g = hd >> 2;
    bf16* Cs = (bf16*)lds;
    bf16* Bs = Cs + 32 * LDC;
    bf16* BT = Bs + 32 * LDC;
    bf16* xdtT = BT + 128 * LDX;
    bf16* xddT = xdtT + 64 * LDX;
    bf16* Wm = xddT + 64 * LDX;
    bf16* hB = Wm + 32 * LDX;
    float* xs = (float*)(hB + 64 * LDC);
    float* acs = xs + 32 * 64;
    const int tid = opaque_tid(), w = __builtin_amdgcn_readfirstlane(tid >> 6), lane = tid & 63, fr = lane & 15, fq = lane >> 4;
    bf16* base = (bf16*)a.ws;
    const bf16* X = base + (size_t)B_SSX * BUFE; const bf16* BC = base + (size_t)B_SSBC * BUFE; bf16* Z = base + (size_t)B_SSZ * BUFE;
    const float* small = (const float*)(a.ws + WS_SMALL);
    const float* cw = a.in[7] + (size_t)l * 4 * 2048; const float* cb = a.in[8] + (size_t)l * 2048;
    const float dskip = a.in[11][l * 16 + hd];
    const size_t rowbase = (size_t)b * SEQ;
    const int tq = tid >> 4, cq = tid & 15, tv = (tid >> 3) & 31, cv = tid & 7;
    const int it = w >> 2, pt = w & 3;
    f32x4 hacc[4];
#pragma unroll
    for (int i = 0; i < 4; ++i) hacc[i] = (f32x4){0.f, 0.f, 0.f, 0.f};
    for (int i = tid; i < 64 * LDC / 2; i += NTHREADS) ((unsigned*)hB)[i] = 0u;
    v4u rB[4], rC[4], rx[4]; float ra = 0.f, rdtv = 0.f; unsigned rz[4];
#define SSM_LOADS(c_) do { const int t0_ = (c_) * 32; { const int pos_ = t0_ + tq; const size_t ro_ = (rowbase + pos_) * DM; LOAD4(rB, BC + ro_ + g * 128 + cq * 8, pos_); LOAD4(rC, BC + ro_ + 512 + g * 128 + cq * 8, pos_); } \
        if (tid >= 256) { const int pos_ = t0_ + tv; LOAD4(rx, X + (rowbase + pos_) * DM + hd * 64 + cv * 8, pos_); } \
        { const size_t r_ = rowbase + t0_ + (lane & 31); rdtv = small[r_ * 64 + 16 + hd]; ra = small[r_ * 64 + 32 + hd]; } \
        _Pragma("unroll") for (int jj_ = 0; jj_ < 4; ++jj_) rz[jj_] = Z[(rowbase + t0_ + 16 * it + 4 * fq + jj_) * DM + hd * 64 + 16 * pt + fr]; } while (0)
    SSM_LOADS(0);
    for (int c = 0; c < SEQ / 32; ++c) {
        const int t0 = c * 32;
        float acum = ra;
#pragma unroll
        for (int off = 1; off < 32; off <<= 1) { const float t = __shfl_up(acum, off, 32); if ((lane & 31) >= off) acum += t; }
        const float ac_last = __shfl(acum, 31);
        {   float o8[8];
            conv8r(rB, cw + 1024 + g * 128 + cq * 8, 2048, cb + 1024 + g * 128 + cq * 8, o8);
            *(v4u*)(Bs + tq * LDC + cq * 8) = pack8(o8);
#pragma unroll
            for (int i = 0; i < 8; ++i) BT[(cq * 8 + i) * LDX + (tq ^ ((cq & 3) << 3))] = (bf16)f2bf(o8[i]);
            conv8r(rC, cw + 1536 + g * 128 + cq * 8, 2048, cb + 1536 + g * 128 + cq * 8, o8);
            *(v4u*)(Cs + tq * LDC + cq * 8) = pack8(o8);
        }
        if (tid < 32) acs[tid] = acum;
        unsigned zr[4];
#pragma unroll
        for (int jj = 0; jj < 4; ++jj) zr[jj] = rz[jj];
        __syncthreads();
        if (w >= 4) { float o8[8]; conv8r(rx, cw + hd * 64 + cv * 8, 2048, cb + hd * 64 + cv * 8, o8);
            const float dtv = __shfl(rdtv, tv), dd = dtv * __expf(ac_last - __shfl(acum, tv));
            *(f32x4*)(xs + tv * 64 + cv * 8) = (f32x4){o8[0], o8[1], o8[2], o8[3]}; *(f32x4*)(xs + tv * 64 + cv * 8 + 4) = (f32x4){o8[4], o8[5], o8[6], o8[7]};
#pragma unroll
            for (int i = 0; i < 8; ++i) { xdtT[(cv * 8 + i) * LDX + (tv ^ ((cv & 3) << 3))] = (bf16)f2bf(o8[i] * dtv); xddT[(cv * 8 + i) * LDX + (tv ^ ((cv & 3) << 3))] = (bf16)f2bf(o8[i] * dd); }
        }
        else { const int gi = w >> 1, gj = w & 1; f32x4 acc = {0.f, 0.f, 0.f, 0.f};
            mma16<128>(acc, Cs + gi * 16 * LDC, LDC, Bs + gj * 16 * LDC, LDC, fr, fq);
            const int sI = 16 * gj + fr; const float as = acs[sI];
#pragma unroll
            for (int jj = 0; jj < 4; ++jj) { const int lI = 16 * gi + 4 * fq + jj; const float v = sI <= lI ? acc[jj] * __expf(acs[lI] - as) : 0.f; Wm[lI * LDX + sI] = (bf16)f2bf(v); } }
        if (c + 1 < SEQ / 32) SSM_LOADS(c + 1);
        __syncthreads();
        {   f32x4 a1 = {0.f, 0.f, 0.f, 0.f}, a2 = {0.f, 0.f, 0.f, 0.f};
            mma32s<false, true>(a1, Wm, it * 16, LDX, xdtT, pt * 16, LDX, fr, fq);
            mma16<128>(a2, Cs + it * 16 * LDC, LDC, hB + pt * 16 * LDC, LDC, fr, fq);
            const int p = 16 * pt + fr;
#pragma unroll
            for (int jj = 0; jj < 4; ++jj) { const int lI = 16 * it + 4 * fq + jj;
                const float y = a1[jj] + __expf(acs[lI]) * a2[jj] + xs[lI * 64 + p] * dskip;
                Z[(rowbase + t0 + lI) * DM + hd * 64 + p] = (bf16)f2bf(y * siluf_(bf2f(zr[jj]))); }
            const float dl = __expf(ac_last);
#pragma unroll
            for (int p2 = 0; p2 < 4; ++p2) { hacc[p2] = hacc[p2] * dl; mma32s<true, true>(hacc[p2], xddT, p2 * 16, LDX, BT, w * 16, LDX, fr, fq); }
        }
        __syncthreads();
#pragma unroll
        for (int p2 = 0; p2 < 4; ++p2)
#pragma unroll
            for (int jj = 0; jj < 4; ++jj) hB[(16 * p2 + 4 * fq + jj) * LDC + 16 * w + fr] = (bf16)f2bf(hacc[p2][jj]);
    }
#undef SSM_LOADS
    __syncthreads();
}

__device__ __forceinline__ void sb_item(unsigned char* lds, CArgsR a, int b, int hd, int qi) {
    constexpr int LD = 72;
    bf16* Ks = (bf16*)lds; bf16* Vs = Ks + 2 * 64 * LD;
    volatile unsigned* alive = (volatile unsigned*)(Vs + 2 * 64 * LD);
    const int tid = opaque_tid(), w = __builtin_amdgcn_readfirstlane(tid >> 6), lane = tid & 63, fr = lane & 15, fq = lane >> 4;
    bf16* base = (bf16*)a.ws;
    bf16* Qb = base + (size_t)B_SBQ * BUFE; const bf16* Kb = base + (size_t)B_SBK * BUFE; const bf16* Vb = base + (size_t)B_SBV * BUFE;
    const size_t rowbase = (size_t)b * SEQ;
    const int t0 = qi * 128, myq = t0 + w * 16 + fr, wmax = t0 + w * 16 + 15;
    bf16* qrow = Qb + (rowbase + myq) * DM + hd * 64;
    bf16x8 qf[2];
    qf[0] = *(const bf16x8*)(qrow + fq * 8); qf[1] = *(const bf16x8*)(qrow + 32 + fq * 8);
    f32x4 oacc[4];
#pragma unroll
    for (int i = 0; i < 4; ++i) oacc[i] = (f32x4){0.f, 0.f, 0.f, 0.f};
    float carry = 1.f;
    const int kr = tid >> 3, d8 = (tid & 7) * 8;
    v4u kreg, vreg;
    int kt = 2 * (qi + 1) - 1;
#define SB_LOAD(t) do { const size_t o_ = (rowbase + (size_t)(t) * 64 + kr) * DM + hd * 64 + d8; kreg = *(const v4u*)(Kb + o_); vreg = *(const v4u*)(Vb + o_); } while (0)
#define SB_STORE(bu) do { *(v4u*)(Ks + (bu) * 64 * LD + kr * LD + d8) = kreg; bf16* vd_ = Vs + (bu) * 64 * LD + d8 * LD + (kr ^ (((d8 >> 3) & 7) << 3)); \
        vd_[0] = (bf16)(vreg.x & 0xffffu); vd_[LD] = (bf16)(vreg.x >> 16); vd_[2 * LD] = (bf16)(vreg.y & 0xffffu); vd_[3 * LD] = (bf16)(vreg.y >> 16); \
        vd_[4 * LD] = (bf16)(vreg.z & 0xffffu); vd_[5 * LD] = (bf16)(vreg.z >> 16); vd_[6 * LD] = (bf16)(vreg.w & 0xffffu); vd_[7 * LD] = (bf16)(vreg.w >> 16); } while (0)
    SB_LOAD(kt); SB_STORE(0);
    __syncthreads();
    int cur = 0;
    for (; kt >= 0; --kt) {
        if (kt > 0) SB_LOAD(kt - 1);
        const int kbase = kt * 64;
        if (kbase <= wmax) {
            const bf16* Kc = Ks + cur * 64 * LD; const bf16* Vc = Vs + cur * 64 * LD;
            f32x4 z[4];
#pragma unroll
            for (int nt = 0; nt < 4; ++nt) { z[nt] = (f32x4){0.f, 0.f, 0.f, 0.f};
#pragma unroll
                for (int k2 = 0; k2 < 2; ++k2) { const bf16x8 af = *(const bf16x8*)(Kc + (nt * 16 + fr) * LD + k2 * 32 + fq * 8);
                    z[nt] = __builtin_amdgcn_mfma_f32_16x16x32_bf16(af, qf[k2], z[nt], 0, 0, 0); } }
            float kp[4][4], sg[4][4], T[4], tot[4], suf[4];
            const bool masked = kbase + 64 > t0 + w * 16;
#pragma unroll
            for (int nt = 0; nt < 4; ++nt) {
#pragma unroll
                for (int j = 0; j < 4; ++j) { const float z2 = z[nt][j] * 0.18033688011112042f;
                    const float ea = __builtin_amdgcn_exp2f(-fabsf(z2)), rc = __builtin_amdgcn_rcpf(1.f + ea); const bool pos = z2 >= 0.f;
                    sg[nt][j] = (pos ? 1.f : ea) * rc; kp[nt][j] = (pos ? ea : 1.f) * rc; }
                if (masked) {
#pragma unroll
                    for (int j = 0; j < 4; ++j) { const bool valid = kbase + nt * 16 + fq * 4 + j < myq; sg[nt][j] = valid ? sg[nt][j] : 0.f; kp[nt][j] = valid ? kp[nt][j] : 1.f; } }
                T[nt] = (kp[nt][0] * kp[nt][1]) * (kp[nt][2] * kp[nt][3]); }
#pragma unroll
            for (int nt = 0; nt < 4; ++nt) { const float p16 = __shfl_xor(T[nt], 16), s1 = T[nt] * p16, p32 = __shfl_xor(s1, 32); tot[nt] = s1 * p32;
                suf[nt] = fq == 0 ? p16 * p32 : fq == 1 ? p32 : fq == 2 ? p16 : 1.f; }
            float run = carry; float wv[4][4];
#pragma unroll
            for (int nt = 3; nt >= 0; --nt) { const float r3 = run * suf[nt], r2 = r3 * kp[nt][3], r1 = r2 * kp[nt][2], r0 = r1 * kp[nt][1];
                wv[nt][0] = sg[nt][0] * r0; wv[nt][1] = sg[nt][1] * r1; wv[nt][2] = sg[nt][2] * r2; wv[nt][3] = sg[nt][3] * r3;
                run *= tot[nt]; }
            carry = run;
#pragma unroll
            for (int kk = 0; kk < 2; ++kk) {
                v4u bw; bw.x = pk2(wv[2 * kk][0], wv[2 * kk][1]); bw.y = pk2(wv[2 * kk][2], wv[2 * kk][3]); bw.z = pk2(wv[2 * kk + 1][0], wv[2 * kk + 1][1]); bw.w = pk2(wv[2 * kk + 1][2], wv[2 * kk + 1][3]);
                const bf16x8 bfr = __builtin_bit_cast(bf16x8, bw);
#pragma unroll
                for (int mt = 0; mt < 4; ++mt) { const int vr = mt * 16 + fr, vs = ((vr >> 3) & 7) << 3; const bf16* vrow = Vc + vr * LD;
                    const v2u lo = *(const v2u*)(vrow + ((32 * kk + 4 * fq) ^ vs)), hi = *(const v2u*)(vrow + ((32 * kk + 16 + 4 * fq) ^ vs));
                    v4u av; av.x = lo.x; av.y = lo.y; av.z = hi.x; av.w = hi.y;
                    oacc[mt] = __builtin_amdgcn_mfma_f32_16x16x32_bf16(__builtin_bit_cast(bf16x8, av), bfr, oacc[mt], 0, 0, 0); }
            }
        }
        {   const bool any_alive = __ballot(carry != 0.f) != 0ull;
            if (lane == 0) alive[cur * 8 + w] = any_alive ? 1u : 0u; }
        if (kt > 0) SB_STORE(cur ^ 1);
        __syncthreads();
        unsigned al = 0u;
#pragma unroll
        for (int i = 0; i < 8; ++i) al |= alive[cur * 8 + i];
        if (al == 0u) break;
        cur ^= 1;
    }
#undef SB_LOAD
#undef SB_STORE
#pragma unroll
    for (int mt = 0; mt < 4; ++mt) { v2u wq; wq.x = pk2(oacc[mt][0], oacc[mt][1]); wq.y = pk2(oacc[mt][2], oacc[mt][3]); *(v2u*)(qrow + mt * 16 + fq * 4) = wq; }
}

__device__ __forceinline__ void phase_mixers(unsigned char* lds, CArgsR a, int l, unsigned long long& probe_acc) {
    unsigned* ctl = (unsigned*)(a.ws + WS_CTL);
    unsigned* counter = ctl + 64 * l; unsigned* gdone = ctl + 64 * l + 32;
    volatile unsigned* slot = (volatile unsigned*)(lds + LDS_BYTES - 64);
    constexpr int NDN = 64;
    const int nb = (int)gridDim.x - NDN;
    if ((int)blockIdx.x < NDN) { PT0(); dn_item(lds, a, l, (int)blockIdx.x, probe_acc); if (blockIdx.x == 0 && l == 0) PT1(9); }
    else {
        bf16* base = (bf16*)a.ws; bf16* Wreg = (bf16*)(a.ws + WS_W);
        pg8::Gemm g{base, Wreg + W_IN + (size_t)4096 * DM, MT, 6144, DM}; pg8::StaticOrder S; S.init(MT, 6144, nb, (int)blockIdx.x - NDN);
        EpiRoute E{base, 16};
        pg8::gemm_phase<EpiRoute, pg8::StaticOrder, true, true>((PG8_LAS unsigned char*)lds, g, S, E);
        __builtin_amdgcn_fence(__ATOMIC_RELEASE, "agent");
        asm volatile("s_waitcnt vmcnt(0)" ::: "memory");
        __syncthreads();
        if (threadIdx.x == 0) __hip_atomic_fetch_add(gdone, 1u, __ATOMIC_RELAXED, __HIP_MEMORY_SCOPE_AGENT);
    }
    if (threadIdx.x == 0) {
        unsigned sp = 0u;
        while (__hip_atomic_load(gdone, __ATOMIC_RELAXED, __HIP_MEMORY_SCOPE_AGENT) < (unsigned)nb && ++sp < (1u << 22)) __builtin_amdgcn_s_sleep(2);
        __builtin_amdgcn_fence(__ATOMIC_ACQUIRE, "agent");
        asm volatile("s_waitcnt vmcnt(0)" ::: "memory");
    }
    __syncthreads();
    constexpr unsigned NITEMS = 128 + 2048;
    for (;;) {
        if (threadIdx.x == 0) *slot = __hip_atomic_fetch_add(counter, 1u, __ATOMIC_RELAXED, __HIP_MEMORY_SCOPE_AGENT);
        __syncthreads();
        const unsigned item = *slot;
        __syncthreads();
        if (item >= NITEMS) break;
        PT0();
        if (item < 128) { ssm_item(lds, a, l, (int)item); if (item == 0 && l == 0) PT1(10); }
        else { const int r = (int)item - 128, qi = 15 - (r >> 7), bh = r & 127; sb_item(lds, a, bh >> 4, bh & 15, qi); if (item == 128 && l == 0) PT1(11); }
    }
}

__device__ __forceinline__ void phase_norms(CArgsR a, int l) {
    const int tid = opaque_tid(), lane = tid & 63, wave = tid >> 6, gw = blockIdx.x * NWAVES + wave, NGW = gridDim.x * NWAVES;
    bf16* base = (bf16*)a.ws;
    const bf16* Oraw = base + (size_t)B_DNV * BUFE; bf16* G = base + (size_t)B_DNG * BUFE; bf16* Y = base + (size_t)B_SSZ * BUFE;
    const float* dnw = a.in[6] + (size_t)l * 128 + (lane & 7) * 16; const float* snw = a.in[12] + (size_t)l * DM + lane * 16;
    float w1[16], w2[16];
#pragma unroll
    for (int i = 0; i < 16; ++i) { w1[i] = dnw[i]; w2[i] = snw[i]; }
    for (int m = gw; m < MT; m += NGW) {
        const size_t o = (size_t)m * DM + lane * 16;
        float v[16], s, r;
        unpack8(*(const v4u*)(Y + o), v); unpack8(*(const v4u*)(Y + o + 8), v + 8);
        s = 0.f;
#pragma unroll
        for (int i = 0; i < 16; ++i) s += v[i] * v[i];
        s = red16(s);
        r = rsqrtf(s * (1.f / 256.f) + EPS);
#pragma unroll
        for (int i = 0; i < 16; ++i) v[i] = v[i] * r * w2[i];
        *(v4u*)(Y + o) = pack8(v); *(v4u*)(Y + o + 8) = pack8(v + 8);
    }
}

#define LAS __attribute__((address_space(3)))
#define XB_TMO      128
#define XB_XCNT(j)  (256  + 64 * (j))
#define XB_XSUB(j)  (1280 + 64 * (j))
#define XB_XGEN(j)  (2304 + 64 * (j))
#define XB_TOP      3328
#define XB_TOPGEN   3392
#define XCD_BAR_WORDS 3456
#define XB_SPIN_CAP (1u << 18)

__device__ __forceinline__ unsigned xb_ld(unsigned* p)              { return __hip_atomic_load(p, __ATOMIC_RELAXED, __HIP_MEMORY_SCOPE_AGENT); }
__device__ __forceinline__ unsigned xb_add(unsigned* p, unsigned v) { return __hip_atomic_fetch_add(p, v, __ATOMIC_RELAXED, __HIP_MEMORY_SCOPE_AGENT); }
__device__ __forceinline__ unsigned xb_xcc_id() { return (unsigned)__builtin_amdgcn_s_getreg((3 << 11) | 20) & 0xFu; }
#define XB_SPIN(cond, bar) do { unsigned _sp = 0; while (cond) { __builtin_amdgcn_s_sleep(1); \
    if ((++_sp & 255u) == 0u) { if (xb_ld(&(bar)[XB_TMO])) break; if (_sp > XB_SPIN_CAP) { atomicAdd(&(bar)[XB_TMO], 1u); break; } } } } while (0)

struct XcdBarrier {
    unsigned* bar; unsigned x;
    volatile LAS unsigned* st;
};

__device__ __forceinline__ XcdBarrier xcd_barrier_post(unsigned* bar, volatile LAS unsigned* st) {
    XcdBarrier b; b.bar = bar; b.x = xb_xcc_id(); b.st = st;
    if (threadIdx.x == 0) (void)xb_add(&bar[XB_XCNT(b.x)], 1u);
    return b;
}
__device__ __forceinline__ void xcd_barrier_complete(unsigned* bar, unsigned x, unsigned& nloc, unsigned& nx) {
    const unsigned G = gridDim.x * gridDim.y * gridDim.z;
    unsigned sum, cnt, mine, sp = 0u;
    for (;;) {
        sum = 0u; cnt = 0u; mine = 0u;
#pragma unroll
        for (unsigned j = 0; j < 16; ++j) { const unsigned c = xb_ld(&bar[XB_XCNT(j)]); sum += c; cnt += (c > 0u) ? 1u : 0u; mine = (j == x) ? c : mine; }
        if (sum == G) break;
        __builtin_amdgcn_s_sleep(1);
        if ((++sp & 255u) == 0u) { if (xb_ld(&bar[XB_TMO])) break; if (sp > XB_SPIN_CAP) { atomicAdd(&bar[XB_TMO], 1u); break; } }
    }
    nloc = mine > 0u ? mine : 1u; nx = cnt > 0u ? cnt : 1u;
}

__device__ __forceinline__ void xcd_barrier(const XcdBarrier& b) {
    asm volatile("s_waitcnt vmcnt(0)" ::: "memory");
    __syncthreads();
    if (threadIdx.x == 0) {
        unsigned* bar = b.bar;
        __builtin_amdgcn_s_waitcnt(0);
        unsigned nloc = b.st[0], nx = b.st[1];
        if (nloc == 0u) { xcd_barrier_complete(bar, b.x, nloc, nx); b.st[0] = nloc; b.st[1] = nx; }
        const unsigned old = xb_add(&bar[XB_XSUB(b.x)], 1u);
        const unsigned gen = old / nloc;
        if (old + 1u == (gen + 1u) * nloc) {
            __builtin_amdgcn_fence(__ATOMIC_RELEASE, "agent");
            asm volatile("s_waitcnt vmcnt(0)" ::: "memory");
            const unsigned og = xb_add(&bar[XB_TOP], 1u);
            const unsigned tg = og / nx;
            if (og + 1u == (tg + 1u) * nx) xb_add(&bar[XB_TOPGEN], 1u);
            else XB_SPIN(xb_ld(&bar[XB_TOPGEN]) == tg, bar);
            __builtin_amdgcn_fence(__ATOMIC_ACQUIRE, "agent");
            xb_add(&bar[XB_XGEN(b.x)], 1u);
            asm volatile("s_waitcnt vmcnt(0)" ::: "memory");
        } else {
            XB_SPIN(xb_ld(&bar[XB_XGEN(b.x)]) == gen, bar);
            __builtin_amdgcn_fence(__ATOMIC_ACQUIRE, "agent");
            asm volatile("s_waitcnt vmcnt(0)" ::: "memory");
        }
    }
    __syncthreads();
}

__global__ void __launch_bounds__(NTHREADS, 2) hybrid_fwd(Args a_unused) {
    extern __shared__ __attribute__((aligned(16))) unsigned char lds[];
    cg::grid_group grid = cg::this_grid();
    PG8_LAS unsigned char* ldsl = (PG8_LAS unsigned char*)lds;
    unsigned long long probe_acc = 0ull;
#define A_ (*kargs())
    volatile LAS unsigned* bst = (volatile LAS unsigned*)((LAS unsigned char*)lds + LDS_BYTES - 32);
    if (threadIdx.x == 0) { bst[0] = 0u; bst[1] = 0u; }
    __syncthreads();
    const XcdBarrier bar = xcd_barrier_post((unsigned*)(a_unused.ws + WS_BAR), bst);
#pragma unroll 1
    for (int l = 0; l < 2; ++l) {
        asm volatile("" : "+s"(l));
        {   CArgsR a = A_; const float* xin = l == 0 ? a.in[0] : a.out;
            PT0(); phase0(lds, a, l, xin);
        if (l == 0) grid.sync(); else xcd_barrier(bar); PT1(0); }
        {   CArgsR a = A_; bf16* base = (bf16*)a.ws; bf16* Wreg = (bf16*)(a.ws + WS_W);
            pg8::Gemm g{base, Wreg + W_IN, MT, 4096, DM}; pg8::StaticOrder S; S.init(MT, 4096, (int)gridDim.x, (int)blockIdx.x);
            EpiRoute E{base, 0};
            PT0(); pg8::gemm_phase<EpiRoute, pg8::StaticOrder, true, true>(ldsl, g, S, E);
        xcd_barrier(bar); PT1(1); }
        { PT0(); phase_mixers(lds, A_, l, probe_acc);
        xcd_barrier(bar); PT1(2); }
        { PT0(); phase_norms(A_, l);
        xcd_barrier(bar); PT1(3); }
        {   CArgsR a = A_; bf16* base = (bf16*)a.ws; bf16* Wreg = (bf16*)(a.ws + WS_W);
            pg8::Gemm g{base, Wreg + W_G, 4 * MT, 6144, DM}; SchedGate S{(int)gridDim.x, (int)blockIdx.x};
            EpiGate E{base + (size_t)B_SBK * BUFE, (float*)(base + (size_t)B_DNK * BUFE), base + (size_t)B_DNQ * BUFE};
            PT0(); pg8::gemm_phase<EpiGate, SchedGate, true, true>(ldsl, g, S, E);
        xcd_barrier(bar); PT1(4); }
        {   CArgsR a = A_; bf16* base = (bf16*)a.ws; bf16* Wreg = (bf16*)(a.ws + WS_W); const float* xin = l == 0 ? a.in[0] : a.out;
            pg8::Gemm g{base + (size_t)B_DNQ * BUFE, Wreg + W_OUT, MT, DM, DM}; pg8::StaticOrder S; S.init(MT, DM, (int)gridDim.x, (int)blockIdx.x);
            EpiResid E{xin, a.out};
            PT0(); pg8::gemm_phase<EpiResid, pg8::StaticOrder, false, true>(ldsl, g, S, E);
        xcd_barrier(bar); PT1(5); }
        {   CArgsR a = A_; bf16* base = (bf16*)a.ws; const float* nw = a.in[15] + (size_t)l * DM; const float* xo = a.out;
            const int tid = opaque_tid(), lane = tid & 63, gw = blockIdx.x * NWAVES + (tid >> 6), NGW = gridDim.x * NWAVES;
            PT0(); for (int m = gw; m < MT; m += 4 * NGW) rms_rows_to_bf16<4>(xo + (size_t)m * DM, (size_t)NGW * DM, nw, base + (size_t)m * DM, lane);
        xcd_barrier(bar); PT1(6); }
        {   CArgsR a = A_; bf16* base = (bf16*)a.ws; bf16* Wreg = (bf16*)(a.ws + WS_W);
            pg8::Gemm g{base, Wreg + W_UP, MT, DFF, DM}; pg8::StaticOrder S; S.init(MT, DFF, (int)gridDim.x, (int)blockIdx.x);
            EpiRelu2 E{base + (size_t)B_DNQ * BUFE};
            PT0(); pg8::gemm_phase<EpiRelu2, pg8::StaticOrder, true, true>(ldsl, g, S, E);
        xcd_barrier(bar); PT1(7); }
        {   CArgsR a = A_; bf16* base = (bf16*)a.ws; bf16* Wreg = (bf16*)(a.ws + WS_W);
            pg8::Gemm g{base + (size_t)B_DNQ * BUFE, Wreg + W_DOWN, MT, DM, DFF}; pg8::StaticOrder S; S.init(MT, DM, (int)gridDim.x, (int)blockIdx.x);
            EpiResid E{a.out, a.out};
            PT0(); pg8::gemm_phase<EpiResid, pg8::StaticOrder, false, true>(ldsl, g, S, E);
        xcd_barrier(bar); PT1(8); }
    }
    {
        CArgsR a = A_; const float* nw = a.in[18]; float* xo = a.out;
        const int tid = opaque_tid(), lane = tid & 63, gw = blockIdx.x * NWAVES + (tid >> 6), NGW = gridDim.x * NWAVES;
        for (int m = gw; m < MT; m += 4 * NGW) {
            const f32x4* wr = (const f32x4*)nw + lane; f32x4 v[4][4]; float rs[4];
#pragma unroll
            for (int r = 0; r < 4; ++r)
#pragma unroll
                for (int j = 0; j < 4; ++j) v[r][j] = ((const f32x4*)(xo + (size_t)(m + r * NGW) * DM) + lane)[64 * j];
#pragma unroll
            for (int r = 0; r < 4; ++r) { float s = 0.f;
#pragma unroll
                for (int j = 0; j < 4; ++j) s += (v[r][j][0] * v[r][j][0] + v[r][j][1] * v[r][j][1]) + (v[r][j][2] * v[r][j][2] + v[r][j][3] * v[r][j][3]);
                rs[r] = s; }
#pragma unroll
            for (int r = 0; r < 4; ++r) rs[r] = rsqrtf(wave_sum(rs[r]) * (1.f / DM) + EPS);
#pragma unroll
            for (int j = 0; j < 4; ++j) { const f32x4 ww = wr[64 * j];
#pragma unroll
                for (int r = 0; r < 4; ++r) { f32x4 o4;
#pragma unroll
                    for (int i = 0; i < 4; ++i) o4[i] = v[r][j][i] * rs[r] * ww[i];
                    ((f32x4*)(xo + (size_t)(m + r * NGW) * DM) + lane)[64 * j] = o4; } }
        }
    }
#undef A_
    if (PROBE_SEL) { const unsigned long long t0 = rt(); while (rt() - t0 < probe_acc) __builtin_amdgcn_s_sleep(8); }
}

extern "C" void kernel_launch(void* const* d_in, const int* in_sizes, int n_in, void* d_out, int out_size, void* d_ws, size_t ws_size, hipStream_t stream) {
    static int grid = 0;
    if (grid == 0) {
        if (n_in != 19 || out_size != MT * DM || ws_size < WS_NEED) { fprintf(stderr, "kernel_launch: unexpected shapes (n_in %d out %d ws %zu need %zu)\n", n_in, out_size, ws_size, (size_t)WS_NEED); grid = -1; return; }
        int dev = 0, cus = 0, per_cu = 0;
        hipGetDevice(&dev); hipDeviceGetAttribute(&cus, hipDeviceAttributeMultiprocessorCount, dev);
        if (hipFuncSetAttribute((const void*)hybrid_fwd, hipFuncAttributeMaxDynamicSharedMemorySize, LDS_BYTES) != hipSuccess) { fprintf(stderr, "kernel_launch: hipFuncSetAttribute failed\n"); grid = -1; return; }
        if (hipOccupancyMaxActiveBlocksPerMultiprocessor(&per_cu, (const void*)hybrid_fwd, NTHREADS, LDS_BYTES) != hipSuccess || per_cu < 1) { fprintf(stderr, "kernel_launch: occupancy query gave %d\n", per_cu); per_cu = 1; }
        (void)hipGetLastError();
        grid = cus * per_cu;
    }
    if (grid < 0) return;
    if (hipMemsetAsync((char*)d_ws + WS_CTL, 0, CTL_BYTES, stream) != hipSuccess) { fprintf(stderr, "kernel_launch: memset of the control words failed\n"); return; }
    Args a{};
    for (int i = 0; i < 19; ++i) a.in[i] = (const float*)d_in[i];
    a.out = (float*)d_out; a.ws = (unsigned char*)d_ws;
    void* args[] = {&a};
    hipError_t e = hipLaunchCooperativeKernel((const void*)hybrid_fwd, dim3(grid), dim3(NTHREADS), args, LDS_BYTES, stream);
    if (e != hipSuccess) fprintf(stderr, "cooperative launch failed: %s (grid %d)\n", hipGetErrorString(e), grid);
}
```
